# Optimizing an MI355X kernel written in HIP

```python
import math
import jax
import jax.numpy as jnp
from jax import lax
import numpy as np

D_MODEL = 1024
BATCH = 2
SEQ = 16384
DEPTH = 4

GRID_W = 64
CTX_LEN = 256
N_MIXERS = 3
N_RWKV = (DEPTH + 2) // 3
N_SSD = (DEPTH + 1) // 3
N_ATTN = DEPTH // 3
NORM_EPS = 1e-6

RW_HEAD = 64
RW_HEADS = D_MODEL // RW_HEAD
RW_DECAY_LORA = 64
RW_A_LORA = 64
RW_GATE_LORA = 128
RW_GN_EPS = 64e-5

SSD_INNER = 2 * D_MODEL
SSD_HEAD = 64
SSD_HEADS = SSD_INNER // SSD_HEAD
SSD_GROUPS = 8
SSD_STATE = 128
SSD_CONV = 3
SSD_CHUNK = 64
SSD_CONV_DIM = SSD_INNER + 2 * SSD_GROUPS * SSD_STATE
SSD_IN_DIM = SSD_INNER + SSD_CONV_DIM + 2 * SSD_HEADS

AT_HEADS = 16
AT_KV_HEADS = 4
AT_HEAD = 64
AT_WINDOW = 128
AT_BLOCK = 128
ROPE_BASE = 10000.0

FFN_DIM = 2816
FFN_CONV = 3

kernel_name = 'hybrid_rwkv_ssd_swa_flow_backbone'


def _ident(t):
    return t


def _flip(t):
    return jnp.flip(t, axis=1)


def rmsnorm(x, g, eps=NORM_EPS):
    xf = x.astype(jnp.float32)
    xf = xf * lax.rsqrt(jnp.mean(xf * xf, axis=-1, keepdims=True) + eps)
    return (xf * g.astype(jnp.float32)).astype(x.dtype)


def modulate(x, g, shift, scale):
    return rmsnorm(x, g) * (1 + scale) + shift


def dwconv_centred(x, w):
    K = w.shape[0]
    half = K // 2
    T = x.shape[1]
    xp = jnp.pad(x, ((0, 0), (half, half), (0, 0)))
    out = xp[:, 0:T] * w[0]
    for k in range(1, K):
        out = out + xp[:, k:k + T] * w[k]
    return out


def token_shift_centred(x):
    xp = jnp.pad(x, ((0, 0), (1, 1), (0, 0)))
    return 0.5 * (xp[:, :-2] + xp[:, 2:])


def _rotate(x, pos):
    d = x.shape[-1]
    inv = ROPE_BASE ** (-jnp.arange(0, d, 2, dtype=jnp.float32) / d)
    ang = pos.astype(jnp.float32)[:, None] * inv[None, :]
    cos = jnp.cos(ang)[None, :, None, :].astype(x.dtype)
    sin = jnp.sin(ang)[None, :, None, :].astype(x.dtype)
    x1, x2 = jnp.split(x, 2, axis=-1)
    return jnp.concatenate([x1 * cos - x2 * sin, x1 * sin + x2 * cos], axis=-1)


def rope_2d(x, row, col):
    xr, xc = jnp.split(x, 2, axis=-1)
    return jnp.concatenate([_rotate(xr, row), _rotate(xc, col)], axis=-1)


def rwkv7_scan(r, w, k, v, kk, a, s0):
    def step(s, inp):
        r_t, w_t, k_t, v_t, kk_t, a_t = inp
        s_kk = jnp.einsum('bhvk,bhk->bhv', s, kk_t)
        s = (s * w_t[:, :, None, :] - s_kk[..., None] * (kk_t * a_t)[:, :, None, :]
             + v_t[..., None] * k_t[:, :, None, :])
        return s, jnp.einsum('bhvk,bhk->bhv', s, r_t)
    xs = tuple(jnp.moveaxis(t, 1, 0) for t in (r, w, k, v, kk, a))
    s_fin, ys = lax.scan(step, s0, xs)
    return jnp.moveaxis(ys, 0, 1), s_fin


def rwkv7_stream(h, mu, wr, wk, wv, w0, w1, w2, a0, a1, a2, k_k, k_a):
    b, T, _ = h.shape
    heads = lambda t: t.reshape(b, T, RW_HEADS, RW_HEAD)
    dx = token_shift_centred(h) - h
    xr, xw, xk, xv, xa, xg = (h + dx * mu[i] for i in range(6))
    r = heads(xr @ wr)
    k = xk @ wk
    v = heads(xv @ wv)
    kkf = heads(k * k_k).astype(jnp.float32)
    kk = (kkf * lax.rsqrt(jnp.sum(kkf * kkf, axis=-1, keepdims=True) + 1e-12)).astype(h.dtype)
    dirs = []
    for d in range(2):
        w_log = -jax.nn.softplus(-(w0[d] + jnp.tanh(xw @ w1[d]) @ w2[d])) - 0.5
        decay = jnp.exp(-jnp.exp(w_log))
        a = jax.nn.sigmoid(a0[d] + (xa @ a1[d]) @ a2[d])
        dirs.append((heads(decay), heads(a), heads(k * (1 + (a - 1) * k_a))))
    return r, v, kk, xg, dirs


def head_groupnorm(y, g, bias):
    yf = y.astype(jnp.float32)
    mu = jnp.mean(yf, axis=-1, keepdims=True)
    var = jnp.mean(jnp.square(yf - mu), axis=-1, keepdims=True)
    yn = ((yf - mu) * lax.rsqrt(var + RW_GN_EPS)).astype(y.dtype)
    b, T = y.shape[:2]
    return yn.reshape(b, T, -1) * g + bias


def rwkv7_mixer(hc, hl, ctx_out, mu, wr, wk, wv, wo, w0, w1, w2, a0, a1, a2, g1, g2, k_k, k_a, r_k, ln_g, ln_b):
    proj = (mu, wr, wk, wv, w0, w1, w2, a0, a1, a2, k_k, k_a)
    sc = rwkv7_stream(hc, *proj)
    sl = rwkv7_stream(hl, *proj)
    b = hl.shape[0]
    s0 = jnp.zeros((b, RW_HEADS, RW_HEAD, RW_HEAD), hl.dtype)
    rc, vc, kkc, _, dc = sc
    rl, vl, kkl, _, dl = sl
    ys_c, ys_l = [], []
    for d, f in enumerate((_ident, _flip)):
        wc, ac, kc = dc[d]
        wl, al, kl = dl[d]
        yc_d, s_ctx = rwkv7_scan(f(rc), f(wc), f(kc), f(vc), f(kkc), f(ac), s0)
        yl_d, _ = rwkv7_scan(f(rl), f(wl), f(kl), f(vl), f(kkl), f(al), s_ctx)
        ys_c.append(f(yc_d))
        ys_l.append(f(yl_d))

    def finish(s, ys):
        r, v, _, xg, dirs = s
        bb, T = r.shape[:2]
        bonus = sum(jnp.sum(r * kd * r_k, axis=-1, keepdims=True) for _, _, kd in dirs) * v
        y = head_groupnorm(ys[0] + ys[1], ln_g, ln_b) + bonus.reshape(bb, T, -1)
        g = jax.nn.sigmoid(xg @ g1) @ g2
        return (y * g) @ wo

    yl = finish(sl, ys_l)
    yc = finish(sc, ys_c) if ctx_out else None
    return yc, yl


def ssd_scan(x, dt, A, B, C, h0):
    b, T, H, P = x.shape
    G, N = B.shape[2], B.shape[3]
    E = H // G
    Q = SSD_CHUNK
    nc = T // Q
    xdt = (x * dt[..., None]).reshape(b, nc, Q, G, E, P)
    Bq = B.reshape(b, nc, Q, G, N)
    Cq = C.reshape(b, nc, Q, G, N)
    a_cs = jnp.cumsum((dt * A).reshape(b, nc, Q, G, E), axis=2)
    a_t = jnp.moveaxis(a_cs, 2, -1)
    seg = a_t[..., :, None] - a_t[..., None, :]
    lower = jnp.tril(jnp.ones((Q, Q), dtype=bool))
    decay = jnp.exp(jnp.where(lower, seg, -jnp.inf))
    cb = jnp.einsum('bcign,bcjgn->bcgij', Cq, Bq)
    y_diag = jnp.einsum('bcgeij,bcjgep->bcigep', cb[:, :, :, None] * decay, xdt)
    from_start = jnp.exp(a_cs)
    to_end = jnp.exp(a_cs[:, :, -1:] - a_cs)
    chunk_decay = jnp.exp(a_cs[:, :, -1])

    def step(h, inp):
        c_q, b_q, x_q, fs, te, cd = inp
        y_off = jnp.einsum('bign,bgepn,bige->bigep', c_q, h, fs)
        h = cd[..., None, None] * h + jnp.einsum('bjgn,bjge,bjgep->bgepn', b_q, te, x_q)
        return h, y_off

    xs = tuple(jnp.moveaxis(t, 1, 0) for t in (Cq, Bq, xdt, from_start, to_end, chunk_decay))
    h_fin, y_off = lax.scan(step, h0.reshape(b, G, E, P, N), xs)
    y = y_diag + jnp.moveaxis(y_off, 0, 1)
    return y.reshape(b, T, H, P), h_fin.reshape(b, H, P, N)


def ssd_project(h, w_in, conv_w, conv_b):
    b, T, _ = h.shape
    z, xbc, dt = jnp.split(h @ w_in, [SSD_INNER, SSD_INNER + SSD_CONV_DIM], axis=-1)
    xbc = jax.nn.silu(dwconv_centred(xbc, conv_w) + conv_b)
    xs, B, C = jnp.split(xbc, [SSD_INNER, SSD_INNER + SSD_GROUPS * SSD_STATE], axis=-1)
    return (z, xs.reshape(b, T, SSD_HEADS, SSD_HEAD), B.reshape(b, T, SSD_GROUPS, SSD_STATE),
            C.reshape(b, T, SSD_GROUPS, SSD_STATE), dt)


def group_rmsnorm(y, g, groups):
    b, T, C = y.shape
    yf = y.astype(jnp.float32).reshape(b, T, groups, C // groups)
    yf = yf * lax.rsqrt(jnp.mean(yf * yf, axis=-1, keepdims=True) + NORM_EPS)
    return (yf.reshape(b, T, C) * g.astype(jnp.float32)).astype(y.dtype)


def ssd_mixer(hc, hl, ctx_out, w_in, conv_w, conv_b, dt_bias, a_log, d_skip, norm_g, w_out):
    pc = ssd_project(hc, w_in, conv_w, conv_b)
    pl = ssd_project(hl, w_in, conv_w, conv_b)
    b = hl.shape[0]
    h0 = jnp.zeros((b, SSD_HEADS, SSD_HEAD, SSD_STATE), hl.dtype)
    ys_c, ys_l = [], []
    for d, f in enumerate((_ident, _flip)):
        A = -jnp.exp(a_log[d])
        dtc = jax.nn.softplus(pc[4][..., d * SSD_HEADS:(d + 1) * SSD_HEADS] + dt_bias[d])
        dtl = jax.nn.softplus(pl[4][..., d * SSD_HEADS:(d + 1) * SSD_HEADS] + dt_bias[d])
        yc_d, h_ctx = ssd_scan(f(pc[1]), f(dtc), A, f(pc[2]), f(pc[3]), h0)
        yl_d, _ = ssd_scan(f(pl[1]), f(dtl), A, f(pl[2]), f(pl[3]), h_ctx)
        ys_c.append(f(yc_d))
        ys_l.append(f(yl_d))

    def finish(ys, z, xs):
        y = ys[0] + ys[1] + xs * d_skip[:, None]
        bb, T = y.shape[:2]
        y = y.reshape(bb, T, SSD_INNER) * jax.nn.silu(z)
        return group_rmsnorm(y, norm_g, SSD_GROUPS) @ w_out

    yl = finish(ys_l, pl[0], pl[1])
    yc = finish(ys_c, pc[0], pc[1]) if ctx_out else None
    return yc, yl


def sink_softmax(scores, sink_g):
    b, kh, g, q, _ = scores[0].shape
    sink_col = jnp.broadcast_to(sink_g.astype(scores[0].dtype)[None, :, :, None, None], (b, kh, g, q, 1))
    logits = jnp.concatenate(list(scores) + [sink_col], axis=-1).astype(jnp.float32)
    p = jax.nn.softmax(logits, axis=-1).astype(scores[0].dtype)[..., :-1]
    cuts, acc = [], 0
    for s in scores[:-1]:
        acc += s.shape[-1]
        cuts.append(acc)
    return jnp.split(p, cuts, axis=-1)


def window_attn_mixer(hc, hl, ctx_out, row, col, w_qkv, w_o, sink):
    b, T, _ = hl.shape
    grp = AT_HEADS // AT_KV_HEADS
    scale = AT_HEAD ** -0.5

    def qkv(h):
        n = h.shape[1]
        q, k, v = jnp.split(h @ w_qkv, [AT_HEADS * AT_HEAD, (AT_HEADS + AT_KV_HEADS) * AT_HEAD], axis=-1)
        return (q.reshape(b, n, AT_HEADS, AT_HEAD), k.reshape(b, n, AT_KV_HEADS, AT_HEAD),
                v.reshape(b, n, AT_KV_HEADS, AT_HEAD))

    qc, kc, vc = qkv(hc)
    ql, kl, vl = qkv(hl)
    ql = rope_2d(ql, row, col).reshape(b, T, AT_KV_HEADS, grp, AT_HEAD)
    kl = rope_2d(kl, row, col)
    sink_g = sink.reshape(AT_KV_HEADS, grp)
    pad = ((0, 0), (AT_WINDOW, AT_WINDOW), (0, 0), (0, 0))
    kl_p = jnp.pad(kl, pad)
    vl_p = jnp.pad(vl, pad)
    span = AT_BLOCK + 2 * AT_WINDOW
    q_off = jnp.arange(AT_BLOCK)
    k_off = jnp.arange(span) - AT_WINDOW

    def block(i):
        start = i * AT_BLOCK
        q = lax.dynamic_slice_in_dim(ql, start, AT_BLOCK, axis=1)
        k = lax.dynamic_slice_in_dim(kl_p, start, span, axis=1)
        v = lax.dynamic_slice_in_dim(vl_p, start, span, axis=1)
        qpos = start + q_off
        kpos = start + k_off
        allowed = ((jnp.abs(qpos[:, None] - kpos[None, :]) <= AT_WINDOW)
                   & (kpos[None, :] >= 0) & (kpos[None, :] < T))
        s_loc = jnp.where(allowed, jnp.einsum('bqkgd,bskd->bkgqs', q, k) * scale, -jnp.inf)
        s_ctx = jnp.einsum('bqkgd,bskd->bkgqs', q, kc) * scale
        p_loc, p_ctx = sink_softmax([s_loc, s_ctx], sink_g)
        o = jnp.einsum('bkgqs,bskd->bqkgd', p_loc, v) + jnp.einsum('bkgqs,bskd->bqkgd', p_ctx, vc)
        return o.reshape(b, AT_BLOCK, AT_HEADS * AT_HEAD)

    o_l = lax.map(block, jnp.arange(T // AT_BLOCK))
    yl = jnp.moveaxis(o_l, 0, 1).reshape(b, T, AT_HEADS * AT_HEAD) @ w_o
    yc = None
    if ctx_out:
        n = hc.shape[1]
        qg = qc.reshape(b, n, AT_KV_HEADS, grp, AT_HEAD)
        (p_c,) = sink_softmax([jnp.einsum('bqkgd,bskd->bkgqs', qg, kc) * scale], sink_g)
        yc = jnp.einsum('bkgqs,bskd->bqkgd', p_c, vc).reshape(b, n, AT_HEADS * AT_HEAD) @ w_o
    return yc, yl


def conv_ffn(h, w_in, conv_w, w_out):
    u = dwconv_centred(h @ w_in, conv_w)
    a, gate = jnp.split(u, 2, axis=-1)
    return (a * jax.nn.silu(gate)) @ w_out


def setup_inputs(seed: int = 0) -> dict:
    key = jax.random.key(seed)
    keys = iter(jax.random.split(key, 64))
    f32 = jnp.float32

    def nrm(shape, scale=1.0):
        return scale * jax.random.normal(next(keys), shape, f32)

    def uni(shape, lo, hi):
        return jax.random.uniform(next(keys), shape, f32, lo, hi)

    D = D_MODEL
    dt0 = jnp.exp(uni((N_SSD, 2, SSD_HEADS), math.log(1e-3), math.log(1e-1)))
    return {
        'x': nrm((BATCH, SEQ, D)),
        'c': nrm((BATCH, D)),
        'ctx': nrm((BATCH, CTX_LEN, D)),
        'c_ctx': nrm((D,)),
        'ada_w': nrm((DEPTH, D, 6 * D), 0.5 * D ** -0.5),
        'ada_b': nrm((DEPTH, 6 * D), 0.01),
        'norm1_g': 1.0 + nrm((DEPTH, D), 0.02),
        'norm2_g': 1.0 + nrm((DEPTH, D), 0.02),
        'ffn_w_in': nrm((DEPTH, D, 2 * FFN_DIM), D ** -0.5),
        'ffn_conv': nrm((DEPTH, FFN_CONV, 2 * FFN_DIM), FFN_CONV ** -0.5),
        'ffn_w_out': nrm((DEPTH, FFN_DIM, D), FFN_DIM ** -0.5),
        'final_g': 1.0 + nrm((D,), 0.02),
        'rw_mu': uni((N_RWKV, 6, D), 0.0, 1.0),
        'rw_wr': nrm((N_RWKV, D, D), D ** -0.5),
        'rw_wk': nrm((N_RWKV, D, D), D ** -0.5),
        'rw_wv': nrm((N_RWKV, D, D), D ** -0.5),
        'rw_wo': nrm((N_RWKV, D, D), D ** -0.5),
        'rw_w0': uni((N_RWKV, 2, D), -6.0, 0.0),
        'rw_w1': nrm((N_RWKV, 2, D, RW_DECAY_LORA), D ** -0.5),
        'rw_w2': nrm((N_RWKV, 2, RW_DECAY_LORA, D), 0.5 * RW_DECAY_LORA ** -0.5),
        'rw_a0': nrm((N_RWKV, 2, D), 0.3),
        'rw_a1': nrm((N_RWKV, 2, D, RW_A_LORA), D ** -0.5),
        'rw_a2': nrm((N_RWKV, 2, RW_A_LORA, D), 0.5 * RW_A_LORA ** -0.5),
        'rw_g1': nrm((N_RWKV, D, RW_GATE_LORA), D ** -0.5),
        'rw_g2': nrm((N_RWKV, RW_GATE_LORA, D), RW_GATE_LORA ** -0.5),
        'rw_kk': 0.85 + nrm((N_RWKV, D), 0.05),
        'rw_ka': 1.0 + nrm((N_RWKV, D), 0.05),
        'rw_rk': nrm((N_RWKV, RW_HEADS, RW_HEAD), 0.1),
        'rw_ln_g': 1.0 + nrm((N_RWKV, D), 0.02),
        'rw_ln_b': nrm((N_RWKV, D), 0.01),
        'ssd_w_in': nrm((N_SSD, D, SSD_IN_DIM), D ** -0.5),
        'ssd_conv_w': nrm((N_SSD, SSD_CONV, SSD_CONV_DIM), SSD_CONV ** -0.5),
        'ssd_conv_b': nrm((N_SSD, SSD_CONV_DIM), 0.01),
        'ssd_dt_bias': jnp.log(jnp.expm1(dt0)),
        'ssd_a_log': jnp.log(uni((N_SSD, 2, SSD_HEADS), 1.0, 16.0)),
        'ssd_d': 1.0 + nrm((N_SSD, SSD_HEADS), 0.02),
        'ssd_norm_g': 1.0 + nrm((N_SSD, SSD_INNER), 0.02),
        'ssd_w_out': nrm((N_SSD, SSD_INNER, D), SSD_INNER ** -0.5),
        'at_w_qkv': nrm((N_ATTN, D, (AT_HEADS + 2 * AT_KV_HEADS) * AT_HEAD), D ** -0.5),
        'at_w_o': nrm((N_ATTN, AT_HEADS * AT_HEAD, D), (AT_HEADS * AT_HEAD) ** -0.5),
        'at_sink': nrm((N_ATTN, AT_HEADS)),
    }


def reference(x, c, ctx, c_ctx, ada_w, ada_b, norm1_g, norm2_g, ffn_w_in, ffn_conv, ffn_w_out, final_g,
              rw_mu, rw_wr, rw_wk, rw_wv, rw_wo, rw_w0, rw_w1, rw_w2, rw_a0, rw_a1, rw_a2, rw_g1, rw_g2,
              rw_kk, rw_ka, rw_rk, rw_ln_g, rw_ln_b,
              ssd_w_in, ssd_conv_w, ssd_conv_b, ssd_dt_bias, ssd_a_log, ssd_d, ssd_norm_g, ssd_w_out,
              at_w_qkv, at_w_o, at_sink):
    T = x.shape[1]
    rows = T // GRID_W
    row = jnp.repeat(jnp.arange(rows), GRID_W, total_repeat_length=T)
    col = jnp.tile(jnp.arange(GRID_W), rows)
    silu_c = jax.nn.silu(c)
    silu_cc = jax.nn.silu(c_ctx)
    xl, xc = x, ctx
    for i in range(DEPTH):
        kind, j = i % N_MIXERS, i // N_MIXERS
        ctx_out = i < DEPTH - 1
        ml = jnp.split((silu_c @ ada_w[i] + ada_b[i])[:, None, :], 6, axis=-1)
        mc = jnp.split(silu_cc @ ada_w[i] + ada_b[i], 6, axis=-1)
        hl = modulate(xl, norm1_g[i], ml[0], ml[1])
        hc = modulate(xc, norm1_g[i], mc[0], mc[1])
        if kind == 0:
            yc, yl = rwkv7_mixer(hc, hl, ctx_out, rw_mu[j], rw_wr[j], rw_wk[j], rw_wv[j], rw_wo[j],
                                 rw_w0[j], rw_w1[j], rw_w2[j], rw_a0[j], rw_a1[j], rw_a2[j],
                                 rw_g1[j], rw_g2[j], rw_kk[j], rw_ka[j], rw_rk[j], rw_ln_g[j], rw_ln_b[j])
        elif kind == 1:
            yc, yl = ssd_mixer(hc, hl, ctx_out, ssd_w_in[j], ssd_conv_w[j], ssd_conv_b[j], ssd_dt_bias[j],
                               ssd_a_log[j], ssd_d[j], ssd_norm_g[j], ssd_w_out[j])
        else:
            yc, yl = window_attn_mixer(hc, hl, ctx_out, row, col, at_w_qkv[j], at_w_o[j], at_sink[j])
        xl = xl + ml[2] * yl
        xl = xl + ml[5] * conv_ffn(modulate(xl, norm2_g[i], ml[3], ml[4]), ffn_w_in[i], ffn_conv[i], ffn_w_out[i])
        if ctx_out:
            xc = xc + mc[2] * yc
            xc = xc + mc[5] * conv_ffn(modulate(xc, norm2_g[i], mc[3], mc[4]), ffn_w_in[i], ffn_conv[i], ffn_w_out[i])
    return rmsnorm(xl, final_g)
```

```cpp
#include <hip/hip_runtime.h>
#include <hip/hip_cooperative_groups.h>
#include <hip/hip_fp16.h>
#include <cstdio>
namespace cg = cooperative_groups;

typedef unsigned short u16;
typedef short bf16x8 __attribute__((ext_vector_type(8)));
typedef float f32x4 __attribute__((ext_vector_type(4)));
typedef float f32x2 __attribute__((ext_vector_type(2)));
#define MFMA(a, b, c) __builtin_amdgcn_mfma_f32_16x16x32_bf16(a, b, c, 0, 0, 0)
#define DI __device__ __forceinline__

constexpr int D = 1024, NBAT = 2, T = 16384, TC = 256, TS = T + TC, R = NBAT * TS, FF = 2816;
enum { IX = 0, IC, ICTX, ICC, IADAW, IADAB, IN1, IN2, IFWIN, IFCONV, IFWOUT, IFINAL, IRMU, IRWR, IRWK, IRWV, IRWO, IRW0, IRW1, IRW2, IRA0, IRA1,
       IRA2, IRG1, IRG2, IRKK, IRKA, IRRK, IRLNG, IRLNB, ISWIN, ISCONVW, ISCONVB, ISDTB, ISALOG, ISD, ISNG, ISWOUT, IAQKV, IAWO, IASINK };

__device__ __forceinline__ unsigned long long rfl64(unsigned long long v) {
  unsigned lo = __builtin_amdgcn_readfirstlane((unsigned)v), hi = __builtin_amdgcn_readfirstlane((unsigned)(v >> 32));
  return ((unsigned long long)hi << 32) | lo;
}
struct Params {
  const float* in[41]; float* out; char* ws;
  __device__ __forceinline__ const float* inp(int i) const { return (const float*)rfl64((unsigned long long)in[i]); }
  __device__ __forceinline__ float* outp() const { return (float*)rfl64((unsigned long long)out); }
  __device__ __forceinline__ char* wsp() const { return (char*)rfl64((unsigned long long)ws); }
};

constexpr size_t alup(size_t x) { return (x + 255) & ~(size_t)255; }
constexpr size_t OFF_XC = 0;
constexpr size_t OFF_BAR = OFF_XC + alup((size_t)512 * 1024 * 4);
constexpr size_t OFF_MODP = OFF_BAR + 16384;
constexpr size_t OFF_MOD = OFF_MODP + alup((size_t)16 * 4 * 3 * 6144 * 4);
constexpr size_t OFF_SSQ = OFF_MOD + alup((size_t)4 * 3 * 6144 * 4);
constexpr size_t OFF_DT = OFF_SSQ + alup((size_t)R * 8 * 4);
constexpr size_t OFF_BONUS = OFF_DT;
constexpr size_t OFF_RWST = OFF_DT + alup((size_t)R * 64 * 4);
constexpr size_t OFF_H = OFF_RWST + alup((size_t)256 * 256 * 4 * 4);
constexpr size_t OFF_RING = OFF_H;
constexpr size_t OFF_WT = OFF_H + alup((size_t)R * 1024 * 2);
constexpr size_t WT_ELEMS = 17170432;
constexpr size_t OFF_SCR = OFF_WT + alup(WT_ELEMS * 2);
constexpr size_t SCR_BYTES = (size_t)R * 4096 * 2 + (size_t)R * 2048 * 2;
static_assert(OFF_SCR + SCR_BYTES <= (size_t)536870912, "workspace too large");
constexpr size_t WT_W1T = 0, WT_W2T = (size_t)5632 * 1024, WT_MIX = WT_W2T + (size_t)1024 * 2816;
constexpr size_t WT_R1T = WT_MIX, WT_LUT = WT_R1T + (size_t)3456 * 1024, WT_G2T = WT_LUT + (size_t)2 * 16 * 128 * 128, WT_RWO = WT_G2T + (size_t)1024 * 128;
constexpr size_t WT_SX = WT_MIX, WT_SZ = WT_SX + (size_t)4224 * 1024, WT_SO = WT_SZ + (size_t)2048 * 1024;
constexpr size_t WT_AQ = WT_MIX, WT_AO = WT_AQ + (size_t)1536 * 1024;
static_assert(WT_SO + (size_t)1024 * 2048 <= WT_ELEMS, "wt");
static_assert((size_t)2 * 2 * 2 * 1024 * 16 * 512 <= (size_t)R * 1024 * 2, "ring");

DI u16 f2b(float f) { unsigned u = __float_as_uint(f); u += 0x7fffu + ((u >> 16) & 1u); return (u16)(u >> 16); }
DI float b2f(u16 h) { return __uint_as_float(((unsigned)h) << 16); }
DI unsigned pack2(float a, float b) { return (unsigned)f2b(a) | ((unsigned)f2b(b) << 16); }
DI float blo(unsigned u) { return __uint_as_float(u << 16); }
DI float bhi(unsigned u) { return __uint_as_float(u & 0xffff0000u); }
DI float siluf(float x) { return x / (1.f + __expf(-x)); }
DI float sigmf(float x) { return 1.f / (1.f + __expf(-x)); }
DI float softplusf(float x) { return x > 20.f ? x : log1pf(__expf(x)); }
DI int otid() { int t = threadIdx.x; asm volatile("" : "+v"(t)); return t; }
DI void lds_barrier() { asm volatile("s_waitcnt lgkmcnt(0)\n\ts_barrier" ::: "memory"); }
DI f32x4 gload_f4(const float* p) { f32x4 v; asm volatile("global_load_dwordx4 %0, %1, off" : "=v"(v) : "v"(p) : "memory"); return v; }
DI void vm_wait0() { asm volatile("s_waitcnt vmcnt(0)" ::: "memory"); }
DI float wsum(float v) { for (int o = 32; o; o >>= 1) v += __shfl_xor(v, o); return v; }
DI float* xrow_ptr(const Params& p, int r) {
  int b = r / TS, q = r - b * TS;
  return q < TC ? (float*)(p.ws + OFF_XC) + ((size_t)(b * TC + q) << 10) : p.out + ((size_t)(b * T + q - TC) << 10);
}
DI const float* mod_ptr(const Params& p, int l, int r) {
  int b = r / TS, q = r - b * TS;
  int v = q < TC ? 2 : b;
  return (const float*)(p.ws + OFF_MOD) + (size_t)(l * 3 + v) * 6144;
}


#define XB_TMO      128
#define XB_XCNT(j)  (256  + 64 * (j))
#define XB_XSUB(j)  (1280 + 64 * (j))
#define XB_XGEN(j)  (2304 + 64 * (j))
#define XB_TOP      3328
#define XB_TOPGEN   3392
#define XCD_BAR_WORDS 3456
#define XB_SPIN_CAP (1u << 18)
#define LAS __attribute__((address_space(3)))
DI unsigned xb_ld(unsigned* p) { return __hip_atomic_load(p, __ATOMIC_RELAXED, __HIP_MEMORY_SCOPE_AGENT); }
DI unsigned xb_add(unsigned* p, unsigned v) { return __hip_atomic_fetch_add(p, v, __ATOMIC_RELAXED, __HIP_MEMORY_SCOPE_AGENT); }
DI unsigned xb_xcc_id() { return (unsigned)__builtin_amdgcn_s_getreg((3 << 11) | 20) & 0xFu; }
#define XB_SPIN(cond, bar) do { unsigned _sp = 0; while (cond) { __builtin_amdgcn_s_sleep(1); \
    if ((++_sp & 255u) == 0u) { if (xb_ld(&(bar)[XB_TMO])) break; if (_sp > XB_SPIN_CAP) { atomicAdd(&(bar)[XB_TMO], 1u); break; } } } } while (0)
struct XcdBarrier { unsigned* bar; unsigned x; volatile LAS unsigned* st; };
DI XcdBarrier xcd_barrier_post(unsigned* bar, volatile LAS unsigned* st) {
  XcdBarrier b; b.bar = bar; b.x = xb_xcc_id(); b.st = st;
  if (threadIdx.x == 0) (void)xb_add(&bar[XB_XCNT(b.x)], 1u);
  return b;
}
DI void xcd_barrier_complete(unsigned* bar, unsigned x, unsigned& nloc, unsigned& nx) {
  const unsigned G = gridDim.x * gridDim.y * gridDim.z;
  unsigned sum, cnt, mine, sp = 0u;
  for (;;) {
    sum = 0u; cnt = 0u; mine = 0u;
#pragma unroll
    for (unsigned j = 0; j < 16; ++j) { const unsigned c = xb_ld(&bar[XB_XCNT(j)]); sum += c; cnt += (c > 0u) ? 1u : 0u; mine = (j == x) ? c : mine; }
    if (sum == G) break;
    __builtin_amdgcn_s_sleep(1);
    if ((++sp & 255u) == 0u) { if (xb_ld(&bar[XB_TMO])) break; if (sp > XB_SPIN_CAP) { atomicAdd(&bar[XB_TMO], 1u); break; } }
  }
  nloc = mine > 0u ? mine : 1u; nx = cnt > 0u ? cnt : 1u;
}
DI void xcd_barrier(const XcdBarrier& b) {
  asm volatile("s_waitcnt vmcnt(0)" ::: "memory");
  __syncthreads();
  if (threadIdx.x == 0) {
    unsigned* bar = b.bar;
    __builtin_amdgcn_s_waitcnt(0);
    unsigned nloc = b.st[0], nx = b.st[1];
    if (nloc == 0u) { xcd_barrier_complete(bar, b.x, nloc, nx); b.st[0] = nloc; b.st[1] = nx; }
    const unsigned old = xb_add(&bar[XB_XSUB(b.x)], 1u);
    const unsigned gen = old / nloc;
    if (old + 1u == (gen + 1u) * nloc) {
      __builtin_amdgcn_fence(__ATOMIC_RELEASE, "agent");
      asm volatile("s_waitcnt vmcnt(0)" ::: "memory");
      const unsigned og = xb_add(&bar[XB_TOP], 1u);
      const unsigned tg = og / nx;
      if (og + 1u == (tg + 1u) * nx) xb_add(&bar[XB_TOPGEN], 1u);
      else XB_SPIN(xb_ld(&bar[XB_TOPGEN]) == tg, bar);
      __builtin_amdgcn_fence(__ATOMIC_ACQUIRE, "agent");
      xb_add(&bar[XB_XGEN(b.x)], 1u);
      asm volatile("s_waitcnt vmcnt(0)" ::: "memory");
    } else {
      XB_SPIN(xb_ld(&bar[XB_XGEN(b.x)]) == gen, bar);
      __builtin_amdgcn_fence(__ATOMIC_ACQUIRE, "agent");
      asm volatile("s_waitcnt vmcnt(0)" ::: "memory");
    }
  }
  __syncthreads();
}

constexpr int LDS_ROW = 64;
struct SmemG { u16 A[2][256 * LDS_ROW]; u16 B[2][128 * LDS_ROW]; };
template <class AL>
DI void gemm_main(const AL& al, const u16* __restrict__ Bt, int ldb, int K, f32x4 (&acc)[4][4], char* smem) {
  SmemG& s = *(SmemG*)smem;
  const int tid = otid(), lane = tid & 63, wave = tid >> 6, wr = wave >> 1, wc = wave & 1, fr = lane & 15, fq = lane >> 4;
#pragma unroll
  for (int m = 0; m < 4; ++m)
#pragma unroll
    for (int n = 0; n < 4; ++n) acc[m][n] = (f32x4){0.f, 0.f, 0.f, 0.f};
  uint4 ra[4], rb[2];
  const int nk = K >> 6;
  const int lrow = tid >> 3, lkc = (tid & 7) * 8, lsw = ((tid & 7) ^ (lrow & 7)) * 8;
  __syncthreads();
#pragma unroll
  for (int i = 0; i < 4; ++i) ra[i] = al(lrow + i * 64, lkc);
#pragma unroll
  for (int i = 0; i < 2; ++i) rb[i] = *(const uint4*)(Bt + (size_t)(lrow + i * 64) * ldb + lkc);
#pragma unroll
  for (int i = 0; i < 4; ++i) *(uint4*)&s.A[0][(lrow + i * 64) * LDS_ROW + lsw] = al.post(ra[i], lrow + i * 64, lkc);
#pragma unroll
  for (int i = 0; i < 2; ++i) *(uint4*)&s.B[0][(lrow + i * 64) * LDS_ROW + lsw] = rb[i];
  __syncthreads();
  for (int kt = 0; kt < nk; ++kt) {
    const int buf = kt & 1;
    const int kn = (kt + 1 < nk ? kt + 1 : kt) * 64 + lkc;
#pragma unroll
    for (int i = 0; i < 2; ++i) {
      const u16* bp = Bt + (size_t)(lrow + i * 64) * ldb + kn;
      asm volatile("global_load_dwordx4 %0, %1, off" : "=v"(rb[i]) : "v"(bp) : "memory");
    }
#pragma unroll
    for (int i = 0; i < 4; ++i) ra[i] = al(lrow + i * 64, kn);
    __builtin_amdgcn_sched_barrier(0);
#pragma unroll
    for (int kh = 0; kh < 2; ++kh) {
      bf16x8 a[4], b[4];
#pragma unroll
      for (int m = 0; m < 4; ++m) a[m] = *(const bf16x8*)&s.A[buf][(wr * 64 + m * 16 + fr) * LDS_ROW + (((kh * 4 + fq) ^ (fr & 7)) << 3)];
#pragma unroll
      for (int n = 0; n < 4; ++n) b[n] = *(const bf16x8*)&s.B[buf][(wc * 64 + n * 16 + fr) * LDS_ROW + (((kh * 4 + fq) ^ (fr & 7)) << 3)];
      __builtin_amdgcn_s_setprio(1);
#pragma unroll
      for (int m = 0; m < 4; ++m)
#pragma unroll
        for (int n = 0; n < 4; ++n) acc[m][n] = MFMA(b[n], a[m], acc[m][n]);
      __builtin_amdgcn_s_setprio(0);
    }
    asm volatile("s_waitcnt vmcnt(0)" ::: "memory");
#pragma unroll
    for (int i = 0; i < 4; ++i) *(uint4*)&s.A[buf ^ 1][(lrow + i * 64) * LDS_ROW + lsw] = al.post(ra[i], lrow + i * 64, kn);
#pragma unroll
    for (int i = 0; i < 2; ++i) *(uint4*)&s.B[buf ^ 1][(lrow + i * 64) * LDS_ROW + lsw] = rb[i];
    __syncthreads();
  }
}

template <class AL>
DI void gemm_main3(const AL& al, const u16* __restrict__ Bt, int ldb, int K, f32x4 (&acc)[4][4], char* smem) {
  SmemG& s = *(SmemG*)smem;
  const int tid = otid(), lane = tid & 63, wave = tid >> 6, wr = wave >> 1, wc = wave & 1, fr = lane & 15, fq = lane >> 4;
  const bool grpY = __builtin_amdgcn_readfirstlane(wave) >= 4;
#pragma unroll
  for (int m = 0; m < 4; ++m)
#pragma unroll
    for (int n = 0; n < 4; ++n) acc[m][n] = (f32x4){0.f, 0.f, 0.f, 0.f};
  uint4 ra[4], rb[2];
  const int nk = K >> 6;
  const int lrow = tid >> 3, lkc = (tid & 7) * 8, lsw = ((tid & 7) ^ (lrow & 7)) * 8;
  __syncthreads();
#pragma unroll
  for (int i = 0; i < 4; ++i) ra[i] = al(lrow + i * 64, lkc);
#pragma unroll
  for (int i = 0; i < 2; ++i) rb[i] = *(const uint4*)(Bt + (size_t)(lrow + i * 64) * ldb + lkc);
#pragma unroll
  for (int i = 0; i < 4; ++i) *(uint4*)&s.A[0][(lrow + i * 64) * LDS_ROW + lsw] = al.post(ra[i], lrow + i * 64, lkc);
#pragma unroll
  for (int i = 0; i < 2; ++i) *(uint4*)&s.B[0][(lrow + i * 64) * LDS_ROW + lsw] = rb[i];
  __syncthreads();
  const u16* abase = &s.A[0][(wr * 64 + fr) * LDS_ROW];
  const u16* bbase = &s.B[0][(wc * 64 + fr) * LDS_ROW];
  bf16x8 fa[4], fb[4];
#define G3_RD(BUF, KH) do { \
    _Pragma("unroll") for (int m = 0; m < 4; ++m) fa[m] = *(const bf16x8*)(abase + (BUF) * 256 * LDS_ROW + m * 16 * LDS_ROW + ((((KH) * 4 + fq) ^ (fr & 7)) << 3)); \
    _Pragma("unroll") for (int n = 0; n < 4; ++n) fb[n] = *(const bf16x8*)(bbase + (BUF) * 128 * LDS_ROW + n * 16 * LDS_ROW + ((((KH) * 4 + fq) ^ (fr & 7)) << 3)); } while (0)
#define G3_MM() do { \
    _Pragma("unroll") for (int m = 0; m < 4; ++m) _Pragma("unroll") for (int n = 0; n < 4; ++n) acc[m][n] = MFMA(fb[n], fa[m], acc[m][n]); } while (0)
  int kn = (1 < nk ? 1 : 0) * 64 + lkc;
#pragma unroll
  for (int i = 0; i < 2; ++i) {
    const u16* bp = Bt + (size_t)(lrow + i * 64) * ldb + kn;
    asm volatile("global_load_dwordx4 %0, %1, off" : "=v"(rb[i]) : "v"(bp) : "memory");
  }
#pragma unroll
  for (int i = 0; i < 4; ++i) ra[i] = al(lrow + i * 64, kn);
  if (grpY) G3_RD(0, 0);
  __builtin_amdgcn_sched_barrier(0);
  for (int kt = 0; kt < nk; ++kt) {
    const int buf = kt & 1;
    if (!grpY) G3_RD(buf, 0);
    __builtin_amdgcn_sched_barrier(0);
    G3_MM();
    __builtin_amdgcn_sched_barrier(0);
    if (grpY) G3_RD(buf, 1);
    __builtin_amdgcn_sched_barrier(0);
    asm volatile("s_waitcnt vmcnt(0)" ::: "memory");
#pragma unroll
    for (int i = 0; i < 4; ++i) *(uint4*)&s.A[buf ^ 1][(lrow + i * 64) * LDS_ROW + lsw] = al.post(ra[i], lrow + i * 64, kn);
#pragma unroll
    for (int i = 0; i < 2; ++i) *(uint4*)&s.B[buf ^ 1][(lrow + i * 64) * LDS_ROW + lsw] = rb[i];
    if (kt + 2 < nk) {
      kn = (kt + 2) * 64 + lkc;
#pragma unroll
      for (int i = 0; i < 2; ++i) {
        const u16* bp = Bt + (size_t)(lrow + i * 64) * ldb + kn;
        asm volatile("global_load_dwordx4 %0, %1, off" : "=v"(rb[i]) : "v"(bp) : "memory");
      }
#pragma unroll
      for (int i = 0; i < 4; ++i) ra[i] = al(lrow + i * 64, kn);
    }
    __builtin_amdgcn_sched_barrier(0);
    lds_barrier();
    if (!grpY) G3_RD(buf, 1);
    __builtin_amdgcn_sched_barrier(0);
    G3_MM();
    __builtin_amdgcn_sched_barrier(0);
    if (grpY) G3_RD(buf ^ 1, 0);
    __builtin_amdgcn_sched_barrier(0);
    lds_barrier();
  }
  asm volatile("s_waitcnt vmcnt(0)" ::: "memory");
  __syncthreads();
}

template <class AL>
DI void gemm_main4(const AL& al, const u16* __restrict__ Bt, int ldb, int K, f32x4 (&acc)[4][4], char* smem) {
  SmemG& s = *(SmemG*)smem;
  const int tid = otid(), lane = tid & 63, wave = tid >> 6, wr = wave >> 1, wc = wave & 1, fr = lane & 15, fq = lane >> 4;
#pragma unroll
  for (int m = 0; m < 4; ++m)
#pragma unroll
    for (int n = 0; n < 4; ++n) acc[m][n] = (f32x4){0.f, 0.f, 0.f, 0.f};
  uint4 a0[4], a1[4], b00, b01, b10, b11;
  const int nk = K >> 6;
  const int lrow = tid >> 3, lkc = (tid & 7) * 8, lsw = ((tid & 7) ^ (lrow & 7)) * 8;
  __syncthreads();
#pragma unroll
  for (int i = 0; i < 4; ++i) a0[i] = al(lrow + i * 64, lkc);
#pragma unroll
  for (int i = 0; i < 1; ++i) { b00 = *(const uint4*)(Bt + (size_t)lrow * ldb + lkc); b01 = *(const uint4*)(Bt + (size_t)(lrow + 64) * ldb + lkc); }
#pragma unroll
  for (int i = 0; i < 4; ++i) *(uint4*)&s.A[0][(lrow + i * 64) * LDS_ROW + lsw] = al.post(a0[i], lrow + i * 64, lkc);
#pragma unroll
  for (int i = 0; i < 1; ++i) { *(uint4*)&s.B[0][lrow * LDS_ROW + lsw] = b00; *(uint4*)&s.B[0][(lrow + 64) * LDS_ROW + lsw] = b01; }
  __syncthreads();
  auto g4_load = [&](uint4 (&RA)[4], uint4& RB0, uint4& RB1, int KN) {
#pragma unroll
    for (int i = 0; i < 4; ++i) RA[i] = al(lrow + i * 64, KN);
    RB0 = *(const uint4*)(Bt + (size_t)lrow * ldb + KN);
    RB1 = *(const uint4*)(Bt + (size_t)(lrow + 64) * ldb + KN);
  };
  auto g4_store = [&](uint4 (&RA)[4], uint4& RB0, uint4& RB1, int BUF, int KN) {
#pragma unroll
    for (int i = 0; i < 4; ++i) *(uint4*)&s.A[BUF][(lrow + i * 64) * LDS_ROW + lsw] = al.post(RA[i], lrow + i * 64, KN);
    *(uint4*)&s.B[BUF][lrow * LDS_ROW + lsw] = RB0;
    *(uint4*)&s.B[BUF][(lrow + 64) * LDS_ROW + lsw] = RB1;
  };
#define G4_COMPUTE(BUF) do { \
    _Pragma("unroll") for (int kh = 0; kh < 2; ++kh) { \
      bf16x8 a[4], b[4]; \
      _Pragma("unroll") for (int m = 0; m < 4; ++m) a[m] = *(const bf16x8*)&s.A[BUF][(wr * 64 + m * 16 + fr) * LDS_ROW + (((kh * 4 + fq) ^ (fr & 7)) << 3)]; \
      _Pragma("unroll") for (int n = 0; n < 4; ++n) b[n] = *(const bf16x8*)&s.B[BUF][(wc * 64 + n * 16 + fr) * LDS_ROW + (((kh * 4 + fq) ^ (fr & 7)) << 3)]; \
      __builtin_amdgcn_s_setprio(1); \
      _Pragma("unroll") for (int m = 0; m < 4; ++m) _Pragma("unroll") for (int n = 0; n < 4; ++n) acc[m][n] = MFMA(b[n], a[m], acc[m][n]); \
      __builtin_amdgcn_s_setprio(0); } } while (0)
  int k1 = 64 + lkc, k2 = (2 < nk ? 2 : nk - 1) * 64 + lkc;
  g4_load(a0, b00, b01, k1);
  g4_load(a1, b10, b11, k2);
  __builtin_amdgcn_sched_barrier(0);
  for (int kt = 0; kt < nk; kt += 2) {
    G4_COMPUTE(0);
    __builtin_amdgcn_sched_barrier(0);
    g4_store(a0, b00, b01, 1, k1);
    k1 = (kt + 3 < nk ? kt + 3 : nk - 1) * 64 + lkc;
    g4_load(a0, b00, b01, k1);
    __builtin_amdgcn_sched_barrier(0);
    __syncthreads();
    G4_COMPUTE(1);
    __builtin_amdgcn_sched_barrier(0);
    g4_store(a1, b10, b11, 0, k2);
    k2 = (kt + 4 < nk ? kt + 4 : nk - 1) * 64 + lkc;
    g4_load(a1, b10, b11, k2);
    __builtin_amdgcn_sched_barrier(0);
    __syncthreads();
  }
}


struct SmemG2 { u16 A[2][256 * LDS_ROW]; u16 B[2][256 * LDS_ROW]; };
template <class AL>
DI void gemm_main2(const AL& al, const u16* __restrict__ Bt, int ldb, int K, f32x4 (&acc)[4][8], char* smem) {
  SmemG2& s = *(SmemG2*)smem;
  const int tid = otid(), lane = tid & 63, wave = tid >> 6, wr = wave >> 1, wc = wave & 1, fr = lane & 15, fq = lane >> 4;
#pragma unroll
  for (int m = 0; m < 4; ++m)
#pragma unroll
    for (int n = 0; n < 8; ++n) acc[m][n] = (f32x4){0.f, 0.f, 0.f, 0.f};
  uint4 ra[4], rb[4];
  const int nk = K >> 6;
  const int lrow = tid >> 3, lkc = (tid & 7) * 8, lsw = ((tid & 7) ^ (lrow & 7)) * 8;
  __syncthreads();
#pragma unroll
  for (int i = 0; i < 4; ++i) ra[i] = al(lrow + i * 64, lkc);
#pragma unroll
  for (int i = 0; i < 4; ++i) rb[i] = *(const uint4*)(Bt + (size_t)(lrow + i * 64) * ldb + lkc);
#pragma unroll
  for (int i = 0; i < 4; ++i) *(uint4*)&s.A[0][(lrow + i * 64) * LDS_ROW + lsw] = al.post(ra[i], lrow + i * 64, lkc);
#pragma unroll
  for (int i = 0; i < 4; ++i) *(uint4*)&s.B[0][(lrow + i * 64) * LDS_ROW + lsw] = rb[i];
  __syncthreads();
  for (int kt = 0; kt < nk; ++kt) {
    const int buf = kt & 1;
    const int kn = (kt + 1 < nk ? kt + 1 : kt) * 64 + lkc;
#pragma unroll
    for (int i = 0; i < 4; ++i) ra[i] = al(lrow + i * 64, kn);
    __builtin_amdgcn_sched_barrier(0);
#pragma unroll
    for (int kh = 0; kh < 2; ++kh) {
      bf16x8 a[4];
#pragma unroll
      for (int m = 0; m < 4; ++m) a[m] = *(const bf16x8*)&s.A[buf][(wr * 64 + m * 16 + fr) * LDS_ROW + (((kh * 4 + fq) ^ (fr & 7)) << 3)];
      bf16x8 bc = *(const bf16x8*)&s.B[buf][(wc * 128 + fr) * LDS_ROW + (((kh * 4 + fq) ^ (fr & 7)) << 3)];
#pragma unroll
      for (int n = 0; n < 8; ++n) {
        const bf16x8 bn = *(const bf16x8*)&s.B[buf][(wc * 128 + (n < 7 ? n + 1 : n) * 16 + fr) * LDS_ROW + (((kh * 4 + fq) ^ (fr & 7)) << 3)];
        __builtin_amdgcn_sched_barrier(0);
        __builtin_amdgcn_s_setprio(1);
#pragma unroll
        for (int m = 0; m < 4; ++m) acc[m][n] = MFMA(bc, a[m], acc[m][n]);
        __builtin_amdgcn_s_setprio(0);
        bc = bn;
      }
      __builtin_amdgcn_sched_barrier(0);
      if (kh == 0) {
#pragma unroll
        for (int i = 0; i < 4; ++i) *(uint4*)&s.A[buf ^ 1][(lrow + i * 64) * LDS_ROW + lsw] = al.post(ra[i], lrow + i * 64, kn);
#pragma unroll
        for (int i = 0; i < 4; ++i) {
          const u16* bp = Bt + (size_t)(lrow + i * 64) * ldb + kn;
          asm volatile("global_load_dwordx4 %0, %1, off" : "=v"(rb[i]) : "v"(bp) : "memory");
        }
        __builtin_amdgcn_sched_barrier(0);
      }
    }
    asm volatile("s_waitcnt vmcnt(0)" ::: "memory");
#pragma unroll
    for (int i = 0; i < 4; ++i) *(uint4*)&s.B[buf ^ 1][(lrow + i * 64) * LDS_ROW + lsw] = rb[i];
    __syncthreads();
  }
}

DI bool next_tile(int it, int MT, int NT, int GN, int& mt, int& nt) {
  const int xcd = blockIdx.x & 7, lb = blockIdx.x >> 3, GM = 8 / GN;
  const int gm = xcd / GN, gn = xcd - gm * GN;
  const int m0 = gm * MT / GM, m1 = (gm + 1) * MT / GM, n0 = gn * NT / GN, n1 = (gn + 1) * NT / GN;
  const int nl = n1 - n0, tl = lb + it * (gridDim.x >> 3);
  if (tl >= (m1 - m0) * nl) return false;
  const int q = tl / nl;
  mt = m0 + q; nt = n0 + (tl - q * nl);
  return true;
}
struct ALPlain {
  const u16* base; int ld;
  DI uint4 operator()(int i, int k) const { return *(const uint4*)(base + (size_t)i * ld + k); }
  DI uint4 post(uint4 v, int, int) const { return v; }
};

DI void ph_prologue(const Params& p, char* smem) {
  const int tid = otid();
  {
    const float4* x = (const float4*)p.in[IX]; float4* o = (float4*)p.out;
    const size_t n = (size_t)NBAT * T * D / 4;
    for (size_t i = (size_t)blockIdx.x * 512 + tid; i < n; i += (size_t)gridDim.x * 512) o[i] = x[i];
    const float4* c = (const float4*)p.in[ICTX]; float4* xc = (float4*)(p.ws + OFF_XC);
    const size_t nc = (size_t)NBAT * TC * D / 4;
    for (size_t i = (size_t)blockIdx.x * 512 + tid; i < nc; i += (size_t)gridDim.x * 512) xc[i] = c[i];
  }
  float* modp = (float*)(p.ws + OFF_MODP);
  float* sc = (float*)smem;
  __syncthreads();
  for (int e = tid; e < 3072; e += 512) { const float v = e < 2048 ? p.in[IC][e] : p.in[ICC][e - 2048]; sc[e] = siluf(v); }
  __syncthreads();
  const int half = tid >> 8, col = tid & 255;
  for (int it = blockIdx.x * 2 + half; it < 4 * 24 * 16; it += gridDim.x * 2) {
    int l = it / (24 * 16), rem = it - l * 24 * 16, cc = rem / 16, kc = rem & 15;
    int n = cc * 256 + col;
    const float* w = p.in[IADAW] + (size_t)l * 1024 * 6144 + (size_t)(kc * 64) * 6144 + n;
    float a0 = 0.f, a1 = 0.f, a2 = 0.f;
#pragma unroll
    for (int kb = 0; kb < 64; kb += 16) {
      float wv[16];
#pragma unroll
      for (int k = 0; k < 16; ++k) wv[k] = w[(size_t)(kb + k) * 6144];
#pragma unroll
      for (int k = 0; k < 16; ++k) {
        const int kk = kc * 64 + kb + k;
        a0 += sc[kk] * wv[k]; a1 += sc[1024 + kk] * wv[k]; a2 += sc[2048 + kk] * wv[k];
      }
    }
    size_t o = ((size_t)(kc * 4 + l) * 3) * 6144 + n;
    modp[o] = a0; modp[o + 6144] = a1; modp[o + 2 * 6144] = a2;
  }
}
DI void ph_modreduce(const Params& p) {
  const float* modp = (const float*)(p.ws + OFF_MODP); float* mod = (float*)(p.ws + OFF_MOD);
  for (int i = blockIdx.x * 512 + otid(); i < 4 * 3 * 6144; i += gridDim.x * 512) {
    int l = i / (3 * 6144), n = i % 6144;
    float a = p.in[IADAB][l * 6144 + n];
    for (int kc = 0; kc < 16; ++kc) a += modp[(size_t)kc * 4 * 3 * 6144 + i];
    mod[i] = a;
  }
}

struct CvtJob { const float* src; u16* dst; int K, N, ld, ldd, mode; };
DI void cvt_run(const CvtJob& j, int& rot, char* smem) {
  float* tile = (float*)smem;
  const int tid = otid();
  if (j.mode == 4) {
    size_t n = (size_t)j.K * j.N;
    for (size_t i = (size_t)blockIdx.x * 512 + tid; i < n; i += (size_t)gridDim.x * 512) j.dst[i] = 0;
    return;
  }
  const int tk = j.K >> 6, tn = j.N >> 6, nt = tk * tn;
  int start = (blockIdx.x + gridDim.x - (rot % gridDim.x)) % gridDim.x;
  for (int t = start; t < nt; t += gridDim.x) {
    int kt = t / tn, ntl = t - kt * tn;
    __syncthreads();
    {
      f32x4 lv[2];
#pragma unroll
      for (int i = 0; i < 2; ++i) { const int e = tid + i * 512, kk = e >> 4, n4 = (e & 15) * 4; lv[i] = gload_f4(j.src + (size_t)(kt * 64 + kk) * j.ld + ntl * 64 + n4); }
      asm volatile("s_waitcnt vmcnt(0)" : "+v"(lv[0]), "+v"(lv[1]) :: "memory");
#pragma unroll
      for (int i = 0; i < 2; ++i) { const int e = tid + i * 512, kk = e >> 4, n4 = (e & 15) * 4; float* tp = tile + kk * 65 + n4; tp[0] = lv[i][0]; tp[1] = lv[i][1]; tp[2] = lv[i][2]; tp[3] = lv[i][3]; }
    }
    __syncthreads();
    for (int e = tid; e < 4096; e += 512) {
      int nn = e >> 6, kk = e & 63; float v = tile[kk * 65 + nn];
      int n = ntl * 64 + nn, k = kt * 64 + kk;
      if (j.mode == 0) j.dst[(size_t)n * j.ldd + k] = f2b(v);
      else if (j.mode == 1) { int rr = n < FF ? (n >> 7) * 256 + (n & 127) : ((n - FF) >> 7) * 256 + 128 + ((n - FF) & 127); j.dst[(size_t)rr * j.ldd + k] = f2b(v); }
      else {
        int h = n >> 6, c = n & 63, ty = j.mode - 2;
        u16* d = j.dst + (size_t)h * 128 * 128 + (size_t)((c >> 5) * 64 + ty * 32 + (c & 31)) * 128;
        d[ty * 64 + k] = f2b(v); d[(1 - ty) * 64 + k] = 0;
      }
    }
  }
  rot += nt;
}
DI void ph_convert(const Params& p, int l, char* smem) {
  u16* wt = (u16*)(p.ws + OFF_WT);
  int rot = 0;
  CvtJob j;
  j = {p.in[IFWIN] + (size_t)l * 1024 * 5632, wt + WT_W1T, 1024, 5632, 5632, 1024, 1}; cvt_run(j, rot, smem);
  j = {p.in[IFWOUT] + (size_t)l * FF * 1024, wt + WT_W2T, FF, 1024, 1024, FF, 0}; cvt_run(j, rot, smem);
  const int kind = l % 3, jj = l / 3;
  if (kind == 0) {
    j = {p.in[IRWR] + (size_t)jj * 1048576, wt + WT_R1T, 1024, 1024, 1024, 1024, 0}; cvt_run(j, rot, smem);
    j = {p.in[IRWK] + (size_t)jj * 1048576, wt + WT_R1T + (size_t)1024 * 1024, 1024, 1024, 1024, 1024, 0}; cvt_run(j, rot, smem);
    j = {p.in[IRWV] + (size_t)jj * 1048576, wt + WT_R1T + (size_t)2048 * 1024, 1024, 1024, 1024, 1024, 0}; cvt_run(j, rot, smem);
    for (int d = 0; d < 2; ++d) {
      j = {p.in[IRW1] + (size_t)(jj * 2 + d) * 65536, wt + WT_R1T + (size_t)(3072 + d * 64) * 1024, 1024, 64, 64, 1024, 0}; cvt_run(j, rot, smem);
      j = {p.in[IRA1] + (size_t)(jj * 2 + d) * 65536, wt + WT_R1T + (size_t)(3200 + d * 64) * 1024, 1024, 64, 64, 1024, 0}; cvt_run(j, rot, smem);
      j = {p.in[IRW2] + (size_t)(jj * 2 + d) * 65536, wt + WT_LUT + (size_t)d * 16 * 128 * 128, 64, 1024, 1024, 128, 2}; cvt_run(j, rot, smem);
      j = {p.in[IRA2] + (size_t)(jj * 2 + d) * 65536, wt + WT_LUT + (size_t)d * 16 * 128 * 128, 64, 1024, 1024, 128, 3}; cvt_run(j, rot, smem);
    }
    j = {p.in[IRG1] + (size_t)jj * 131072, wt + WT_R1T + (size_t)3328 * 1024, 1024, 128, 128, 1024, 0}; cvt_run(j, rot, smem);
    j = {p.in[IRG2] + (size_t)jj * 131072, wt + WT_G2T, 128, 1024, 1024, 128, 0}; cvt_run(j, rot, smem);
    j = {p.in[IRWO] + (size_t)jj * 1048576, wt + WT_RWO, 1024, 1024, 1024, 1024, 0}; cvt_run(j, rot, smem);
  } else if (kind == 1) {
    j = {p.in[ISWIN] + (size_t)jj * 1024 * 6208 + 2048, wt + WT_SX, 1024, 4160, 6208, 1024, 0}; cvt_run(j, rot, smem);
    j = {nullptr, wt + WT_SX + (size_t)4160 * 1024, 64, 1024, 0, 0, 4}; cvt_run(j, rot, smem);
    j = {p.in[ISWIN] + (size_t)jj * 1024 * 6208, wt + WT_SZ, 1024, 2048, 6208, 1024, 0}; cvt_run(j, rot, smem);
    j = {p.in[ISWOUT] + (size_t)jj * 2048 * 1024, wt + WT_SO, 2048, 1024, 1024, 2048, 0}; cvt_run(j, rot, smem);
    float* ssq = (float*)(p.ws + OFF_SSQ);
    for (int i = blockIdx.x * 512 + otid(); i < R * 8; i += gridDim.x * 512) ssq[i] = 0.f;
  } else {
    j = {p.in[IAQKV] + (size_t)jj * 1024 * 1536, wt + WT_AQ, 1024, 1536, 1536, 1024, 0}; cvt_run(j, rot, smem);
    j = {p.in[IAWO] + (size_t)jj * 1048576, wt + WT_AO, 1024, 1024, 1024, 1024, 0}; cvt_run(j, rot, smem);
  }
}

DI void ph_norm(const Params& p, int l, int which) {
  const int lane = otid() & 63, gw = blockIdx.x * 8 + (otid() >> 6), nw = gridDim.x * 8;
  const float* g = (which ? p.in[IN2] : p.in[IN1]) + l * 1024;
  u16* H = (u16*)(p.ws + OFF_H);
  for (int r = gw; r < R; r += nw) {
    const float* xr = xrow_ptr(p, r);
    const float* md = mod_ptr(p, l, r) + which * 3072;
    float4 v[4]; float ss = 0.f;
#pragma unroll
    for (int j = 0; j < 4; ++j) { v[j] = *(const float4*)(xr + j * 256 + lane * 4); ss += v[j].x * v[j].x + v[j].y * v[j].y + v[j].z * v[j].z + v[j].w * v[j].w; }
    ss = wsum(ss);
    const float rs = rsqrtf(ss * (1.f / 1024.f) + 1e-6f);
#pragma unroll
    for (int j = 0; j < 4; ++j) {
      const int c = j * 256 + lane * 4;
      float4 gg = *(const float4*)(g + c), sh = *(const float4*)(md + c), sc = *(const float4*)(md + 1024 + c);
      float o0 = v[j].x * rs * gg.x * (1.f + sc.x) + sh.x, o1 = v[j].y * rs * gg.y * (1.f + sc.y) + sh.y;
      float o2 = v[j].z * rs * gg.z * (1.f + sc.z) + sh.z, o3 = v[j].w * rs * gg.w * (1.f + sc.w) + sh.w;
      uint2 w; w.x = pack2(o0, o1); w.y = pack2(o2, o3);
      *(uint2*)(H + (size_t)r * 1024 + c) = w;
    }
  }
}
DI void ph_final(const Params& p) {
  const int lane = otid() & 63, gw = blockIdx.x * 8 + (otid() >> 6), nw = gridDim.x * 8;
  for (int r = gw; r < NBAT * T; r += nw) {
    float* xr = p.out + (size_t)r * 1024;
    float4 v[4]; float ss = 0.f;
#pragma unroll
    for (int j = 0; j < 4; ++j) { v[j] = *(float4*)(xr + j * 256 + lane * 4); ss += v[j].x * v[j].x + v[j].y * v[j].y + v[j].z * v[j].z + v[j].w * v[j].w; }
    ss = wsum(ss);
    const float rs = rsqrtf(ss * (1.f / 1024.f) + 1e-6f);
#pragma unroll
    for (int j = 0; j < 4; ++j) {
      float4 g = *(const float4*)(p.in[IFINAL] + j * 256 + lane * 4);
      float4 w = v[j]; w.x *= rs * g.x; w.y *= rs * g.y; w.z *= rs * g.z; w.w *= rs * g.w;
      *(float4*)(xr + j * 256 + lane * 4) = w;
    }
  }
}

template <class AL>
DI void resid_tile(const Params& p, const AL& al, const u16* Bt, int K, int l, int gi, int mt, int nt, char* smem) {
  f32x4 acc[4][4];
  gemm_main4(al, Bt + (size_t)nt * 128 * K, K, K, acc, smem);
  const int lane = otid() & 63, wave = otid() >> 6, wr = wave >> 1, wc = wave & 1, fr = lane & 15, fq = lane >> 4;
  const int row0 = mt * 256;
  const float* md = mod_ptr(p, l, row0) + gi * 1024;
  float4 g[4];
#pragma unroll
  for (int n = 0; n < 4; ++n) g[n] = *(const float4*)(md + nt * 128 + wc * 64 + n * 16 + fq * 4);
  float* xr0 = xrow_ptr(p, row0) + (size_t)(wr * 64 + fr) * 1024 + nt * 128 + wc * 64 + fq * 4;
#pragma unroll
  for (int mh = 0; mh < 2; ++mh) {
    f32x4 x[2][4];
#pragma unroll
    for (int m2 = 0; m2 < 2; ++m2)
#pragma unroll
      for (int n = 0; n < 4; ++n) x[m2][n] = gload_f4(xr0 + (size_t)((mh * 2 + m2) * 16) * 1024 + n * 16);
    asm volatile("s_waitcnt vmcnt(0)" : "+v"(x[0][0]), "+v"(x[0][1]), "+v"(x[0][2]), "+v"(x[0][3]), "+v"(x[1][0]), "+v"(x[1][1]), "+v"(x[1][2]), "+v"(x[1][3]) :: "memory");
#pragma unroll
    for (int m2 = 0; m2 < 2; ++m2)
#pragma unroll
      for (int n = 0; n < 4; ++n) {
        const int m = mh * 2 + m2;
        f32x4 v = x[m2][n];
        v[0] += g[n].x * acc[m][n][0]; v[1] += g[n].y * acc[m][n][1]; v[2] += g[n].z * acc[m][n][2]; v[3] += g[n].w * acc[m][n][3];
        *(f32x4*)(xr0 + (size_t)(m * 16) * 1024 + n * 16) = v;
      }
  }
}
DI void ph_resid_gemm(const Params& p, const u16* A, int lda, const u16* Bt, int K, int l, int gi, char* smem) {
  const bool skip_ctx = (l == 3);
  for (int it = 0;; ++it) {
    int mt, nt; if (!next_tile(it, skip_ctx ? 128 : 130, 8, 1, mt, nt)) break;
    if (skip_ctx) mt = mt + 1 + (mt >> 6);
    ALPlain al{A + (size_t)mt * 256 * lda, lda};
    resid_tile(p, al, Bt, K, l, gi, mt, nt, smem);
  }
}

struct ALHalo {
  const u16* base; int t0m1, len;
  DI uint4 operator()(int i, int k) const {
    int t = t0m1 + i;
    if (t < 0 || t >= len) return make_uint4(0, 0, 0, 0);
    return *(const uint4*)(base + (size_t)t * 1024 + k);
  }
  DI uint4 post(uint4 v, int, int) const { return v; }
};
DI void ph_ffn1(const Params& p, int l, char* smem) {
  const u16* H = (const u16*)(p.ws + OFF_H);
  const u16* W1T = (const u16*)(p.ws + OFF_WT) + WT_W1T;
  u16* G = (u16*)(p.ws + OFF_SCR);
  const int tid = otid(), lane = tid & 63, wave = tid >> 6, wr = wave >> 1, wc = wave & 1, fr = lane & 15, fq = lane >> 4;
  for (int it = 0;; ++it) {
    int mt, nt; if (!next_tile(it, 134, 22, 2, mt, nt)) break;
    const int b = mt / 67, ml = mt - b * 67;
    int rowbase, t0, len;
    if (ml < 2) { rowbase = b * TS; t0 = ml * 254; len = TC; } else { rowbase = b * TS + TC; t0 = (ml - 2) * 254; len = T; }
    ALHalo al{H + (size_t)rowbase * 1024, t0 - 1, len};
    f32x4 acc[4][8];
    gemm_main2(al, W1T + (size_t)nt * 256 * 1024, 1024, 1024, acc, smem);
    u16* P16 = (u16*)smem;
#pragma unroll
    for (int m = 0; m < 4; ++m)
#pragma unroll
      for (int n = 0; n < 8; ++n) {
        uint2 w; w.x = pack2(acc[m][n][0], acc[m][n][1]); w.y = pack2(acc[m][n][2], acc[m][n][3]);
        *(uint2*)&P16[(wr * 64 + m * 16 + fr) * 264 + wc * 128 + n * 16 + fq * 4] = w;
      }
    __syncthreads();
    {
      const int c2 = (tid & 63) * 2, rg = tid >> 6;
      const float* cw = p.in[IFCONV] + (size_t)l * 3 * 5632;
      const int ca = nt * 128 + c2, cg2 = FF + ca;
      const float2 a0 = *(const float2*)(cw + ca), a1 = *(const float2*)(cw + 5632 + ca), a2 = *(const float2*)(cw + 2 * 5632 + ca);
      const float2 g0 = *(const float2*)(cw + cg2), g1 = *(const float2*)(cw + 5632 + cg2), g2 = *(const float2*)(cw + 2 * 5632 + cg2);
      const int i0 = 1 + rg * 32, i1 = min(i0 + 32, 255);
      unsigned pa = *(const unsigned*)&P16[(i0 - 1) * 264 + c2], ca_ = *(const unsigned*)&P16[i0 * 264 + c2];
      unsigned pg = *(const unsigned*)&P16[(i0 - 1) * 264 + 128 + c2], cgv = *(const unsigned*)&P16[i0 * 264 + 128 + c2];
      for (int i = i0; i < i1; ++i) {
        const unsigned na = *(const unsigned*)&P16[(i + 1) * 264 + c2], ng = *(const unsigned*)&P16[(i + 1) * 264 + 128 + c2];
        const float ua0 = a0.x * blo(pa) + a1.x * blo(ca_) + a2.x * blo(na), ua1 = a0.y * bhi(pa) + a1.y * bhi(ca_) + a2.y * bhi(na);
        const float ug0 = g0.x * blo(pg) + g1.x * blo(cgv) + g2.x * blo(ng), ug1 = g0.y * bhi(pg) + g1.y * bhi(cgv) + g2.y * bhi(ng);
        const int tt = t0 - 1 + i;
        if (tt < len) *(unsigned*)&G[(size_t)(rowbase + tt) * FF + ca] = pack2(ua0 * siluf(ug0), ua1 * siluf(ug1));
        pa = ca_; ca_ = na; pg = cgv; cgv = ng;
      }
    }
  }
}

struct ALMix {
  const u16* H; int row0; const float* mu;
  DI uint4 operator()(int i, int k) const {
    const int row = row0 + i, q = row % TS;
    const bool hp = (q != 0) && (q != TC), hn = (q != TC - 1) && (q != TS - 1);
    const u16* pc = H + (size_t)row * 1024 + k;
    uint4 c = *(const uint4*)pc;
    uint4 a = hp ? *(const uint4*)(pc - 1024) : make_uint4(0, 0, 0, 0);
    uint4 b = hn ? *(const uint4*)(pc + 1024) : make_uint4(0, 0, 0, 0);
    float4 m0 = *(const float4*)(mu + k), m1 = *(const float4*)(mu + k + 4);
    uint4 o;
#define MIX1(cc, aa, bb, mlo, mhi) pack2(blo(cc) + (0.5f * (blo(aa) + blo(bb)) - blo(cc)) * (mlo), bhi(cc) + (0.5f * (bhi(aa) + bhi(bb)) - bhi(cc)) * (mhi))
    o.x = MIX1(c.x, a.x, b.x, m0.x, m0.y); o.y = MIX1(c.y, a.y, b.y, m0.z, m0.w);
    o.z = MIX1(c.z, a.z, b.z, m1.x, m1.y); o.w = MIX1(c.w, a.w, b.w, m1.z, m1.w);
    return o;
  }
  DI uint4 post(uint4 v, int, int) const { return v; }
};
constexpr int P1LD = 3456;
DI void ph_rw_r1(const Params& p, int jj, char* smem) {
  const u16* H = (const u16*)(p.ws + OFF_H);
  const u16* BT = (const u16*)(p.ws + OFF_WT) + WT_R1T;
  u16* P1 = (u16*)(p.ws + OFF_SCR);
  const int lane = otid() & 63, wave = otid() >> 6, wr = wave >> 1, wc = wave & 1, fr = lane & 15, fq = lane >> 4;
  for (int it = 0;; ++it) {
    int mt, nt; if (!next_tile(it, 130, 27, 1, mt, nt)) break;
    const int mi = nt < 8 ? 0 : nt < 16 ? 2 : nt < 24 ? 3 : nt == 24 ? 1 : nt == 25 ? 4 : 5;
    ALMix al{H, mt * 256, p.in[IRMU] + (size_t)(jj * 6 + mi) * 1024};
    f32x4 acc[4][4];
    gemm_main3(al, BT + (size_t)nt * 128 * 1024, 1024, 1024, acc, smem);
#pragma unroll
    for (int m = 0; m < 4; ++m) {
      const int row = mt * 256 + wr * 64 + m * 16 + fr;
#pragma unroll
      for (int n = 0; n < 4; ++n) {
        const int c = nt * 128 + wc * 64 + n * 16 + fq * 4;
        float v0 = acc[m][n][0], v1 = acc[m][n][1], v2 = acc[m][n][2], v3 = acc[m][n][3];
        if (nt == 24) { v0 = tanhf(v0); v1 = tanhf(v1); v2 = tanhf(v2); v3 = tanhf(v3); }
        else if (nt == 26) { v0 = sigmf(v0); v1 = sigmf(v1); v2 = sigmf(v2); v3 = sigmf(v3); }
        uint2 w; w.x = pack2(v0, v1); w.y = pack2(v2, v3);
        *(uint2*)(P1 + (size_t)row * P1LD + c) = w;
      }
    }
  }
}
DI int scan_row(int b, int d, int pos) { return d == 0 ? b * TS + pos : (pos < TC ? b * TS + TC - 1 - pos : b * TS + (TS + TC - 1) - pos); }

struct ALLora {
  const u16* P1; int rowbase, rowstep, d;
  DI uint4 operator()(int i, int k) const {
    const int row = rowbase + i * rowstep;
    const int col = k < 64 ? 3072 + d * 64 + k : 3200 + d * 64 + (k - 64);
    return *(const uint4*)(P1 + (size_t)row * P1LD + col);
  }
  DI uint4 post(uint4 v, int, int) const { return v; }
};
DI uint2 pack4h(float a, float b, float c, float d) {
  __half2 x = __floats2half2_rn(a, b), y = __floats2half2_rn(c, d);
  uint2 r; r.x = *(unsigned*)&x; r.y = *(unsigned*)&y; return r;
}
DI void ph_rw_produce(const Params& p, int jj, int s, char* smem) {
  const u16* P1 = (const u16*)(p.ws + OFF_SCR);
  const u16* LUT = (const u16*)(p.ws + OFF_WT) + WT_LUT;
  __half* ring = (__half*)(p.ws + OFF_RING) + (size_t)(s & 1) * ((size_t)2 * 2 * 1024 * 16 * 256);
  float* bonus = (float*)(p.ws + OFF_BONUS);
  float* red = (float*)(smem + sizeof(SmemG));
  const int lane = otid() & 63, wave = otid() >> 6, wr = wave >> 1, wc = wave & 1, fr = lane & 15, fq = lane >> 4;
  const int npt = min(4, 65 - s * 4);
  for (int t = blockIdx.x; t < 2 * 2 * npt * 16; t += gridDim.x) {
    const int h = t & 15, ptl = (t >> 4) % npt, bd = (t >> 4) / npt, d = bd & 1, b = bd >> 1;
    const int pos0 = (s * 4 + ptl) * 256;
    const int rowbase = scan_row(b, d, pos0), rowstep = d ? -1 : 1;
    ALLora al{P1, rowbase, rowstep, d};
    f32x4 acc[4][4];
    gemm_main3(al, LUT + (size_t)(d * 16 + h) * 128 * 128, 128, 128, acc, smem);
    float4 kkw[2], kaw[2], rkw[2], w0v[2], a0v[2];
#pragma unroll
    for (int nn = 0; nn < 2; ++nn) {
      const int ch = h * 64 + wc * 32 + nn * 16 + fq * 4;
      kkw[nn] = *(const float4*)(p.in[IRKK] + jj * 1024 + ch); kaw[nn] = *(const float4*)(p.in[IRKA] + jj * 1024 + ch);
      rkw[nn] = *(const float4*)(p.in[IRRK] + jj * 1024 + ch);
      w0v[nn] = *(const float4*)(p.in[IRW0] + (jj * 2 + d) * 1024 + ch); a0v[nn] = *(const float4*)(p.in[IRA0] + (jj * 2 + d) * 1024 + ch);
    }
    float ssk[4];
#pragma unroll
    for (int m = 0; m < 4; ++m) {
      const int row = rowbase + (wr * 64 + m * 16 + fr) * rowstep;
      float s1 = 0.f;
#pragma unroll
      for (int nn = 0; nn < 2; ++nn) {
        const int ch = h * 64 + wc * 32 + nn * 16 + fq * 4;
        uint2 k2 = *(const uint2*)(P1 + (size_t)row * P1LD + 1024 + ch);
        float q0 = blo(k2.x) * kkw[nn].x, q1 = bhi(k2.x) * kkw[nn].y, q2 = blo(k2.y) * kkw[nn].z, q3 = bhi(k2.y) * kkw[nn].w;
        s1 += q0 * q0 + q1 * q1 + q2 * q2 + q3 * q3;
      }
      s1 += __shfl_xor(s1, 16); s1 += __shfl_xor(s1, 32);
      ssk[m] = s1;
    }
    if (fq == 0) {
#pragma unroll
      for (int m = 0; m < 4; ++m) red[(wr * 64 + m * 16 + fr) * 2 + wc] = ssk[m];
    }
    __syncthreads();
    float c3[4];
#pragma unroll
    for (int m = 0; m < 4; ++m) {
      const int pi = wr * 64 + m * 16 + fr;
      const float rs = rsqrtf(red[pi * 2] + red[pi * 2 + 1] + 1e-12f);
      const int posl = ptl * 256 + pi;
      __half* rp = ring + ((((size_t)(b * 2 + d) * 1024 + posl) * 16 + h) * 256);
      float cc = 0.f;
#pragma unroll
      for (int nn = 0; nn < 2; ++nn) {
        const int chl = wc * 32 + nn * 16 + fq * 4;
        const float kq[4] = {kkw[nn].x, kkw[nn].y, kkw[nn].z, kkw[nn].w}, ka[4] = {kaw[nn].x, kaw[nn].y, kaw[nn].z, kaw[nn].w};
        const float rk[4] = {rkw[nn].x, rkw[nn].y, rkw[nn].z, rkw[nn].w}, w0[4] = {w0v[nn].x, w0v[nn].y, w0v[nn].z, w0v[nn].w};
        const float a0[4] = {a0v[nn].x, a0v[nn].y, a0v[nn].z, a0v[nn].w};
        float okk[4], owm[4], oka[4], okd[4];
        const int rowm = rowbase + pi * rowstep;
        const uint2 r2 = *(const uint2*)(P1 + (size_t)rowm * P1LD + h * 64 + chl), k2 = *(const uint2*)(P1 + (size_t)rowm * P1LD + 1024 + h * 64 + chl);
        const float rvv[4] = {blo(r2.x), bhi(r2.x), blo(r2.y), bhi(r2.y)}, kvv[4] = {blo(k2.x), bhi(k2.x), blo(k2.y), bhi(k2.y)};
#pragma unroll
        for (int j = 0; j < 4; ++j) {
          const float k = kvv[j];
          const float kk = k * kq[j] * rs;
          const float a = sigmf(a0[j] + acc[m][nn + 2][j]);
          const float wlog = -__logf(1.f + __expf(-(w0[j] + acc[m][nn][j]))) - 0.5f;
          const float ew = -__expf(wlog);
          const float wm1 = ew * (1.f + ew * (0.5f + ew * (0.16666667f + ew * (0.041666668f + ew * (0.0083333338f + ew * (0.0013888889f + ew * 0.0001984127f))))));
          const float kd = k * (1.f + (a - 1.f) * ka[j]);
          okk[j] = kk; owm[j] = wm1; oka[j] = kk * a; okd[j] = kd;
          cc += rvv[j] * kd * rk[j];
        }
        *(uint2*)(rp + chl) = pack4h(okk[0], okk[1], okk[2], okk[3]);
        *(uint2*)(rp + 64 + chl) = pack4h(owm[0], owm[1], owm[2], owm[3]);
        *(uint2*)(rp + 128 + chl) = pack4h(oka[0], oka[1], oka[2], oka[3]);
        *(uint2*)(rp + 192 + chl) = pack4h(okd[0], okd[1], okd[2], okd[3]);
      }
      cc += __shfl_xor(cc, 16); cc += __shfl_xor(cc, 32);
      c3[m] = cc;
    }
    __syncthreads();
    if (fq == 0) {
#pragma unroll
      for (int m = 0; m < 4; ++m) red[(wr * 64 + m * 16 + fr) * 2 + wc] = c3[m];
    }
    __syncthreads();
    if (wc == 0 && fq == 0) {
#pragma unroll
      for (int m = 0; m < 4; ++m) {
        const int pi = wr * 64 + m * 16 + fr;
        bonus[(size_t)(rowbase + pi * rowstep) * 32 + h * 2 + d] = red[pi * 2] + red[pi * 2 + 1];
      }
    }
  }
}
DI float ror_add16(float x) {
  x += __int_as_float(__builtin_amdgcn_update_dpp(0, __float_as_int(x), 0x128, 0xf, 0xf, false));
  x += __int_as_float(__builtin_amdgcn_update_dpp(0, __float_as_int(x), 0x124, 0xf, 0xf, false));
  x += __int_as_float(__builtin_amdgcn_update_dpp(0, __float_as_int(x), 0x122, 0xf, 0xf, false));
  x += __int_as_float(__builtin_amdgcn_update_dpp(0, __float_as_int(x), 0x121, 0xf, 0xf, false));
  return x;
}
constexpr int SCH = 32, STEPF = 336;
DI void ph_rw_scan(const Params& p, int s, char* smem, bool save = true) {
  if (blockIdx.x >= 256) return;
  const u16* P1 = (const u16*)(p.ws + OFF_SCR);
  const __half* ring = (const __half*)(p.ws + OFF_RING) + (size_t)(s & 1) * ((size_t)2 * 2 * 1024 * 16 * 256);
  u16* Y = (u16*)(p.ws + OFF_SCR) + (size_t)R * P1LD;
  float* st = (float*)(p.ws + OFF_RWST);
  float* buf = (float*)smem;
  float* ybuf = buf + 2 * SCH * STEPF;
  const int tid = otid(), lane = tid & 63, wave = tid >> 6;
  const int xcd_ = blockIdx.x & 7, slot_ = blockIdx.x >> 3;
  const int bh_ = xcd_ * 4 + (slot_ >> 3), rq = slot_ & 3;
  const int b = bh_ >> 4, h = bh_ & 15, d = (slot_ >> 2) & 1;
  const int npos = min(1024, TS - s * 1024), nch = npos / SCH;
  const int rl = (wave & 3) * 4 + (lane >> 4), q = lane & 15;
  f32x2 sa = (f32x2){0.f, 0.f}, sb = (f32x2){0.f, 0.f};
  if (wave < 4 && s > 0) { float4 v = *(const float4*)(st + ((size_t)blockIdx.x * 256 + tid) * 4); sa = (f32x2){v.x, v.y}; sb = (f32x2){v.z, v.w}; }
  u16* Yd = Y + (size_t)d * R * 1024;
  uint4 lr[4], lrr = make_uint4(0, 0, 0, 0), lrv = make_uint4(0, 0, 0, 0);
  auto gload = [&](int c) {
    const int lt = tid - 256;
#pragma unroll
    for (int i = 0; i < 4; ++i) {
      const int cidx = lt + i * 256, stp = cidx >> 5, off = (cidx & 31) * 8;
      const int posl = c * SCH + stp;
      lr[i] = *(const uint4*)(ring + ((((size_t)(b * 2 + d) * 1024 + posl) * 16 + h) * 256) + off);
    }
    {
      const int stp = lt >> 3, off = (lt & 7) * 8;
      const int row = scan_row(b, d, s * 1024 + c * SCH + stp);
      lrr = *(const uint4*)(P1 + (size_t)row * P1LD + h * 64 + off);
    }
    {
      const int l2 = lt & 63, stp = l2 >> 1, off = (l2 & 1) * 8;
      const int row = scan_row(b, d, s * 1024 + c * SCH + stp);
      lrv = *(const uint4*)(P1 + (size_t)row * P1LD + 2048 + h * 64 + rq * 16 + off);
    }
  };
  auto swrite = [&](int c) {
    const int lt = tid - 256;
    float* bb = buf + (c & 1) * SCH * STEPF;
#pragma unroll
    for (int i = 0; i < 4; ++i) {
      const int cidx = lt + i * 256, stp = cidx >> 5, off = (cidx & 31) * 8;
      const __half2* hp = (const __half2*)&lr[i];
      float2 f0 = __half22float2(hp[0]), f1 = __half22float2(hp[1]), f2 = __half22float2(hp[2]), f3 = __half22float2(hp[3]);
      float* dst = bb + stp * STEPF + off;
      *(float4*)dst = make_float4(f0.x, f0.y, f1.x, f1.y);
      *(float4*)(dst + 4) = make_float4(f2.x, f2.y, f3.x, f3.y);
    }
    {
      const int stp = lt >> 3, off = (lt & 7) * 8;
      float* dst = bb + stp * STEPF + 256 + off;
      *(float4*)dst = make_float4(blo(lrr.x), bhi(lrr.x), blo(lrr.y), bhi(lrr.y));
      *(float4*)(dst + 4) = make_float4(blo(lrr.z), bhi(lrr.z), blo(lrr.w), bhi(lrr.w));
    }
    if (lt < 64) {
      const int stp = lt >> 1, off = (lt & 1) * 8;
      float* dst = bb + stp * STEPF + 320 + off;
      *(float4*)dst = make_float4(blo(lrv.x), bhi(lrv.x), blo(lrv.y), bhi(lrv.y));
      *(float4*)(dst + 4) = make_float4(blo(lrv.z), bhi(lrv.z), blo(lrv.w), bhi(lrv.w));
    }
  };
  if (wave >= 4) { gload(0); swrite(0); if (nch > 1) gload(1); }
  lds_barrier();
  for (int c = 0; c < nch; ++c) {
    if (wave < 4) {
      const float* bb = buf + (c & 1) * SCH * STEPF;
      const int pos0 = s * 1024 + c * SCH;
      const int row0 = scan_row(b, d, pos0), rstep = d ? -1 : 1;
      u16* yp = Yd + (size_t)row0 * 1024 + h * 64 + rq * 16 + rl;
      float4 kk = *(const float4*)(bb + q * 4), wm = *(const float4*)(bb + 64 + q * 4), ka = *(const float4*)(bb + 128 + q * 4);
      float4 kd = *(const float4*)(bb + 192 + q * 4), rr = *(const float4*)(bb + 256 + q * 4);
      float vv = bb[320 + rl];
      float yv[16];
#pragma unroll
      for (int stp = 0; stp < SCH; ++stp) {
        const float* sn = bb + (stp + 1 < SCH ? stp + 1 : stp) * STEPF;
        const float4 kkn = *(const float4*)(sn + q * 4), wmn = *(const float4*)(sn + 64 + q * 4), kan = *(const float4*)(sn + 128 + q * 4);
        const float4 kdn = *(const float4*)(sn + 192 + q * 4), rrn = *(const float4*)(sn + 256 + q * 4);
        const float vvn = sn[320 + rl];
        __builtin_amdgcn_sched_barrier(0);
        const f32x2 vv2 = (f32x2){vv, vv};
        f32x2 ta = sa * (f32x2){wm.x, wm.y} + sa, tb = sb * (f32x2){wm.z, wm.w} + sb;
        ta = vv2 * (f32x2){kd.x, kd.y} + ta; tb = vv2 * (f32x2){kd.z, kd.w} + tb;
        f32x2 ud = sa * (f32x2){kk.x, kk.y}; ud = sb * (f32x2){kk.z, kk.w} + ud;
        float u = ror_add16(ud.x + ud.y);
        const f32x2 nu = (f32x2){-u, -u};
        sa = nu * (f32x2){ka.x, ka.y} + ta; sb = nu * (f32x2){ka.z, ka.w} + tb;
        f32x2 yd2 = sa * (f32x2){rr.x, rr.y}; yd2 = sb * (f32x2){rr.z, rr.w} + yd2;
        yv[stp & 15] = yd2.x + yd2.y;
        if ((stp & 15) == 15) {
          const bool b3 = q & 8, b2 = q & 4, b1 = q & 2, b0 = q & 1;
          float z8[8], z4[4], z2[2];
#pragma unroll
          for (int i = 0; i < 8; ++i) { const float kp = b3 ? yv[i + 8] : yv[i], sd = b3 ? yv[i] : yv[i + 8]; z8[i] = kp + __int_as_float(__builtin_amdgcn_update_dpp(0, __float_as_int(sd), 0x140, 0xf, 0xf, false)); }
#pragma unroll
          for (int i = 0; i < 4; ++i) { const float kp = b2 ? z8[i + 4] : z8[i], sd = b2 ? z8[i] : z8[i + 4]; z4[i] = kp + __int_as_float(__builtin_amdgcn_update_dpp(0, __float_as_int(sd), 0x141, 0xf, 0xf, false)); }
#pragma unroll
          for (int i = 0; i < 2; ++i) { const float kp = b1 ? z4[i + 2] : z4[i], sd = b1 ? z4[i] : z4[i + 2]; z2[i] = kp + __int_as_float(__builtin_amdgcn_update_dpp(0, __float_as_int(sd), 0x1B, 0xf, 0xf, false)); }
          const float kp = b0 ? z2[1] : z2[0], sd = b0 ? z2[0] : z2[1];
          const float yq = kp + __int_as_float(__builtin_amdgcn_update_dpp(0, __float_as_int(sd), 0xB1, 0xf, 0xf, false));
          yp[(ptrdiff_t)((stp & ~15) + q) * rstep * 1024] = f2b(yq);
        }
        kk = kkn; wm = wmn; ka = kan; kd = kdn; rr = rrn; vv = vvn;
      }
    } else {
      if (c + 1 < nch) swrite(c + 1);
      if (c + 2 < nch) gload(c + 2);
    }
    lds_barrier();
  }
  if (wave < 4 && save) *(float4*)(st + ((size_t)blockIdx.x * 256 + tid) * 4) = make_float4(sa.x, sa.y, sb.x, sb.y);
  __syncthreads();
}
DI void ph_rw_finish(const Params& p, int jj, char* smem) {
  const u16* P1 = (const u16*)(p.ws + OFF_SCR);
  const u16* G2T = (const u16*)(p.ws + OFF_WT) + WT_G2T;
  u16* Y0 = (u16*)(p.ws + OFF_SCR) + (size_t)R * P1LD;
  const u16* Y1 = Y0 + (size_t)R * 1024;
  const float* bonus = (const float*)(p.ws + OFF_BONUS);
  const int lane = otid() & 63, wave = otid() >> 6, wr = wave >> 1, wc = wave & 1, fr = lane & 15, fq = lane >> 4;
  for (int it = 0;; ++it) {
    int mt, nt; if (!next_tile(it, 130, 8, 1, mt, nt)) break;
    ALPlain al{P1 + (size_t)mt * 256 * P1LD + 3328, P1LD};
    f32x4 acc[4][4];
    gemm_main3(al, G2T + (size_t)nt * 128 * 128, 128, 128, acc, smem);
    const int h = nt * 2 + wc;
#pragma unroll
    for (int m = 0; m < 4; ++m) {
      const int row = mt * 256 + wr * 64 + m * 16 + fr;
      float y[4][4]; float sm = 0.f;
#pragma unroll
      for (int n = 0; n < 4; ++n) {
        const int c = h * 64 + n * 16 + fq * 4;
        uint2 a = *(const uint2*)(Y0 + (size_t)row * 1024 + c), b2 = *(const uint2*)(Y1 + (size_t)row * 1024 + c);
        y[n][0] = blo(a.x) + blo(b2.x); y[n][1] = bhi(a.x) + bhi(b2.x); y[n][2] = blo(a.y) + blo(b2.y); y[n][3] = bhi(a.y) + bhi(b2.y);
        sm += y[n][0] + y[n][1] + y[n][2] + y[n][3];
      }
      sm += __shfl_xor(sm, 16); sm += __shfl_xor(sm, 32);
      const float mean = sm * (1.f / 64.f);
      float vs = 0.f;
#pragma unroll
      for (int n = 0; n < 4; ++n)
#pragma unroll
        for (int j = 0; j < 4; ++j) { float dlt = y[n][j] - mean; vs += dlt * dlt; }
      vs += __shfl_xor(vs, 16); vs += __shfl_xor(vs, 32);
      const float rs = rsqrtf(vs * (1.f / 64.f) + 64e-5f);
      const float bn = bonus[(size_t)row * 32 + h * 2] + bonus[(size_t)row * 32 + h * 2 + 1];
#pragma unroll
      for (int n = 0; n < 4; ++n) {
        const int c = h * 64 + n * 16 + fq * 4;
        float4 lg = *(const float4*)(p.in[IRLNG] + jj * 1024 + c), lb = *(const float4*)(p.in[IRLNB] + jj * 1024 + c);
        uint2 v2 = *(const uint2*)(P1 + (size_t)row * P1LD + 2048 + c);
        float o0 = ((y[n][0] - mean) * rs * lg.x + lb.x + bn * blo(v2.x)) * acc[m][n][0];
        float o1 = ((y[n][1] - mean) * rs * lg.y + lb.y + bn * bhi(v2.x)) * acc[m][n][1];
        float o2 = ((y[n][2] - mean) * rs * lg.z + lb.z + bn * blo(v2.y)) * acc[m][n][2];
        float o3 = ((y[n][3] - mean) * rs * lg.w + lb.w + bn * bhi(v2.y)) * acc[m][n][3];
        uint2 w; w.x = pack2(o0, o1); w.y = pack2(o2, o3);
        *(uint2*)(Y0 + (size_t)row * 1024 + c) = w;
      }
    }
  }
}

DI void ph_ssd_s1(const Params& p, int jj, char* smem) {
  const u16* H = (const u16*)(p.ws + OFF_H);
  const u16* BT = (const u16*)(p.ws + OFF_WT) + WT_SX;
  u16* XBC = (u16*)(p.ws + OFF_SCR);
  float* DTg = (float*)(p.ws + OFF_DT);
  float* P = (float*)smem;
  const float* cw = p.in[ISCONVW] + (size_t)jj * 3 * 4096;
  const float* cb = p.in[ISCONVB] + (size_t)jj * 4096;
  const int tid = otid(), lane = tid & 63, wave = tid >> 6, wr = wave >> 1, wc = wave & 1, fr = lane & 15, fq = lane >> 4;
  for (int it = 0;; ++it) {
    int mt, nt; if (!next_tile(it, 134, 33, 1, mt, nt)) break;
    const int b = mt / 67, ml = mt - b * 67;
    int rowbase, t0, len;
    if (ml < 2) { rowbase = b * TS; t0 = ml * 254; len = TC; } else { rowbase = b * TS + TC; t0 = (ml - 2) * 254; len = T; }
    ALHalo al{H + (size_t)rowbase * 1024, t0 - 1, len};
    f32x4 acc[4][4];
    gemm_main3(al, BT + (size_t)nt * 128 * 1024, 1024, 1024, acc, smem);
#pragma unroll
    for (int m = 0; m < 4; ++m)
#pragma unroll
      for (int n = 0; n < 4; ++n) *(f32x4*)&P[(wr * 64 + m * 16 + fr) * 132 + wc * 64 + n * 16 + fq * 4] = acc[m][n];
    __syncthreads();
    if (nt < 32) {
      const int col = tid & 127, rg = tid >> 7, ch = nt * 128 + col;
      const float w0 = cw[ch], w1 = cw[4096 + ch], w2 = cw[8192 + ch], bias = cb[ch];
      const int i0 = 1 + rg * 64, i1 = min(i0 + 64, 255);
      float pv = P[(i0 - 1) * 132 + col], cv = P[i0 * 132 + col];
      for (int i = i0; i < i1; ++i) {
        const float nv = P[(i + 1) * 132 + col];
        const float v = w0 * pv + w1 * cv + w2 * nv + bias;
        const int tt = t0 - 1 + i;
        if (tt < len) XBC[(size_t)(rowbase + tt) * 4096 + ch] = f2b(siluf(v));
        pv = cv; cv = nv;
      }
    } else {
      const int col = tid & 63, rg = tid >> 6;
      const int i0 = 1 + rg * 32, i1 = min(i0 + 32, 255);
      for (int i = i0; i < i1; ++i) { const int tt = t0 - 1 + i; if (tt < len) DTg[(size_t)(rowbase + tt) * 64 + col] = P[i * 132 + col]; }
    }
  }
}
DI void ph_ssd_scan(const Params& p, int jj, char* smem) {
  if (blockIdx.x >= 256) return;
  const u16* XBC = (const u16*)(p.ws + OFF_SCR);
  u16* Y = (u16*)(p.ws + OFF_SCR) + (size_t)R * 4096;
  const float* DTg = (const float*)(p.ws + OFF_DT);
  const int tid = otid(), lane = tid & 63, wave = tid >> 6, fr = lane & 15, fq = lane >> 4;
  const int xcd_ = blockIdx.x & 7, slot_ = blockIdx.x >> 3, gid_ = xcd_ * 2 + (slot_ >> 4), mem_ = slot_ & 15;
  const int b = gid_ >> 3, g = gid_ & 7, head = g * 4 + (mem_ >> 2), pq = mem_ & 3;
  constexpr int DIRB = 80896;
  const int xp_ = tid & 15, xj0 = (tid >> 4) & 15;
  float Aneg[2], dtb[2];
#pragma unroll
  for (int d = 0; d < 2; ++d) { Aneg[d] = -__expf(p.in[ISALOG][(jj * 2 + d) * 32 + head]); dtb[d] = p.in[ISDTB][(jj * 2 + d) * 32 + head]; }
  const float Dsk = p.in[ISD][jj * 32 + head];
  f32x4 hst[2] = {(f32x4){0.f, 0.f, 0.f, 0.f}, (f32x4){0.f, 0.f, 0.f, 0.f}};
  uint4 pre[2][5];
  float dtpre[2] = {0.f, 0.f};
  auto gl_raw = [&](int ci, int d, uint4 (&pr)[5], float& dtp) {
    const int r0 = scan_row(b, d, ci * 64), r63 = scan_row(b, d, ci * 64 + 63);
    const int rmin = min(r0, r63);
    const int cc = tid & 31, rrb = tid >> 5;
    const int gcb = cc < 16 ? 2048 + g * 128 + cc * 8 : 3072 + g * 128 + (cc - 16) * 8;
    const u16* src = XBC + (size_t)(rmin + rrb) * 4096 + gcb;
#pragma unroll
    for (int i = 0; i < 4; ++i) pr[i] = *(const uint4*)(src + (size_t)i * 16 * 4096);
    pr[4] = *(const uint4*)(XBC + (size_t)(rmin + ((tid & 127) >> 1)) * 4096 + head * 64 + pq * 16 + (tid & 1) * 8);
    dtp = DTg[(size_t)(r0 + lane * (d ? -1 : 1)) * 64 + d * 32 + head];
  };
  __syncthreads();
  gl_raw(0, 0, pre[0], dtpre[0]);
  gl_raw(0, 1, pre[1], dtpre[1]);
  for (int ci = 0; ci < 260; ++ci) {
    const bool second = ci < 4 ? (ci >= 2) : (ci - 4 >= 128);
    unsigned ypre[2][2];
#pragma unroll
    for (int d = 0; d < 2; ++d) {
      u16* Cs = (u16*)(smem + d * DIRB); u16* Bs = Cs + 64 * 144; u16* BsT = Bs + 64 * 144; u16* Ms = BsT + 128 * 80;
      u16* XdtT = Ms + 64 * 72; u16* XwT = XdtT + 16 * 80; u16* Hs = XwT + 16 * 80;
      float* Xp = (float*)(Hs + 16 * 144); float* dts = Xp + 64 * 16; float* css = dts + 64;
      const int r0 = scan_row(b, d, ci * 64), rstep = d ? -1 : 1;
      {
        int t2 = tid; asm volatile("" : "+v"(t2));
        const int cc = t2 & 31;
#pragma unroll
        for (int i = 0; i < 4; ++i) {
          const int rr = (t2 >> 5) + 16 * i, j = d ? 63 - rr : rr;
          if (cc < 16) {
            *(uint4*)&Bs[j * 144 + cc * 8] = pre[d][i];
            const u16* hv = (const u16*)&pre[d][i];
#pragma unroll
            for (int e = 0; e < 8; ++e) BsT[(cc * 8 + e) * 80 + (j ^ ((cc & 7) << 3))] = hv[e];
          } else *(uint4*)&Cs[j * 144 + (cc - 16) * 8] = pre[d][i];
        }
        if (t2 < 128) {
          const int rr = t2 >> 1, j = d ? 63 - rr : rr;
          const u16* hv = (const u16*)&pre[d][4];
#pragma unroll
          for (int e = 0; e < 8; ++e) Xp[j * 16 + (tid & 1) * 8 + e] = b2f(hv[e]);
        }
      }
      if (wave == d) {
        const float dt = softplusf(dtpre[d] + dtb[d]);
        float a = dt * Aneg[d];
#pragma unroll
        for (int o = 1; o < 64; o <<= 1) { float tv = __shfl_up(a, o); if (lane >= o) a += tv; }
        dts[lane] = dt; css[lane] = a;
      }
#pragma unroll
      for (int e = 0; e < 4; ++e) Hs[(fq * 4 + e) * 144 + wave * 16 + fr] = f2b(hst[d][e]);
#pragma unroll
      for (int e = 0; e < 2; ++e) {
        const u16* yb = Y + (size_t)(r0 + ((wave & 3) * 16 + fq * 4 + 2 * e) * rstep) * 2048 + head * 64 + pq * 16 + fr;
        ypre[d][e] = (unsigned)yb[0] | ((unsigned)yb[(ptrdiff_t)rstep * 2048] << 16);
      }
      __builtin_amdgcn_sched_barrier(0);
    }
    __builtin_amdgcn_sched_barrier(0);
    if (ci + 1 < 260) { gl_raw(ci + 1, 0, pre[0], dtpre[0]); gl_raw(ci + 1, 1, pre[1], dtpre[1]); }
    lds_barrier();
#pragma unroll
    for (int d = 0; d < 2; ++d) {
      u16* Cs = (u16*)(smem + d * DIRB); u16* Bs = Cs + 64 * 144; u16* BsT = Bs + 64 * 144; u16* Ms = BsT + 128 * 80;
      u16* XdtT = Ms + 64 * 72; u16* XwT = XdtT + 16 * 80; u16* Hs = XwT + 16 * 80;
      float* Xp = (float*)(Hs + 16 * 144); float* dts = Xp + 64 * 16; float* css = dts + 64;
      const float cs63 = css[63];
      if (tid < 256) {
#pragma unroll
        for (int i = 0; i < 4; ++i) {
          const int j = xj0 + 16 * i;
          const float xv = Xp[j * 16 + xp_];
          const float dt = dts[j];
          XdtT[xp_ * 80 + j] = f2b(xv * dt);
          XwT[xp_ * 80 + j] = f2b(xv * dt * __expf(cs63 - css[j]));
        }
      }
      const int ib = wave >> 1;
#pragma unroll
      for (int jb2 = 0; jb2 < 2; ++jb2) {
        const int jb = (wave & 1) * 2 + jb2;
        f32x4 acc = (f32x4){0.f, 0.f, 0.f, 0.f};
#pragma unroll
        for (int ks = 0; ks < 4; ++ks) {
          const bf16x8 bfr = *(const bf16x8*)&Bs[(jb * 16 + fr) * 144 + ks * 32 + fq * 8];
          const bf16x8 cfr = *(const bf16x8*)&Cs[(ib * 16 + fr) * 144 + ks * 32 + fq * 8];
          acc = MFMA(bfr, cfr, acc);
        }
        const int i = ib * 16 + fr;
        const float csi = css[i];
        float mv[4];
#pragma unroll
        for (int e = 0; e < 4; ++e) { const int j = jb * 16 + fq * 4 + e; mv[e] = (j <= i) ? acc[e] * __expf(csi - css[j]) : 0.f; }
        uint2 w; w.x = pack2(mv[0], mv[1]); w.y = pack2(mv[2], mv[3]);
        *(uint2*)&Ms[i * 72 + jb * 16 + fq * 4] = w;
      }
      __builtin_amdgcn_sched_barrier(0);
    }
    lds_barrier();
#pragma unroll
    for (int d = 0; d < 2; ++d) {
      u16* Cs = (u16*)(smem + d * DIRB); u16* Bs = Cs + 64 * 144; u16* BsT = Bs + 64 * 144; u16* Ms = BsT + 128 * 80;
      u16* XdtT = Ms + 64 * 72; u16* XwT = XdtT + 16 * 80; u16* Hs = XwT + 16 * 80;
      float* Xp = (float*)(Hs + 16 * 144); float* dts = Xp + 64 * 16; float* css = dts + 64;
      const int r0 = scan_row(b, d, ci * 64), rstep = d ? -1 : 1;
      const float cs63 = css[63];
      if (wave < 4) {
        const int ib = wave;
        f32x4 yd = (f32x4){0.f, 0.f, 0.f, 0.f}, yo = (f32x4){0.f, 0.f, 0.f, 0.f};
#pragma unroll
        for (int ks = 0; ks < 2; ++ks) {
          const bf16x8 mf = *(const bf16x8*)&Ms[(ib * 16 + fr) * 72 + ks * 32 + fq * 8];
          const bf16x8 xf = *(const bf16x8*)&XdtT[fr * 80 + ks * 32 + fq * 8];
          yd = MFMA(mf, xf, yd);
        }
#pragma unroll
        for (int ks = 0; ks < 4; ++ks) {
          const bf16x8 cf = *(const bf16x8*)&Cs[(ib * 16 + fr) * 144 + ks * 32 + fq * 8];
          const bf16x8 hf = *(const bf16x8*)&Hs[fr * 144 + ks * 32 + fq * 8];
          yo = MFMA(cf, hf, yo);
        }
#pragma unroll
        for (int e = 0; e < 4; ++e) {
          const int i = ib * 16 + fq * 4 + e;
          float y = yd[e] + __expf(css[i]) * yo[e];
          u16* ya = Y + (size_t)(r0 + i * rstep) * 2048 + head * 64 + pq * 16 + fr;
          if (second) y += ((e & 1) ? bhi(ypre[d][e >> 1]) : blo(ypre[d][e >> 1])) + Xp[i * 16 + fr] * Dsk;
          *ya = f2b(y);
        }
      }
      {
        const float dec = __expf(cs63);
        hst[d][0] *= dec; hst[d][1] *= dec; hst[d][2] *= dec; hst[d][3] *= dec;
#pragma unroll
        for (int ks = 0; ks < 2; ++ks) {
          const bf16x8 xf = *(const bf16x8*)&XwT[fr * 80 + ks * 32 + fq * 8];
          const bf16x8 bf = *(const bf16x8*)&BsT[(wave * 16 + fr) * 80 + (((ks * 4 + fq) ^ ((wave * 2 + (fr >> 3)) & 7)) << 3)];
          hst[d] = MFMA(xf, bf, hst[d]);
        }
      }
      __builtin_amdgcn_sched_barrier(0);
    }
    if (ci == 1 || ci == 131) asm volatile("s_waitcnt vmcnt(0)" ::: "memory");
    lds_barrier();
  }
}
DI void ph_ssd_s3(const Params& p, char* smem) {
  const u16* H = (const u16*)(p.ws + OFF_H);
  const u16* BT = (const u16*)(p.ws + OFF_WT) + WT_SZ;
  u16* Y = (u16*)(p.ws + OFF_SCR) + (size_t)R * 4096;
  float* ssq = (float*)(p.ws + OFF_SSQ);
  const int lane = otid() & 63, wave = otid() >> 6, wr = wave >> 1, wc = wave & 1, fr = lane & 15, fq = lane >> 4;
  for (int it = 0;; ++it) {
    int mt, nt; if (!next_tile(it, 130, 16, 1, mt, nt)) break;
    ALPlain al{H + (size_t)mt * 256 * 1024, 1024};
    f32x4 acc[4][4];
    gemm_main3(al, BT + (size_t)nt * 128 * 1024, 1024, 1024, acc, smem);
#pragma unroll
    for (int m = 0; m < 4; ++m) {
      const int row = mt * 256 + wr * 64 + m * 16 + fr;
      float sq = 0.f;
#pragma unroll
      for (int n = 0; n < 4; ++n) {
        const int c = nt * 128 + wc * 64 + n * 16 + fq * 4;
        uint2 yv = *(const uint2*)(Y + (size_t)row * 2048 + c);
        const float o0 = blo(yv.x) * siluf(acc[m][n][0]), o1 = bhi(yv.x) * siluf(acc[m][n][1]);
        const float o2 = blo(yv.y) * siluf(acc[m][n][2]), o3 = bhi(yv.y) * siluf(acc[m][n][3]);
        sq += o0 * o0 + o1 * o1 + o2 * o2 + o3 * o3;
        uint2 w; w.x = pack2(o0, o1); w.y = pack2(o2, o3);
        *(uint2*)(Y + (size_t)row * 2048 + c) = w;
      }
      sq += __shfl_xor(sq, 16); sq += __shfl_xor(sq, 32);
      if (fq == 0) atomicAdd(ssq + (size_t)row * 8 + (nt >> 1), sq);
    }
  }
}
struct ALScale {
  const u16* Y; int row0; const float* rsT; const float* ngT;
  DI uint4 operator()(int i, int k) const { return *(const uint4*)(Y + (size_t)(row0 + i) * 2048 + k); }
  DI uint4 post(uint4 c, int i, int k) const {
    const float rs = rsT[i * 8 + (k >> 8)];
    const float4 g0 = *(const float4*)(ngT + k), g1 = *(const float4*)(ngT + k + 4);
    uint4 o;
    o.x = pack2(blo(c.x) * rs * g0.x, bhi(c.x) * rs * g0.y); o.y = pack2(blo(c.y) * rs * g0.z, bhi(c.y) * rs * g0.w);
    o.z = pack2(blo(c.z) * rs * g1.x, bhi(c.z) * rs * g1.y); o.w = pack2(blo(c.w) * rs * g1.z, bhi(c.w) * rs * g1.w);
    return o;
  }
};
DI void ph_ssd_s4(const Params& p, int l, int jj, char* smem) {
  const u16* Y = (const u16*)(p.ws + OFF_SCR) + (size_t)R * 4096;
  const u16* BT = (const u16*)(p.ws + OFF_WT) + WT_SO;
  for (int it = 0;; ++it) {
    int mt, nt; if (!next_tile(it, 130, 8, 1, mt, nt)) break;
    float* rsT = (float*)(smem + 112640); float* ngT = rsT + 2048;
    {
      const float* ssq = (const float*)(p.ws + OFF_SSQ) + (size_t)mt * 256 * 8;
      const float* ng = p.in[ISNG] + jj * 2048;
      for (int e = otid(); e < 2048; e += 512) { rsT[e] = rsqrtf(ssq[e] * (1.f / 256.f) + 1e-6f); ngT[e] = ng[e]; }
    }
    ALScale al{Y, mt * 256, rsT, ngT};
    resid_tile(p, al, BT, 2048, l, 2, mt, nt, smem);
  }
}

DI void ph_at_qkv(const Params& p, char* smem) {
  const u16* H = (const u16*)(p.ws + OFF_H);
  const u16* BT = (const u16*)(p.ws + OFF_WT) + WT_AQ;
  u16* QKV = (u16*)(p.ws + OFF_SCR);
  const int lane = otid() & 63, wave = otid() >> 6, wr = wave >> 1, wc = wave & 1, fr = lane & 15, fq = lane >> 4;
  for (int it = 0;; ++it) {
    int mt, nt; if (!next_tile(it, 130, 12, 1, mt, nt)) break;
    ALPlain al{H + (size_t)mt * 256 * 1024, 1024};
    f32x4 acc[4][4];
    gemm_main3(al, BT + (size_t)nt * 128 * 1024, 1024, 1024, acc, smem);
    const int q0 = (mt * 256) % TS;
    const bool rope = (q0 >= TC) && (nt < 10);
#pragma unroll
    for (int m = 0; m < 4; ++m) {
      const int rl = wr * 64 + m * 16 + fr;
      const int row = mt * 256 + rl;
      if (rope) {
        const int tt = q0 - TC + rl;
        const float prow = (float)(tt >> 6), pcol = (float)(tt & 63);
#pragma unroll
        for (int e = 0; e < 4; ++e) {
          const float inv = exp2f(-13.287712379549449f * (float)(fq * 4 + e) * (1.f / 16.f));
          float sn, cs;
          sincosf(prow * inv, &sn, &cs);
          float x1 = acc[m][0][e], x2 = acc[m][1][e];
          acc[m][0][e] = x1 * cs - x2 * sn; acc[m][1][e] = x1 * sn + x2 * cs;
          sincosf(pcol * inv, &sn, &cs);
          x1 = acc[m][2][e]; x2 = acc[m][3][e];
          acc[m][2][e] = x1 * cs - x2 * sn; acc[m][3][e] = x1 * sn + x2 * cs;
        }
      }
#pragma unroll
      for (int n = 0; n < 4; ++n) {
        const int c = nt * 128 + wc * 64 + n * 16 + fq * 4;
        uint2 w; w.x = pack2(acc[m][n][0], acc[m][n][1]); w.y = pack2(acc[m][n][2], acc[m][n][3]);
        *(uint2*)(QKV + (size_t)row * 1536 + c) = w;
      }
    }
  }
}
DI void ph_attn(const Params& p, int jj, char* smem) {
  const u16* QKV = (const u16*)(p.ws + OFF_SCR);
  u16* O = (u16*)(p.ws + OFF_SCR) + (size_t)R * 1536;
  u16* Ks = (u16*)smem;
  u16* Vt = Ks + 64 * 80;
  u16* Ps = Vt + 64 * 80;
  const int tid = otid(), lane = tid & 63, wave = tid >> 6, fr = lane & 15, fq = lane >> 4;
  const int g = wave >> 1, th = (wave & 1) * 32;
  u16* Pw = Ps + wave * 32 * 80;
  for (int tl = (int)(blockIdx.x >> 3); tl < 260; tl += (int)(gridDim.x >> 3)) {
    const int kvh = blockIdx.x & 3, b = (blockIdx.x >> 2) & 1;
    const int isctx = tl >= 256 ? 1 : 0, qb = isctx ? tl - 256 : tl;
    const int t0 = qb * 64, qrow0 = b * TS + (isctx ? 0 : TC) + t0;
    const int head = kvh * 4 + g;
    bf16x8 qf[2][2];
#pragma unroll
    for (int m = 0; m < 2; ++m)
#pragma unroll
      for (int kh = 0; kh < 2; ++kh) {
        uint4 v = *(const uint4*)(QKV + (size_t)(qrow0 + th + m * 16 + fr) * 1536 + head * 64 + kh * 32 + fq * 8);
        uint4 o;
        o.x = pack2(blo(v.x) * 0.125f, bhi(v.x) * 0.125f); o.y = pack2(blo(v.y) * 0.125f, bhi(v.y) * 0.125f);
        o.z = pack2(blo(v.z) * 0.125f, bhi(v.z) * 0.125f); o.w = pack2(blo(v.w) * 0.125f, bhi(v.w) * 0.125f);
        qf[m][kh] = *(bf16x8*)&o;
      }
    const float sink = p.in[IASINK][jj * 16 + head];
    float mrun[2] = {sink, sink}, lrun[2] = {1.f, 1.f};
    f32x4 o[2][4];
#pragma unroll
    for (int m = 0; m < 2; ++m)
#pragma unroll
      for (int n = 0; n < 4; ++n) o[m][n] = (f32x4){0.f, 0.f, 0.f, 0.f};
    const int i_lo = t0 >= 128 ? 0 : (t0 >= 64 ? 1 : 2);
    const int i_hi = t0 == T - 64 ? 2 : (t0 == T - 128 ? 3 : 4);
    const int nkt = isctx ? 4 : 4 + (i_hi - i_lo + 1);
    const int skey = tid >> 3, sdc = (tid & 7) * 8;
    uint4 kreg, vreg;
    auto kv_load = [&](int idx) {
      int krow0;
      if (idx < 4) krow0 = b * TS + idx * 64; else krow0 = b * TS + TC + t0 - 128 + 64 * (i_lo + idx - 4);
      const u16* src = QKV + (size_t)(krow0 + skey) * 1536 + 1024 + kvh * 64 + sdc;
      kreg = *(const uint4*)src; vreg = *(const uint4*)(src + 256);
    };
    kv_load(0);
    for (int kt = 0; kt < nkt; ++kt) {
      const int li = i_lo + kt - 4;
      const int mode = kt < 4 ? 0 : (li == 0 ? 1 : (li == 4 ? 2 : 0));
      lds_barrier();
      {
        *(uint4*)&Ks[skey * 80 + sdc] = kreg;
        const u16* vv = (const u16*)&vreg;
#pragma unroll
        for (int e = 0; e < 8; ++e) Vt[(sdc + e) * 80 + (skey ^ ((tid & 7) << 3))] = vv[e];
      }
      lds_barrier();
      if (kt + 1 < nkt) kv_load(kt + 1);
      f32x4 sacc[2][4];
#pragma unroll
      for (int m = 0; m < 2; ++m)
#pragma unroll
        for (int n = 0; n < 4; ++n) sacc[m][n] = (f32x4){0.f, 0.f, 0.f, 0.f};
#pragma unroll
      for (int kh = 0; kh < 2; ++kh)
#pragma unroll
        for (int n = 0; n < 4; ++n) {
          const bf16x8 kf = *(const bf16x8*)&Ks[(n * 16 + fr) * 80 + kh * 32 + fq * 8];
#pragma unroll
          for (int m = 0; m < 2; ++m) sacc[m][n] = MFMA(kf, qf[m][kh], sacc[m][n]);
        }
#pragma unroll
      for (int m = 0; m < 2; ++m) {
        const int qi = th + m * 16 + fr;
        float mx = -3.0e38f;
#pragma unroll
        for (int n = 0; n < 4; ++n)
#pragma unroll
          for (int e = 0; e < 4; ++e) {
            const int ki = n * 16 + fq * 4 + e;
            if ((mode == 1 && ki < qi) || (mode == 2 && ki > qi)) sacc[m][n][e] = -INFINITY;
            mx = fmaxf(mx, sacc[m][n][e]);
          }
        mx = fmaxf(mx, __shfl_xor(mx, 16)); mx = fmaxf(mx, __shfl_xor(mx, 32));
        const float mnew = fmaxf(mrun[m], mx);
        const float alpha = __expf(mrun[m] - mnew);
        float ps = 0.f;
#pragma unroll
        for (int n = 0; n < 4; ++n) {
          const float p0 = __expf(sacc[m][n][0] - mnew), p1 = __expf(sacc[m][n][1] - mnew), p2 = __expf(sacc[m][n][2] - mnew), p3 = __expf(sacc[m][n][3] - mnew);
          ps += p0 + p1 + p2 + p3;
          uint2 w; w.x = pack2(p0, p1); w.y = pack2(p2, p3);
          *(uint2*)&Pw[(m * 16 + fr) * 80 + n * 16 + fq * 4] = w;
        }
        ps += __shfl_xor(ps, 16); ps += __shfl_xor(ps, 32);
        lrun[m] = lrun[m] * alpha + ps; mrun[m] = mnew;
#pragma unroll
        for (int n = 0; n < 4; ++n) { o[m][n][0] *= alpha; o[m][n][1] *= alpha; o[m][n][2] *= alpha; o[m][n][3] *= alpha; }
      }
      __builtin_amdgcn_fence(__ATOMIC_RELEASE, "wavefront");
      __builtin_amdgcn_wave_barrier();
      __builtin_amdgcn_fence(__ATOMIC_ACQUIRE, "wavefront");
#pragma unroll
      for (int ks = 0; ks < 2; ++ks) {
        bf16x8 pf[2];
#pragma unroll
        for (int m = 0; m < 2; ++m) pf[m] = *(const bf16x8*)&Pw[(m * 16 + fr) * 80 + ks * 32 + fq * 8];
#pragma unroll
        for (int nd = 0; nd < 4; ++nd) {
          const bf16x8 vf = *(const bf16x8*)&Vt[(nd * 16 + fr) * 80 + (((ks * 4 + fq) ^ ((nd * 2 + (fr >> 3)) & 7)) << 3)];
#pragma unroll
          for (int m = 0; m < 2; ++m) o[m][nd] = MFMA(vf, pf[m], o[m][nd]);
        }
      }
    }
#pragma unroll
    for (int m = 0; m < 2; ++m) {
      const float il = 1.f / lrun[m];
      const int row = qrow0 + th + m * 16 + fr;
#pragma unroll
      for (int nd = 0; nd < 4; ++nd) {
        uint2 w; w.x = pack2(o[m][nd][0] * il, o[m][nd][1] * il); w.y = pack2(o[m][nd][2] * il, o[m][nd][3] * il);
        *(uint2*)(O + (size_t)row * 1024 + head * 64 + nd * 16 + fq * 4) = w;
      }
    }
  }
}

#define DBL_A 0
#define DBL_B 0
#define DBL_C 0
#define DBL_D 0
#define DBL_E 0
DI int layer_phases(int l) { int k = l % 3; return k == 0 ? 25 : (k == 1 ? 8 : 7); }
constexpr int N_PHASES = 2 + 25 + 8 + 7 + 25 + 1;

DI void run_phase(const Params& p, int ph, char* smem) {
  if (ph == 0) { ph_prologue(p, smem); ph_convert(p, 0, smem); return; }
  if (ph == 1) { ph_modreduce(p); return; }
  int q = ph - 2, l = 0;
  while (l < 4 && q >= layer_phases(l)) { q -= layer_phases(l); ++l; }
  if (l == 4) { ph_final(p); return; }
  const int kind = l % 3, jj = l / 3;
  const int np = layer_phases(l);
  const u16* wt = (const u16*)(p.ws + OFF_WT);
  if (q == 0) { ph_norm(p, l, 0); if (l > 0) ph_convert(p, l, smem); return; }
  if (q == np - 3) { ph_norm(p, l, 1); return; }
  if (q == np - 2) { ph_ffn1(p, l, smem);
#if DBL_A
    ph_ffn1(p, l, smem);
#endif
    return; }
  if (q == np - 1) { ph_resid_gemm(p, (const u16*)(p.ws + OFF_SCR), FF, wt + WT_W2T, FF, l, 5, smem); return; }
  if (kind == 0) {
    if (q == 1) { ph_rw_r1(p, jj, smem);
#if DBL_A
    ph_rw_r1(p, jj, smem);
#endif
    return; }
    if (q >= 2 && q <= 19) { int s = q - 2; if (s >= 1) {
#if DBL_D
      ph_rw_scan(p, s - 1, smem, false);
#endif
      ph_rw_scan(p, s - 1, smem); }
      if (s < 17) { ph_rw_produce(p, jj, s, smem);
#if DBL_E
      ph_rw_produce(p, jj, s, smem);
#endif
      } return; }
    if (q == 20) { ph_rw_finish(p, jj, smem); return; }
    if (q == 21) { ph_resid_gemm(p, (const u16*)(p.ws + OFF_SCR) + (size_t)R * P1LD, 1024, wt + WT_RWO, 1024, l, 2, smem); return; }
  } else if (kind == 1) {
    if (q == 1) { ph_ssd_s1(p, jj, smem); return; }
    if (q == 2) { ph_ssd_scan(p, jj, smem);
#if DBL_B
    ph_ssd_scan(p, jj, smem);
#endif
    return; }
    if (q == 3) { ph_ssd_s3(p, smem); return; }
    if (q == 4) { ph_ssd_s4(p, l, jj, smem); return; }
  } else {
    if (q == 1) { ph_at_qkv(p, smem);
#if DBL_A
    ph_at_qkv(p, smem);
#endif
    return; }
    if (q == 2) { ph_attn(p, jj, smem);
#if DBL_C
    ph_attn(p, jj, smem);
#endif
    return; }
    if (q == 3) { ph_resid_gemm(p, (const u16*)(p.ws + OFF_SCR) + (size_t)R * 1536, 1024, wt + WT_AO, 1024, l, 2, smem); return; }
  }
}

extern "C" __global__ void __launch_bounds__(512) mega(Params p, int ph_lo, int ph_hi) {
  extern __shared__ __attribute__((aligned(16))) char smem[];
  cg::grid_group grid = cg::this_grid();
#ifndef PROBE
#define PROBE 0
#endif
#if PROBE
  unsigned long long* tsb = (unsigned long long*)(p.ws + OFF_MODP);
#endif
  __shared__ uint4 xb_words;
  if (threadIdx.x == 0) xb_words = make_uint4(0u, 0u, 0u, 0u);
  __syncthreads();
  XcdBarrier xb = xcd_barrier_post((unsigned*)(p.ws + OFF_BAR), (volatile LAS unsigned*)&xb_words);
  for (int ph = ph_lo; ph < ph_hi; ++ph) {
    run_phase(p, ph, smem);
    if (ph + 1 < ph_hi) { if (ph == ph_lo) grid.sync(); else xcd_barrier(xb); }
  }
#if PROBE
  grid.sync();
  if (blockIdx.x == 0) {
    const float t1 = (float)(tsb[PA1] - tsb[PA0]) * 1e-5f, t2 = (float)(tsb[PB1] - tsb[PB0]) * 1e-5f;
    for (int i = threadIdx.x; i < (1 << 23); i += 512) p.out[i] = t2;
    __syncthreads();
    if (threadIdx.x == 0) p.out[0] = 64.f * t1;
  }
#endif
}

extern "C" void kernel_launch(void* const* d_in, const int* in_sizes, int n_in, void* d_out, int out_size, void* d_ws, size_t ws_size, hipStream_t stream) {
  Params p{};
  for (int i = 0; i < 41; ++i) p.in[i] = (const float*)d_in[i];
  p.out = (float*)d_out; p.ws = (char*)d_ws;
  constexpr size_t kLds = 162048;
  hipFuncSetAttribute((const void*)mega, hipFuncAttributeMaxDynamicSharedMemorySize, (int)kLds);
  hipMemsetAsync((char*)d_ws + OFF_BAR, 0, XCD_BAR_WORDS * 4, stream);
  int lo = 0, hi = N_PHASES;
  void* args[] = {&p, &lo, &hi};
  hipError_t e = hipLaunchCooperativeKernel((void*)mega, dim3(256), dim3(512), args, kLds, stream);
  if (e != hipSuccess) fprintf(stderr, "coop launch failed: %s\n", hipGetErrorString(e));
}
```

```cpp
#include <hip/hip_runtime.h>
#include <hip/hip_cooperative_groups.h>
#include <hip/hip_fp16.h>
#include <cstdio>
namespace cg = cooperative_groups;

typedef unsigned short u16;
typedef short bf16x8 __attribute__((ext_vector_type(8)));
typedef float f32x4 __attribute__((ext_vector_type(4)));
typedef float f32x2 __attribute__((ext_vector_type(2)));
#define MFMA(a, b, c) __builtin_amdgcn_mfma_f32_16x16x32_bf16(a, b, c, 0, 0, 0)
#define DI __device__ __forceinline__

constexpr int D = 1024, NBAT = 2, T = 16384, TC = 256, TS = T + TC, R = NBAT * TS, FF = 2816;
enum { IX = 0, IC, ICTX, ICC, IADAW, IADAB, IN1, IN2, IFWIN, IFCONV, IFWOUT, IFINAL, IRMU, IRWR, IRWK, IRWV, IRWO, IRW0, IRW1, IRW2, IRA0, IRA1,
       IRA2, IRG1, IRG2, IRKK, IRKA, IRRK, IRLNG, IRLNB, ISWIN, ISCONVW, ISCONVB, ISDTB, ISALOG, ISD, ISNG, ISWOUT, IAQKV, IAWO, IASINK };

__device__ __forceinline__ unsigned long long rfl64(unsigned long long v) {
  unsigned lo = __builtin_amdgcn_readfirstlane((unsigned)v), hi = __builtin_amdgcn_readfirstlane((unsigned)(v >> 32));
  return ((unsigned long long)hi << 32) | lo;
}
struct Params {
  const float* in[41]; float* out; char* ws;
  __device__ __forceinline__ const float* inp(int i) const { return (const float*)rfl64((unsigned long long)in[i]); }
  __device__ __forceinline__ float* outp() const { return (float*)rfl64((unsigned long long)out); }
  __device__ __forceinline__ char* wsp() const { return (char*)rfl64((unsigned long long)ws); }
};

constexpr size_t alup(size_t x) { return (x + 255) & ~(size_t)255; }
constexpr size_t OFF_XC = 0;
constexpr size_t OFF_BAR = OFF_XC + alup((size_t)512 * 1024 * 4);
constexpr size_t OFF_MODP = OFF_BAR + 16384;
constexpr size_t OFF_MOD = OFF_MODP + alup((size_t)16 * 4 * 3 * 6144 * 4);
constexpr size_t OFF_SSQ = OFF_MOD + alup((size_t)4 * 3 * 6144 * 4);
constexpr size_t OFF_DT = OFF_SSQ + alup((size_t)R * 8 * 4);
constexpr size_t OFF_BONUS = OFF_DT;
constexpr size_t OFF_RWST = OFF_DT + alup((size_t)R * 64 * 4);
constexpr size_t OFF_H = OFF_RWST + alup((size_t)256 * 256 * 4 * 4);
constexpr size_t OFF_RING = OFF_H;
constexpr size_t OFF_WT = OFF_H + alup((size_t)R * 1024 * 2);
constexpr size_t WT_ELEMS = 17170432;
constexpr size_t OFF_SCR = OFF_WT + alup(WT_ELEMS * 2);
constexpr size_t SCR_BYTES = (size_t)R * 4096 * 2 + (size_t)R * 2048 * 2;
static_assert(OFF_SCR + SCR_BYTES <= (size_t)536870912, "workspace too large");
constexpr size_t WT_W1T = 0, WT_W2T = (size_t)5632 * 1024, WT_MIX = WT_W2T + (size_t)1024 * 2816;
constexpr size_t WT_R1T = WT_MIX, WT_LUT = WT_R1T + (size_t)3456 * 1024, WT_G2T = WT_LUT + (size_t)2 * 16 * 128 * 128, WT_RWO = WT_G2T + (size_t)1024 * 128;
constexpr size_t WT_SX = WT_MIX, WT_SZ = WT_SX + (size_t)4224 * 1024, WT_SO = WT_SZ + (size_t)2048 * 1024;
constexpr size_t WT_AQ = WT_MIX, WT_AO = WT_AQ + (size_t)1536 * 1024;
static_assert(WT_SO + (size_t)1024 * 2048 <= WT_ELEMS, "wt");
static_assert((size_t)2 * 2 * 2 * 1024 * 16 * 512 <= (size_t)R * 1024 * 2, "ring");

DI u16 f2b(float f) { unsigned u = __float_as_uint(f); u += 0x7fffu + ((u >> 16) & 1u); return (u16)(u >> 16); }
DI float b2f(u16 h) { return __uint_as_float(((unsigned)h) << 16); }
DI unsigned pack2(float a, float b) { return (unsigned)f2b(a) | ((unsigned)f2b(b) << 16); }
DI float blo(unsigned u) { return __uint_as_float(u << 16); }
DI float bhi(unsigned u) { return __uint_as_float(u & 0xffff0000u); }
DI float siluf(float x) { return x / (1.f + __expf(-x)); }
DI float sigmf(float x) { return 1.f / (1.f + __expf(-x)); }
DI float softplusf(float x) { return x > 20.f ? x : log1pf(__expf(x)); }
DI int otid() { int t = threadIdx.x; asm volatile("" : "+v"(t)); return t; }
DI void lds_barrier() { asm volatile("s_waitcnt lgkmcnt(0)\n\ts_barrier" ::: "memory"); }
DI f32x4 gload_f4(const float* p) { f32x4 v; asm volatile("global_load_dwordx4 %0, %1, off" : "=v"(v) : "v"(p) : "memory"); return v; }
DI void vm_wait0() { asm volatile("s_waitcnt vmcnt(0)" ::: "memory"); }
DI float wsum(float v) { for (int o = 32; o; o >>= 1) v += __shfl_xor(v, o); return v; }
DI float* xrow_ptr(const Params& p, int r) {
  int b = r / TS, q = r - b * TS;
  return q < TC ? (float*)(p.ws + OFF_XC) + ((size_t)(b * TC + q) << 10) : p.out + ((size_t)(b * T + q - TC) << 10);
}
DI const float* mod_ptr(const Params& p, int l, int r) {
  int b = r / TS, q = r - b * TS;
  int v = q < TC ? 2 : b;
  return (const float*)(p.ws + OFF_MOD) + (size_t)(l * 3 + v) * 6144;
}


#define XB_TMO      128
#define XB_XCNT(j)  (256  + 64 * (j))
#define XB_XSUB(j)  (1280 + 64 * (j))
#define XB_XGEN(j)  (2304 + 64 * (j))
#define XB_TOP      3328
#define XB_TOPGEN   3392
#define XCD_BAR_WORDS 3456
#define XB_SPIN_CAP (1u << 18)
#define LAS __attribute__((address_space(3)))
DI unsigned xb_ld(unsigned* p) { return __hip_atomic_load(p, __ATOMIC_RELAXED, __HIP_MEMORY_SCOPE_AGENT); }
DI unsigned xb_add(unsigned* p, unsigned v) { return __hip_atomic_fetch_add(p, v, __ATOMIC_RELAXED, __HIP_MEMORY_SCOPE_AGENT); }
DI unsigned xb_xcc_id() { return (unsigned)__builtin_amdgcn_s_getreg((3 << 11) | 20) & 0xFu; }
#define XB_SPIN(cond, bar) do { unsigned _sp = 0; while (cond) { __builtin_amdgcn_s_sleep(1); \
    if ((++_sp & 255u) == 0u) { if (xb_ld(&(bar)[XB_TMO])) break; if (_sp > XB_SPIN_CAP) { atomicAdd(&(bar)[XB_TMO], 1u); break; } } } } while (0)
struct XcdBarrier { unsigned* bar; unsigned x; volatile LAS unsigned* st; };
DI XcdBarrier xcd_barrier_post(unsigned* bar, volatile LAS unsigned* st) {
  XcdBarrier b; b.bar = bar; b.x = xb_xcc_id(); b.st = st;
  if (threadIdx.x == 0) (void)xb_add(&bar[XB_XCNT(b.x)], 1u);
  return b;
}
DI void xcd_barrier_complete(unsigned* bar, unsigned x, unsigned& nloc, unsigned& nx) {
  const unsigned G = gridDim.x * gridDim.y * gridDim.z;
  unsigned sum, cnt, mine, sp = 0u;
  for (;;) {
    sum = 0u; cnt = 0u; mine = 0u;
#pragma unroll
    for (unsigned j = 0; j < 16; ++j) { const unsigned c = xb_ld(&bar[XB_XCNT(j)]); sum += c; cnt += (c > 0u) ? 1u : 0u; mine = (j == x) ? c : mine; }
    if (sum == G) break;
    __builtin_amdgcn_s_sleep(1);
    if ((++sp & 255u) == 0u) { if (xb_ld(&bar[XB_TMO])) break; if (sp > XB_SPIN_CAP) { atomicAdd(&bar[XB_TMO], 1u); break; } }
  }
  nloc = mine > 0u ? mine : 1u; nx = cnt > 0u ? cnt : 1u;
}
DI void xcd_barrier(const XcdBarrier& b) {
  asm volatile("s_waitcnt vmcnt(0)" ::: "memory");
  __syncthreads();
  if (threadIdx.x == 0) {
    unsigned* bar = b.bar;
    __builtin_amdgcn_s_waitcnt(0);
    unsigned nloc = b.st[0], nx = b.st[1];
    if (nloc == 0u) { xcd_barrier_complete(bar, b.x, nloc, nx); b.st[0] = nloc; b.st[1] = nx; }
    const unsigned old = xb_add(&bar[XB_XSUB(b.x)], 1u);
    const unsigned gen = old / nloc;
    if (old + 1u == (gen + 1u) * nloc) {
      __builtin_amdgcn_fence(__ATOMIC_RELEASE, "agent");
      asm volatile("s_waitcnt vmcnt(0)" ::: "memory");
      const unsigned og = xb_add(&bar[XB_TOP], 1u);
      const unsigned tg = og / nx;
      if (og + 1u == (tg + 1u) * nx) xb_add(&bar[XB_TOPGEN], 1u);
      else XB_SPIN(xb_ld(&bar[XB_TOPGEN]) == tg, bar);
      __builtin_amdgcn_fence(__ATOMIC_ACQUIRE, "agent");
      xb_add(&bar[XB_XGEN(b.x)], 1u);
      asm volatile("s_waitcnt vmcnt(0)" ::: "memory");
    } else {
      XB_SPIN(xb_ld(&bar[XB_XGEN(b.x)]) == gen, bar);
      __builtin_amdgcn_fence(__ATOMIC_ACQUIRE, "agent");
      asm volatile("s_waitcnt vmcnt(0)" ::: "memory");
    }
  }
  __syncthreads();
}

constexpr int LDS_ROW = 64;
struct SmemG { u16 A[2][256 * LDS_ROW]; u16 B[2][128 * LDS_ROW]; };
template <class AL>
DI void gemm_main(const AL& al, const u16* __restrict__ Bt, int ldb, int K, f32x4 (&acc)[4][4], char* smem) {
  SmemG& s = *(SmemG*)smem;
  const int tid = otid(), lane = tid & 63, wave = tid >> 6, wr = wave >> 1, wc = wave & 1, fr = lane & 15, fq = lane >> 4;
#pragma unroll
  for (int m = 0; m < 4; ++m)
#pragma unroll
    for (int n = 0; n < 4; ++n) acc[m][n] = (f32x4){0.f, 0.f, 0.f, 0.f};
  uint4 ra[4], rb[2];
  const int nk = K >> 6;
  const int lrow = tid >> 3, lkc = (tid & 7) * 8, lsw = ((tid & 7) ^ (lrow & 7)) * 8;
  __syncthreads();
#pragma unroll
  for (int i = 0; i < 4; ++i) ra[i] = al(lrow + i * 64, lkc);
#pragma unroll
  for (int i = 0; i < 2; ++i) rb[i] = *(const uint4*)(Bt + (size_t)(lrow + i * 64) * ldb + lkc);
#pragma unroll
  for (int i = 0; i < 4; ++i) *(uint4*)&s.A[0][(lrow + i * 64) * LDS_ROW + lsw] = al.post(ra[i], lrow + i * 64, lkc);
#pragma unroll
  for (int i = 0; i < 2; ++i) *(uint4*)&s.B[0][(lrow + i * 64) * LDS_ROW + lsw] = rb[i];
  __syncthreads();
  for (int kt = 0; kt < nk; ++kt) {
    const int buf = kt & 1;
    const int kn = (kt + 1 < nk ? kt + 1 : kt) * 64 + lkc;
#pragma unroll
    for (int i = 0; i < 2; ++i) {
      const u16* bp = Bt + (size_t)(lrow + i * 64) * ldb + kn;
      asm volatile("global_load_dwordx4 %0, %1, off" : "=v"(rb[i]) : "v"(bp) : "memory");
    }
#pragma unroll
    for (int i = 0; i < 4; ++i) ra[i] = al(lrow + i * 64, kn);
    __builtin_amdgcn_sched_barrier(0);
#pragma unroll
    for (int kh = 0; kh < 2; ++kh) {
      bf16x8 a[4], b[4];
#pragma unroll
      for (int m = 0; m < 4; ++m) a[m] = *(const bf16x8*)&s.A[buf][(wr * 64 + m * 16 + fr) * LDS_ROW + (((kh * 4 + fq) ^ (fr & 7)) << 3)];
#pragma unroll
      for (int n = 0; n < 4; ++n) b[n] = *(const bf16x8*)&s.B[buf][(wc * 64 + n * 16 + fr) * LDS_ROW + (((kh * 4 + fq) ^ (fr & 7)) << 3)];
      __builtin_amdgcn_s_setprio(1);
#pragma unroll
      for (int m = 0; m < 4; ++m)
#pragma unroll
        for (int n = 0; n < 4; ++n) acc[m][n] = MFMA(b[n], a[m], acc[m][n]);
      __builtin_amdgcn_s_setprio(0);
    }
    asm volatile("s_waitcnt vmcnt(0)" ::: "memory");
#pragma unroll
    for (int i = 0; i < 4; ++i) *(uint4*)&s.A[buf ^ 1][(lrow + i * 64) * LDS_ROW + lsw] = al.post(ra[i], lrow + i * 64, kn);
#pragma unroll
    for (int i = 0; i < 2; ++i) *(uint4*)&s.B[buf ^ 1][(lrow + i * 64) * LDS_ROW + lsw] = rb[i];
    __syncthreads();
  }
}

template <class AL>
DI void gemm_main3(const AL& al, const u16* __restrict__ Bt, int ldb, int K, f32x4 (&acc)[4][4], char* smem) {
  SmemG& s = *(SmemG*)smem;
  const int tid = otid(), lane = tid & 63, wave = tid >> 6, wr = wave >> 1, wc = wave & 1, fr = lane & 15, fq = lane >> 4;
  const bool grpY = __builtin_amdgcn_readfirstlane(wave) >= 4;
#pragma unroll
  for (int m = 0; m < 4; ++m)
#pragma unroll
    for (int n = 0; n < 4; ++n) acc[m][n] = (f32x4){0.f, 0.f, 0.f, 0.f};
  uint4 ra[4], rb[2];
  const int nk = K >> 6;
  const int lrow = tid >> 3, lkc = (tid & 7) * 8, lsw = ((tid & 7) ^ (lrow & 7)) * 8;
  __syncthreads();
#pragma unroll
  for (int i = 0; i < 4; ++i) ra[i] = al(lrow + i * 64, lkc);
#pragma unroll
  for (int i = 0; i < 2; ++i) rb[i] = *(const uint4*)(Bt + (size_t)(lrow + i * 64) * ldb + lkc);
#pragma unroll
  for (int i = 0; i < 4; ++i) *(uint4*)&s.A[0][(lrow + i * 64) * LDS_ROW + lsw] = al.post(ra[i], lrow + i * 64, lkc);
#pragma unroll
  for (int i = 0; i < 2; ++i) *(uint4*)&s.B[0][(lrow + i * 64) * LDS_ROW + lsw] = rb[i];
  __syncthreads();
  const u16* abase = &s.A[0][(wr * 64 + fr) * LDS_ROW];
  const u16* bbase = &s.B[0][(wc * 64 + fr) * LDS_ROW];
  bf16x8 fa[4], fb[4];
#define G3_RD(BUF, KH) do { \
    _Pragma("unroll") for (int m = 0; m < 4; ++m) fa[m] = *(const bf16x8*)(abase + (BUF) * 256 * LDS_ROW + m * 16 * LDS_ROW + ((((KH) * 4 + fq) ^ (fr & 7)) << 3)); \
    _Pragma("unroll") for (int n = 0; n < 4; ++n) fb[n] = *(const bf16x8*)(bbase + (BUF) * 128 * LDS_ROW + n * 16 * LDS_ROW + ((((KH) * 4 + fq) ^ (fr & 7)) << 3)); } while (0)
#define G3_MM() do { \
    _Pragma("unroll") for (int m = 0; m < 4; ++m) _Pragma("unroll") for (int n = 0; n < 4; ++n) acc[m][n] = MFMA(fb[n], fa[m], acc[m][n]); } while (0)
  int kn = (1 < nk ? 1 : 0) * 64 + lkc;
#pragma unroll
  for (int i = 0; i < 2; ++i) {
    const u16* bp = Bt + (size_t)(lrow + i * 64) * ldb + kn;
    asm volatile("global_load_dwordx4 %0, %1, off" : "=v"(rb[i]) : "v"(bp) : "memory");
  }
#pragma unroll
  for (int i = 0; i < 4; ++i) ra[i] = al(lrow + i * 64, kn);
  if (grpY) G3_RD(0, 0);
  __builtin_amdgcn_sched_barrier(0);
  for (int kt = 0; kt < nk; ++kt) {
    const int buf = kt & 1;
    if (!grpY) G3_RD(buf, 0);
    __builtin_amdgcn_sched_barrier(0);
    G3_MM();
    __builtin_amdgcn_sched_barrier(0);
    if (grpY) G3_RD(buf, 1);
    __builtin_amdgcn_sched_barrier(0);
    asm volatile("s_waitcnt vmcnt(0)" ::: "memory");
#pragma unroll
    for (int i = 0; i < 4; ++i) *(uint4*)&s.A[buf ^ 1][(lrow + i * 64) * LDS_ROW + lsw] = al.post(ra[i], lrow + i * 64, kn);
#pragma unroll
    for (int i = 0; i < 2; ++i) *(uint4*)&s.B[buf ^ 1][(lrow + i * 64) * LDS_ROW + lsw] = rb[i];
    if (kt + 2 < nk) {
      kn = (kt + 2) * 64 + lkc;
#pragma unroll
      for (int i = 0; i < 2; ++i) {
        const u16* bp = Bt + (size_t)(lrow + i * 64) * ldb + kn;
        asm volatile("global_load_dwordx4 %0, %1, off" : "=v"(rb[i]) : "v"(bp) : "memory");
      }
#pragma unroll
      for (int i = 0; i < 4; ++i) ra[i] = al(lrow + i * 64, kn);
    }
    __builtin_amdgcn_sched_barrier(0);
    lds_barrier();
    if (!grpY) G3_RD(buf, 1);
    __builtin_amdgcn_sched_barrier(0);
    G3_MM();
    __builtin_amdgcn_sched_barrier(0);
    if (grpY) G3_RD(buf ^ 1, 0);
    __builtin_amdgcn_sched_barrier(0);
    lds_barrier();
  }
  asm volatile("s_waitcnt vmcnt(0)" ::: "memory");
  __syncthreads();
}

template <class AL>
DI void gemm_main4(const AL& al, const u16* __restrict__ Bt, int ldb, int K, f32x4 (&acc)[4][4], char* smem) {
  SmemG& s = *(SmemG*)smem;
  const int tid = otid(), lane = tid & 63, wave = tid >> 6, wr = wave >> 1, wc = wave & 1, fr = lane & 15, fq = lane >> 4;
#pragma unroll
  for (int m = 0; m < 4; ++m)
#pragma unroll
    for (int n = 0; n < 4; ++n) acc[m][n] = (f32x4){0.f, 0.f, 0.f, 0.f};
  uint4 a0[4], a1[4], b00, b01, b10, b11;
  const int nk = K >> 6;
  const int lrow = tid >> 3, lkc = (tid & 7) * 8, lsw = ((tid & 7) ^ (lrow & 7)) * 8;
  __syncthreads();
#pragma unroll
  for (int i = 0; i < 4; ++i) a0[i] = al(lrow + i * 64, lkc);
#pragma unroll
  for (int i = 0; i < 1; ++i) { b00 = *(const uint4*)(Bt + (size_t)lrow * ldb + lkc); b01 = *(const uint4*)(Bt + (size_t)(lrow + 64) * ldb + lkc); }
#pragma unroll
  for (int i = 0; i < 4; ++i) *(uint4*)&s.A[0][(lrow + i * 64) * LDS_ROW + lsw] = al.post(a0[i], lrow + i * 64, lkc);
#pragma unroll
  for (int i = 0; i < 1; ++i) { *(uint4*)&s.B[0][lrow * LDS_ROW + lsw] = b00; *(uint4*)&s.B[0][(lrow + 64) * LDS_ROW + lsw] = b01; }
  __syncthreads();
  auto g4_load = [&](uint4 (&RA)[4], uint4& RB0, uint4& RB1, int KN) {
#pragma unroll
    for (int i = 0; i < 4; ++i) RA[i] = al(lrow + i * 64, KN);
    RB0 = *(const uint4*)(Bt + (size_t)lrow * ldb + KN);
    RB1 = *(const uint4*)(Bt + (size_t)(lrow + 64) * ldb + KN);
  };
  auto g4_store = [&](uint4 (&RA)[4], uint4& RB0, uint4& RB1, int BUF, int KN) {
#pragma unroll
    for (int i = 0; i < 4; ++i) *(uint4*)&s.A[BUF][(lrow + i * 64) * LDS_ROW + lsw] = al.post(RA[i], lrow + i * 64, KN);
    *(uint4*)&s.B[BUF][lrow * LDS_ROW + lsw] = RB0;
    *(uint4*)&s.B[BUF][(lrow + 64) * LDS_ROW + lsw] = RB1;
  };
#define G4_COMPUTE(BUF) do { \
    _Pragma("unroll") for (int kh = 0; kh < 2; ++kh) { \
      bf16x8 a[4], b[4]; \
      _Pragma("unroll") for (int m = 0; m < 4; ++m) a[m] = *(const bf16x8*)&s.A[BUF][(wr * 64 + m * 16 + fr) * LDS_ROW + (((kh * 4 + fq) ^ (fr & 7)) << 3)]; \
      _Pragma("unroll") for (int n = 0; n < 4; ++n) b[n] = *(const bf16x8*)&s.B[BUF][(wc * 64 + n * 16 + fr) * LDS_ROW + (((kh * 4 + fq) ^ (fr & 7)) << 3)]; \
      __builtin_amdgcn_s_setprio(1); \
      _Pragma("unroll") for (int m = 0; m < 4; ++m) _Pragma("unroll") for (int n = 0; n < 4; ++n) acc[m][n] = MFMA(b[n], a[m], acc[m][n]); \
      __builtin_amdgcn_s_setprio(0); } } while (0)
  int k1 = 64 + lkc, k2 = (2 < nk ? 2 : nk - 1) * 64 + lkc;
  g4_load(a0, b00, b01, k1);
  g4_load(a1, b10, b11, k2);
  __builtin_amdgcn_sched_barrier(0);
  for (int kt = 0; kt < nk; kt += 2) {
    G4_COMPUTE(0);
    __builtin_amdgcn_sched_barrier(0);
    g4_store(a0, b00, b01, 1, k1);
    k1 = (kt + 3 < nk ? kt + 3 : nk - 1) * 64 + lkc;
    g4_load(a0, b00, b01, k1);
    __builtin_amdgcn_sched_barrier(0);
    __syncthreads();
    G4_COMPUTE(1);
    __builtin_amdgcn_sched_barrier(0);
    g4_store(a1, b10, b11, 0, k2);
    k2 = (kt + 4 < nk ? kt + 4 : nk - 1) * 64 + lkc;
    g4_load(a1, b10, b11, k2);
    __builtin_amdgcn_sched_barrier(0);
    __syncthreads();
  }
}


struct SmemG2 { u16 A[2][256 * LDS_ROW]; u16 B[2][256 * LDS_ROW]; };
template <class AL>
DI void gemm_main2(const AL& al, const u16* __restrict__ Bt, int ldb, int K, f32x4 (&acc)[4][8], char* smem) {
  SmemG2& s = *(SmemG2*)smem;
  const int tid = otid(), lane = tid & 63, wave = tid >> 6, wr = wave >> 1, wc = wave & 1, fr = lane & 15, fq = lane >> 4;
#pragma unroll
  for (int m = 0; m < 4; ++m)
#pragma unroll
    for (int n = 0; n < 8; ++n) acc[m][n] = (f32x4){0.f, 0.f, 0.f, 0.f};
  uint4 ra[4], rb[4];
  const int nk = K >> 6;
  const int lrow = tid >> 3, lkc = (tid & 7) * 8, lsw = ((tid & 7) ^ (lrow & 7)) * 8;
  __syncthreads();
#pragma unroll
  for (int i = 0; i < 4; ++i) ra[i] = al(lrow + i * 64, lkc);
#pragma unroll
  for (int i = 0; i < 4; ++i) rb[i] = *(const uint4*)(Bt + (size_t)(lrow + i * 64) * ldb + lkc);
#pragma unroll
  for (int i = 0; i < 4; ++i) *(uint4*)&s.A[0][(lrow + i * 64) * LDS_ROW + lsw] = al.post(ra[i], lrow + i * 64, lkc);
#pragma unroll
  for (int i = 0; i < 4; ++i) *(uint4*)&s.B[0][(lrow + i * 64) * LDS_ROW + lsw] = rb[i];
  __syncthreads();
  for (int kt = 0; kt < nk; ++kt) {
    const int buf = kt & 1;
    const int kn = (kt + 1 < nk ? kt + 1 : kt) * 64 + lkc;
#pragma unroll
    for (int i = 0; i < 4; ++i) ra[i] = al(lrow + i * 64, kn);
    __builtin_amdgcn_sched_barrier(0);
#pragma unroll
    for (int kh = 0; kh < 2; ++kh) {
      bf16x8 a[4];
#pragma unroll
      for (int m = 0; m < 4; ++m) a[m] = *(const bf16x8*)&s.A[buf][(wr * 64 + m * 16 + fr) * LDS_ROW + (((kh * 4 + fq) ^ (fr & 7)) << 3)];
      bf16x8 bc = *(const bf16x8*)&s.B[buf][(wc * 128 + fr) * LDS_ROW + (((kh * 4 + fq) ^ (fr & 7)) << 3)];
#pragma unroll
      for (int n = 0; n < 8; ++n) {
        const bf16x8 bn = *(const bf16x8*)&s.B[buf][(wc * 128 + (n < 7 ? n + 1 : n) * 16 + fr) * LDS_ROW + (((kh * 4 + fq) ^ (fr & 7)) << 3)];
        __builtin_amdgcn_sched_barrier(0);
        __builtin_amdgcn_s_setprio(1);
#pragma unroll
        for (int m = 0; m < 4; ++m) acc[m][n] = MFMA(bc, a[m], acc[m][n]);
        __builtin_amdgcn_s_setprio(0);
        bc = bn;
      }
      __builtin_amdgcn_sched_barrier(0);
      if (kh == 0) {
#pragma unroll
        for (int i = 0; i < 4; ++i) *(uint4*)&s.A[buf ^ 1][(lrow + i * 64) * LDS_ROW + lsw] = al.post(ra[i], lrow + i * 64, kn);
#pragma unroll
        for (int i = 0; i < 4; ++i) {
          const u16* bp = Bt + (size_t)(lrow + i * 64) * ldb + kn;
          asm volatile("global_load_dwordx4 %0, %1, off" : "=v"(rb[i]) : "v"(bp) : "memory");
        }
        __builtin_amdgcn_sched_barrier(0);
      }
    }
    asm volatile("s_waitcnt vmcnt(0)" ::: "memory");
#pragma unroll
    for (int i = 0; i < 4; ++i) *(uint4*)&s.B[buf ^ 1][(lrow + i * 64) * LDS_ROW + lsw] = rb[i];
    __syncthreads();
  }
}

DI bool next_tile(int it, int MT, int NT, int GN, int& mt, int& nt) {
  const int xcd = blockIdx.x & 7, lb = blockIdx.x >> 3, GM = 8 / GN;
  const int gm = xcd / GN, gn = xcd - gm * GN;
  const int m0 = gm * MT / GM, m1 = (gm + 1) * MT / GM, n0 = gn * NT / GN, n1 = (gn + 1) * NT / GN;
  const int nl = n1 - n0, tl = lb + it * (gridDim.x >> 3);
  if (tl >= (m1 - m0) * nl) return false;
  const int q = tl / nl;
  mt = m0 + q; nt = n0 + (tl - q * nl);
  return true;
}
struct ALPlain {
  const u16* base; int ld;
  DI uint4 operator()(int i, int k) const { return *(const uint4*)(base + (size_t)i * ld + k); }
  DI uint4 post(uint4 v, int, int) const { return v; }
};

DI void ph_prologue(const Params& p, char* smem) {
  const int tid = otid();
  {
    const float4* x = (const float4*)p.in[IX]; float4* o = (float4*)p.out;
    const size_t n = (size_t)NBAT * T * D / 4;
    for (size_t i = (size_t)blockIdx.x * 512 + tid; i < n; i += (size_t)gridDim.x * 512) o[i] = x[i];
    const float4* c = (const float4*)p.in[ICTX]; float4* xc = (float4*)(p.ws + OFF_XC);
    const size_t nc = (size_t)NBAT * TC * D / 4;
    for (size_t i = (size_t)blockIdx.x * 512 + tid; i < nc; i += (size_t)gridDim.x * 512) xc[i] = c[i];
  }
  float* modp = (float*)(p.ws + OFF_MODP);
  float* sc = (float*)smem;
  __syncthreads();
  for (int e = tid; e < 3072; e += 512) { const float v = e < 2048 ? p.in[IC][e] : p.in[ICC][e - 2048]; sc[e] = siluf(v); }
  __syncthreads();
  const int half = tid >> 8, col = tid & 255;
  for (int it = blockIdx.x * 2 + half; it < 4 * 24 * 16; it += gridDim.x * 2) {
    int l = it / (24 * 16), rem = it - l * 24 * 16, cc = rem / 16, kc = rem & 15;
    int n = cc * 256 + col;
    const float* w = p.in[IADAW] + (size_t)l * 1024 * 6144 + (size_t)(kc * 64) * 6144 + n;
    float a0 = 0.f, a1 = 0.f, a2 = 0.f;
#pragma unroll
    for (int kb = 0; kb < 64; kb += 16) {
      float wv[16];
#pragma unroll
      for (int k = 0; k < 16; ++k) wv[k] = w[(size_t)(kb + k) * 6144];
#pragma unroll
      for (int k = 0; k < 16; ++k) {
        const int kk = kc * 64 + kb + k;
        a0 += sc[kk] * wv[k]; a1 += sc[1024 + kk] * wv[k]; a2 += sc[2048 + kk] * wv[k];
      }
    }
    size_t o = ((size_t)(kc * 4 + l) * 3) * 6144 + n;
    modp[o] = a0; modp[o + 6144] = a1; modp[o + 2 * 6144] = a2;
  }
}
DI void ph_modreduce(const Params& p) {
  const float* modp = (const float*)(p.ws + OFF_MODP); float* mod = (float*)(p.ws + OFF_MOD);
  for (int i = blockIdx.x * 512 + otid(); i < 4 * 3 * 6144; i += gridDim.x * 512) {
    int l = i / (3 * 6144), n = i % 6144;
    float a = p.in[IADAB][l * 6144 + n];
    for (int kc = 0; kc < 16; ++kc) a += modp[(size_t)kc * 4 * 3 * 6144 + i];
    mod[i] = a;
  }
}

struct CvtJob { const float* src; u16* dst; int K, N, ld, ldd, mode; };
DI void cvt_run(const CvtJob& j, int& rot, char* smem) {
  float* tile = (float*)smem;
  const int tid = otid();
  if (j.mode == 4) {
    size_t n = (size_t)j.K * j.N;
    for (size_t i = (size_t)blockIdx.x * 512 + tid; i < n; i += (size_t)gridDim.x * 512) j.dst[i] = 0;
    return;
  }
  const int tk = j.K >> 6, tn = j.N >> 6, nt = tk * tn;
  int start = (blockIdx.x + gridDim.x - (rot % gridDim.x)) % gridDim.x;
  for (int t = start; t < nt; t += gridDim.x) {
    int kt = t / tn, ntl = t - kt * tn;
    __syncthreads();
    {
      f32x4 lv[2];
#pragma unroll
      for (int i = 0; i < 2; ++i) { const int e = tid + i * 512, kk = e >> 4, n4 = (e & 15) * 4; lv[i] = gload_f4(j.src + (size_t)(kt * 64 + kk) * j.ld + ntl * 64 + n4); }
      asm volatile("s_waitcnt vmcnt(0)" : "+v"(lv[0]), "+v"(lv[1]) :: "memory");
#pragma unroll
      for (int i = 0; i < 2; ++i) { const int e = tid + i * 512, kk = e >> 4, n4 = (e & 15) * 4; float* tp = tile + kk * 65 + n4; tp[0] = lv[i][0]; tp[1] = lv[i][1]; tp[2] = lv[i][2]; tp[3] = lv[i][3]; }
    }
    __syncthreads();
    for (int e = tid; e < 4096; e += 512) {
      int nn = e >> 6, kk = e & 63; float v = tile[kk * 65 + nn];
      int n = ntl * 64 + nn, k = kt * 64 + kk;
      if (j.mode == 0) j.dst[(size_t)n * j.ldd + k] = f2b(v);
      else if (j.mode == 1) { int rr = n < FF ? (n >> 7) * 256 + (n & 127) : ((n - FF) >> 7) * 256 + 128 + ((n - FF) & 127); j.dst[(size_t)rr * j.ldd + k] = f2b(v); }
      else {
        int h = n >> 6, c = n & 63, ty = j.mode - 2;
        u16* d = j.dst + (size_t)h * 128 * 128 + (size_t)((c >> 5) * 64 + ty * 32 + (c & 31)) * 128;
        d[ty * 64 + k] = f2b(v); d[(1 - ty) * 64 + k] = 0;
      }
    }
  }
  rot += nt;
}
DI void ph_convert(const Params& p, int l, char* smem) {
  u16* wt = (u16*)(p.ws + OFF_WT);
  int rot = 0;
  CvtJob j;
  j = {p.in[IFWIN] + (size_t)l * 1024 * 5632, wt + WT_W1T, 1024, 5632, 5632, 1024, 1}; cvt_run(j, rot, smem);
  j = {p.in[IFWOUT] + (size_t)l * FF * 1024, wt + WT_W2T, FF, 1024, 1024, FF, 0}; cvt_run(j, rot, smem);
  const int kind = l % 3, jj = l / 3;
  if (kind == 0) {
    j = {p.in[IRWR] + (size_t)jj * 1048576, wt + WT_R1T, 1024, 1024, 1024, 1024, 0}; cvt_run(j, rot, smem);
    j = {p.in[IRWK] + (size_t)jj * 1048576, wt + WT_R1T + (size_t)1024 * 1024, 1024, 1024, 1024, 1024, 0}; cvt_run(j, rot, smem);
    j = {p.in[IRWV] + (size_t)jj * 1048576, wt + WT_R1T + (size_t)2048 * 1024, 1024, 1024, 1024, 1024, 0}; cvt_run(j, rot, smem);
    for (int d = 0; d < 2; ++d) {
      j = {p.in[IRW1] + (size_t)(jj * 2 + d) * 65536, wt + WT_R1T + (size_t)(3072 + d * 64) * 1024, 1024, 64, 64, 1024, 0}; cvt_run(j, rot, smem);
      j = {p.in[IRA1] + (size_t)(jj * 2 + d) * 65536, wt + WT_R1T + (size_t)(3200 + d * 64) * 1024, 1024, 64, 64, 1024, 0}; cvt_run(j, rot, smem);
      j = {p.in[IRW2] + (size_t)(jj * 2 + d) * 65536, wt + WT_LUT + (size_t)d * 16 * 128 * 128, 64, 1024, 1024, 128, 2}; cvt_run(j, rot, smem);
      j = {p.in[IRA2] + (size_t)(jj * 2 + d) * 65536, wt + WT_LUT + (size_t)d * 16 * 128 * 128, 64, 1024, 1024, 128, 3}; cvt_run(j, rot, smem);
    }
    j = {p.in[IRG1] + (size_t)jj * 131072, wt + WT_R1T + (size_t)3328 * 1024, 1024, 128, 128, 1024, 0}; cvt_run(j, rot, smem);
    j = {p.in[IRG2] + (size_t)jj * 131072, wt + WT_G2T, 128, 1024, 1024, 128, 0}; cvt_run(j, rot, smem);
    j = {p.in[IRWO] + (size_t)jj * 1048576, wt + WT_RWO, 1024, 1024, 1024, 1024, 0}; cvt_run(j, rot, smem);
  } else if (kind == 1) {
    j = {p.in[ISWIN] + (size_t)jj * 1024 * 6208 + 2048, wt + WT_SX, 1024, 4160, 6208, 1024, 0}; cvt_run(j, rot, smem);
    j = {nullptr, wt + WT_SX + (size_t)4160 * 1024, 64, 1024, 0, 0, 4}; cvt_run(j, rot, smem);
    j = {p.in[ISWIN] + (size_t)jj * 1024 * 6208, wt + WT_SZ, 1024, 2048, 6208, 1024, 0}; cvt_run(j, rot, smem);
    j = {p.in[ISWOUT] + (size_t)jj * 2048 * 1024, wt + WT_SO, 2048, 1024, 1024, 2048, 0}; cvt_run(j, rot, smem);
    float* ssq = (float*)(p.ws + OFF_SSQ);
    for (int i = blockIdx.x * 512 + otid(); i < R * 8; i += gridDim.x * 512) ssq[i] = 0.f;
  } else {
    j = {p.in[IAQKV] + (size_t)jj * 1024 * 1536, wt + WT_AQ, 1024, 1536, 1536, 1024, 0}; cvt_run(j, rot, smem);
    j = {p.in[IAWO] + (size_t)jj * 1048576, wt + WT_AO, 1024, 1024, 1024, 1024, 0}; cvt_run(j, rot, smem);
  }
}

DI void ph_norm(const Params& p, int l, int which) {
  const int lane = otid() & 63, gw = blockIdx.x * 8 + (otid() >> 6), nw = gridDim.x * 8;
  const float* g = (which ? p.in[IN2] : p.in[IN1]) + l * 1024;
  u16* H = (u16*)(p.ws + OFF_H);
  float4 gg[4];
#pragma unroll
  for (int j = 0; j < 4; ++j) gg[j] = *(const float4*)(g + j * 256 + lane * 4);
  float4 v[4], vn[4];
  if (gw < R) {
    const float* xr = xrow_ptr(p, gw);
#pragma unroll
    for (int j = 0; j < 4; ++j) v[j] = *(const float4*)(xr + j * 256 + lane * 4);
  }
  for (int r = gw; r < R; r += nw) {
    {
      const float* xn = xrow_ptr(p, r + nw < R ? r + nw : r);
#pragma unroll
      for (int j = 0; j < 4; ++j) vn[j] = *(const float4*)(xn + j * 256 + lane * 4);
    }
    const float* md = mod_ptr(p, l, r) + which * 3072;
    float4 sh[4], sc[4];
#pragma unroll
    for (int j = 0; j < 4; ++j) { sh[j] = *(const float4*)(md + j * 256 + lane * 4); sc[j] = *(const float4*)(md + 1024 + j * 256 + lane * 4); }
    __builtin_amdgcn_sched_barrier(0);
    float ss = 0.f;
#pragma unroll
    for (int j = 0; j < 4; ++j) ss += v[j].x * v[j].x + v[j].y * v[j].y + v[j].z * v[j].z + v[j].w * v[j].w;
    ss = wsum(ss);
    const float rs = rsqrtf(ss * (1.f / 1024.f) + 1e-6f);
#pragma unroll
    for (int j = 0; j < 4; ++j) {
      const int c = j * 256 + lane * 4;
      float o0 = v[j].x * rs * gg[j].x * (1.f + sc[j].x) + sh[j].x, o1 = v[j].y * rs * gg[j].y * (1.f + sc[j].y) + sh[j].y;
      float o2 = v[j].z * rs * gg[j].z * (1.f + sc[j].z) + sh[j].z, o3 = v[j].w * rs * gg[j].w * (1.f + sc[j].w) + sh[j].w;
      uint2 w; w.x = pack2(o0, o1); w.y = pack2(o2, o3);
      *(uint2*)(H + (size_t)r * 1024 + c) = w;
    }
#pragma unroll
    for (int j = 0; j < 4; ++j) v[j] = vn[j];
  }
}
DI void ph_final(const Params& p) {
  const int lane = otid() & 63, gw = blockIdx.x * 8 + (otid() >> 6), nw = gridDim.x * 8;
  for (int r = gw; r < NBAT * T; r += nw) {
    float* xr = p.out + (size_t)r * 1024;
    float4 v[4]; float ss = 0.f;
#pragma unroll
    for (int j = 0; j < 4; ++j) { v[j] = *(float4*)(xr + j * 256 + lane * 4); ss += v[j].x * v[j].x + v[j].y * v[j].y + v[j].z * v[j].z + v[j].w * v[j].w; }
    ss = wsum(ss);
    const float rs = rsqrtf(ss * (1.f / 1024.f) + 1e-6f);
#pragma unroll
    for (int j = 0; j < 4; ++j) {
      float4 g = *(const float4*)(p.in[IFINAL] + j * 256 + lane * 4);
      float4 w = v[j]; w.x *= rs * g.x; w.y *= rs * g.y; w.z *= rs * g.z; w.w *= rs * g.w;
      *(float4*)(xr + j * 256 + lane * 4) = w;
    }
  }
}

template <class AL>
DI void resid_tile(const Params& p, const AL& al, const u16* Bt, int K, int l, int gi, int mt, int nt, char* smem) {
  f32x4 acc[4][4];
  gemm_main4(al, Bt + (size_t)nt * 128 * K, K, K, acc, smem);
  const int lane = otid() & 63, wave = otid() >> 6, wr = wave >> 1, wc = wave & 1, fr = lane & 15, fq = lane >> 4;
  const int row0 = mt * 256;
  const float* md = mod_ptr(p, l, row0) + gi * 1024;
  float4 g[4];
#pragma unroll
  for (int n = 0; n < 4; ++n) g[n] = *(const float4*)(md + nt * 128 + wc * 64 + n * 16 + fq * 4);
  float* xr0 = xrow_ptr(p, row0) + (size_t)(wr * 64 + fr) * 1024 + nt * 128 + wc * 64 + fq * 4;
#pragma unroll
  for (int mh = 0; mh < 2; ++mh) {
    f32x4 x[2][4];
#pragma unroll
    for (int m2 = 0; m2 < 2; ++m2)
#pragma unroll
      for (int n = 0; n < 4; ++n) x[m2][n] = gload_f4(xr0 + (size_t)((mh * 2 + m2) * 16) * 1024 + n * 16);
    asm volatile("s_waitcnt vmcnt(0)" : "+v"(x[0][0]), "+v"(x[0][1]), "+v"(x[0][2]), "+v"(x[0][3]), "+v"(x[1][0]), "+v"(x[1][1]), "+v"(x[1][2]), "+v"(x[1][3]) :: "memory");
#pragma unroll
    for (int m2 = 0; m2 < 2; ++m2)
#pragma unroll
      for (int n = 0; n < 4; ++n) {
        const int m = mh * 2 + m2;
        f32x4 v = x[m2][n];
        v[0] += g[n].x * acc[m][n][0]; v[1] += g[n].y * acc[m][n][1]; v[2] += g[n].z * acc[m][n][2]; v[3] += g[n].w * acc[m][n][3];
        *(f32x4*)(xr0 + (size_t)(m * 16) * 1024 + n * 16) = v;
      }
  }
}
DI void ph_resid_gemm(const Params& p, const u16* A, int lda, const u16* Bt, int K, int l, int gi, char* smem) {
  const bool skip_ctx = (l == 3);
  for (int it = 0;; ++it) {
    int mt, nt; if (!next_tile(it, skip_ctx ? 128 : 130, 8, 1, mt, nt)) break;
    if (skip_ctx) mt = mt + 1 + (mt >> 6);
    ALPlain al{A + (size_t)mt * 256 * lda, lda};
    resid_tile(p, al, Bt, K, l, gi, mt, nt, smem);
  }
}

struct ALHalo {
  const u16* base; int t0m1, len;
  DI uint4 operator()(int i, int k) const {
    int t = t0m1 + i;
    if (t < 0 || t >= len) return make_uint4(0, 0, 0, 0);
    return *(const uint4*)(base + (size_t)t * 1024 + k);
  }
  DI uint4 post(uint4 v, int, int) const { return v; }
};
DI void ph_ffn1(const Params& p, int l, char* smem) {
  const u16* H = (const u16*)(p.ws + OFF_H);
  const u16* W1T = (const u16*)(p.ws + OFF_WT) + WT_W1T;
  u16* G = (u16*)(p.ws + OFF_SCR);
  const int tid = otid(), lane = tid & 63, wave = tid >> 6, wr = wave >> 1, wc = wave & 1, fr = lane & 15, fq = lane >> 4;
  for (int it = 0;; ++it) {
    int mt, nt; if (!next_tile(it, 134, 22, 2, mt, nt)) break;
    const int b = mt / 67, ml = mt - b * 67;
    int rowbase, t0, len;
    if (ml < 2) { rowbase = b * TS; t0 = ml * 254; len = TC; } else { rowbase = b * TS + TC; t0 = (ml - 2) * 254; len = T; }
    ALHalo al{H + (size_t)rowbase * 1024, t0 - 1, len};
    f32x4 acc[4][8];
    gemm_main2(al, W1T + (size_t)nt * 256 * 1024, 1024, 1024, acc, smem);
    u16* P16 = (u16*)smem;
#pragma unroll
    for (int m = 0; m < 4; ++m)
#pragma unroll
      for (int n = 0; n < 8; ++n) {
        uint2 w; w.x = pack2(acc[m][n][0], acc[m][n][1]); w.y = pack2(acc[m][n][2], acc[m][n][3]);
        *(uint2*)&P16[(wr * 64 + m * 16 + fr) * 264 + wc * 128 + n * 16 + fq * 4] = w;
      }
    __syncthreads();
    {
      const int c2 = (tid & 63) * 2, rg = tid >> 6;
      const float* cw = p.in[IFCONV] + (size_t)l * 3 * 5632;
      const int ca = nt * 128 + c2, cg2 = FF + ca;
      const float2 a0 = *(const float2*)(cw + ca), a1 = *(const float2*)(cw + 5632 + ca), a2 = *(const float2*)(cw + 2 * 5632 + ca);
      const float2 g0 = *(const float2*)(cw + cg2), g1 = *(const float2*)(cw + 5632 + cg2), g2 = *(const float2*)(cw + 2 * 5632 + cg2);
      const int i0 = 1 + rg * 32, i1 = min(i0 + 32, 255);
      unsigned pa = *(const unsigned*)&P16[(i0 - 1) * 264 + c2], ca_ = *(const unsigned*)&P16[i0 * 264 + c2];
      unsigned pg = *(const unsigned*)&P16[(i0 - 1) * 264 + 128 + c2], cgv = *(const unsigned*)&P16[i0 * 264 + 128 + c2];
      for (int i = i0; i < i1; ++i) {
        const unsigned na = *(const unsigned*)&P16[(i + 1) * 264 + c2], ng = *(const unsigned*)&P16[(i + 1) * 264 + 128 + c2];
        const float ua0 = a0.x * blo(pa) + a1.x * blo(ca_) + a2.x * blo(na), ua1 = a0.y * bhi(pa) + a1.y * bhi(ca_) + a2.y * bhi(na);
        const float ug0 = g0.x * blo(pg) + g1.x * blo(cgv) + g2.x * blo(ng), ug1 = g0.y * bhi(pg) + g1.y * bhi(cgv) + g2.y * bhi(ng);
        const int tt = t0 - 1 + i;
        if (tt < len) *(unsigned*)&G[(size_t)(rowbase + tt) * FF + ca] = pack2(ua0 * siluf(ug0), ua1 * siluf(ug1));
        pa = ca_; ca_ = na; pg = cgv; cgv = ng;
      }
    }
  }
}

struct ALMix {
  const u16* H; int row0; const float* mu;
  DI uint4 operator()(int i, int k) const {
    const int row = row0 + i, q = row % TS;
    const bool hp = (q != 0) && (q != TC), hn = (q != TC - 1) && (q != TS - 1);
    const u16* pc = H + (size_t)row * 1024 + k;
    uint4 c = *(const uint4*)pc;
    uint4 a = hp ? *(const uint4*)(pc - 1024) : make_uint4(0, 0, 0, 0);
    uint4 b = hn ? *(const uint4*)(pc + 1024) : make_uint4(0, 0, 0, 0);
    float4 m0 = *(const float4*)(mu + k), m1 = *(const float4*)(mu + k + 4);
    uint4 o;
#define MIX1(cc, aa, bb, mlo, mhi) pack2(blo(cc) + (0.5f * (blo(aa) + blo(bb)) - blo(cc)) * (mlo), bhi(cc) + (0.5f * (bhi(aa) + bhi(bb)) - bhi(cc)) * (mhi))
    o.x = MIX1(c.x, a.x, b.x, m0.x, m0.y); o.y = MIX1(c.y, a.y, b.y, m0.z, m0.w);
    o.z = MIX1(c.z, a.z, b.z, m1.x, m1.y); o.w = MIX1(c.w, a.w, b.w, m1.z, m1.w);
    return o;
  }
  DI uint4 post(uint4 v, int, int) const { return v; }
};
constexpr int P1LD = 3456;
DI void ph_rw_r1(const Params& p, int jj, char* smem) {
  const u16* H = (const u16*)(p.ws + OFF_H);
  const u16* BT = (const u16*)(p.ws + OFF_WT) + WT_R1T;
  u16* P1 = (u16*)(p.ws + OFF_SCR);
  const int lane = otid() & 63, wave = otid() >> 6, wr = wave >> 1, wc = wave & 1, fr = lane & 15, fq = lane >> 4;
  for (int it = 0;; ++it) {
    int mt, nt; if (!next_tile(it, 130, 27, 1, mt, nt)) break;
    const int mi = nt < 8 ? 0 : nt < 16 ? 2 : nt < 24 ? 3 : nt == 24 ? 1 : nt == 25 ? 4 : 5;
    ALMix al{H, mt * 256, p.in[IRMU] + (size_t)(jj * 6 + mi) * 1024};
    f32x4 acc[4][4];
    gemm_main3(al, BT + (size_t)nt * 128 * 1024, 1024, 1024, acc, smem);
#pragma unroll
    for (int m = 0; m < 4; ++m) {
      const int row = mt * 256 + wr * 64 + m * 16 + fr;
#pragma unroll
      for (int n = 0; n < 4; ++n) {
        const int c = nt * 128 + wc * 64 + n * 16 + fq * 4;
        float v0 = acc[m][n][0], v1 = acc[m][n][1], v2 = acc[m][n][2], v3 = acc[m][n][3];
        if (nt == 24) { v0 = tanhf(v0); v1 = tanhf(v1); v2 = tanhf(v2); v3 = tanhf(v3); }
        else if (nt == 26) { v0 = sigmf(v0); v1 = sigmf(v1); v2 = sigmf(v2); v3 = sigmf(v3); }
        uint2 w; w.x = pack2(v0, v1); w.y = pack2(v2, v3);
        *(uint2*)(P1 + (size_t)row * P1LD + c) = w;
      }
    }
  }
}
DI int scan_row(int b, int d, int pos) { return d == 0 ? b * TS + pos : (pos < TC ? b * TS + TC - 1 - pos : b * TS + (TS + TC - 1) - pos); }

struct ALLora {
  const u16* P1; int rowbase, rowstep, d;
  DI uint4 operator()(int i, int k) const {
    const int row = rowbase + i * rowstep;
    const int col = k < 64 ? 3072 + d * 64 + k : 3200 + d * 64 + (k - 64);
    return *(const uint4*)(P1 + (size_t)row * P1LD + col);
  }
  DI uint4 post(uint4 v, int, int) const { return v; }
};
DI uint2 pack4h(float a, float b, float c, float d) {
  __half2 x = __floats2half2_rn(a, b), y = __floats2half2_rn(c, d);
  uint2 r; r.x = *(unsigned*)&x; r.y = *(unsigned*)&y; return r;
}
DI void ph_rw_produce(const Params& p, int jj, int s, char* smem) {
  const u16* P1 = (const u16*)(p.ws + OFF_SCR);
  const u16* LUT = (const u16*)(p.ws + OFF_WT) + WT_LUT;
  __half* ring = (__half*)(p.ws + OFF_RING) + (size_t)(s & 1) * ((size_t)2 * 2 * 1024 * 16 * 256);
  float* bonus = (float*)(p.ws + OFF_BONUS);
  float* red = (float*)(smem + sizeof(SmemG));
  const int lane = otid() & 63, wave = otid() >> 6, wr = wave >> 1, wc = wave & 1, fr = lane & 15, fq = lane >> 4;
  const int npt = min(4, 65 - s * 4);
  for (int t = blockIdx.x; t < 2 * 2 * npt * 16; t += gridDim.x) {
    const int h = t & 15, ptl = (t >> 4) % npt, bd = (t >> 4) / npt, d = bd & 1, b = bd >> 1;
    const int pos0 = (s * 4 + ptl) * 256;
    const int rowbase = scan_row(b, d, pos0), rowstep = d ? -1 : 1;
    ALLora al{P1, rowbase, rowstep, d};
    f32x4 acc[4][4];
    gemm_main3(al, LUT + (size_t)(d * 16 + h) * 128 * 128, 128, 128, acc, smem);
    float4 kkw[2], kaw[2], rkw[2], w0v[2], a0v[2];
#pragma unroll
    for (int nn = 0; nn < 2; ++nn) {
      const int ch = h * 64 + wc * 32 + nn * 16 + fq * 4;
      kkw[nn] = *(const float4*)(p.in[IRKK] + jj * 1024 + ch); kaw[nn] = *(const float4*)(p.in[IRKA] + jj * 1024 + ch);
      rkw[nn] = *(const float4*)(p.in[IRRK] + jj * 1024 + ch);
      w0v[nn] = *(const float4*)(p.in[IRW0] + (jj * 2 + d) * 1024 + ch); a0v[nn] = *(const float4*)(p.in[IRA0] + (jj * 2 + d) * 1024 + ch);
    }
    float ssk[4];
#pragma unroll
    for (int m = 0; m < 4; ++m) {
      const int row = rowbase + (wr * 64 + m * 16 + fr) * rowstep;
      float s1 = 0.f;
#pragma unroll
      for (int nn = 0; nn < 2; ++nn) {
        const int ch = h * 64 + wc * 32 + nn * 16 + fq * 4;
        uint2 k2 = *(const uint2*)(P1 + (size_t)row * P1LD + 1024 + ch);
        float q0 = blo(k2.x) * kkw[nn].x, q1 = bhi(k2.x) * kkw[nn].y, q2 = blo(k2.y) * kkw[nn].z, q3 = bhi(k2.y) * kkw[nn].w;
        s1 += q0 * q0 + q1 * q1 + q2 * q2 + q3 * q3;
      }
      s1 += __shfl_xor(s1, 16); s1 += __shfl_xor(s1, 32);
      ssk[m] = s1;
    }
    if (fq == 0) {
#pragma unroll
      for (int m = 0; m < 4; ++m) red[(wr * 64 + m * 16 + fr) * 2 + wc] = ssk[m];
    }
    __syncthreads();
    float c3[4];
#pragma unroll
    for (int m = 0; m < 4; ++m) {
      const int pi = wr * 64 + m * 16 + fr;
      const float rs = rsqrtf(red[pi * 2] + red[pi * 2 + 1] + 1e-12f);
      const int posl = ptl * 256 + pi;
      __half* rp = ring + ((((size_t)(b * 2 + d) * 1024 + posl) * 16 + h) * 256);
      float cc = 0.f;
#pragma unroll
      for (int nn = 0; nn < 2; ++nn) {
        const int chl = wc * 32 + nn * 16 + fq * 4;
        const float kq[4] = {kkw[nn].x, kkw[nn].y, kkw[nn].z, kkw[nn].w}, ka[4] = {kaw[nn].x, kaw[nn].y, kaw[nn].z, kaw[nn].w};
        const float rk[4] = {rkw[nn].x, rkw[nn].y, rkw[nn].z, rkw[nn].w}, w0[4] = {w0v[nn].x, w0v[nn].y, w0v[nn].z, w0v[nn].w};
        const float a0[4] = {a0v[nn].x, a0v[nn].y, a0v[nn].z, a0v[nn].w};
        float okk[4], owm[4], oka[4], okd[4];
        const int rowm = rowbase + pi * rowstep;
        const uint2 r2 = *(const uint2*)(P1 + (size_t)rowm * P1LD + h * 64 + chl), k2 = *(const uint2*)(P1 + (size_t)rowm * P1LD + 1024 + h * 64 + chl);
        const float rvv[4] = {blo(r2.x), bhi(r2.x), blo(r2.y), bhi(r2.y)}, kvv[4] = {blo(k2.x), bhi(k2.x), blo(k2.y), bhi(k2.y)};
#pragma unroll
        for (int j = 0; j < 4; ++j) {
          const float k = kvv[j];
          const float kk = k * kq[j] * rs;
          const float a = sigmf(a0[j] + acc[m][nn + 2][j]);
          const float wlog = -__logf(1.f + __expf(-(w0[j] + acc[m][nn][j]))) - 0.5f;
          const float ew = -__expf(wlog);
          const float wm1 = ew * (1.f + ew * (0.5f + ew * (0.16666667f + ew * (0.041666668f + ew * (0.0083333338f + ew * (0.0013888889f + ew * 0.0001984127f))))));
          const float kd = k * (1.f + (a - 1.f) * ka[j]);
          okk[j] = kk; owm[j] = wm1; oka[j] = kk * a; okd[j] = kd;
          cc += rvv[j] * kd * rk[j];
        }
        *(uint2*)(rp + chl) = pack4h(okk[0], okk[1], okk[2], okk[3]);
        *(uint2*)(rp + 64 + chl) = pack4h(owm[0], owm[1], owm[2], owm[3]);
        *(uint2*)(rp + 128 + chl) = pack4h(oka[0], oka[1], oka[2], oka[3]);
        *(uint2*)(rp + 192 + chl) = pack4h(okd[0], okd[1], okd[2], okd[3]);
      }
      cc += __shfl_xor(cc, 16); cc += __shfl_xor(cc, 32);
      c3[m] = cc;
    }
    __syncthreads();
    if (fq == 0) {
#pragma unroll
      for (int m = 0; m < 4; ++m) red[(wr * 64 + m * 16 + fr) * 2 + wc] = c3[m];
    }
    __syncthreads();
    if (wc == 0 && fq == 0) {
#pragma unroll
      for (int m = 0; m < 4; ++m) {
        const int pi = wr * 64 + m * 16 + fr;
        bonus[(size_t)(rowbase + pi * rowstep) * 32 + h * 2 + d] = red[pi * 2] + red[pi * 2 + 1];
      }
    }
  }
}
DI float ror_add16(float x) {
  x += __int_as_float(__builtin_amdgcn_update_dpp(0, __float_as_int(x), 0x128, 0xf, 0xf, false));
  x += __int_as_float(__builtin_amdgcn_update_dpp(0, __float_as_int(x), 0x124, 0xf, 0xf, false));
  x += __int_as_float(__builtin_amdgcn_update_dpp(0, __float_as_int(x), 0x122, 0xf, 0xf, false));
  x += __int_as_float(__builtin_amdgcn_update_dpp(0, __float_as_int(x), 0x121, 0xf, 0xf, false));
  return x;
}
constexpr int SCH = 32, STEPF = 336;
DI void ph_rw_scan(const Params& p, int s, char* smem, bool save = true) {
  if (blockIdx.x >= 256) return;
  const u16* P1 = (const u16*)(p.ws + OFF_SCR);
  const __half* ring = (const __half*)(p.ws + OFF_RING) + (size_t)(s & 1) * ((size_t)2 * 2 * 1024 * 16 * 256);
  u16* Y = (u16*)(p.ws + OFF_SCR) + (size_t)R * P1LD;
  float* st = (float*)(p.ws + OFF_RWST);
  float* buf = (float*)smem;
  float* ybuf = buf + 2 * SCH * STEPF;
  const int tid = otid(), lane = tid & 63, wave = tid >> 6;
  const int xcd_ = blockIdx.x & 7, slot_ = blockIdx.x >> 3;
  const int bh_ = xcd_ * 4 + (slot_ >> 3), rq = slot_ & 3;
  const int b = bh_ >> 4, h = bh_ & 15, d = (slot_ >> 2) & 1;
  const int npos = min(1024, TS - s * 1024), nch = npos / SCH;
  const int rl = (wave & 3) * 4 + (lane >> 4), q = lane & 15;
  f32x2 sa = (f32x2){0.f, 0.f}, sb = (f32x2){0.f, 0.f};
  if (wave < 4 && s > 0) { float4 v = *(const float4*)(st + ((size_t)blockIdx.x * 256 + tid) * 4); sa = (f32x2){v.x, v.y}; sb = (f32x2){v.z, v.w}; }
  u16* Yd = Y + (size_t)d * R * 1024;
  uint4 lr[4], lrr = make_uint4(0, 0, 0, 0), lrv = make_uint4(0, 0, 0, 0);
  auto gload = [&](int c) {
    const int lt = tid - 256;
#pragma unroll
    for (int i = 0; i < 4; ++i) {
      const int cidx = lt + i * 256, stp = cidx >> 5, off = (cidx & 31) * 8;
      const int posl = c * SCH + stp;
      lr[i] = *(const uint4*)(ring + ((((size_t)(b * 2 + d) * 1024 + posl) * 16 + h) * 256) + off);
    }
    {
      const int stp = lt >> 3, off = (lt & 7) * 8;
      const int row = scan_row(b, d, s * 1024 + c * SCH + stp);
      lrr = *(const uint4*)(P1 + (size_t)row * P1LD + h * 64 + off);
    }
    {
      const int l2 = lt & 63, stp = l2 >> 1, off = (l2 & 1) * 8;
      const int row = scan_row(b, d, s * 1024 + c * SCH + stp);
      lrv = *(const uint4*)(P1 + (size_t)row * P1LD + 2048 + h * 64 + rq * 16 + off);
    }
  };
  auto swrite = [&](int c) {
    const int lt = tid - 256;
    float* bb = buf + (c & 1) * SCH * STEPF;
#pragma unroll
    for (int i = 0; i < 4; ++i) {
      const int cidx = lt + i * 256, stp = cidx >> 5, off = (cidx & 31) * 8;
      const __half2* hp = (const __half2*)&lr[i];
      float2 f0 = __half22float2(hp[0]), f1 = __half22float2(hp[1]), f2 = __half22float2(hp[2]), f3 = __half22float2(hp[3]);
      float* dst = bb + stp * STEPF + off;
      *(float4*)dst = make_float4(f0.x, f0.y, f1.x, f1.y);
      *(float4*)(dst + 4) = make_float4(f2.x, f2.y, f3.x, f3.y);
    }
    {
      const int stp = lt >> 3, off = (lt & 7) * 8;
      float* dst = bb + stp * STEPF + 256 + off;
      *(float4*)dst = make_float4(blo(lrr.x), bhi(lrr.x), blo(lrr.y), bhi(lrr.y));
      *(float4*)(dst + 4) = make_float4(blo(lrr.z), bhi(lrr.z), blo(lrr.w), bhi(lrr.w));
    }
    if (lt < 64) {
      const int stp = lt >> 1, off = (lt & 1) * 8;
      float* dst = bb + stp * STEPF + 320 + off;
      *(float4*)dst = make_float4(blo(lrv.x), bhi(lrv.x), blo(lrv.y), bhi(lrv.y));
      *(float4*)(dst + 4) = make_float4(blo(lrv.z), bhi(lrv.z), blo(lrv.w), bhi(lrv.w));
    }
  };
  if (wave >= 4) { gload(0); swrite(0); if (nch > 1) gload(1); }
  lds_barrier();
  for (int c = 0; c < nch; ++c) {
    if (wave < 4) {
      const float* bb = buf + (c & 1) * SCH * STEPF;
      const int pos0 = s * 1024 + c * SCH;
      const int row0 = scan_row(b, d, pos0), rstep = d ? -1 : 1;
      u16* yp = Yd + (size_t)row0 * 1024 + h * 64 + rq * 16 + rl;
      float4 kk = *(const float4*)(bb + q * 4), wm = *(const float4*)(bb + 64 + q * 4), ka = *(const float4*)(bb + 128 + q * 4);
      float4 kd = *(const float4*)(bb + 192 + q * 4), rr = *(const float4*)(bb + 256 + q * 4);
      float vv = bb[320 + rl];
      float yv[16];
#pragma unroll
      for (int stp = 0; stp < SCH; ++stp) {
        const float* sn = bb + (stp + 1 < SCH ? stp + 1 : stp) * STEPF;
        const float4 kkn = *(const float4*)(sn + q * 4), wmn = *(const float4*)(sn + 64 + q * 4), kan = *(const float4*)(sn + 128 + q * 4);
        const float4 kdn = *(const float4*)(sn + 192 + q * 4), rrn = *(const float4*)(sn + 256 + q * 4);
        const float vvn = sn[320 + rl];
        __builtin_amdgcn_sched_barrier(0);
        const f32x2 vv2 = (f32x2){vv, vv};
        f32x2 ta = sa * (f32x2){wm.x, wm.y} + sa, tb = sb * (f32x2){wm.z, wm.w} + sb;
        ta = vv2 * (f32x2){kd.x, kd.y} + ta; tb = vv2 * (f32x2){kd.z, kd.w} + tb;
        f32x2 ud = sa * (f32x2){kk.x, kk.y}; ud = sb * (f32x2){kk.z, kk.w} + ud;
        float u = ror_add16(ud.x + ud.y);
        const f32x2 nu = (f32x2){-u, -u};
        sa = nu * (f32x2){ka.x, ka.y} + ta; sb = nu * (f32x2){ka.z, ka.w} + tb;
        f32x2 yd2 = sa * (f32x2){rr.x, rr.y}; yd2 = sb * (f32x2){rr.z, rr.w} + yd2;
        yv[stp & 15] = yd2.x + yd2.y;
        if ((stp & 15) == 15) {
          const bool b3 = q & 8, b2 = q & 4, b1 = q & 2, b0 = q & 1;
          float z8[8], z4[4], z2[2];
#pragma unroll
          for (int i = 0; i < 8; ++i) { const float kp = b3 ? yv[i + 8] : yv[i], sd = b3 ? yv[i] : yv[i + 8]; z8[i] = kp + __int_as_float(__builtin_amdgcn_update_dpp(0, __float_as_int(sd), 0x140, 0xf, 0xf, false)); }
#pragma unroll
          for (int i = 0; i < 4; ++i) { const float kp = b2 ? z8[i + 4] : z8[i], sd = b2 ? z8[i] : z8[i + 4]; z4[i] = kp + __int_as_float(__builtin_amdgcn_update_dpp(0, __float_as_int(sd), 0x141, 0xf, 0xf, false)); }
#pragma unroll
          for (int i = 0; i < 2; ++i) { const float kp = b1 ? z4[i + 2] : z4[i], sd = b1 ? z4[i] : z4[i + 2]; z2[i] = kp + __int_as_float(__builtin_amdgcn_update_dpp(0, __float_as_int(sd), 0x1B, 0xf, 0xf, false)); }
          const float kp = b0 ? z2[1] : z2[0], sd = b0 ? z2[0] : z2[1];
          const float yq = kp + __int_as_float(__builtin_amdgcn_update_dpp(0, __float_as_int(sd), 0xB1, 0xf, 0xf, false));
          yp[(ptrdiff_t)((stp & ~15) + q) * rstep * 1024] = f2b(yq);
        }
        kk = kkn; wm = wmn; ka = kan; kd = kdn; rr = rrn; vv = vvn;
      }
    } else {
      if (c + 1 < nch) swrite(c + 1);
      if (c + 2 < nch) gload(c + 2);
    }
    lds_barrier();
  }
  if (wave < 4 && save) *(float4*)(st + ((size_t)blockIdx.x * 256 + tid) * 4) = make_float4(sa.x, sa.y, sb.x, sb.y);
  __syncthreads();
}
DI void ph_rw_finish(const Params& p, int jj, char* smem) {
  const u16* P1 = (const u16*)(p.ws + OFF_SCR);
  const u16* G2T = (const u16*)(p.ws + OFF_WT) + WT_G2T;
  u16* Y0 = (u16*)(p.ws + OFF_SCR) + (size_t)R * P1LD;
  const u16* Y1 = Y0 + (size_t)R * 1024;
  const float* bonus = (const float*)(p.ws + OFF_BONUS);
  const int lane = otid() & 63, wave = otid() >> 6, wr = wave >> 1, wc = wave & 1, fr = lane & 15, fq = lane >> 4;
  for (int it = 0;; ++it) {
    int mt, nt; if (!next_tile(it, 130, 8, 1, mt, nt)) break;
    ALPlain al{P1 + (size_t)mt * 256 * P1LD + 3328, P1LD};
    f32x4 acc[4][4];
    gemm_main3(al, G2T + (size_t)nt * 128 * 128, 128, 128, acc, smem);
    const int h = nt * 2 + wc;
#pragma unroll
    for (int m = 0; m < 4; ++m) {
      const int row = mt * 256 + wr * 64 + m * 16 + fr;
      float y[4][4]; float sm = 0.f;
#pragma unroll
      for (int n = 0; n < 4; ++n) {
        const int c = h * 64 + n * 16 + fq * 4;
        uint2 a = *(const uint2*)(Y0 + (size_t)row * 1024 + c), b2 = *(const uint2*)(Y1 + (size_t)row * 1024 + c);
        y[n][0] = blo(a.x) + blo(b2.x); y[n][1] = bhi(a.x) + bhi(b2.x); y[n][2] = blo(a.y) + blo(b2.y); y[n][3] = bhi(a.y) + bhi(b2.y);
        sm += y[n][0] + y[n][1] + y[n][2] + y[n][3];
      }
      sm += __shfl_xor(sm, 16); sm += __shfl_xor(sm, 32);
      const float mean = sm * (1.f / 64.f);
      float vs = 0.f;
#pragma unroll
      for (int n = 0; n < 4; ++n)
#pragma unroll
        for (int j = 0; j < 4; ++j) { float dlt = y[n][j] - mean; vs += dlt * dlt; }
      vs += __shfl_xor(vs, 16); vs += __shfl_xor(vs, 32);
      const float rs = rsqrtf(vs * (1.f / 64.f) + 64e-5f);
      const float bn = bonus[(size_t)row * 32 + h * 2] + bonus[(size_t)row * 32 + h * 2 + 1];
#pragma unroll
      for (int n = 0; n < 4; ++n) {
        const int c = h * 64 + n * 16 + fq * 4;
        float4 lg = *(const float4*)(p.in[IRLNG] + jj * 1024 + c), lb = *(const float4*)(p.in[IRLNB] + jj * 1024 + c);
        uint2 v2 = *(const uint2*)(P1 + (size_t)row * P1LD + 2048 + c);
        float o0 = ((y[n][0] - mean) * rs * lg.x + lb.x + bn * blo(v2.x)) * acc[m][n][0];
        float o1 = ((y[n][1] - mean) * rs * lg.y + lb.y + bn * bhi(v2.x)) * acc[m][n][1];
        float o2 = ((y[n][2] - mean) * rs * lg.z + lb.z + bn * blo(v2.y)) * acc[m][n][2];
        float o3 = ((y[n][3] - mean) * rs * lg.w + lb.w + bn * bhi(v2.y)) * acc[m][n][3];
        uint2 w; w.x = pack2(o0, o1); w.y = pack2(o2, o3);
        *(uint2*)(Y0 + (size_t)row * 1024 + c) = w;
      }
    }
  }
}

DI void ph_ssd_s1(const Params& p, int jj, char* smem) {
  const u16* H = (const u16*)(p.ws + OFF_H);
  const u16* BT = (const u16*)(p.ws + OFF_WT) + WT_SX;
  u16* XBC = (u16*)(p.ws + OFF_SCR);
  float* DTg = (float*)(p.ws + OFF_DT);
  float* P = (float*)smem;
  const float* cw = p.in[ISCONVW] + (size_t)jj * 3 * 4096;
  const float* cb = p.in[ISCONVB] + (size_t)jj * 4096;
  const int tid = otid(), lane = tid & 63, wave = tid >> 6, wr = wave >> 1, wc = wave & 1, fr = lane & 15, fq = lane >> 4;
  for (int it = 0;; ++it) {
    int mt, nt; if (!next_tile(it, 134, 33, 1, mt, nt)) break;
    const int b = mt / 67, ml = mt - b * 67;
    int rowbase, t0, len;
    if (ml < 2) { rowbase = b * TS; t0 = ml * 254; len = TC; } else { rowbase = b * TS + TC; t0 = (ml - 2) * 254; len = T; }
    ALHalo al{H + (size_t)rowbase * 1024, t0 - 1, len};
    f32x4 acc[4][4];
    gemm_main3(al, BT + (size_t)nt * 128 * 1024, 1024, 1024, acc, smem);
#pragma unroll
    for (int m = 0; m < 4; ++m)
#pragma unroll
      for (int n = 0; n < 4; ++n) *(f32x4*)&P[(wr * 64 + m * 16 + fr) * 132 + wc * 64 + n * 16 + fq * 4] = acc[m][n];
    __syncthreads();
    if (nt < 32) {
      const int col = tid & 127, rg = tid >> 7, ch = nt * 128 + col;
      const float w0 = cw[ch], w1 = cw[4096 + ch], w2 = cw[8192 + ch], bias = cb[ch];
      const int i0 = 1 + rg * 64, i1 = min(i0 + 64, 255);
      float pv = P[(i0 - 1) * 132 + col], cv = P[i0 * 132 + col];
      for (int i = i0; i < i1; ++i) {
        const float nv = P[(i + 1) * 132 + col];
        const float v = w0 * pv + w1 * cv + w2 * nv + bias;
        const int tt = t0 - 1 + i;
        if (tt < len) XBC[(size_t)(rowbase + tt) * 4096 + ch] = f2b(siluf(v));
        pv = cv; cv = nv;
      }
    } else {
      const int col = tid & 63, rg = tid >> 6;
      const int i0 = 1 + rg * 32, i1 = min(i0 + 32, 255);
      for (int i = i0; i < i1; ++i) { const int tt = t0 - 1 + i; if (tt < len) DTg[(size_t)(rowbase + tt) * 64 + col] = P[i * 132 + col]; }
    }
  }
}
DI void ph_ssd_scan(const Params& p, int jj, char* smem) {
  if (blockIdx.x >= 256) return;
  const u16* XBC = (const u16*)(p.ws + OFF_SCR);
  u16* Y = (u16*)(p.ws + OFF_SCR) + (size_t)R * 4096;
  const float* DTg = (const float*)(p.ws + OFF_DT);
  const int tid = otid(), lane = tid & 63, wave = tid >> 6, fr = lane & 15, fq = lane >> 4;
  const int xcd_ = blockIdx.x & 7, slot_ = blockIdx.x >> 3, gid_ = xcd_ * 2 + (slot_ >> 4), mem_ = slot_ & 15;
  const int b = gid_ >> 3, g = gid_ & 7, head = g * 4 + (mem_ >> 2), pq = mem_ & 3;
  constexpr int DIRB = 80896;
  const int xp_ = tid & 15, xj0 = (tid >> 4) & 15;
  float Aneg[2], dtb[2];
#pragma unroll
  for (int d = 0; d < 2; ++d) { Aneg[d] = -__expf(p.in[ISALOG][(jj * 2 + d) * 32 + head]); dtb[d] = p.in[ISDTB][(jj * 2 + d) * 32 + head]; }
  const float Dsk = p.in[ISD][jj * 32 + head];
  f32x4 hst[2] = {(f32x4){0.f, 0.f, 0.f, 0.f}, (f32x4){0.f, 0.f, 0.f, 0.f}};
  uint4 pre[2][5];
  float dtpre[2] = {0.f, 0.f};
  auto gl_raw = [&](int ci, int d, uint4 (&pr)[5], float& dtp) {
    const int r0 = scan_row(b, d, ci * 64), r63 = scan_row(b, d, ci * 64 + 63);
    const int rmin = min(r0, r63);
    const int cc = tid & 31, rrb = tid >> 5;
    const int gcb = cc < 16 ? 2048 + g * 128 + cc * 8 : 3072 + g * 128 + (cc - 16) * 8;
    const u16* src = XBC + (size_t)(rmin + rrb) * 4096 + gcb;
#pragma unroll
    for (int i = 0; i < 4; ++i) pr[i] = *(const uint4*)(src + (size_t)i * 16 * 4096);
    pr[4] = *(const uint4*)(XBC + (size_t)(rmin + ((tid & 127) >> 1)) * 4096 + head * 64 + pq * 16 + (tid & 1) * 8);
    dtp = DTg[(size_t)(r0 + lane * (d ? -1 : 1)) * 64 + d * 32 + head];
  };
  __syncthreads();
  gl_raw(0, 0, pre[0], dtpre[0]);
  gl_raw(0, 1, pre[1], dtpre[1]);
  for (int ci = 0; ci < 260; ++ci) {
    const bool second = ci < 4 ? (ci >= 2) : (ci - 4 >= 128);
    unsigned ypre[2][2];
#pragma unroll
    for (int d = 0; d < 2; ++d) {
      u16* Cs = (u16*)(smem + d * DIRB); u16* Bs = Cs + 64 * 144; u16* BsT = Bs + 64 * 144; u16* Ms = BsT + 128 * 80;
      u16* XdtT = Ms + 64 * 72; u16* XwT = XdtT + 16 * 80; u16* Hs = XwT + 16 * 80;
      float* Xp = (float*)(Hs + 16 * 144); float* dts = Xp + 64 * 16; float* css = dts + 64;
      const int r0 = scan_row(b, d, ci * 64), rstep = d ? -1 : 1;
      {
        int t2 = tid; asm volatile("" : "+v"(t2));
        const int cc = t2 & 31;
#pragma unroll
        for (int i = 0; i < 4; ++i) {
          const int rr = (t2 >> 5) + 16 * i, j = d ? 63 - rr : rr;
          if (cc < 16) {
            *(uint4*)&Bs[j * 144 + cc * 8] = pre[d][i];
            const u16* hv = (const u16*)&pre[d][i];
#pragma unroll
            for (int e = 0; e < 8; ++e) BsT[(cc * 8 + e) * 80 + (j ^ ((cc & 7) << 3))] = hv[e];
          } else *(uint4*)&Cs[j * 144 + (cc - 16) * 8] = pre[d][i];
        }
        if (t2 < 128) {
          const int rr = t2 >> 1, j = d ? 63 - rr : rr;
          const u16* hv = (const u16*)&pre[d][4];
#pragma unroll
          for (int e = 0; e < 8; ++e) Xp[j * 16 + (tid & 1) * 8 + e] = b2f(hv[e]);
        }
      }
      if (wave == d) {
        const float dt = softplusf(dtpre[d] + dtb[d]);
        float a = dt * Aneg[d];
#pragma unroll
        for (int o = 1; o < 64; o <<= 1) { float tv = __shfl_up(a, o); if (lane >= o) a += tv; }
        dts[lane] = dt; css[lane] = a;
      }
#pragma unroll
      for (int e = 0; e < 4; ++e) Hs[(fq * 4 + e) * 144 + wave * 16 + fr] = f2b(hst[d][e]);
#pragma unroll
      for (int e = 0; e < 2; ++e) {
        const u16* yb = Y + (size_t)(r0 + ((wave & 3) * 16 + fq * 4 + 2 * e) * rstep) * 2048 + head * 64 + pq * 16 + fr;
        ypre[d][e] = (unsigned)yb[0] | ((unsigned)yb[(ptrdiff_t)rstep * 2048] << 16);
      }
      __builtin_amdgcn_sched_barrier(0);
    }
    __builtin_amdgcn_sched_barrier(0);
    if (ci + 1 < 260) { gl_raw(ci + 1, 0, pre[0], dtpre[0]); gl_raw(ci + 1, 1, pre[1], dtpre[1]); }
    lds_barrier();
#pragma unroll
    for (int d = 0; d < 2; ++d) {
      u16* Cs = (u16*)(smem + d * DIRB); u16* Bs = Cs + 64 * 144; u16* BsT = Bs + 64 * 144; u16* Ms = BsT + 128 * 80;
      u16* XdtT = Ms + 64 * 72; u16* XwT = XdtT + 16 * 80; u16* Hs = XwT + 16 * 80;
      float* Xp = (float*)(Hs + 16 * 144); float* dts = Xp + 64 * 16; float* css = dts + 64;
      const float cs63 = css[63];
      if (tid < 256) {
#pragma unroll
        for (int i = 0; i < 4; ++i) {
          const int j = xj0 + 16 * i;
          const float xv = Xp[j * 16 + xp_];
          const float dt = dts[j];
          XdtT[xp_ * 80 + j] = f2b(xv * dt);
          XwT[xp_ * 80 + j] = f2b(xv * dt * __expf(cs63 - css[j]));
        }
      }
      const int ib = wave >> 1;
#pragma unroll
      for (int jb2 = 0; jb2 < 2; ++jb2) {
        const int jb = (wave & 1) * 2 + jb2;
        f32x4 acc = (f32x4){0.f, 0.f, 0.f, 0.f};
#pragma unroll
        for (int ks = 0; ks < 4; ++ks) {
          const bf16x8 bfr = *(const bf16x8*)&Bs[(jb * 16 + fr) * 144 + ks * 32 + fq * 8];
          const bf16x8 cfr = *(const bf16x8*)&Cs[(ib * 16 + fr) * 144 + ks * 32 + fq * 8];
          acc = MFMA(bfr, cfr, acc);
        }
        const int i = ib * 16 + fr;
        const float csi = css[i];
        float mv[4];
#pragma unroll
        for (int e = 0; e < 4; ++e) { const int j = jb * 16 + fq * 4 + e; mv[e] = (j <= i) ? acc[e] * __expf(csi - css[j]) : 0.f; }
        uint2 w; w.x = pack2(mv[0], mv[1]); w.y = pack2(mv[2], mv[3]);
        *(uint2*)&Ms[i * 72 + jb * 16 + fq * 4] = w;
      }
      __builtin_amdgcn_sched_barrier(0);
    }
    lds_barrier();
#pragma unroll
    for (int d = 0; d < 2; ++d) {
      u16* Cs = (u16*)(smem + d * DIRB); u16* Bs = Cs + 64 * 144; u16* BsT = Bs + 64 * 144; u16* Ms = BsT + 128 * 80;
      u16* XdtT = Ms + 64 * 72; u16* XwT = XdtT + 16 * 80; u16* Hs = XwT + 16 * 80;
      float* Xp = (float*)(Hs + 16 * 144); float* dts = Xp + 64 * 16; float* css = dts + 64;
      const int r0 = scan_row(b, d, ci * 64), rstep = d ? -1 : 1;
      const float cs63 = css[63];
      if (wave < 4) {
        const int ib = wave;
        f32x4 yd = (f32x4){0.f, 0.f, 0.f, 0.f}, yo = (f32x4){0.f, 0.f, 0.f, 0.f};
#pragma unroll
        for (int ks = 0; ks < 2; ++ks) {
          const bf16x8 mf = *(const bf16x8*)&Ms[(ib * 16 + fr) * 72 + ks * 32 + fq * 8];
          const bf16x8 xf = *(const bf16x8*)&XdtT[fr * 80 + ks * 32 + fq * 8];
          yd = MFMA(mf, xf, yd);
        }
#pragma unroll
        for (int ks = 0; ks < 4; ++ks) {
          const bf16x8 cf = *(const bf16x8*)&Cs[(ib * 16 + fr) * 144 + ks * 32 + fq * 8];
          const bf16x8 hf = *(const bf16x8*)&Hs[fr * 144 + ks * 32 + fq * 8];
          yo = MFMA(cf, hf, yo);
        }
#pragma unroll
        for (int e = 0; e < 4; ++e) {
          const int i = ib * 16 + fq * 4 + e;
          float y = yd[e] + __expf(css[i]) * yo[e];
          u16* ya = Y + (size_t)(r0 + i * rstep) * 2048 + head * 64 + pq * 16 + fr;
          if (second) y += ((e & 1) ? bhi(ypre[d][e >> 1]) : blo(ypre[d][e >> 1])) + Xp[i * 16 + fr] * Dsk;
          *ya = f2b(y);
        }
      }
      {
        const float dec = __expf(cs63);
        hst[d][0] *= dec; hst[d][1] *= dec; hst[d][2] *= dec; hst[d][3] *= dec;
#pragma unroll
        for (int ks = 0; ks < 2; ++ks) {
          const bf16x8 xf = *(const bf16x8*)&XwT[fr * 80 + ks * 32 + fq * 8];
          const bf16x8 bf = *(const bf16x8*)&BsT[(wave * 16 + fr) * 80 + (((ks * 4 + fq) ^ ((wave * 2 + (fr >> 3)) & 7)) << 3)];
          hst[d] = MFMA(xf, bf, hst[d]);
        }
      }
      __builtin_amdgcn_sched_barrier(0);
    }
    if (ci == 1 || ci == 131) asm volatile("s_waitcnt vmcnt(0)" ::: "memory");
    lds_barrier();
  }
}
DI void ph_ssd_s3(const Params& p, char* smem) {
  const u16* H = (const u16*)(p.ws + OFF_H);
  const u16* BT = (const u16*)(p.ws + OFF_WT) + WT_SZ;
  u16* Y = (u16*)(p.ws + OFF_SCR) + (size_t)R * 4096;
  float* ssq = (float*)(p.ws + OFF_SSQ);
  const int lane = otid() & 63, wave = otid() >> 6, wr = wave >> 1, wc = wave & 1, fr = lane & 15, fq = lane >> 4;
  for (int it = 0;; ++it) {
    int mt, nt; if (!next_tile(it, 130, 16, 1, mt, nt)) break;
    ALPlain al{H + (size_t)mt * 256 * 1024, 1024};
    f32x4 acc[4][4];
    gemm_main3(al, BT + (size_t)nt * 128 * 1024, 1024, 1024, acc, smem);
#pragma unroll
    for (int m = 0; m < 4; ++m) {
      const int row = mt * 256 + wr * 64 + m * 16 + fr;
      float sq = 0.f;
#pragma unroll
      for (int n = 0; n < 4; ++n) {
        const int c = nt * 128 + wc * 64 + n * 16 + fq * 4;
        uint2 yv = *(const uint2*)(Y + (size_t)row * 2048 + c);
        const float o0 = blo(yv.x) * siluf(acc[m][n][0]), o1 = bhi(yv.x) * siluf(acc[m][n][1]);
        const float o2 = blo(yv.y) * siluf(acc[m][n][2]), o3 = bhi(yv.y) * siluf(acc[m][n][3]);
        sq += o0 * o0 + o1 * o1 + o2 * o2 + o3 * o3;
        uint2 w; w.x = pack2(o0, o1); w.y = pack2(o2, o3);
        *(uint2*)(Y + (size_t)row * 2048 + c) = w;
      }
      sq += __shfl_xor(sq, 16); sq += __shfl_xor(sq, 32);
      if (fq == 0) atomicAdd(ssq + (size_t)row * 8 + (nt >> 1), sq);
    }
  }
}
struct ALScale {
  const u16* Y; int row0; const float* rsT; const float* ngT;
  DI uint4 operator()(int i, int k) const { return *(const uint4*)(Y + (size_t)(row0 + i) * 2048 + k); }
  DI uint4 post(uint4 c, int i, int k) const {
    const float rs = rsT[i * 8 + (k >> 8)];
    const float4 g0 = *(const float4*)(ngT + k), g1 = *(const float4*)(ngT + k + 4);
    uint4 o;
    o.x = pack2(blo(c.x) * rs * g0.x, bhi(c.x) * rs * g0.y); o.y = pack2(blo(c.y) * rs * g0.z, bhi(c.y) * rs * g0.w);
    o.z = pack2(blo(c.z) * rs * g1.x, bhi(c.z) * rs * g1.y); o.w = pack2(blo(c.w) * rs * g1.z, bhi(c.w) * rs * g1.w);
    return o;
  }
};
DI void ph_ssd_s4(const Params& p, int l, int jj, char* smem) {
  const u16* Y = (const u16*)(p.ws + OFF_SCR) + (size_t)R * 4096;
  const u16* BT = (const u16*)(p.ws + OFF_WT) + WT_SO;
  for (int it = 0;; ++it) {
    int mt, nt; if (!next_tile(it, 130, 8, 1, mt, nt)) break;
    float* rsT = (float*)(smem + 112640); float* ngT = rsT + 2048;
    {
      const float* ssq = (const float*)(p.ws + OFF_SSQ) + (size_t)mt * 256 * 8;
      const float* ng = p.in[ISNG] + jj * 2048;
      for (int e = otid(); e < 2048; e += 512) { rsT[e] = rsqrtf(ssq[e] * (1.f / 256.f) + 1e-6f); ngT[e] = ng[e]; }
    }
    ALScale al{Y, mt * 256, rsT, ngT};
    resid_tile(p, al, BT, 2048, l, 2, mt, nt, smem);
  }
}

DI void ph_at_qkv(const Params& p, char* smem) {
  const u16* H = (const u16*)(p.ws + OFF_H);
  const u16* BT = (const u16*)(p.ws + OFF_WT) + WT_AQ;
  u16* QKV = (u16*)(p.ws + OFF_SCR);
  const int lane = otid() & 63, wave = otid() >> 6, wr = wave >> 1, wc = wave & 1, fr = lane & 15, fq = lane >> 4;
  for (int it = 0;; ++it) {
    int mt, nt; if (!next_tile(it, 130, 12, 1, mt, nt)) break;
    ALPlain al{H + (size_t)mt * 256 * 1024, 1024};
    f32x4 acc[4][4];
    gemm_main3(al, BT + (size_t)nt * 128 * 1024, 1024, 1024, acc, smem);
    const int q0 = (mt * 256) % TS;
    const bool rope = (q0 >= TC) && (nt < 10);
#pragma unroll
    for (int m = 0; m < 4; ++m) {
      const int rl = wr * 64 + m * 16 + fr;
      const int row = mt * 256 + rl;
      if (rope) {
        const int tt = q0 - TC + rl;
        const float prow = (float)(tt >> 6), pcol = (float)(tt & 63);
#pragma unroll
        for (int e = 0; e < 4; ++e) {
          const float inv = exp2f(-13.287712379549449f * (float)(fq * 4 + e) * (1.f / 16.f));
          float sn, cs;
          sincosf(prow * inv, &sn, &cs);
          float x1 = acc[m][0][e], x2 = acc[m][1][e];
          acc[m][0][e] = x1 * cs - x2 * sn; acc[m][1][e] = x1 * sn + x2 * cs;
          sincosf(pcol * inv, &sn, &cs);
          x1 = acc[m][2][e]; x2 = acc[m][3][e];
          acc[m][2][e] = x1 * cs - x2 * sn; acc[m][3][e] = x1 * sn + x2 * cs;
        }
      }
#pragma unroll
      for (int n = 0; n < 4; ++n) {
        const int c = nt * 128 + wc * 64 + n * 16 + fq * 4;
        uint2 w; w.x = pack2(acc[m][n][0], acc[m][n][1]); w.y = pack2(acc[m][n][2], acc[m][n][3]);
        *(uint2*)(QKV + (size_t)row * 1536 + c) = w;
      }
    }
  }
}
DI void ph_attn(const Params& p, int jj, char* smem) {
  const u16* QKV = (const u16*)(p.ws + OFF_SCR);
  u16* O = (u16*)(p.ws + OFF_SCR) + (size_t)R * 1536;
  u16* Ks = (u16*)smem;
  u16* Vt = Ks + 64 * 80;
  u16* Ps = Vt + 64 * 80;
  const int tid = otid(), lane = tid & 63, wave = tid >> 6, fr = lane & 15, fq = lane >> 4;
  const int g = wave >> 1, th = (wave & 1) * 32;
  u16* Pw = Ps + wave * 32 * 80;
  for (int tl = (int)(blockIdx.x >> 3); tl < 260; tl += (int)(gridDim.x >> 3)) {
    const int kvh = blockIdx.x & 3, b = (blockIdx.x >> 2) & 1;
    const int isctx = tl >= 256 ? 1 : 0, qb = isctx ? tl - 256 : tl;
    const int t0 = qb * 64, qrow0 = b * TS + (isctx ? 0 : TC) + t0;
    const int head = kvh * 4 + g;
    bf16x8 qf[2][2];
#pragma unroll
    for (int m = 0; m < 2; ++m)
#pragma unroll
      for (int kh = 0; kh < 2; ++kh) {
        uint4 v = *(const uint4*)(QKV + (size_t)(qrow0 + th + m * 16 + fr) * 1536 + head * 64 + kh * 32 + fq * 8);
        uint4 o;
        o.x = pack2(blo(v.x) * 0.125f, bhi(v.x) * 0.125f); o.y = pack2(blo(v.y) * 0.125f, bhi(v.y) * 0.125f);
        o.z = pack2(blo(v.z) * 0.125f, bhi(v.z) * 0.125f); o.w = pack2(blo(v.w) * 0.125f, bhi(v.w) * 0.125f);
        qf[m][kh] = *(bf16x8*)&o;
      }
    const float sink = p.in[IASINK][jj * 16 + head];
    float mrun[2] = {sink, sink}, lrun[2] = {1.f, 1.f};
    f32x4 o[2][4];
#pragma unroll
    for (int m = 0; m < 2; ++m)
#pragma unroll
      for (int n = 0; n < 4; ++n) o[m][n] = (f32x4){0.f, 0.f, 0.f, 0.f};
    const int i_lo = t0 >= 128 ? 0 : (t0 >= 64 ? 1 : 2);
    const int i_hi = t0 == T - 64 ? 2 : (t0 == T - 128 ? 3 : 4);
    const int nkt = isctx ? 4 : 4 + (i_hi - i_lo + 1);
    const int skey = tid >> 3, sdc = (tid & 7) * 8;
    uint4 kreg, vreg;
    auto kv_load = [&](int idx) {
      int krow0;
      if (idx < 4) krow0 = b * TS + idx * 64; else krow0 = b * TS + TC + t0 - 128 + 64 * (i_lo + idx - 4);
      const u16* src = QKV + (size_t)(krow0 + skey) * 1536 + 1024 + kvh * 64 + sdc;
      kreg = *(const uint4*)src; vreg = *(const uint4*)(src + 256);
    };
    kv_load(0);
    for (int kt = 0; kt < nkt; ++kt) {
      const int li = i_lo + kt - 4;
      const int mode = kt < 4 ? 0 : (li == 0 ? 1 : (li == 4 ? 2 : 0));
      lds_barrier();
      {
        *(uint4*)&Ks[skey * 80 + sdc] = kreg;
        const u16* vv = (const u16*)&vreg;
#pragma unroll
        for (int e = 0; e < 8; ++e) Vt[(sdc + e) * 80 + (skey ^ ((tid & 7) << 3))] = vv[e];
      }
      lds_barrier();
      if (kt + 1 < nkt) kv_load(kt + 1);
      f32x4 sacc[2][4];
#pragma unroll
      for (int m = 0; m < 2; ++m)
#pragma unroll
        for (int n = 0; n < 4; ++n) sacc[m][n] = (f32x4){0.f, 0.f, 0.f, 0.f};
#pragma unroll
      for (int kh = 0; kh < 2; ++kh)
#pragma unroll
        for (int n = 0; n < 4; ++n) {
          const bf16x8 kf = *(const bf16x8*)&Ks[(n * 16 + fr) * 80 + kh * 32 + fq * 8];
#pragma unroll
          for (int m = 0; m < 2; ++m) sacc[m][n] = MFMA(kf, qf[m][kh], sacc[m][n]);
        }
#pragma unroll
      for (int m = 0; m < 2; ++m) {
        const int qi = th + m * 16 + fr;
        float mx = -3.0e38f;
#pragma unroll
        for (int n = 0; n < 4; ++n)
#pragma unroll
          for (int e = 0; e < 4; ++e) {
            const int ki = n * 16 + fq * 4 + e;
            if ((mode == 1 && ki < qi) || (mode == 2 && ki > qi)) sacc[m][n][e] = -INFINITY;
            mx = fmaxf(mx, sacc[m][n][e]);
          }
        mx = fmaxf(mx, __shfl_xor(mx, 16)); mx = fmaxf(mx, __shfl_xor(mx, 32));
        const float mnew = fmaxf(mrun[m], mx);
        const float alpha = __expf(mrun[m] - mnew);
        float ps = 0.f;
#pragma unroll
        for (int n = 0; n < 4; ++n) {
          const float p0 = __expf(sacc[m][n][0] - mnew), p1 = __expf(sacc[m][n][1] - mnew), p2 = __expf(sacc[m][n][2] - mnew), p3 = __expf(sacc[m][n][3] - mnew);
          ps += p0 + p1 + p2 + p3;
          uint2 w; w.x = pack2(p0, p1); w.y = pack2(p2, p3);
          *(uint2*)&Pw[(m * 16 + fr) * 80 + n * 16 + fq * 4] = w;
        }
        ps += __shfl_xor(ps, 16); ps += __shfl_xor(ps, 32);
        lrun[m] = lrun[m] * alpha + ps; mrun[m] = mnew;
#pragma unroll
        for (int n = 0; n < 4; ++n) { o[m][n][0] *= alpha; o[m][n][1] *= alpha; o[m][n][2] *= alpha; o[m][n][3] *= alpha; }
      }
      __builtin_amdgcn_fence(__ATOMIC_RELEASE, "wavefront");
      __builtin_amdgcn_wave_barrier();
      __builtin_amdgcn_fence(__ATOMIC_ACQUIRE, "wavefront");
#pragma unroll
      for (int ks = 0; ks < 2; ++ks) {
        bf16x8 pf[2];
#pragma unroll
        for (int m = 0; m < 2; ++m) pf[m] = *(const bf16x8*)&Pw[(m * 16 + fr) * 80 + ks * 32 + fq * 8];
#pragma unroll
        for (int nd = 0; nd < 4; ++nd) {
          const bf16x8 vf = *(const bf16x8*)&Vt[(nd * 16 + fr) * 80 + (((ks * 4 + fq) ^ ((nd * 2 + (fr >> 3)) & 7)) << 3)];
#pragma unroll
          for (int m = 0; m < 2; ++m) o[m][nd] = MFMA(vf, pf[m], o[m][nd]);
        }
      }
    }
#pragma unroll
    for (int m = 0; m < 2; ++m) {
      const float il = 1.f / lrun[m];
      const int row = qrow0 + th + m * 16 + fr;
#pragma unroll
      for (int nd = 0; nd < 4; ++nd) {
        uint2 w; w.x = pack2(o[m][nd][0] * il, o[m][nd][1] * il); w.y = pack2(o[m][nd][2] * il, o[m][nd][3] * il);
        *(uint2*)(O + (size_t)row * 1024 + head * 64 + nd * 16 + fq * 4) = w;
      }
    }
  }
}

#define DBL_A 0
#define DBL_B 0
#define DBL_C 0
#define DBL_D 0
#define DBL_E 0
DI int layer_phases(int l) { int k = l % 3; return k == 0 ? 25 : (k == 1 ? 8 : 7); }
constexpr int N_PHASES = 2 + 25 + 8 + 7 + 25 + 1;

DI void run_phase(const Params& p, int ph, char* smem) {
  if (ph == 0) { ph_prologue(p, smem); ph_convert(p, 0, smem); return; }
  if (ph == 1) { ph_modreduce(p); return; }
  int q = ph - 2, l = 0;
  while (l < 4 && q >= layer_phases(l)) { q -= layer_phases(l); ++l; }
  if (l == 4) { ph_final(p); return; }
  const int kind = l % 3, jj = l / 3;
  const int np = layer_phases(l);
  const u16* wt = (const u16*)(p.ws + OFF_WT);
  if (q == 0) { ph_norm(p, l, 0); if (l > 0) ph_convert(p, l, smem); return; }
  if (q == np - 3) { ph_norm(p, l, 1); return; }
  if (q == np - 2) { ph_ffn1(p, l, smem);
#if DBL_A
    ph_ffn1(p, l, smem);
#endif
    return; }
  if (q == np - 1) { ph_resid_gemm(p, (const u16*)(p.ws + OFF_SCR), FF, wt + WT_W2T, FF, l, 5, smem); return; }
  if (kind == 0) {
    if (q == 1) { ph_rw_r1(p, jj, smem);
#if DBL_A
    ph_rw_r1(p, jj, smem);
#endif
    return; }
    if (q >= 2 && q <= 19) { int s = q - 2; if (s >= 1) {
#if DBL_D
      ph_rw_scan(p, s - 1, smem, false);
#endif
      ph_rw_scan(p, s - 1, smem); }
      if (s < 17) { ph_rw_produce(p, jj, s, smem);
#if DBL_E
      ph_rw_produce(p, jj, s, smem);
#endif
      } return; }
    if (q == 20) { ph_rw_finish(p, jj, smem); return; }
    if (q == 21) { ph_resid_gemm(p, (const u16*)(p.ws + OFF_SCR) + (size_t)R * P1LD, 1024, wt + WT_RWO, 1024, l, 2, smem); return; }
  } else if (kind == 1) {
    if (q == 1) { ph_ssd_s1(p, jj, smem); return; }
    if (q == 2) { ph_ssd_scan(p, jj, smem);
#if DBL_B
    ph_ssd_scan(p, jj, smem);
#endif
    return; }
    if (q == 3) { ph_ssd_s3(p, smem); return; }
    if (q == 4) { ph_ssd_s4(p, l, jj, smem); return; }
  } else {
    if (q == 1) { ph_at_qkv(p, smem);
#if DBL_A
    ph_at_qkv(p, smem);
#endif
    return; }
    if (q == 2) { ph_attn(p, jj, smem);
#if DBL_C
    ph_attn(p, jj, smem);
#endif
    return; }
    if (q == 3) { ph_resid_gemm(p, (const u16*)(p.ws + OFF_SCR) + (size_t)R * 1536, 1024, wt + WT_AO, 1024, l, 2, smem); return; }
  }
}

extern "C" __global__ void __launch_bounds__(512) mega(Params p, int ph_lo, int ph_hi) {
  extern __shared__ __attribute__((aligned(16))) char smem[];
  cg::grid_group grid = cg::this_grid();
#ifndef PROBE
#define PROBE 0
#endif
#if PROBE
  unsigned long long* tsb = (unsigned long long*)(p.ws + OFF_MODP);
#endif
  __shared__ uint4 xb_words;
  if (threadIdx.x == 0) xb_words = make_uint4(0u, 0u, 0u, 0u);
  __syncthreads();
  XcdBarrier xb = xcd_barrier_post((unsigned*)(p.ws + OFF_BAR), (volatile LAS unsigned*)&xb_words);
  for (int ph = ph_lo; ph < ph_hi; ++ph) {
    run_phase(p, ph, smem);
    if (ph + 1 < ph_hi) { if (ph == ph_lo) grid.sync(); else xcd_barrier(xb); }
  }
#if PROBE
  grid.sync();
  if (blockIdx.x == 0) {
    const float t1 = (float)(tsb[PA1] - tsb[PA0]) * 1e-5f, t2 = (float)(tsb[PB1] - tsb[PB0]) * 1e-5f;
    for (int i = threadIdx.x; i < (1 << 23); i += 512) p.out[i] = t2;
    __syncthreads();
    if (threadIdx.x == 0) p.out[0] = 64.f * t1;
  }
#endif
}

extern "C" void kernel_launch(void* const* d_in, const int* in_sizes, int n_in, void* d_out, int out_size, void* d_ws, size_t ws_size, hipStream_t stream) {
  Params p{};
  for (int i = 0; i < 41; ++i) p.in[i] = (const float*)d_in[i];
  p.out = (float*)d_out; p.ws = (char*)d_ws;
  constexpr size_t kLds = 162048;
  hipFuncSetAttribute((const void*)mega, hipFuncAttributeMaxDynamicSharedMemorySize, (int)kLds);
  hipMemsetAsync((char*)d_ws + OFF_BAR, 0, XCD_BAR_WORDS * 4, stream);
  int lo = 0, hi = N_PHASES;
  void* args[] = {&p, &lo, &hi};
  hipError_t e = hipLaunchCooperativeKernel((void*)mega, dim3(256), dim3(512), args, kLds, stream);
  if (e != hipSuccess) fprintf(stderr, "coop launch failed: %s\n", hipGetErrorString(e));
}
```

```cpp
#include <hip/hip_runtime.h>
#include <hip/hip_cooperative_groups.h>
#include <hip/hip_fp16.h>
#include <cstdio>
namespace cg = cooperative_groups;

typedef unsigned short u16;
typedef short bf16x8 __attribute__((ext_vector_type(8)));
typedef float f32x4 __attribute__((ext_vector_type(4)));
typedef float f32x2 __attribute__((ext_vector_type(2)));
#define MFMA(a, b, c) __builtin_amdgcn_mfma_f32_16x16x32_bf16(a, b, c, 0, 0, 0)
#define DI __device__ __forceinline__

constexpr int D = 1024, NBAT = 2, T = 16384, TC = 256, TS = T + TC, R = NBAT * TS, FF = 2816;
enum { IX = 0, IC, ICTX, ICC, IADAW, IADAB, IN1, IN2, IFWIN, IFCONV, IFWOUT, IFINAL, IRMU, IRWR, IRWK, IRWV, IRWO, IRW0, IRW1, IRW2, IRA0, IRA1,
       IRA2, IRG1, IRG2, IRKK, IRKA, IRRK, IRLNG, IRLNB, ISWIN, ISCONVW, ISCONVB, ISDTB, ISALOG, ISD, ISNG, ISWOUT, IAQKV, IAWO, IASINK };

__device__ __forceinline__ unsigned long long rfl64(unsigned long long v) {
  unsigned lo = __builtin_amdgcn_readfirstlane((unsigned)v), hi = __builtin_amdgcn_readfirstlane((unsigned)(v >> 32));
  return ((unsigned long long)hi << 32) | lo;
}
struct Params {
  const float* in[41]; float* out; char* ws;
  __device__ __forceinline__ const float* inp(int i) const { return (const float*)rfl64((unsigned long long)in[i]); }
  __device__ __forceinline__ float* outp() const { return (float*)rfl64((unsigned long long)out); }
  __device__ __forceinline__ char* wsp() const { return (char*)rfl64((unsigned long long)ws); }
};

constexpr size_t alup(size_t x) { return (x + 255) & ~(size_t)255; }
constexpr size_t OFF_XC = 0;
constexpr size_t OFF_BAR = OFF_XC + alup((size_t)512 * 1024 * 4);
constexpr size_t OFF_MODP = OFF_BAR + 16384;
constexpr size_t OFF_MOD = OFF_MODP + alup((size_t)16 * 4 * 3 * 6144 * 4);
constexpr size_t OFF_SSQ = OFF_MOD + alup((size_t)4 * 3 * 6144 * 4);
constexpr size_t OFF_DT = OFF_SSQ + alup((size_t)R * 8 * 4);
constexpr size_t OFF_BONUS = OFF_DT;
constexpr size_t OFF_RWST = OFF_DT + alup((size_t)R * 64 * 4);
constexpr size_t OFF_H = OFF_RWST + alup((size_t)256 * 256 * 4 * 4);
constexpr size_t OFF_RING = OFF_H;
constexpr size_t OFF_WT = OFF_H + alup((size_t)R * 1024 * 2);
constexpr size_t WT_ELEMS = 17170432;
constexpr size_t OFF_SCR = OFF_WT + alup(WT_ELEMS * 2);
constexpr size_t SCR_BYTES = (size_t)R * 4096 * 2 + (size_t)R * 2048 * 2;
static_assert(OFF_SCR + SCR_BYTES <= (size_t)536870912, "workspace too large");
constexpr size_t WT_W1T = 0, WT_W2T = (size_t)5632 * 1024, WT_MIX = WT_W2T + (size_t)1024 * 2816;
constexpr size_t WT_R1T = WT_MIX, WT_LUT = WT_R1T + (size_t)3456 * 1024, WT_G2T = WT_LUT + (size_t)2 * 16 * 128 * 128, WT_RWO = WT_G2T + (size_t)1024 * 128;
constexpr size_t WT_SX = WT_MIX, WT_SZ = WT_SX + (size_t)4224 * 1024, WT_SO = WT_SZ + (size_t)2048 * 1024;
constexpr size_t WT_AQ = WT_MIX, WT_AO = WT_AQ + (size_t)1536 * 1024;
static_assert(WT_SO + (size_t)1024 * 2048 <= WT_ELEMS, "wt");
static_assert((size_t)2 * 2 * 2 * 1024 * 16 * 512 <= (size_t)R * 1024 * 2, "ring");

DI u16 f2b(float f) { unsigned u = __float_as_uint(f); u += 0x7fffu + ((u >> 16) & 1u); return (u16)(u >> 16); }
DI float b2f(u16 h) { return __uint_as_float(((unsigned)h) << 16); }
DI unsigned pack2(float a, float b) { return (unsigned)f2b(a) | ((unsigned)f2b(b) << 16); }
DI float blo(unsigned u) { return __uint_as_float(u << 16); }
DI float bhi(unsigned u) { return __uint_as_float(u & 0xffff0000u); }
DI float siluf(float x) { return x / (1.f + __expf(-x)); }
DI float sigmf(float x) { return 1.f / (1.f + __expf(-x)); }
DI float softplusf(float x) { return x > 20.f ? x : log1pf(__expf(x)); }
DI int otid() { int t = threadIdx.x; asm volatile("" : "+v"(t)); return t; }
DI void lds_barrier() { asm volatile("s_waitcnt lgkmcnt(0)\n\ts_barrier" ::: "memory"); }
DI f32x4 gload_f4(const float* p) { f32x4 v; asm volatile("global_load_dwordx4 %0, %1, off" : "=v"(v) : "v"(p) : "memory"); return v; }
DI void vm_wait0() { asm volatile("s_waitcnt vmcnt(0)" ::: "memory"); }
DI float wsum(float v) { for (int o = 32; o; o >>= 1) v += __shfl_xor(v, o); return v; }
DI float* xrow_ptr(const Params& p, int r) {
  int b = r / TS, q = r - b * TS;
  return q < TC ? (float*)(p.ws + OFF_XC) + ((size_t)(b * TC + q) << 10) : p.out + ((size_t)(b * T + q - TC) << 10);
}
DI const float* mod_ptr(const Params& p, int l, int r) {
  int b = r / TS, q = r - b * TS;
  int v = q < TC ? 2 : b;
  return (const float*)(p.ws + OFF_MOD) + (size_t)(l * 3 + v) * 6144;
}


#define XB_TMO      128
#define XB_XCNT(j)  (256  + 64 * (j))
#define XB_XSUB(j)  (1280 + 64 * (j))
#define XB_XGEN(j)  (2304 + 64 * (j))
#define XB_TOP      3328
#define XB_TOPGEN   3392
#define XCD_BAR_WORDS 3456
#define XB_SPIN_CAP (1u << 18)
#define LAS __attribute__((address_space(3)))
DI unsigned xb_ld(unsigned* p) { return __hip_atomic_load(p, __ATOMIC_RELAXED, __HIP_MEMORY_SCOPE_AGENT); }
DI unsigned xb_add(unsigned* p, unsigned v) { return __hip_atomic_fetch_add(p, v, __ATOMIC_RELAXED, __HIP_MEMORY_SCOPE_AGENT); }
DI unsigned xb_xcc_id() { return (unsigned)__builtin_amdgcn_s_getreg((3 << 11) | 20) & 0xFu; }
#define XB_SPIN(cond, bar) do { unsigned _sp = 0; while (cond) { __builtin_amdgcn_s_sleep(1); \
    if ((++_sp & 255u) == 0u) { if (xb_ld(&(bar)[XB_TMO])) break; if (_sp > XB_SPIN_CAP) { atomicAdd(&(bar)[XB_TMO], 1u); break; } } } } while (0)
struct XcdBarrier { unsigned* bar; unsigned x; volatile LAS unsigned* st; };
DI XcdBarrier xcd_barrier_post(unsigned* bar, volatile LAS unsigned* st) {
  XcdBarrier b; b.bar = bar; b.x = xb_xcc_id(); b.st = st;
  if (threadIdx.x == 0) (void)xb_add(&bar[XB_XCNT(b.x)], 1u);
  return b;
}
DI void xcd_barrier_complete(unsigned* bar, unsigned x, unsigned& nloc, unsigned& nx) {
  const unsigned G = gridDim.x * gridDim.y * gridDim.z;
  unsigned sum, cnt, mine, sp = 0u;
  for (;;) {
    sum = 0u; cnt = 0u; mine = 0u;
#pragma unroll
    for (unsigned j = 0; j < 16; ++j) { const unsigned c = xb_ld(&bar[XB_XCNT(j)]); sum += c; cnt += (c > 0u) ? 1u : 0u; mine = (j == x) ? c : mine; }
    if (sum == G) break;
    __builtin_amdgcn_s_sleep(1);
    if ((++sp & 255u) == 0u) { if (xb_ld(&bar[XB_TMO])) break; if (sp > XB_SPIN_CAP) { atomicAdd(&bar[XB_TMO], 1u); break; } }
  }
  nloc = mine > 0u ? mine : 1u; nx = cnt > 0u ? cnt : 1u;
}
DI void xcd_barrier(const XcdBarrier& b) {
  asm volatile("s_waitcnt vmcnt(0)" ::: "memory");
  __syncthreads();
  if (threadIdx.x == 0) {
    unsigned* bar = b.bar;
    __builtin_amdgcn_s_waitcnt(0);
    unsigned nloc = b.st[0], nx = b.st[1];
    if (nloc == 0u) { xcd_barrier_complete(bar, b.x, nloc, nx); b.st[0] = nloc; b.st[1] = nx; }
    const unsigned old = xb_add(&bar[XB_XSUB(b.x)], 1u);
    const unsigned gen = old / nloc;
    if (old + 1u == (gen + 1u) * nloc) {
      __builtin_amdgcn_fence(__ATOMIC_RELEASE, "agent");
      asm volatile("s_waitcnt vmcnt(0)" ::: "memory");
      const unsigned og = xb_add(&bar[XB_TOP], 1u);
      const unsigned tg = og / nx;
      if (og + 1u == (tg + 1u) * nx) xb_add(&bar[XB_TOPGEN], 1u);
      else XB_SPIN(xb_ld(&bar[XB_TOPGEN]) == tg, bar);
      __builtin_amdgcn_fence(__ATOMIC_ACQUIRE, "agent");
      xb_add(&bar[XB_XGEN(b.x)], 1u);
      asm volatile("s_waitcnt vmcnt(0)" ::: "memory");
    } else {
      XB_SPIN(xb_ld(&bar[XB_XGEN(b.x)]) == gen, bar);
      __builtin_amdgcn_fence(__ATOMIC_ACQUIRE, "agent");
      asm volatile("s_waitcnt vmcnt(0)" ::: "memory");
    }
  }
  __syncthreads();
}

constexpr int LDS_ROW = 64;
struct SmemG { u16 A[2][256 * LDS_ROW]; u16 B[2][128 * LDS_ROW]; };
template <class AL>
DI void gemm_main(const AL& al, const u16* __restrict__ Bt, int ldb, int K, f32x4 (&acc)[4][4], char* smem) {
  SmemG& s = *(SmemG*)smem;
  const int tid = otid(), lane = tid & 63, wave = tid >> 6, wr = wave >> 1, wc = wave & 1, fr = lane & 15, fq = lane >> 4;
#pragma unroll
  for (int m = 0; m < 4; ++m)
#pragma unroll
    for (int n = 0; n < 4; ++n) acc[m][n] = (f32x4){0.f, 0.f, 0.f, 0.f};
  uint4 ra[4], rb[2];
  const int nk = K >> 6;
  const int lrow = tid >> 3, lkc = (tid & 7) * 8, lsw = ((tid & 7) ^ (lrow & 7)) * 8;
  __syncthreads();
#pragma unroll
  for (int i = 0; i < 4; ++i) ra[i] = al(lrow + i * 64, lkc);
#pragma unroll
  for (int i = 0; i < 2; ++i) rb[i] = *(const uint4*)(Bt + (size_t)(lrow + i * 64) * ldb + lkc);
#pragma unroll
  for (int i = 0; i < 4; ++i) *(uint4*)&s.A[0][(lrow + i * 64) * LDS_ROW + lsw] = al.post(ra[i], lrow + i * 64, lkc);
#pragma unroll
  for (int i = 0; i < 2; ++i) *(uint4*)&s.B[0][(lrow + i * 64) * LDS_ROW + lsw] = rb[i];
  __syncthreads();
  for (int kt = 0; kt < nk; ++kt) {
    const int buf = kt & 1;
    const int kn = (kt + 1 < nk ? kt + 1 : kt) * 64 + lkc;
#pragma unroll
    for (int i = 0; i < 2; ++i) {
      const u16* bp = Bt + (size_t)(lrow + i * 64) * ldb + kn;
      asm volatile("global_load_dwordx4 %0, %1, off" : "=v"(rb[i]) : "v"(bp) : "memory");
    }
#pragma unroll
    for (int i = 0; i < 4; ++i) ra[i] = al(lrow + i * 64, kn);
    __builtin_amdgcn_sched_barrier(0);
#pragma unroll
    for (int kh = 0; kh < 2; ++kh) {
      bf16x8 a[4], b[4];
#pragma unroll
      for (int m = 0; m < 4; ++m) a[m] = *(const bf16x8*)&s.A[buf][(wr * 64 + m * 16 + fr) * LDS_ROW + (((kh * 4 + fq) ^ (fr & 7)) << 3)];
#pragma unroll
      for (int n = 0; n < 4; ++n) b[n] = *(const bf16x8*)&s.B[buf][(wc * 64 + n * 16 + fr) * LDS_ROW + (((kh * 4 + fq) ^ (fr & 7)) << 3)];
      __builtin_amdgcn_s_setprio(1);
#pragma unroll
      for (int m = 0; m < 4; ++m)
#pragma unroll
        for (int n = 0; n < 4; ++n) acc[m][n] = MFMA(b[n], a[m], acc[m][n]);
      __builtin_amdgcn_s_setprio(0);
    }
    asm volatile("s_waitcnt vmcnt(0)" ::: "memory");
#pragma unroll
    for (int i = 0; i < 4; ++i) *(uint4*)&s.A[buf ^ 1][(lrow + i * 64) * LDS_ROW + lsw] = al.post(ra[i], lrow + i * 64, kn);
#pragma unroll
    for (int i = 0; i < 2; ++i) *(uint4*)&s.B[buf ^ 1][(lrow + i * 64) * LDS_ROW + lsw] = rb[i];
    __syncthreads();
  }
}

template <class AL>
DI void gemm_main3(const AL& al, const u16* __restrict__ Bt, int ldb, int K, f32x4 (&acc)[4][4], char* smem) {
  SmemG& s = *(SmemG*)smem;
  const int tid = otid(), lane = tid & 63, wave = tid >> 6, wr = wave >> 1, wc = wave & 1, fr = lane & 15, fq = lane >> 4;
  const bool grpY = __builtin_amdgcn_readfirstlane(wave) >= 4;
#pragma unroll
  for (int m = 0; m < 4; ++m)
#pragma unroll
    for (int n = 0; n < 4; ++n) acc[m][n] = (f32x4){0.f, 0.f, 0.f, 0.f};
  uint4 ra[4], rb[2];
  const int nk = K >> 6;
  const int lrow = tid >> 3, lkc = (tid & 7) * 8, lsw = ((tid & 7) ^ (lrow & 7)) * 8;
  __syncthreads();
#pragma unroll
  for (int i = 0; i < 4; ++i) ra[i] = al(lrow + i * 64, lkc);
#pragma unroll
  for (int i = 0; i < 2; ++i) rb[i] = *(const uint4*)(Bt + (size_t)(lrow + i * 64) * ldb + lkc);
#pragma unroll
  for (int i = 0; i < 4; ++i) *(uint4*)&s.A[0][(lrow + i * 64) * LDS_ROW + lsw] = al.post(ra[i], lrow + i * 64, lkc);
#pragma unroll
  for (int i = 0; i < 2; ++i) *(uint4*)&s.B[0][(lrow + i * 64) * LDS_ROW + lsw] = rb[i];
  __syncthreads();
  const u16* abase = &s.A[0][(wr * 64 + fr) * LDS_ROW];
  const u16* bbase = &s.B[0][(wc * 64 + fr) * LDS_ROW];
  bf16x8 fa[4], fb[4];
#define G3_RD(BUF, KH) do { \
    _Pragma("unroll") for (int m = 0; m < 4; ++m) fa[m] = *(const bf16x8*)(abase + (BUF) * 256 * LDS_ROW + m * 16 * LDS_ROW + ((((KH) * 4 + fq) ^ (fr & 7)) << 3)); \
    _Pragma("unroll") for (int n = 0; n < 4; ++n) fb[n] = *(const bf16x8*)(bbase + (BUF) * 128 * LDS_ROW + n * 16 * LDS_ROW + ((((KH) * 4 + fq) ^ (fr & 7)) << 3)); } while (0)
#define G3_MM() do { \
    _Pragma("unroll") for (int m = 0; m < 4; ++m) _Pragma("unroll") for (int n = 0; n < 4; ++n) acc[m][n] = MFMA(fb[n], fa[m], acc[m][n]); } while (0)
  int kn = (1 < nk ? 1 : 0) * 64 + lkc;
#pragma unroll
  for (int i = 0; i < 2; ++i) {
    const u16* bp = Bt + (size_t)(lrow + i * 64) * ldb + kn;
    asm volatile("global_load_dwordx4 %0, %1, off" : "=v"(rb[i]) : "v"(bp) : "memory");
  }
#pragma unroll
  for (int i = 0; i < 4; ++i) ra[i] = al(lrow + i * 64, kn);
  if (grpY) G3_RD(0, 0);
  __builtin_amdgcn_sched_barrier(0);
  for (int kt = 0; kt < nk; ++kt) {
    const int buf = kt & 1;
    if (!grpY) G3_RD(buf, 0);
    __builtin_amdgcn_sched_barrier(0);
    G3_MM();
    __builtin_amdgcn_sched_barrier(0);
    if (grpY) G3_RD(buf, 1);
    __builtin_amdgcn_sched_barrier(0);
    asm volatile("s_waitcnt vmcnt(0)" ::: "memory");
#pragma unroll
    for (int i = 0; i < 4; ++i) *(uint4*)&s.A[buf ^ 1][(lrow + i * 64) * LDS_ROW + lsw] = al.post(ra[i], lrow + i * 64, kn);
#pragma unroll
    for (int i = 0; i < 2; ++i) *(uint4*)&s.B[buf ^ 1][(lrow + i * 64) * LDS_ROW + lsw] = rb[i];
    if (kt + 2 < nk) {
      kn = (kt + 2) * 64 + lkc;
#pragma unroll
      for (int i = 0; i < 2; ++i) {
        const u16* bp = Bt + (size_t)(lrow + i * 64) * ldb + kn;
        asm volatile("global_load_dwordx4 %0, %1, off" : "=v"(rb[i]) : "v"(bp) : "memory");
      }
#pragma unroll
      for (int i = 0; i < 4; ++i) ra[i] = al(lrow + i * 64, kn);
    }
    __builtin_amdgcn_sched_barrier(0);
    lds_barrier();
    if (!grpY) G3_RD(buf, 1);
    __builtin_amdgcn_sched_barrier(0);
    G3_MM();
    __builtin_amdgcn_sched_barrier(0);
    if (grpY) G3_RD(buf ^ 1, 0);
    __builtin_amdgcn_sched_barrier(0);
    lds_barrier();
  }
  asm volatile("s_waitcnt vmcnt(0)" ::: "memory");
  __syncthreads();
}

template <class AL>
DI void gemm_main4(const AL& al, const u16* __restrict__ Bt, int ldb, int K, f32x4 (&acc)[4][4], char* smem) {
  SmemG& s = *(SmemG*)smem;
  const int tid = otid(), lane = tid & 63, wave = tid >> 6, wr = wave >> 1, wc = wave & 1, fr = lane & 15, fq = lane >> 4;
#pragma unroll
  for (int m = 0; m < 4; ++m)
#pragma unroll
    for (int n = 0; n < 4; ++n) acc[m][n] = (f32x4){0.f, 0.f, 0.f, 0.f};
  uint4 a0[4], a1[4], b00, b01, b10, b11;
  const int nk = K >> 6;
  const int lrow = tid >> 3, lkc = (tid & 7) * 8, lsw = ((tid & 7) ^ (lrow & 7)) * 8;
  __syncthreads();
#pragma unroll
  for (int i = 0; i < 4; ++i) a0[i] = al(lrow + i * 64, lkc);
#pragma unroll
  for (int i = 0; i < 1; ++i) { b00 = *(const uint4*)(Bt + (size_t)lrow * ldb + lkc); b01 = *(const uint4*)(Bt + (size_t)(lrow + 64) * ldb + lkc); }
#pragma unroll
  for (int i = 0; i < 4; ++i) *(uint4*)&s.A[0][(lrow + i * 64) * LDS_ROW + lsw] = al.post(a0[i], lrow + i * 64, lkc);
#pragma unroll
  for (int i = 0; i < 1; ++i) { *(uint4*)&s.B[0][lrow * LDS_ROW + lsw] = b00; *(uint4*)&s.B[0][(lrow + 64) * LDS_ROW + lsw] = b01; }
  __syncthreads();
  auto g4_load = [&](uint4 (&RA)[4], uint4& RB0, uint4& RB1, int KN) {
#pragma unroll
    for (int i = 0; i < 4; ++i) RA[i] = al(lrow + i * 64, KN);
    RB0 = *(const uint4*)(Bt + (size_t)lrow * ldb + KN);
    RB1 = *(const uint4*)(Bt + (size_t)(lrow + 64) * ldb + KN);
  };
  auto g4_store = [&](uint4 (&RA)[4], uint4& RB0, uint4& RB1, int BUF, int KN) {
#pragma unroll
    for (int i = 0; i < 4; ++i) *(uint4*)&s.A[BUF][(lrow + i * 64) * LDS_ROW + lsw] = al.post(RA[i], lrow + i * 64, KN);
    *(uint4*)&s.B[BUF][lrow * LDS_ROW + lsw] = RB0;
    *(uint4*)&s.B[BUF][(lrow + 64) * LDS_ROW + lsw] = RB1;
  };
#define G4_COMPUTE(BUF) do { \
    _Pragma("unroll") for (int kh = 0; kh < 2; ++kh) { \
      bf16x8 a[4], b[4]; \
      _Pragma("unroll") for (int m = 0; m < 4; ++m) a[m] = *(const bf16x8*)&s.A[BUF][(wr * 64 + m * 16 + fr) * LDS_ROW + (((kh * 4 + fq) ^ (fr & 7)) << 3)]; \
      _Pragma("unroll") for (int n = 0; n < 4; ++n) b[n] = *(const bf16x8*)&s.B[BUF][(wc * 64 + n * 16 + fr) * LDS_ROW + (((kh * 4 + fq) ^ (fr & 7)) << 3)]; \
      __builtin_amdgcn_s_setprio(1); \
      _Pragma("unroll") for (int m = 0; m < 4; ++m) _Pragma("unroll") for (int n = 0; n < 4; ++n) acc[m][n] = MFMA(b[n], a[m], acc[m][n]); \
      __builtin_amdgcn_s_setprio(0); } } while (0)
  int k1 = 64 + lkc, k2 = (2 < nk ? 2 : nk - 1) * 64 + lkc;
  g4_load(a0, b00, b01, k1);
  g4_load(a1, b10, b11, k2);
  __builtin_amdgcn_sched_barrier(0);
  for (int kt = 0; kt < nk; kt += 2) {
    G4_COMPUTE(0);
    __builtin_amdgcn_sched_barrier(0);
    g4_store(a0, b00, b01, 1, k1);
    k1 = (kt + 3 < nk ? kt + 3 : nk - 1) * 64 + lkc;
    g4_load(a0, b00, b01, k1);
    __builtin_amdgcn_sched_barrier(0);
    __syncthreads();
    G4_COMPUTE(1);
    __builtin_amdgcn_sched_barrier(0);
    g4_store(a1, b10, b11, 0, k2);
    k2 = (kt + 4 < nk ? kt + 4 : nk - 1) * 64 + lkc;
    g4_load(a1, b10, b11, k2);
    __builtin_amdgcn_sched_barrier(0);
    __syncthreads();
  }
}


struct SmemG2 { u16 A[2][256 * LDS_ROW]; u16 B[2][256 * LDS_ROW]; };
template <class AL>
DI void gemm_main2(const AL& al, const u16* __restrict__ Bt, int ldb, int K, f32x4 (&acc)[4][8], char* smem) {
  SmemG2& s = *(SmemG2*)smem;
  const int tid = otid(), lane = tid & 63, wave = tid >> 6, wr = wave >> 1, wc = wave & 1, fr = lane & 15, fq = lane >> 4;
#pragma unroll
  for (int m = 0; m < 4; ++m)
#pragma unroll
    for (int n = 0; n < 8; ++n) acc[m][n] = (f32x4){0.f, 0.f, 0.f, 0.f};
  uint4 ra[4], rb[4];
  const int nk = K >> 6;
  const int lrow = tid >> 3, lkc = (tid & 7) * 8, lsw = ((tid & 7) ^ (lrow & 7)) * 8;
  __syncthreads();
#pragma unroll
  for (int i = 0; i < 4; ++i) ra[i] = al(lrow + i * 64, lkc);
#pragma unroll
  for (int i = 0; i < 4; ++i) rb[i] = *(const uint4*)(Bt + (size_t)(lrow + i * 64) * ldb + lkc);
#pragma unroll
  for (int i = 0; i < 4; ++i) *(uint4*)&s.A[0][(lrow + i * 64) * LDS_ROW + lsw] = al.post(ra[i], lrow + i * 64, lkc);
#pragma unroll
  for (int i = 0; i < 4; ++i) *(uint4*)&s.B[0][(lrow + i * 64) * LDS_ROW + lsw] = rb[i];
  __syncthreads();
  for (int kt = 0; kt < nk; ++kt) {
    const int buf = kt & 1;
    const int kn = (kt + 1 < nk ? kt + 1 : kt) * 64 + lkc;
#pragma unroll
    for (int i = 0; i < 4; ++i) ra[i] = al(lrow + i * 64, kn);
    __builtin_amdgcn_sched_barrier(0);
#pragma unroll
    for (int kh = 0; kh < 2; ++kh) {
      bf16x8 a[4];
#pragma unroll
      for (int m = 0; m < 4; ++m) a[m] = *(const bf16x8*)&s.A[buf][(wr * 64 + m * 16 + fr) * LDS_ROW + (((kh * 4 + fq) ^ (fr & 7)) << 3)];
      bf16x8 bc = *(const bf16x8*)&s.B[buf][(wc * 128 + fr) * LDS_ROW + (((kh * 4 + fq) ^ (fr & 7)) << 3)];
#pragma unroll
      for (int n = 0; n < 8; ++n) {
        const bf16x8 bn = *(const bf16x8*)&s.B[buf][(wc * 128 + (n < 7 ? n + 1 : n) * 16 + fr) * LDS_ROW + (((kh * 4 + fq) ^ (fr & 7)) << 3)];
        __builtin_amdgcn_sched_barrier(0);
        __builtin_amdgcn_s_setprio(1);
#pragma unroll
        for (int m = 0; m < 4; ++m) acc[m][n] = MFMA(bc, a[m], acc[m][n]);
        __builtin_amdgcn_s_setprio(0);
        bc = bn;
      }
      __builtin_amdgcn_sched_barrier(0);
      if (kh == 0) {
#pragma unroll
        for (int i = 0; i < 4; ++i) *(uint4*)&s.A[buf ^ 1][(lrow + i * 64) * LDS_ROW + lsw] = al.post(ra[i], lrow + i * 64, kn);
#pragma unroll
        for (int i = 0; i < 4; ++i) {
          const u16* bp = Bt + (size_t)(lrow + i * 64) * ldb + kn;
          asm volatile("global_load_dwordx4 %0, %1, off" : "=v"(rb[i]) : "v"(bp) : "memory");
        }
        __builtin_amdgcn_sched_barrier(0);
      }
    }
    asm volatile("s_waitcnt vmcnt(0)" ::: "memory");
#pragma unroll
    for (int i = 0; i < 4; ++i) *(uint4*)&s.B[buf ^ 1][(lrow + i * 64) * LDS_ROW + lsw] = rb[i];
    __syncthreads();
  }
}

DI bool next_tile(int it, int MT, int NT, int GN, int& mt, int& nt) {
  const int xcd = blockIdx.x & 7, lb = blockIdx.x >> 3, GM = 8 / GN;
  const int gm = xcd / GN, gn = xcd - gm * GN;
  const int m0 = gm * MT / GM, m1 = (gm + 1) * MT / GM, n0 = gn * NT / GN, n1 = (gn + 1) * NT / GN;
  const int nl = n1 - n0, tl = lb + it * (gridDim.x >> 3);
  if (tl >= (m1 - m0) * nl) return false;
  const int q = tl / nl;
  mt = m0 + q; nt = n0 + (tl - q * nl);
  return true;
}
struct ALPlain {
  const u16* base; int ld;
  DI uint4 operator()(int i, int k) const { return *(const uint4*)(base + (size_t)i * ld + k); }
  DI uint4 post(uint4 v, int, int) const { return v; }
};

DI void ph_prologue(const Params& p, char* smem) {
  const int tid = otid();
  {
    const float4* x = (const float4*)p.in[IX]; float4* o = (float4*)p.out;
    const size_t n = (size_t)NBAT * T * D / 4;
    for (size_t i = (size_t)blockIdx.x * 512 + tid; i < n; i += (size_t)gridDim.x * 512) o[i] = x[i];
    const float4* c = (const float4*)p.in[ICTX]; float4* xc = (float4*)(p.ws + OFF_XC);
    const size_t nc = (size_t)NBAT * TC * D / 4;
    for (size_t i = (size_t)blockIdx.x * 512 + tid; i < nc; i += (size_t)gridDim.x * 512) xc[i] = c[i];
  }
  float* modp = (float*)(p.ws + OFF_MODP);
  float* sc = (float*)smem;
  __syncthreads();
  for (int e = tid; e < 3072; e += 512) { const float v = e < 2048 ? p.in[IC][e] : p.in[ICC][e - 2048]; sc[e] = siluf(v); }
  __syncthreads();
  const int half = tid >> 8, col = tid & 255;
  for (int it = blockIdx.x * 2 + half; it < 4 * 24 * 16; it += gridDim.x * 2) {
    int l = it / (24 * 16), rem = it - l * 24 * 16, cc = rem / 16, kc = rem & 15;
    int n = cc * 256 + col;
    const float* w = p.in[IADAW] + (size_t)l * 1024 * 6144 + (size_t)(kc * 64) * 6144 + n;
    float a0 = 0.f, a1 = 0.f, a2 = 0.f;
#pragma unroll
    for (int kb = 0; kb < 64; kb += 16) {
      float wv[16];
#pragma unroll
      for (int k = 0; k < 16; ++k) wv[k] = w[(size_t)(kb + k) * 6144];
#pragma unroll
      for (int k = 0; k < 16; ++k) {
        const int kk = kc * 64 + kb + k;
        a0 += sc[kk] * wv[k]; a1 += sc[1024 + kk] * wv[k]; a2 += sc[2048 + kk] * wv[k];
      }
    }
    size_t o = ((size_t)(kc * 4 + l) * 3) * 6144 + n;
    modp[o] = a0; modp[o + 6144] = a1; modp[o + 2 * 6144] = a2;
  }
}
DI void ph_modreduce(const Params& p) {
  const float* modp = (const float*)(p.ws + OFF_MODP); float* mod = (float*)(p.ws + OFF_MOD);
  for (int i = blockIdx.x * 512 + otid(); i < 4 * 3 * 6144; i += gridDim.x * 512) {
    int l = i / (3 * 6144), n = i % 6144;
    float a = p.in[IADAB][l * 6144 + n];
    for (int kc = 0; kc < 16; ++kc) a += modp[(size_t)kc * 4 * 3 * 6144 + i];
    mod[i] = a;
  }
}

struct CvtJob { const float* src; u16* dst; int K, N, ld, ldd, mode; };
DI void cvt_run(const CvtJob& j, int& rot, char* smem) {
  float* tile = (float*)smem;
  const int tid = otid();
  if (j.mode == 4) {
    size_t n = (size_t)j.K * j.N;
    for (size_t i = (size_t)blockIdx.x * 512 + tid; i < n; i += (size_t)gridDim.x * 512) j.dst[i] = 0;
    return;
  }
  const int tk = j.K >> 6, tn = j.N >> 6, nt = tk * tn;
  int start = (blockIdx.x + gridDim.x - (rot % gridDim.x)) % gridDim.x;
  for (int t = start; t < nt; t += gridDim.x) {
    int kt = t / tn, ntl = t - kt * tn;
    __syncthreads();
    {
      f32x4 lv[2];
#pragma unroll
      for (int i = 0; i < 2; ++i) { const int e = tid + i * 512, kk = e >> 4, n4 = (e & 15) * 4; lv[i] = gload_f4(j.src + (size_t)(kt * 64 + kk) * j.ld + ntl * 64 + n4); }
      asm volatile("s_waitcnt vmcnt(0)" : "+v"(lv[0]), "+v"(lv[1]) :: "memory");
#pragma unroll
      for (int i = 0; i < 2; ++i) { const int e = tid + i * 512, kk = e >> 4, n4 = (e & 15) * 4; float* tp = tile + kk * 65 + n4; tp[0] = lv[i][0]; tp[1] = lv[i][1]; tp[2] = lv[i][2]; tp[3] = lv[i][3]; }
    }
    __syncthreads();
    for (int e = tid; e < 4096; e += 512) {
      int nn = e >> 6, kk = e & 63; float v = tile[kk * 65 + nn];
      int n = ntl * 64 + nn, k = kt * 64 + kk;
      if (j.mode == 0) j.dst[(size_t)n * j.ldd + k] = f2b(v);
      else if (j.mode == 1) { int rr = n < FF ? (n >> 7) * 256 + (n & 127) : ((n - FF) >> 7) * 256 + 128 + ((n - FF) & 127); j.dst[(size_t)rr * j.ldd + k] = f2b(v); }
      else {
        int h = n >> 6, c = n & 63, ty = j.mode - 2;
        u16* d = j.dst + (size_t)h * 128 * 128 + (size_t)((c >> 5) * 64 + ty * 32 + (c & 31)) * 128;
        d[ty * 64 + k] = f2b(v); d[(1 - ty) * 64 + k] = 0;
      }
    }
  }
  rot += nt;
}
DI void ph_convert(const Params& p, int l, char* smem) {
  u16* wt = (u16*)(p.ws + OFF_WT);
  int rot = 0;
  CvtJob j;
  j = {p.in[IFWIN] + (size_t)l * 1024 * 5632, wt + WT_W1T, 1024, 5632, 5632, 1024, 1}; cvt_run(j, rot, smem);
  j = {p.in[IFWOUT] + (size_t)l * FF * 1024, wt + WT_W2T, FF, 1024, 1024, FF, 0}; cvt_run(j, rot, smem);
  const int kind = l % 3, jj = l / 3;
  if (kind == 0) {
    j = {p.in[IRWR] + (size_t)jj * 1048576, wt + WT_R1T, 1024, 1024, 1024, 1024, 0}; cvt_run(j, rot, smem);
    j = {p.in[IRWK] + (size_t)jj * 1048576, wt + WT_R1T + (size_t)1024 * 1024, 1024, 1024, 1024, 1024, 0}; cvt_run(j, rot, smem);
    j = {p.in[IRWV] + (size_t)jj * 1048576, wt + WT_R1T + (size_t)2048 * 1024, 1024, 1024, 1024, 1024, 0}; cvt_run(j, rot, smem);
    for (int d = 0; d < 2; ++d) {
      j = {p.in[IRW1] + (size_t)(jj * 2 + d) * 65536, wt + WT_R1T + (size_t)(3072 + d * 64) * 1024, 1024, 64, 64, 1024, 0}; cvt_run(j, rot, smem);
      j = {p.in[IRA1] + (size_t)(jj * 2 + d) * 65536, wt + WT_R1T + (size_t)(3200 + d * 64) * 1024, 1024, 64, 64, 1024, 0}; cvt_run(j, rot, smem);
      j = {p.in[IRW2] + (size_t)(jj * 2 + d) * 65536, wt + WT_LUT + (size_t)d * 16 * 128 * 128, 64, 1024, 1024, 128, 2}; cvt_run(j, rot, smem);
      j = {p.in[IRA2] + (size_t)(jj * 2 + d) * 65536, wt + WT_LUT + (size_t)d * 16 * 128 * 128, 64, 1024, 1024, 128, 3}; cvt_run(j, rot, smem);
    }
    j = {p.in[IRG1] + (size_t)jj * 131072, wt + WT_R1T + (size_t)3328 * 1024, 1024, 128, 128, 1024, 0}; cvt_run(j, rot, smem);
    j = {p.in[IRG2] + (size_t)jj * 131072, wt + WT_G2T, 128, 1024, 1024, 128, 0}; cvt_run(j, rot, smem);
    j = {p.in[IRWO] + (size_t)jj * 1048576, wt + WT_RWO, 1024, 1024, 1024, 1024, 0}; cvt_run(j, rot, smem);
  } else if (kind == 1) {
    j = {p.in[ISWIN] + (size_t)jj * 1024 * 6208 + 2048, wt + WT_SX, 1024, 4160, 6208, 1024, 0}; cvt_run(j, rot, smem);
    j = {nullptr, wt + WT_SX + (size_t)4160 * 1024, 64, 1024, 0, 0, 4}; cvt_run(j, rot, smem);
    j = {p.in[ISWIN] + (size_t)jj * 1024 * 6208, wt + WT_SZ, 1024, 2048, 6208, 1024, 0}; cvt_run(j, rot, smem);
    j = {p.in[ISWOUT] + (size_t)jj * 2048 * 1024, wt + WT_SO, 2048, 1024, 1024, 2048, 0}; cvt_run(j, rot, smem);
    float* ssq = (float*)(p.ws + OFF_SSQ);
    for (int i = blockIdx.x * 512 + otid(); i < R * 8; i += gridDim.x * 512) ssq[i] = 0.f;
  } else {
    j = {p.in[IAQKV] + (size_t)jj * 1024 * 1536, wt + WT_AQ, 1024, 1536, 1536, 1024, 0}; cvt_run(j, rot, smem);
    j = {p.in[IAWO] + (size_t)jj * 1048576, wt + WT_AO, 1024, 1024, 1024, 1024, 0}; cvt_run(j, rot, smem);
  }
}

DI void ph_norm(const Params& p, int l, int which) {
  const int lane = otid() & 63, gw = blockIdx.x * 8 + (otid() >> 6), nw = gridDim.x * 8;
  const float* g = (which ? p.in[IN2] : p.in[IN1]) + l * 1024;
  u16* H = (u16*)(p.ws + OFF_H);
  float4 gg[4];
#pragma unroll
  for (int j = 0; j < 4; ++j) gg[j] = *(const float4*)(g + j * 256 + lane * 4);
  float4 v[4], vn[4];
  if (gw < R) {
    const float* xr = xrow_ptr(p, gw);
#pragma unroll
    for (int j = 0; j < 4; ++j) v[j] = *(const float4*)(xr + j * 256 + lane * 4);
  }
  for (int r = gw; r < R; r += nw) {
    {
      const float* xn = xrow_ptr(p, r + nw < R ? r + nw : r);
#pragma unroll
      for (int j = 0; j < 4; ++j) vn[j] = *(const float4*)(xn + j * 256 + lane * 4);
    }
    const float* md = mod_ptr(p, l, r) + which * 3072;
    float4 sh[4], sc[4];
#pragma unroll
    for (int j = 0; j < 4; ++j) { sh[j] = *(const float4*)(md + j * 256 + lane * 4); sc[j] = *(const float4*)(md + 1024 + j * 256 + lane * 4); }
    __builtin_amdgcn_sched_barrier(0);
    float ss = 0.f;
#pragma unroll
    for (int j = 0; j < 4; ++j) ss += v[j].x * v[j].x + v[j].y * v[j].y + v[j].z * v[j].z + v[j].w * v[j].w;
    ss = wsum(ss);
    const float rs = rsqrtf(ss * (1.f / 1024.f) + 1e-6f);
#pragma unroll
    for (int j = 0; j < 4; ++j) {
      const int c = j * 256 + lane * 4;
      float o0 = v[j].x * rs * gg[j].x * (1.f + sc[j].x) + sh[j].x, o1 = v[j].y * rs * gg[j].y * (1.f + sc[j].y) + sh[j].y;
      float o2 = v[j].z * rs * gg[j].z * (1.f + sc[j].z) + sh[j].z, o3 = v[j].w * rs * gg[j].w * (1.f + sc[j].w) + sh[j].w;
      uint2 w; w.x = pack2(o0, o1); w.y = pack2(o2, o3);
      *(uint2*)(H + (size_t)r * 1024 + c) = w;
    }
#pragma unroll
    for (int j = 0; j < 4; ++j) v[j] = vn[j];
  }
}
DI void ph_final(const Params& p) {
  const int lane = otid() & 63, gw = blockIdx.x * 8 + (otid() >> 6), nw = gridDim.x * 8;
  for (int r = gw; r < NBAT * T; r += nw) {
    float* xr = p.out + (size_t)r * 1024;
    float4 v[4]; float ss = 0.f;
#pragma unroll
    for (int j = 0; j < 4; ++j) { v[j] = *(float4*)(xr + j * 256 + lane * 4); ss += v[j].x * v[j].x + v[j].y * v[j].y + v[j].z * v[j].z + v[j].w * v[j].w; }
    ss = wsum(ss);
    const float rs = rsqrtf(ss * (1.f / 1024.f) + 1e-6f);
#pragma unroll
    for (int j = 0; j < 4; ++j) {
      float4 g = *(const float4*)(p.in[IFINAL] + j * 256 + lane * 4);
      float4 w = v[j]; w.x *= rs * g.x; w.y *= rs * g.y; w.z *= rs * g.z; w.w *= rs * g.w;
      *(float4*)(xr + j * 256 + lane * 4) = w;
    }
  }
}

template <class AL>
DI void resid_tile(const Params& p, const AL& al, const u16* Bt, int K, int l, int gi, int mt, int nt, char* smem) {
  f32x4 acc[4][4];
  gemm_main4(al, Bt + (size_t)nt * 128 * K, K, K, acc, smem);
  const int lane = otid() & 63, wave = otid() >> 6, wr = wave >> 1, wc = wave & 1, fr = lane & 15, fq = lane >> 4;
  const int row0 = mt * 256;
  const float* md = mod_ptr(p, l, row0) + gi * 1024;
  float4 g[4];
#pragma unroll
  for (int n = 0; n < 4; ++n) g[n] = *(const float4*)(md + nt * 128 + wc * 64 + n * 16 + fq * 4);
  float* xr0 = xrow_ptr(p, row0) + (size_t)(wr * 64 + fr) * 1024 + nt * 128 + wc * 64 + fq * 4;
#pragma unroll
  for (int mh = 0; mh < 2; ++mh) {
    f32x4 x[2][4];
#pragma unroll
    for (int m2 = 0; m2 < 2; ++m2)
#pragma unroll
      for (int n = 0; n < 4; ++n) x[m2][n] = gload_f4(xr0 + (size_t)((mh * 2 + m2) * 16) * 1024 + n * 16);
    asm volatile("s_waitcnt vmcnt(0)" : "+v"(x[0][0]), "+v"(x[0][1]), "+v"(x[0][2]), "+v"(x[0][3]), "+v"(x[1][0]), "+v"(x[1][1]), "+v"(x[1][2]), "+v"(x[1][3]) :: "memory");
#pragma unroll
    for (int m2 = 0; m2 < 2; ++m2)
#pragma unroll
      for (int n = 0; n < 4; ++n) {
        const int m = mh * 2 + m2;
        f32x4 v = x[m2][n];
        v[0] += g[n].x * acc[m][n][0]; v[1] += g[n].y * acc[m][n][1]; v[2] += g[n].z * acc[m][n][2]; v[3] += g[n].w * acc[m][n][3];
        *(f32x4*)(xr0 + (size_t)(m * 16) * 1024 + n * 16) = v;
      }
  }
}
DI void ph_resid_gemm(const Params& p, const u16* A, int lda, const u16* Bt, int K, int l, int gi, char* smem) {
  const bool skip_ctx = (l == 3);
  for (int it = 0;; ++it) {
    int mt, nt; if (!next_tile(it, skip_ctx ? 128 : 130, 8, 1, mt, nt)) break;
    if (skip_ctx) mt = mt + 1 + (mt >> 6);
    ALPlain al{A + (size_t)mt * 256 * lda, lda};
    resid_tile(p, al, Bt, K, l, gi, mt, nt, smem);
  }
}

struct ALHalo {
  const u16* base; int t0m1, len;
  DI uint4 operator()(int i, int k) const {
    int t = t0m1 + i;
    if (t < 0 || t >= len) return make_uint4(0, 0, 0, 0);
    return *(const uint4*)(base + (size_t)t * 1024 + k);
  }
  DI uint4 post(uint4 v, int, int) const { return v; }
};
DI void ph_ffn1(const Params& p, int l, char* smem) {
  const u16* H = (const u16*)(p.ws + OFF_H);
  const u16* W1T = (const u16*)(p.ws + OFF_WT) + WT_W1T;
  u16* G = (u16*)(p.ws + OFF_SCR);
  const int tid = otid(), lane = tid & 63, wave = tid >> 6, wr = wave >> 1, wc = wave & 1, fr = lane & 15, fq = lane >> 4;
  for (int it = 0;; ++it) {
    int mt, nt; if (!next_tile(it, 134, 22, 2, mt, nt)) break;
    const int b = mt / 67, ml = mt - b * 67;
    int rowbase, t0, len;
    if (ml < 2) { rowbase = b * TS; t0 = ml * 254; len = TC; } else { rowbase = b * TS + TC; t0 = (ml - 2) * 254; len = T; }
    ALHalo al{H + (size_t)rowbase * 1024, t0 - 1, len};
    f32x4 acc[4][8];
    gemm_main2(al, W1T + (size_t)nt * 256 * 1024, 1024, 1024, acc, smem);
    u16* P16 = (u16*)smem;
#pragma unroll
    for (int m = 0; m < 4; ++m)
#pragma unroll
      for (int n = 0; n < 8; ++n) {
        uint2 w; w.x = pack2(acc[m][n][0], acc[m][n][1]); w.y = pack2(acc[m][n][2], acc[m][n][3]);
        *(uint2*)&P16[(wr * 64 + m * 16 + fr) * 264 + wc * 128 + n * 16 + fq * 4] = w;
      }
    __syncthreads();
    {
      const int c2 = (tid & 63) * 2, rg = tid >> 6;
      const float* cw = p.in[IFCONV] + (size_t)l * 3 * 5632;
      const int ca = nt * 128 + c2, cg2 = FF + ca;
      const float2 a0 = *(const float2*)(cw + ca), a1 = *(const float2*)(cw + 5632 + ca), a2 = *(const float2*)(cw + 2 * 5632 + ca);
      const float2 g0 = *(const float2*)(cw + cg2), g1 = *(const float2*)(cw + 5632 + cg2), g2 = *(const float2*)(cw + 2 * 5632 + cg2);
      const int i0 = 1 + rg * 32, i1 = min(i0 + 32, 255);
      unsigned pa = *(const unsigned*)&P16[(i0 - 1) * 264 + c2], ca_ = *(const unsigned*)&P16[i0 * 264 + c2];
      unsigned pg = *(const unsigned*)&P16[(i0 - 1) * 264 + 128 + c2], cgv = *(const unsigned*)&P16[i0 * 264 + 128 + c2];
      for (int i = i0; i < i1; ++i) {
        const unsigned na = *(const unsigned*)&P16[(i + 1) * 264 + c2], ng = *(const unsigned*)&P16[(i + 1) * 264 + 128 + c2];
        const float ua0 = a0.x * blo(pa) + a1.x * blo(ca_) + a2.x * blo(na), ua1 = a0.y * bhi(pa) + a1.y * bhi(ca_) + a2.y * bhi(na);
        const float ug0 = g0.x * blo(pg) + g1.x * blo(cgv) + g2.x * blo(ng), ug1 = g0.y * bhi(pg) + g1.y * bhi(cgv) + g2.y * bhi(ng);
        const int tt = t0 - 1 + i;
        if (tt < len) *(unsigned*)&G[(size_t)(rowbase + tt) * FF + ca] = pack2(ua0 * siluf(ug0), ua1 * siluf(ug1));
        pa = ca_; ca_ = na; pg = cgv; cgv = ng;
      }
    }
  }
}

struct ALMix {
  const u16* H; int row0; const float* mu;
  DI uint4 operator()(int i, int k) const {
    const int row = row0 + i, q = row % TS;
    const bool hp = (q != 0) && (q != TC), hn = (q != TC - 1) && (q != TS - 1);
    const u16* pc = H + (size_t)row * 1024 + k;
    uint4 c = *(const uint4*)pc;
    uint4 a = hp ? *(const uint4*)(pc - 1024) : make_uint4(0, 0, 0, 0);
    uint4 b = hn ? *(const uint4*)(pc + 1024) : make_uint4(0, 0, 0, 0);
    float4 m0 = *(const float4*)(mu + k), m1 = *(const float4*)(mu + k + 4);
    uint4 o;
#define MIX1(cc, aa, bb, mlo, mhi) pack2(blo(cc) + (0.5f * (blo(aa) + blo(bb)) - blo(cc)) * (mlo), bhi(cc) + (0.5f * (bhi(aa) + bhi(bb)) - bhi(cc)) * (mhi))
    o.x = MIX1(c.x, a.x, b.x, m0.x, m0.y); o.y = MIX1(c.y, a.y, b.y, m0.z, m0.w);
    o.z = MIX1(c.z, a.z, b.z, m1.x, m1.y); o.w = MIX1(c.w, a.w, b.w, m1.z, m1.w);
    return o;
  }
  DI uint4 post(uint4 v, int, int) const { return v; }
};
constexpr int P1LD = 3456;
DI void ph_rw_r1(const Params& p, int jj, char* smem) {
  const u16* H = (const u16*)(p.ws + OFF_H);
  const u16* BT = (const u16*)(p.ws + OFF_WT) + WT_R1T;
  u16* P1 = (u16*)(p.ws + OFF_SCR);
  const int lane = otid() & 63, wave = otid() >> 6, wr = wave >> 1, wc = wave & 1, fr = lane & 15, fq = lane >> 4;
  for (int it = 0;; ++it) {
    int mt, nt; if (!next_tile(it, 130, 27, 1, mt, nt)) break;
    const int mi = nt < 8 ? 0 : nt < 16 ? 2 : nt < 24 ? 3 : nt == 24 ? 1 : nt == 25 ? 4 : 5;
    ALMix al{H, mt * 256, p.in[IRMU] + (size_t)(jj * 6 + mi) * 1024};
    f32x4 acc[4][4];
    gemm_main3(al, BT + (size_t)nt * 128 * 1024, 1024, 1024, acc, smem);
#pragma unroll
    for (int m = 0; m < 4; ++m) {
      const int row = mt * 256 + wr * 64 + m * 16 + fr;
#pragma unroll
      for (int n = 0; n < 4; ++n) {
        const int c = nt * 128 + wc * 64 + n * 16 + fq * 4;
        float v0 = acc[m][n][0], v1 = acc[m][n][1], v2 = acc[m][n][2], v3 = acc[m][n][3];
        if (nt == 24) { v0 = tanhf(v0); v1 = tanhf(v1); v2 = tanhf(v2); v3 = tanhf(v3); }
        else if (nt == 26) { v0 = sigmf(v0); v1 = sigmf(v1); v2 = sigmf(v2); v3 = sigmf(v3); }
        uint2 w; w.x = pack2(v0, v1); w.y = pack2(v2, v3);
        *(uint2*)(P1 + (size_t)row * P1LD + c) = w;
      }
    }
  }
}
DI int scan_row(int b, int d, int pos) { return d == 0 ? b * TS + pos : (pos < TC ? b * TS + TC - 1 - pos : b * TS + (TS + TC - 1) - pos); }

struct ALLora {
  const u16* P1; int rowbase, rowstep, d;
  DI uint4 operator()(int i, int k) const {
    const int row = rowbase + i * rowstep;
    const int col = k < 64 ? 3072 + d * 64 + k : 3200 + d * 64 + (k - 64);
    return *(const uint4*)(P1 + (size_t)row * P1LD + col);
  }
  DI uint4 post(uint4 v, int, int) const { return v; }
};
DI uint2 pack4h(float a, float b, float c, float d) {
  __half2 x = __floats2half2_rn(a, b), y = __floats2half2_rn(c, d);
  uint2 r; r.x = *(unsigned*)&x; r.y = *(unsigned*)&y; return r;
}
DI void ph_rw_produce(const Params& p, int jj, int s, char* smem) {
  const u16* P1 = (const u16*)(p.ws + OFF_SCR);
  const u16* LUT = (const u16*)(p.ws + OFF_WT) + WT_LUT;
  __half* ring = (__half*)(p.ws + OFF_RING) + (size_t)(s & 1) * ((size_t)2 * 2 * 1024 * 16 * 256);
  float* bonus = (float*)(p.ws + OFF_BONUS);
  float* red = (float*)(smem + sizeof(SmemG));
  const int lane = otid() & 63, wave = otid() >> 6, wr = wave >> 1, wc = wave & 1, fr = lane & 15, fq = lane >> 4;
  const int npt = min(4, 65 - s * 4);
  for (int t = blockIdx.x; t < 2 * 2 * npt * 16; t += gridDim.x) {
    const int h = t & 15, ptl = (t >> 4) % npt, bd = (t >> 4) / npt, d = bd & 1, b = bd >> 1;
    const int pos0 = (s * 4 + ptl) * 256;
    const int rowbase = scan_row(b, d, pos0), rowstep = d ? -1 : 1;
    ALLora al{P1, rowbase, rowstep, d};
    f32x4 acc[4][4];
    gemm_main3(al, LUT + (size_t)(d * 16 + h) * 128 * 128, 128, 128, acc, smem);
    float4 kkw[2], kaw[2], rkw[2], w0v[2], a0v[2];
#pragma unroll
    for (int nn = 0; nn < 2; ++nn) {
      const int ch = h * 64 + wc * 32 + nn * 16 + fq * 4;
      kkw[nn] = *(const float4*)(p.in[IRKK] + jj * 1024 + ch); kaw[nn] = *(const float4*)(p.in[IRKA] + jj * 1024 + ch);
      rkw[nn] = *(const float4*)(p.in[IRRK] + jj * 1024 + ch);
      w0v[nn] = *(const float4*)(p.in[IRW0] + (jj * 2 + d) * 1024 + ch); a0v[nn] = *(const float4*)(p.in[IRA0] + (jj * 2 + d) * 1024 + ch);
    }
    float ssk[4];
    uint2 kreg[4][2], rreg[4][2];
#pragma unroll
    for (int m = 0; m < 4; ++m) {
      const int row = rowbase + (wr * 64 + m * 16 + fr) * rowstep;
#pragma unroll
      for (int nn = 0; nn < 2; ++nn) {
        const int ch = h * 64 + wc * 32 + nn * 16 + fq * 4;
        kreg[m][nn] = *(const uint2*)(P1 + (size_t)row * P1LD + 1024 + ch);
        rreg[m][nn] = *(const uint2*)(P1 + (size_t)row * P1LD + ch);
      }
    }
    __builtin_amdgcn_sched_barrier(0);
#pragma unroll
    for (int m = 0; m < 4; ++m) {
      float s1 = 0.f;
#pragma unroll
      for (int nn = 0; nn < 2; ++nn) {
        const uint2 k2 = kreg[m][nn];
        float q0 = blo(k2.x) * kkw[nn].x, q1 = bhi(k2.x) * kkw[nn].y, q2 = blo(k2.y) * kkw[nn].z, q3 = bhi(k2.y) * kkw[nn].w;
        s1 += q0 * q0 + q1 * q1 + q2 * q2 + q3 * q3;
      }
      s1 += __shfl_xor(s1, 16); s1 += __shfl_xor(s1, 32);
      ssk[m] = s1;
    }
    if (fq == 0) {
#pragma unroll
      for (int m = 0; m < 4; ++m) red[(wr * 64 + m * 16 + fr) * 2 + wc] = ssk[m];
    }
    __syncthreads();
    float c3[4];
#pragma unroll
    for (int m = 0; m < 4; ++m) {
      const int pi = wr * 64 + m * 16 + fr;
      const float rs = rsqrtf(red[pi * 2] + red[pi * 2 + 1] + 1e-12f);
      const int posl = ptl * 256 + pi;
      __half* rp = ring + ((((size_t)(b * 2 + d) * 1024 + posl) * 16 + h) * 256);
      float cc = 0.f;
#pragma unroll
      for (int nn = 0; nn < 2; ++nn) {
        const int chl = wc * 32 + nn * 16 + fq * 4;
        const float kq[4] = {kkw[nn].x, kkw[nn].y, kkw[nn].z, kkw[nn].w}, ka[4] = {kaw[nn].x, kaw[nn].y, kaw[nn].z, kaw[nn].w};
        const float rk[4] = {rkw[nn].x, rkw[nn].y, rkw[nn].z, rkw[nn].w}, w0[4] = {w0v[nn].x, w0v[nn].y, w0v[nn].z, w0v[nn].w};
        const float a0[4] = {a0v[nn].x, a0v[nn].y, a0v[nn].z, a0v[nn].w};
        float okk[4], owm[4], oka[4], okd[4];
        const int rowm = rowbase + pi * rowstep;
        const uint2 r2 = rreg[m][nn], k2 = kreg[m][nn];
        const float rvv[4] = {blo(r2.x), bhi(r2.x), blo(r2.y), bhi(r2.y)}, kvv[4] = {blo(k2.x), bhi(k2.x), blo(k2.y), bhi(k2.y)};
#pragma unroll
        for (int j = 0; j < 4; ++j) {
          const float k = kvv[j];
          const float kk = k * kq[j] * rs;
          const float a = sigmf(a0[j] + acc[m][nn + 2][j]);
          const float wlog = -__logf(1.f + __expf(-(w0[j] + acc[m][nn][j]))) - 0.5f;
          const float ew = -__expf(wlog);
          const float wm1 = ew * (1.f + ew * (0.5f + ew * (0.16666667f + ew * (0.041666668f + ew * (0.0083333338f + ew * (0.0013888889f + ew * 0.0001984127f))))));
          const float kd = k * (1.f + (a - 1.f) * ka[j]);
          okk[j] = kk; owm[j] = wm1; oka[j] = kk * a; okd[j] = kd;
          cc += rvv[j] * kd * rk[j];
        }
        *(uint2*)(rp + chl) = pack4h(okk[0], okk[1], okk[2], okk[3]);
        *(uint2*)(rp + 64 + chl) = pack4h(owm[0], owm[1], owm[2], owm[3]);
        *(uint2*)(rp + 128 + chl) = pack4h(oka[0], oka[1], oka[2], oka[3]);
        *(uint2*)(rp + 192 + chl) = pack4h(okd[0], okd[1], okd[2], okd[3]);
      }
      cc += __shfl_xor(cc, 16); cc += __shfl_xor(cc, 32);
      c3[m] = cc;
    }
    __syncthreads();
    if (fq == 0) {
#pragma unroll
      for (int m = 0; m < 4; ++m) red[(wr * 64 + m * 16 + fr) * 2 + wc] = c3[m];
    }
    __syncthreads();
    if (wc == 0 && fq == 0) {
#pragma unroll
      for (int m = 0; m < 4; ++m) {
        const int pi = wr * 64 + m * 16 + fr;
        bonus[(size_t)(rowbase + pi * rowstep) * 32 + h * 2 + d] = red[pi * 2] + red[pi * 2 + 1];
      }
    }
  }
}
DI float ror_add16(float x) {
  x += __int_as_float(__builtin_amdgcn_update_dpp(0, __float_as_int(x), 0x128, 0xf, 0xf, false));
  x += __int_as_float(__builtin_amdgcn_update_dpp(0, __float_as_int(x), 0x124, 0xf, 0xf, false));
  x += __int_as_float(__builtin_amdgcn_update_dpp(0, __float_as_int(x), 0x122, 0xf, 0xf, false));
  x += __int_as_float(__builtin_amdgcn_update_dpp(0, __float_as_int(x), 0x121, 0xf, 0xf, false));
  return x;
}
constexpr int SCH = 32, STEPF = 336;
DI void ph_rw_scan(const Params& p, int s, char* smem, bool save = true) {
  if (blockIdx.x >= 256) return;
  const u16* P1 = (const u16*)(p.ws + OFF_SCR);
  const __half* ring = (const __half*)(p.ws + OFF_RING) + (size_t)(s & 1) * ((size_t)2 * 2 * 1024 * 16 * 256);
  u16* Y = (u16*)(p.ws + OFF_SCR) + (size_t)R * P1LD;
  float* st = (float*)(p.ws + OFF_RWST);
  float* buf = (float*)smem;
  float* ybuf = buf + 2 * SCH * STEPF;
  const int tid = otid(), lane = tid & 63, wave = tid >> 6;
  const int xcd_ = blockIdx.x & 7, slot_ = blockIdx.x >> 3;
  const int bh_ = xcd_ * 4 + (slot_ >> 3), rq = slot_ & 3;
  const int b = bh_ >> 4, h = bh_ & 15, d = (slot_ >> 2) & 1;
  const int npos = min(1024, TS - s * 1024), nch = npos / SCH;
  const int rl = (wave & 3) * 4 + (lane >> 4), q = lane & 15;
  f32x2 sa = (f32x2){0.f, 0.f}, sb = (f32x2){0.f, 0.f};
  if (wave < 4 && s > 0) { float4 v = *(const float4*)(st + ((size_t)blockIdx.x * 256 + tid) * 4); sa = (f32x2){v.x, v.y}; sb = (f32x2){v.z, v.w}; }
  u16* Yd = Y + (size_t)d * R * 1024;
  uint4 lr[4], lrr = make_uint4(0, 0, 0, 0), lrv = make_uint4(0, 0, 0, 0);
  auto gload = [&](int c) {
    const int lt = tid - 256;
#pragma unroll
    for (int i = 0; i < 4; ++i) {
      const int cidx = lt + i * 256, stp = cidx >> 5, off = (cidx & 31) * 8;
      const int posl = c * SCH + stp;
      lr[i] = *(const uint4*)(ring + ((((size_t)(b * 2 + d) * 1024 + posl) * 16 + h) * 256) + off);
    }
    {
      const int stp = lt >> 3, off = (lt & 7) * 8;
      const int row = scan_row(b, d, s * 1024 + c * SCH + stp);
      lrr = *(const uint4*)(P1 + (size_t)row * P1LD + h * 64 + off);
    }
    {
      const int l2 = lt & 63, stp = l2 >> 1, off = (l2 & 1) * 8;
      const int row = scan_row(b, d, s * 1024 + c * SCH + stp);
      lrv = *(const uint4*)(P1 + (size_t)row * P1LD + 2048 + h * 64 + rq * 16 + off);
    }
  };
  auto swrite = [&](int c) {
    const int lt = tid - 256;
    float* bb = buf + (c & 1) * SCH * STEPF;
#pragma unroll
    for (int i = 0; i < 4; ++i) {
      const int cidx = lt + i * 256, stp = cidx >> 5, off = (cidx & 31) * 8;
      const __half2* hp = (const __half2*)&lr[i];
      float2 f0 = __half22float2(hp[0]), f1 = __half22float2(hp[1]), f2 = __half22float2(hp[2]), f3 = __half22float2(hp[3]);
      float* dst = bb + stp * STEPF + off;
      *(float4*)dst = make_float4(f0.x, f0.y, f1.x, f1.y);
      *(float4*)(dst + 4) = make_float4(f2.x, f2.y, f3.x, f3.y);
    }
    {
      const int stp = lt >> 3, off = (lt & 7) * 8;
      float* dst = bb + stp * STEPF + 256 + off;
      *(float4*)dst = make_float4(blo(lrr.x), bhi(lrr.x), blo(lrr.y), bhi(lrr.y));
      *(float4*)(dst + 4) = make_float4(blo(lrr.z), bhi(lrr.z), blo(lrr.w), bhi(lrr.w));
    }
    if (lt < 64) {
      const int stp = lt >> 1, off = (lt & 1) * 8;
      float* dst = bb + stp * STEPF + 320 + off;
      *(float4*)dst = make_float4(blo(lrv.x), bhi(lrv.x), blo(lrv.y), bhi(lrv.y));
      *(float4*)(dst + 4) = make_float4(blo(lrv.z), bhi(lrv.z), blo(lrv.w), bhi(lrv.w));
    }
  };
  if (wave >= 4) { gload(0); swrite(0); if (nch > 1) gload(1); }
  lds_barrier();
  for (int c = 0; c < nch; ++c) {
    if (wave < 4) {
      const float* bb = buf + (c & 1) * SCH * STEPF;
      const int pos0 = s * 1024 + c * SCH;
      const int row0 = scan_row(b, d, pos0), rstep = d ? -1 : 1;
      u16* yp = Yd + (size_t)row0 * 1024 + h * 64 + rq * 16 + rl;
      float4 kk = *(const float4*)(bb + q * 4), wm = *(const float4*)(bb + 64 + q * 4), ka = *(const float4*)(bb + 128 + q * 4);
      float4 kd = *(const float4*)(bb + 192 + q * 4), rr = *(const float4*)(bb + 256 + q * 4);
      float vv = bb[320 + rl];
      float yv[16];
#pragma unroll
      for (int stp = 0; stp < SCH; ++stp) {
        const float* sn = bb + (stp + 1 < SCH ? stp + 1 : stp) * STEPF;
        const float4 kkn = *(const float4*)(sn + q * 4), wmn = *(const float4*)(sn + 64 + q * 4), kan = *(const float4*)(sn + 128 + q * 4);
        const float4 kdn = *(const float4*)(sn + 192 + q * 4), rrn = *(const float4*)(sn + 256 + q * 4);
        const float vvn = sn[320 + rl];
        __builtin_amdgcn_sched_barrier(0);
        const f32x2 vv2 = (f32x2){vv, vv};
        f32x2 ta = sa * (f32x2){wm.x, wm.y} + sa, tb = sb * (f32x2){wm.z, wm.w} + sb;
        ta = vv2 * (f32x2){kd.x, kd.y} + ta; tb = vv2 * (f32x2){kd.z, kd.w} + tb;
        f32x2 ud = sa * (f32x2){kk.x, kk.y}; ud = sb * (f32x2){kk.z, kk.w} + ud;
        float u = ror_add16(ud.x + ud.y);
        const f32x2 nu = (f32x2){-u, -u};
        sa = nu * (f32x2){ka.x, ka.y} + ta; sb = nu * (f32x2){ka.z, ka.w} + tb;
        f32x2 yd2 = sa * (f32x2){rr.x, rr.y}; yd2 = sb * (f32x2){rr.z, rr.w} + yd2;
        yv[stp & 15] = yd2.x + yd2.y;
        if ((stp & 15) == 15) {
          const bool b3 = q & 8, b2 = q & 4, b1 = q & 2, b0 = q & 1;
          float z8[8], z4[4], z2[2];
#pragma unroll
          for (int i = 0; i < 8; ++i) { const float kp = b3 ? yv[i + 8] : yv[i], sd = b3 ? yv[i] : yv[i + 8]; z8[i] = kp + __int_as_float(__builtin_amdgcn_update_dpp(0, __float_as_int(sd), 0x140, 0xf, 0xf, false)); }
#pragma unroll
          for (int i = 0; i < 4; ++i) { const float kp = b2 ? z8[i + 4] : z8[i], sd = b2 ? z8[i] : z8[i + 4]; z4[i] = kp + __int_as_float(__builtin_amdgcn_update_dpp(0, __float_as_int(sd), 0x141, 0xf, 0xf, false)); }
#pragma unroll
          for (int i = 0; i < 2; ++i) { const float kp = b1 ? z4[i + 2] : z4[i], sd = b1 ? z4[i] : z4[i + 2]; z2[i] = kp + __int_as_float(__builtin_amdgcn_update_dpp(0, __float_as_int(sd), 0x1B, 0xf, 0xf, false)); }
          const float kp = b0 ? z2[1] : z2[0], sd = b0 ? z2[0] : z2[1];
          const float yq = kp + __int_as_float(__builtin_amdgcn_update_dpp(0, __float_as_int(sd), 0xB1, 0xf, 0xf, false));
          yp[(ptrdiff_t)((stp & ~15) + q) * rstep * 1024] = f2b(yq);
        }
        kk = kkn; wm = wmn; ka = kan; kd = kdn; rr = rrn; vv = vvn;
      }
    } else {
      if (c + 1 < nch) swrite(c + 1);
      if (c + 2 < nch) gload(c + 2);
    }
    lds_barrier();
  }
  if (wave < 4 && save) *(float4*)(st + ((size_t)blockIdx.x * 256 + tid) * 4) = make_float4(sa.x, sa.y, sb.x, sb.y);
  __syncthreads();
}
DI void ph_rw_finish(const Params& p, int jj, char* smem) {
  const u16* P1 = (const u16*)(p.ws + OFF_SCR);
  const u16* G2T = (const u16*)(p.ws + OFF_WT) + WT_G2T;
  u16* Y0 = (u16*)(p.ws + OFF_SCR) + (size_t)R * P1LD;
  const u16* Y1 = Y0 + (size_t)R * 1024;
  const float* bonus = (const float*)(p.ws + OFF_BONUS);
  const int lane = otid() & 63, wave = otid() >> 6, wr = wave >> 1, wc = wave & 1, fr = lane & 15, fq = lane >> 4;
  for (int it = 0;; ++it) {
    int mt, nt; if (!next_tile(it, 130, 8, 1, mt, nt)) break;
    ALPlain al{P1 + (size_t)mt * 256 * P1LD + 3328, P1LD};
    f32x4 acc[4][4];
    gemm_main3(al, G2T + (size_t)nt * 128 * 128, 128, 128, acc, smem);
    const int h = nt * 2 + wc;
#pragma unroll
    for (int m = 0; m < 4; ++m) {
      const int row = mt * 256 + wr * 64 + m * 16 + fr;
      float y[4][4]; float sm = 0.f;
#pragma unroll
      for (int n = 0; n < 4; ++n) {
        const int c = h * 64 + n * 16 + fq * 4;
        uint2 a = *(const uint2*)(Y0 + (size_t)row * 1024 + c), b2 = *(const uint2*)(Y1 + (size_t)row * 1024 + c);
        y[n][0] = blo(a.x) + blo(b2.x); y[n][1] = bhi(a.x) + bhi(b2.x); y[n][2] = blo(a.y) + blo(b2.y); y[n][3] = bhi(a.y) + bhi(b2.y);
        sm += y[n][0] + y[n][1] + y[n][2] + y[n][3];
      }
      sm += __shfl_xor(sm, 16); sm += __shfl_xor(sm, 32);
      const float mean = sm * (1.f / 64.f);
      float vs = 0.f;
#pragma unroll
      for (int n = 0; n < 4; ++n)
#pragma unroll
        for (int j = 0; j < 4; ++j) { float dlt = y[n][j] - mean; vs += dlt * dlt; }
      vs += __shfl_xor(vs, 16); vs += __shfl_xor(vs, 32);
      const float rs = rsqrtf(vs * (1.f / 64.f) + 64e-5f);
      const float bn = bonus[(size_t)row * 32 + h * 2] + bonus[(size_t)row * 32 + h * 2 + 1];
#pragma unroll
      for (int n = 0; n < 4; ++n) {
        const int c = h * 64 + n * 16 + fq * 4;
        float4 lg = *(const float4*)(p.in[IRLNG] + jj * 1024 + c), lb = *(const float4*)(p.in[IRLNB] + jj * 1024 + c);
        uint2 v2 = *(const uint2*)(P1 + (size_t)row * P1LD + 2048 + c);
        float o0 = ((y[n][0] - mean) * rs * lg.x + lb.x + bn * blo(v2.x)) * acc[m][n][0];
        float o1 = ((y[n][1] - mean) * rs * lg.y + lb.y + bn * bhi(v2.x)) * acc[m][n][1];
        float o2 = ((y[n][2] - mean) * rs * lg.z + lb.z + bn * blo(v2.y)) * acc[m][n][2];
        float o3 = ((y[n][3] - mean) * rs * lg.w + lb.w + bn * bhi(v2.y)) * acc[m][n][3];
        uint2 w; w.x = pack2(o0, o1); w.y = pack2(o2, o3);
        *(uint2*)(Y0 + (size_t)row * 1024 + c) = w;
      }
    }
  }
}

DI void ph_ssd_s1(const Params& p, int jj, char* smem) {
  const u16* H = (const u16*)(p.ws + OFF_H);
  const u16* BT = (const u16*)(p.ws + OFF_WT) + WT_SX;
  u16* XBC = (u16*)(p.ws + OFF_SCR);
  float* DTg = (float*)(p.ws + OFF_DT);
  float* P = (float*)smem;
  const float* cw = p.in[ISCONVW] + (size_t)jj * 3 * 4096;
  const float* cb = p.in[ISCONVB] + (size_t)jj * 4096;
  const int tid = otid(), lane = tid & 63, wave = tid >> 6, wr = wave >> 1, wc = wave & 1, fr = lane & 15, fq = lane >> 4;
  for (int it = 0;; ++it) {
    int mt, nt; if (!next_tile(it, 134, 33, 1, mt, nt)) break;
    const int b = mt / 67, ml = mt - b * 67;
    int rowbase, t0, len;
    if (ml < 2) { rowbase = b * TS; t0 = ml * 254; len = TC; } else { rowbase = b * TS + TC; t0 = (ml - 2) * 254; len = T; }
    ALHalo al{H + (size_t)rowbase * 1024, t0 - 1, len};
    f32x4 acc[4][4];
    gemm_main3(al, BT + (size_t)nt * 128 * 1024, 1024, 1024, acc, smem);
#pragma unroll
    for (int m = 0; m < 4; ++m)
#pragma unroll
      for (int n = 0; n < 4; ++n) *(f32x4*)&P[(wr * 64 + m * 16 + fr) * 132 + wc * 64 + n * 16 + fq * 4] = acc[m][n];
    __syncthreads();
    if (nt < 32) {
      const int col = tid & 127, rg = tid >> 7, ch = nt * 128 + col;
      const float w0 = cw[ch], w1 = cw[4096 + ch], w2 = cw[8192 + ch], bias = cb[ch];
      const int i0 = 1 + rg * 64, i1 = min(i0 + 64, 255);
      float pv = P[(i0 - 1) * 132 + col], cv = P[i0 * 132 + col];
      for (int i = i0; i < i1; ++i) {
        const float nv = P[(i + 1) * 132 + col];
        const float v = w0 * pv + w1 * cv + w2 * nv + bias;
        const int tt = t0 - 1 + i;
        if (tt < len) XBC[(size_t)(rowbase + tt) * 4096 + ch] = f2b(siluf(v));
        pv = cv; cv = nv;
      }
    } else {
      const int col = tid & 63, rg = tid >> 6;
      const int i0 = 1 + rg * 32, i1 = min(i0 + 32, 255);
      for (int i = i0; i < i1; ++i) { const int tt = t0 - 1 + i; if (tt < len) DTg[(size_t)(rowbase + tt) * 64 + col] = P[i * 132 + col]; }
    }
  }
}
DI void ph_ssd_scan(const Params& p, int jj, char* smem) {
  if (blockIdx.x >= 256) return;
  const u16* XBC = (const u16*)(p.ws + OFF_SCR);
  u16* Y = (u16*)(p.ws + OFF_SCR) + (size_t)R * 4096;
  const float* DTg = (const float*)(p.ws + OFF_DT);
  const int tid = otid(), lane = tid & 63, wave = tid >> 6, fr = lane & 15, fq = lane >> 4;
  const int xcd_ = blockIdx.x & 7, slot_ = blockIdx.x >> 3, gid_ = xcd_ * 2 + (slot_ >> 4), mem_ = slot_ & 15;
  const int b = gid_ >> 3, g = gid_ & 7, head = g * 4 + (mem_ >> 2), pq = mem_ & 3;
  constexpr int DIRB = 80896;
  const int xp_ = tid & 15, xj0 = (tid >> 4) & 15;
  float Aneg[2], dtb[2];
#pragma unroll
  for (int d = 0; d < 2; ++d) { Aneg[d] = -__expf(p.in[ISALOG][(jj * 2 + d) * 32 + head]); dtb[d] = p.in[ISDTB][(jj * 2 + d) * 32 + head]; }
  const float Dsk = p.in[ISD][jj * 32 + head];
  f32x4 hst[2] = {(f32x4){0.f, 0.f, 0.f, 0.f}, (f32x4){0.f, 0.f, 0.f, 0.f}};
  uint4 pre[2][5];
  float dtpre[2] = {0.f, 0.f};
  auto gl_raw = [&](int ci, int d, uint4 (&pr)[5], float& dtp) {
    const int r0 = scan_row(b, d, ci * 64), r63 = scan_row(b, d, ci * 64 + 63);
    const int rmin = min(r0, r63);
    const int cc = tid & 31, rrb = tid >> 5;
    const int gcb = cc < 16 ? 2048 + g * 128 + cc * 8 : 3072 + g * 128 + (cc - 16) * 8;
    const u16* src = XBC + (size_t)(rmin + rrb) * 4096 + gcb;
#pragma unroll
    for (int i = 0; i < 4; ++i) pr[i] = *(const uint4*)(src + (size_t)i * 16 * 4096);
    pr[4] = *(const uint4*)(XBC + (size_t)(rmin + ((tid & 127) >> 1)) * 4096 + head * 64 + pq * 16 + (tid & 1) * 8);
    dtp = DTg[(size_t)(r0 + lane * (d ? -1 : 1)) * 64 + d * 32 + head];
  };
  __syncthreads();
  gl_raw(0, 0, pre[0], dtpre[0]);
  gl_raw(0, 1, pre[1], dtpre[1]);
  for (int ci = 0; ci < 260; ++ci) {
    const bool second = ci < 4 ? (ci >= 2) : (ci - 4 >= 128);
    unsigned ypre[2][2];
#pragma unroll
    for (int d = 0; d < 2; ++d) {
      u16* Cs = (u16*)(smem + d * DIRB); u16* Bs = Cs + 64 * 144; u16* BsT = Bs + 64 * 144; u16* Ms = BsT + 128 * 80;
      u16* XdtT = Ms + 64 * 72; u16* XwT = XdtT + 16 * 80; u16* Hs = XwT + 16 * 80;
      float* Xp = (float*)(Hs + 16 * 144); float* dts = Xp + 64 * 16; float* css = dts + 64;
      const int r0 = scan_row(b, d, ci * 64), rstep = d ? -1 : 1;
      {
        int t2 = tid; asm volatile("" : "+v"(t2));
        const int cc = t2 & 31;
#pragma unroll
        for (int i = 0; i < 4; ++i) {
          const int rr = (t2 >> 5) + 16 * i, j = d ? 63 - rr : rr;
          if (cc < 16) {
            *(uint4*)&Bs[j * 144 + cc * 8] = pre[d][i];
            const u16* hv = (const u16*)&pre[d][i];
#pragma unroll
            for (int e = 0; e < 8; ++e) BsT[(cc * 8 + e) * 80 + (j ^ ((cc & 7) << 3))] = hv[e];
          } else *(uint4*)&Cs[j * 144 + (cc - 16) * 8] = pre[d][i];
        }
        if (t2 < 128) {
          const int rr = t2 >> 1, j = d ? 63 - rr : rr;
          const u16* hv = (const u16*)&pre[d][4];
#pragma unroll
          for (int e = 0; e < 8; ++e) Xp[j * 16 + (tid & 1) * 8 + e] = b2f(hv[e]);
        }
      }
      if (wave == d) {
        const float dt = softplusf(dtpre[d] + dtb[d]);
        float a = dt * Aneg[d];
#pragma unroll
        for (int o = 1; o < 64; o <<= 1) { float tv = __shfl_up(a, o); if (lane >= o) a += tv; }
        dts[lane] = dt; css[lane] = a;
      }
#pragma unroll
      for (int e = 0; e < 4; ++e) Hs[(fq * 4 + e) * 144 + wave * 16 + fr] = f2b(hst[d][e]);
#pragma unroll
      for (int e = 0; e < 2; ++e) {
        const u16* yb = Y + (size_t)(r0 + ((wave & 3) * 16 + fq * 4 + 2 * e) * rstep) * 2048 + head * 64 + pq * 16 + fr;
        ypre[d][e] = (unsigned)yb[0] | ((unsigned)yb[(ptrdiff_t)rstep * 2048] << 16);
      }
      __builtin_amdgcn_sched_barrier(0);
    }
    __builtin_amdgcn_sched_barrier(0);
    if (ci + 1 < 260) { gl_raw(ci + 1, 0, pre[0], dtpre[0]); gl_raw(ci + 1, 1, pre[1], dtpre[1]); }
    lds_barrier();
#pragma unroll
    for (int d = 0; d < 2; ++d) {
      u16* Cs = (u16*)(smem + d * DIRB); u16* Bs = Cs + 64 * 144; u16* BsT = Bs + 64 * 144; u16* Ms = BsT + 128 * 80;
      u16* XdtT = Ms + 64 * 72; u16* XwT = XdtT + 16 * 80; u16* Hs = XwT + 16 * 80;
      float* Xp = (float*)(Hs + 16 * 144); float* dts = Xp + 64 * 16; float* css = dts + 64;
      const float cs63 = css[63];
      if (tid < 256) {
#pragma unroll
        for (int i = 0; i < 4; ++i) {
          const int j = xj0 + 16 * i;
          const float xv = Xp[j * 16 + xp_];
          const float dt = dts[j];
          XdtT[xp_ * 80 + j] = f2b(xv * dt);
          XwT[xp_ * 80 + j] = f2b(xv * dt * __expf(cs63 - css[j]));
        }
      }
      const int ib = wave >> 1;
#pragma unroll
      for (int jb2 = 0; jb2 < 2; ++jb2) {
        const int jb = (wave & 1) * 2 + jb2;
        f32x4 acc = (f32x4){0.f, 0.f, 0.f, 0.f};
#pragma unroll
        for (int ks = 0; ks < 4; ++ks) {
          const bf16x8 bfr = *(const bf16x8*)&Bs[(jb * 16 + fr) * 144 + ks * 32 + fq * 8];
          const bf16x8 cfr = *(const bf16x8*)&Cs[(ib * 16 + fr) * 144 + ks * 32 + fq * 8];
          acc = MFMA(bfr, cfr, acc);
        }
        const int i = ib * 16 + fr;
        const float csi = css[i];
        float mv[4];
#pragma unroll
        for (int e = 0; e < 4; ++e) { const int j = jb * 16 + fq * 4 + e; mv[e] = (j <= i) ? acc[e] * __expf(csi - css[j]) : 0.f; }
        uint2 w; w.x = pack2(mv[0], mv[1]); w.y = pack2(mv[2], mv[3]);
        *(uint2*)&Ms[i * 72 + jb * 16 + fq * 4] = w;
      }
      __builtin_amdgcn_sched_barrier(0);
    }
    lds_barrier();
#pragma unroll
    for (int d = 0; d < 2; ++d) {
      u16* Cs = (u16*)(smem + d * DIRB); u16* Bs = Cs + 64 * 144; u16* BsT = Bs + 64 * 144; u16* Ms = BsT + 128 * 80;
      u16* XdtT = Ms + 64 * 72; u16* XwT = XdtT + 16 * 80; u16* Hs = XwT + 16 * 80;
      float* Xp = (float*)(Hs + 16 * 144); float* dts = Xp + 64 * 16; float* css = dts + 64;
      const int r0 = scan_row(b, d, ci * 64), rstep = d ? -1 : 1;
      const float cs63 = css[63];
      if (wave < 4) {
        const int ib = wave;
        f32x4 yd = (f32x4){0.f, 0.f, 0.f, 0.f}, yo = (f32x4){0.f, 0.f, 0.f, 0.f};
#pragma unroll
        for (int ks = 0; ks < 2; ++ks) {
          const bf16x8 mf = *(const bf16x8*)&Ms[(ib * 16 + fr) * 72 + ks * 32 + fq * 8];
          const bf16x8 xf = *(const bf16x8*)&XdtT[fr * 80 + ks * 32 + fq * 8];
          yd = MFMA(mf, xf, yd);
        }
#pragma unroll
        for (int ks = 0; ks < 4; ++ks) {
          const bf16x8 cf = *(const bf16x8*)&Cs[(ib * 16 + fr) * 144 + ks * 32 + fq * 8];
          const bf16x8 hf = *(const bf16x8*)&Hs[fr * 144 + ks * 32 + fq * 8];
          yo = MFMA(cf, hf, yo);
        }
#pragma unroll
        for (int e = 0; e < 4; ++e) {
          const int i = ib * 16 + fq * 4 + e;
          float y = yd[e] + __expf(css[i]) * yo[e];
          u16* ya = Y + (size_t)(r0 + i * rstep) * 2048 + head * 64 + pq * 16 + fr;
          if (second) y += ((e & 1) ? bhi(ypre[d][e >> 1]) : blo(ypre[d][e >> 1])) + Xp[i * 16 + fr] * Dsk;
          *ya = f2b(y);
        }
      }
      {
        const float dec = __expf(cs63);
        hst[d][0] *= dec; hst[d][1] *= dec; hst[d][2] *= dec; hst[d][3] *= dec;
#pragma unroll
        for (int ks = 0; ks < 2; ++ks) {
          const bf16x8 xf = *(const bf16x8*)&XwT[fr * 80 + ks * 32 + fq * 8];
          const bf16x8 bf = *(const bf16x8*)&BsT[(wave * 16 + fr) * 80 + (((ks * 4 + fq) ^ ((wave * 2 + (fr >> 3)) & 7)) << 3)];
          hst[d] = MFMA(xf, bf, hst[d]);
        }
      }
      __builtin_amdgcn_sched_barrier(0);
    }
    if (ci == 1 || ci == 131) asm volatile("s_waitcnt vmcnt(0)" ::: "memory");
    lds_barrier();
  }
}
DI void ph_ssd_s3(const Params& p, char* smem) {
  const u16* H = (const u16*)(p.ws + OFF_H);
  const u16* BT = (const u16*)(p.ws + OFF_WT) + WT_SZ;
  u16* Y = (u16*)(p.ws + OFF_SCR) + (size_t)R * 4096;
  float* ssq = (float*)(p.ws + OFF_SSQ);
  const int lane = otid() & 63, wave = otid() >> 6, wr = wave >> 1, wc = wave & 1, fr = lane & 15, fq = lane >> 4;
  for (int it = 0;; ++it) {
    int mt, nt; if (!next_tile(it, 130, 16, 1, mt, nt)) break;
    ALPlain al{H + (size_t)mt * 256 * 1024, 1024};
    f32x4 acc[4][4];
    gemm_main3(al, BT + (size_t)nt * 128 * 1024, 1024, 1024, acc, smem);
#pragma unroll
    for (int m = 0; m < 4; ++m) {
      const int row = mt * 256 + wr * 64 + m * 16 + fr;
      float sq = 0.f;
#pragma unroll
      for (int n = 0; n < 4; ++n) {
        const int c = nt * 128 + wc * 64 + n * 16 + fq * 4;
        uint2 yv = *(const uint2*)(Y + (size_t)row * 2048 + c);
        const float o0 = blo(yv.x) * siluf(acc[m][n][0]), o1 = bhi(yv.x) * siluf(acc[m][n][1]);
        const float o2 = blo(yv.y) * siluf(acc[m][n][2]), o3 = bhi(yv.y) * siluf(acc[m][n][3]);
        sq += o0 * o0 + o1 * o1 + o2 * o2 + o3 * o3;
        uint2 w; w.x = pack2(o0, o1); w.y = pack2(o2, o3);
        *(uint2*)(Y + (size_t)row * 2048 + c) = w;
      }
      sq += __shfl_xor(sq, 16); sq += __shfl_xor(sq, 32);
      if (fq == 0) atomicAdd(ssq + (size_t)row * 8 + (nt >> 1), sq);
    }
  }
}
struct ALScale {
  const u16* Y; int row0; const float* rsT; const float* ngT;
  DI uint4 operator()(int i, int k) const { return *(const uint4*)(Y + (size_t)(row0 + i) * 2048 + k); }
  DI uint4 post(uint4 c, int i, int k) const {
    const float rs = rsT[i * 8 + (k >> 8)];
    const float4 g0 = *(const float4*)(ngT + k), g1 = *(const float4*)(ngT + k + 4);
    uint4 o;
    o.x = pack2(blo(c.x) * rs * g0.x, bhi(c.x) * rs * g0.y); o.y = pack2(blo(c.y) * rs * g0.z, bhi(c.y) * rs * g0.w);
    o.z = pack2(blo(c.z) * rs * g1.x, bhi(c.z) * rs * g1.y); o.w = pack2(blo(c.w) * rs * g1.z, bhi(c.w) * rs * g1.w);
    return o;
  }
};
DI void ph_ssd_s4(const Params& p, int l, int jj, char* smem) {
  const u16* Y = (const u16*)(p.ws + OFF_SCR) + (size_t)R * 4096;
  const u16* BT = (const u16*)(p.ws + OFF_WT) + WT_SO;
  for (int it = 0;; ++it) {
    int mt, nt; if (!next_tile(it, 130, 8, 1, mt, nt)) break;
    float* rsT = (float*)(smem + 112640); float* ngT = rsT + 2048;
    {
      const float* ssq = (const float*)(p.ws + OFF_SSQ) + (size_t)mt * 256 * 8;
      const float* ng = p.in[ISNG] + jj * 2048;
      for (int e = otid(); e < 2048; e += 512) { rsT[e] = rsqrtf(ssq[e] * (1.f / 256.f) + 1e-6f); ngT[e] = ng[e]; }
    }
    ALScale al{Y, mt * 256, rsT, ngT};
    resid_tile(p, al, BT, 2048, l, 2, mt, nt, smem);
  }
}

DI void ph_at_qkv(const Params& p, char* smem) {
  const u16* H = (const u16*)(p.ws + OFF_H);
  const u16* BT = (const u16*)(p.ws + OFF_WT) + WT_AQ;
  u16* QKV = (u16*)(p.ws + OFF_SCR);
  const int lane = otid() & 63, wave = otid() >> 6, wr = wave >> 1, wc = wave & 1, fr = lane & 15, fq = lane >> 4;
  for (int it = 0;; ++it) {
    int mt, nt; if (!next_tile(it, 130, 12, 1, mt, nt)) break;
    ALPlain al{H + (size_t)mt * 256 * 1024, 1024};
    f32x4 acc[4][4];
    gemm_main3(al, BT + (size_t)nt * 128 * 1024, 1024, 1024, acc, smem);
    const int q0 = (mt * 256) % TS;
    const bool rope = (q0 >= TC) && (nt < 10);
#pragma unroll
    for (int m = 0; m < 4; ++m) {
      const int rl = wr * 64 + m * 16 + fr;
      const int row = mt * 256 + rl;
      if (rope) {
        const int tt = q0 - TC + rl;
        const float prow = (float)(tt >> 6), pcol = (float)(tt & 63);
#pragma unroll
        for (int e = 0; e < 4; ++e) {
          const float inv = exp2f(-13.287712379549449f * (float)(fq * 4 + e) * (1.f / 16.f));
          float sn, cs;
          sincosf(prow * inv, &sn, &cs);
          float x1 = acc[m][0][e], x2 = acc[m][1][e];
          acc[m][0][e] = x1 * cs - x2 * sn; acc[m][1][e] = x1 * sn + x2 * cs;
          sincosf(pcol * inv, &sn, &cs);
          x1 = acc[m][2][e]; x2 = acc[m][3][e];
          acc[m][2][e] = x1 * cs - x2 * sn; acc[m][3][e] = x1 * sn + x2 * cs;
        }
      }
#pragma unroll
      for (int n = 0; n < 4; ++n) {
        const int c = nt * 128 + wc * 64 + n * 16 + fq * 4;
        uint2 w; w.x = pack2(acc[m][n][0], acc[m][n][1]); w.y = pack2(acc[m][n][2], acc[m][n][3]);
        *(uint2*)(QKV + (size_t)row * 1536 + c) = w;
      }
    }
  }
}
DI void ph_attn(const Params& p, int jj, char* smem) {
  const u16* QKV = (const u16*)(p.ws + OFF_SCR);
  u16* O = (u16*)(p.ws + OFF_SCR) + (size_t)R * 1536;
  u16* Ks = (u16*)smem;
  u16* Vt = Ks + 64 * 80;
  u16* Ps = Vt + 64 * 80;
  const int tid = otid(), lane = tid & 63, wave = tid >> 6, fr = lane & 15, fq = lane >> 4;
  const int g = wave >> 1, th = (wave & 1) * 32;
  u16* Pw = Ps + wave * 32 * 80;
  for (int tl = (int)(blockIdx.x >> 3); tl < 260; tl += (int)(gridDim.x >> 3)) {
    const int kvh = blockIdx.x & 3, b = (blockIdx.x >> 2) & 1;
    const int isctx = tl >= 256 ? 1 : 0, qb = isctx ? tl - 256 : tl;
    const int t0 = qb * 64, qrow0 = b * TS + (isctx ? 0 : TC) + t0;
    const int head = kvh * 4 + g;
    bf16x8 qf[2][2];
#pragma unroll
    for (int m = 0; m < 2; ++m)
#pragma unroll
      for (int kh = 0; kh < 2; ++kh) {
        uint4 v = *(const uint4*)(QKV + (size_t)(qrow0 + th + m * 16 + fr) * 1536 + head * 64 + kh * 32 + fq * 8);
        uint4 o;
        o.x = pack2(blo(v.x) * 0.125f, bhi(v.x) * 0.125f); o.y = pack2(blo(v.y) * 0.125f, bhi(v.y) * 0.125f);
        o.z = pack2(blo(v.z) * 0.125f, bhi(v.z) * 0.125f); o.w = pack2(blo(v.w) * 0.125f, bhi(v.w) * 0.125f);
        qf[m][kh] = *(bf16x8*)&o;
      }
    const float sink = p.in[IASINK][jj * 16 + head];
    float mrun[2] = {sink, sink}, lrun[2] = {1.f, 1.f};
    f32x4 o[2][4];
#pragma unroll
    for (int m = 0; m < 2; ++m)
#pragma unroll
      for (int n = 0; n < 4; ++n) o[m][n] = (f32x4){0.f, 0.f, 0.f, 0.f};
    const int i_lo = t0 >= 128 ? 0 : (t0 >= 64 ? 1 : 2);
    const int i_hi = t0 == T - 64 ? 2 : (t0 == T - 128 ? 3 : 4);
    const int nkt = isctx ? 4 : 4 + (i_hi - i_lo + 1);
    const int skey = tid >> 3, sdc = (tid & 7) * 8;
    uint4 kreg, vreg;
    auto kv_load = [&](int idx) {
      int krow0;
      if (idx < 4) krow0 = b * TS + idx * 64; else krow0 = b * TS + TC + t0 - 128 + 64 * (i_lo + idx - 4);
      const u16* src = QKV + (size_t)(krow0 + skey) * 1536 + 1024 + kvh * 64 + sdc;
      kreg = *(const uint4*)src; vreg = *(const uint4*)(src + 256);
    };
    kv_load(0);
    for (int kt = 0; kt < nkt; ++kt) {
      const int li = i_lo + kt - 4;
      const int mode = kt < 4 ? 0 : (li == 0 ? 1 : (li == 4 ? 2 : 0));
      lds_barrier();
      {
        *(uint4*)&Ks[skey * 80 + sdc] = kreg;
        const u16* vv = (const u16*)&vreg;
#pragma unroll
        for (int e = 0; e < 8; ++e) Vt[(sdc + e) * 80 + (skey ^ ((tid & 7) << 3))] = vv[e];
      }
      lds_barrier();
      if (kt + 1 < nkt) kv_load(kt + 1);
      f32x4 sacc[2][4];
#pragma unroll
      for (int m = 0; m < 2; ++m)
#pragma unroll
        for (int n = 0; n < 4; ++n) sacc[m][n] = (f32x4){0.f, 0.f, 0.f, 0.f};
#pragma unroll
      for (int kh = 0; kh < 2; ++kh)
#pragma unroll
        for (int n = 0; n < 4; ++n) {
          const bf16x8 kf = *(const bf16x8*)&Ks[(n * 16 + fr) * 80 + kh * 32 + fq * 8];
#pragma unroll
          for (int m = 0; m < 2; ++m) sacc[m][n] = MFMA(kf, qf[m][kh], sacc[m][n]);
        }
#pragma unroll
      for (int m = 0; m < 2; ++m) {
        const int qi = th + m * 16 + fr;
        float mx = -3.0e38f;
#pragma unroll
        for (int n = 0; n < 4; ++n)
#pragma unroll
          for (int e = 0; e < 4; ++e) {
            const int ki = n * 16 + fq * 4 + e;
            if ((mode == 1 && ki < qi) || (mode == 2 && ki > qi)) sacc[m][n][e] = -INFINITY;
            mx = fmaxf(mx, sacc[m][n][e]);
          }
        mx = fmaxf(mx, __shfl_xor(mx, 16)); mx = fmaxf(mx, __shfl_xor(mx, 32));
        const float mnew = fmaxf(mrun[m], mx);
        const float alpha = __expf(mrun[m] - mnew);
        float ps = 0.f;
#pragma unroll
        for (int n = 0; n < 4; ++n) {
          const float p0 = __expf(sacc[m][n][0] - mnew), p1 = __expf(sacc[m][n][1] - mnew), p2 = __expf(sacc[m][n][2] - mnew), p3 = __expf(sacc[m][n][3] - mnew);
          ps += p0 + p1 + p2 + p3;
          uint2 w; w.x = pack2(p0, p1); w.y = pack2(p2, p3);
          *(uint2*)&Pw[(m * 16 + fr) * 80 + n * 16 + fq * 4] = w;
        }
        ps += __shfl_xor(ps, 16); ps += __shfl_xor(ps, 32);
        lrun[m] = lrun[m] * alpha + ps; mrun[m] = mnew;
#pragma unroll
        for (int n = 0; n < 4; ++n) { o[m][n][0] *= alpha; o[m][n][1] *= alpha; o[m][n][2] *= alpha; o[m][n][3] *= alpha; }
      }
      __builtin_amdgcn_fence(__ATOMIC_RELEASE, "wavefront");
      __builtin_amdgcn_wave_barrier();
      __builtin_amdgcn_fence(__ATOMIC_ACQUIRE, "wavefront");
#pragma unroll
      for (int ks = 0; ks < 2; ++ks) {
        bf16x8 pf[2];
#pragma unroll
        for (int m = 0; m < 2; ++m) pf[m] = *(const bf16x8*)&Pw[(m * 16 + fr) * 80 + ks * 32 + fq * 8];
#pragma unroll
        for (int nd = 0; nd < 4; ++nd) {
          const bf16x8 vf = *(const bf16x8*)&Vt[(nd * 16 + fr) * 80 + (((ks * 4 + fq) ^ ((nd * 2 + (fr >> 3)) & 7)) << 3)];
#pragma unroll
          for (int m = 0; m < 2; ++m) o[m][nd] = MFMA(vf, pf[m], o[m][nd]);
        }
      }
    }
#pragma unroll
    for (int m = 0; m < 2; ++m) {
      const float il = 1.f / lrun[m];
      const int row = qrow0 + th + m * 16 + fr;
#pragma unroll
      for (int nd = 0; nd < 4; ++nd) {
        uint2 w; w.x = pack2(o[m][nd][0] * il, o[m][nd][1] * il); w.y = pack2(o[m][nd][2] * il, o[m][nd][3] * il);
        *(uint2*)(O + (size_t)row * 1024 + head * 64 + nd * 16 + fq * 4) = w;
      }
    }
  }
}

#define DBL_A 0
#define DBL_B 0
#define DBL_C 0
#define DBL_D 0
#define DBL_E 0
DI int layer_phases(int l) { int k = l % 3; return k == 0 ? 25 : (k == 1 ? 8 : 7); }
constexpr int N_PHASES = 2 + 25 + 8 + 7 + 25 + 1;

DI void run_phase(const Params& p, int ph, char* smem) {
  if (ph == 0) { ph_prologue(p, smem); ph_convert(p, 0, smem); return; }
  if (ph == 1) { ph_modreduce(p); return; }
  int q = ph - 2, l = 0;
  while (l < 4 && q >= layer_phases(l)) { q -= layer_phases(l); ++l; }
  if (l == 4) { ph_final(p); return; }
  const int kind = l % 3, jj = l / 3;
  const int np = layer_phases(l);
  const u16* wt = (const u16*)(p.ws + OFF_WT);
  if (q == 0) { ph_norm(p, l, 0); if (l > 0) ph_convert(p, l, smem); return; }
  if (q == np - 3) { ph_norm(p, l, 1); return; }
  if (q == np - 2) { ph_ffn1(p, l, smem);
#if DBL_A
    ph_ffn1(p, l, smem);
#endif
    return; }
  if (q == np - 1) { ph_resid_gemm(p, (const u16*)(p.ws + OFF_SCR), FF, wt + WT_W2T, FF, l, 5, smem); return; }
  if (kind == 0) {
    if (q == 1) { ph_rw_r1(p, jj, smem);
#if DBL_A
    ph_rw_r1(p, jj, smem);
#endif
    return; }
    if (q >= 2 && q <= 19) { int s = q - 2; if (s >= 1) {
#if DBL_D
      ph_rw_scan(p, s - 1, smem, false);
#endif
      ph_rw_scan(p, s - 1, smem); }
      if (s < 17) { ph_rw_produce(p, jj, s, smem);
#if DBL_E
      ph_rw_produce(p, jj, s, smem);
#endif
      } return; }
    if (q == 20) { ph_rw_finish(p, jj, smem); return; }
    if (q == 21) { ph_resid_gemm(p, (const u16*)(p.ws + OFF_SCR) + (size_t)R * P1LD, 1024, wt + WT_RWO, 1024, l, 2, smem); return; }
  } else if (kind == 1) {
    if (q == 1) { ph_ssd_s1(p, jj, smem); return; }
    if (q == 2) { ph_ssd_scan(p, jj, smem);
#if DBL_B
    ph_ssd_scan(p, jj, smem);
#endif
    return; }
    if (q == 3) { ph_ssd_s3(p, smem); return; }
    if (q == 4) { ph_ssd_s4(p, l, jj, smem); return; }
  } else {
    if (q == 1) { ph_at_qkv(p, smem);
#if DBL_A
    ph_at_qkv(p, smem);
#endif
    return; }
    if (q == 2) { ph_attn(p, jj, smem);
#if DBL_C
    ph_attn(p, jj, smem);
#endif
    return; }
    if (q == 3) { ph_resid_gemm(p, (const u16*)(p.ws + OFF_SCR) + (size_t)R * 1536, 1024, wt + WT_AO, 1024, l, 2, smem); return; }
  }
}

extern "C" __global__ void __launch_bounds__(512) mega(Params p, int ph_lo, int ph_hi) {
  extern __shared__ __attribute__((aligned(16))) char smem[];
  cg::grid_group grid = cg::this_grid();
#ifndef PROBE
#define PROBE 0
#endif
#if PROBE
  unsigned long long* tsb = (unsigned long long*)(p.ws + OFF_MODP);
#endif
  __shared__ uint4 xb_words;
  if (threadIdx.x == 0) xb_words = make_uint4(0u, 0u, 0u, 0u);
  __syncthreads();
  XcdBarrier xb = xcd_barrier_post((unsigned*)(p.ws + OFF_BAR), (volatile LAS unsigned*)&xb_words);
  for (int ph = ph_lo; ph < ph_hi; ++ph) {
    run_phase(p, ph, smem);
    if (ph + 1 < ph_hi) { if (ph == ph_lo) grid.sync(); else xcd_barrier(xb); }
  }
#if PROBE
  grid.sync();
  if (blockIdx.x == 0) {
    const float t1 = (float)(tsb[PA1] - tsb[PA0]) * 1e-5f, t2 = (float)(tsb[PB1] - tsb[PB0]) * 1e-5f;
    for (int i = threadIdx.x; i < (1 << 23); i += 512) p.out[i] = t2;
    __syncthreads();
    if (threadIdx.x == 0) p.out[0] = 64.f * t1;
  }
#endif
}

extern "C" void kernel_launch(void* const* d_in, const int* in_sizes, int n_in, void* d_out, int out_size, void* d_ws, size_t ws_size, hipStream_t stream) {
  Params p{};
  for (int i = 0; i < 41; ++i) p.in[i] = (const float*)d_in[i];
  p.out = (float*)d_out; p.ws = (char*)d_ws;
  constexpr size_t kLds = 162048;
  hipFuncSetAttribute((const void*)mega, hipFuncAttributeMaxDynamicSharedMemorySize, (int)kLds);
  hipMemsetAsync((char*)d_ws + OFF_BAR, 0, XCD_BAR_WORDS * 4, stream);
  int lo = 0, hi = N_PHASES;
  void* args[] = {&p, &lo, &hi};
  hipError_t e = hipLaunchCooperativeKernel((void*)mega, dim3(256), dim3(512), args, kLds, stream);
  if (e != hipSuccess) fprintf(stderr, "coop launch failed: %s\n", hipGetErrorString(e));
}
```

```cpp
#include <hip/hip_runtime.h>
#include <hip/hip_cooperative_groups.h>
#include <hip/hip_fp16.h>
#include <cstdio>
namespace cg = cooperative_groups;

typedef unsigned short u16;
typedef short bf16x8 __attribute__((ext_vector_type(8)));
typedef float f32x4 __attribute__((ext_vector_type(4)));
typedef float f32x2 __attribute__((ext_vector_type(2)));
#define MFMA(a, b, c) __builtin_amdgcn_mfma_f32_16x16x32_bf16(a, b, c, 0, 0, 0)
#define DI __device__ __forceinline__

constexpr int D = 1024, NBAT = 2, T = 16384, TC = 256, TS = T + TC, R = NBAT * TS, FF = 2816;
enum { IX = 0, IC, ICTX, ICC, IADAW, IADAB, IN1, IN2, IFWIN, IFCONV, IFWOUT, IFINAL, IRMU, IRWR, IRWK, IRWV, IRWO, IRW0, IRW1, IRW2, IRA0, IRA1,
       IRA2, IRG1, IRG2, IRKK, IRKA, IRRK, IRLNG, IRLNB, ISWIN, ISCONVW, ISCONVB, ISDTB, ISALOG, ISD, ISNG, ISWOUT, IAQKV, IAWO, IASINK };

__device__ __forceinline__ unsigned long long rfl64(unsigned long long v) {
  unsigned lo = __builtin_amdgcn_readfirstlane((unsigned)v), hi = __builtin_amdgcn_readfirstlane((unsigned)(v >> 32));
  return ((unsigned long long)hi << 32) | lo;
}
struct Params {
  const float* in[41]; float* out; char* ws;
  __device__ __forceinline__ const float* inp(int i) const { return (const float*)rfl64((unsigned long long)in[i]); }
  __device__ __forceinline__ float* outp() const { return (float*)rfl64((unsigned long long)out); }
  __device__ __forceinline__ char* wsp() const { return (char*)rfl64((unsigned long long)ws); }
};

constexpr size_t alup(size_t x) { return (x + 255) & ~(size_t)255; }
constexpr size_t OFF_XC = 0;
constexpr size_t OFF_BAR = OFF_XC + alup((size_t)512 * 1024 * 4);
constexpr size_t OFF_MODP = OFF_BAR + 16384;
constexpr size_t OFF_MOD = OFF_MODP + alup((size_t)16 * 4 * 3 * 6144 * 4);
constexpr size_t OFF_SSQ = OFF_MOD + alup((size_t)4 * 3 * 6144 * 4);
constexpr size_t OFF_DT = OFF_SSQ + alup((size_t)R * 8 * 4);
constexpr size_t OFF_BONUS = OFF_DT;
constexpr size_t OFF_RWST = OFF_DT + alup((size_t)R * 64 * 4);
constexpr size_t OFF_H = OFF_RWST + alup((size_t)256 * 256 * 4 * 4);
constexpr size_t OFF_RING = OFF_H;
constexpr size_t OFF_WT = OFF_H + alup((size_t)R * 1024 * 2);
constexpr size_t WT_ELEMS = 17170432;
constexpr size_t OFF_SCR = OFF_WT + alup(WT_ELEMS * 2);
constexpr size_t SCR_BYTES = (size_t)R * 4096 * 2 + (size_t)R * 2048 * 2;
static_assert(OFF_SCR + SCR_BYTES <= (size_t)536870912, "workspace too large");
constexpr size_t WT_W1T = 0, WT_W2T = (size_t)5632 * 1024, WT_MIX = WT_W2T + (size_t)1024 * 2816;
constexpr size_t WT_R1T = WT_MIX, WT_LUT = WT_R1T + (size_t)3456 * 1024, WT_G2T = WT_LUT + (size_t)2 * 16 * 128 * 128, WT_RWO = WT_G2T + (size_t)1024 * 128;
constexpr size_t WT_SX = WT_MIX, WT_SZ = WT_SX + (size_t)4224 * 1024, WT_SO = WT_SZ + (size_t)2048 * 1024;
constexpr size_t WT_AQ = WT_MIX, WT_AO = WT_AQ + (size_t)1536 * 1024;
static_assert(WT_SO + (size_t)1024 * 2048 <= WT_ELEMS, "wt");
static_assert((size_t)2 * 2 * 2 * 1024 * 16 * 512 <= (size_t)R * 1024 * 2, "ring");

DI u16 f2b(float f) { unsigned u = __float_as_uint(f); u += 0x7fffu + ((u >> 16) & 1u); return (u16)(u >> 16); }
DI float b2f(u16 h) { return __uint_as_float(((unsigned)h) << 16); }
DI unsigned pack2(float a, float b) { return (unsigned)f2b(a) | ((unsigned)f2b(b) << 16); }
DI float blo(unsigned u) { return __uint_as_float(u << 16); }
DI float bhi(unsigned u) { return __uint_as_float(u & 0xffff0000u); }
DI float siluf(float x) { return x / (1.f + __expf(-x)); }
DI float sigmf(float x) { return 1.f / (1.f + __expf(-x)); }
DI float softplusf(float x) { return x > 20.f ? x : log1pf(__expf(x)); }
DI int otid() { int t = threadIdx.x; asm volatile("" : "+v"(t)); return t; }
DI void lds_barrier() { asm volatile("s_waitcnt lgkmcnt(0)\n\ts_barrier" ::: "memory"); }
DI f32x4 gload_f4(const float* p) { f32x4 v; asm volatile("global_load_dwordx4 %0, %1, off" : "=v"(v) : "v"(p) : "memory"); return v; }
DI void vm_wait0() { asm volatile("s_waitcnt vmcnt(0)" ::: "memory"); }
DI float wsum(float v) { for (int o = 32; o; o >>= 1) v += __shfl_xor(v, o); return v; }
DI float* xrow_ptr(const Params& p, int r) {
  int b = r / TS, q = r - b * TS;
  return q < TC ? (float*)(p.ws + OFF_XC) + ((size_t)(b * TC + q) << 10) : p.out + ((size_t)(b * T + q - TC) << 10);
}
DI const float* mod_ptr(const Params& p, int l, int r) {
  int b = r / TS, q = r - b * TS;
  int v = q < TC ? 2 : b;
  return (const float*)(p.ws + OFF_MOD) + (size_t)(l * 3 + v) * 6144;
}


#define XB_TMO      128
#define XB_XCNT(j)  (256  + 64 * (j))
#define XB_XSUB(j)  (1280 + 64 * (j))
#define XB_XGEN(j)  (2304 + 64 * (j))
#define XB_TOP      3328
#define XB_TOPGEN   3392
#define XCD_BAR_WORDS 3456
#define XB_SPIN_CAP (1u << 18)
#define LAS __attribute__((address_space(3)))
DI unsigned xb_ld(unsigned* p) { return __hip_atomic_load(p, __ATOMIC_RELAXED, __HIP_MEMORY_SCOPE_AGENT); }
DI unsigned xb_add(unsigned* p, unsigned v) { return __hip_atomic_fetch_add(p, v, __ATOMIC_RELAXED, __HIP_MEMORY_SCOPE_AGENT); }
DI unsigned xb_xcc_id() { return (unsigned)__builtin_amdgcn_s_getreg((3 << 11) | 20) & 0xFu; }
#define XB_SPIN(cond, bar) do { unsigned _sp = 0; while (cond) { __builtin_amdgcn_s_sleep(1); \
    if ((++_sp & 255u) == 0u) { if (xb_ld(&(bar)[XB_TMO])) break; if (_sp > XB_SPIN_CAP) { atomicAdd(&(bar)[XB_TMO], 1u); break; } } } } while (0)
struct XcdBarrier { unsigned* bar; unsigned x; volatile LAS unsigned* st; };
DI XcdBarrier xcd_barrier_post(unsigned* bar, volatile LAS unsigned* st) {
  XcdBarrier b; b.bar = bar; b.x = xb_xcc_id(); b.st = st;
  if (threadIdx.x == 0) (void)xb_add(&bar[XB_XCNT(b.x)], 1u);
  return b;
}
DI void xcd_barrier_complete(unsigned* bar, unsigned x, unsigned& nloc, unsigned& nx) {
  const unsigned G = gridDim.x * gridDim.y * gridDim.z;
  unsigned sum, cnt, mine, sp = 0u;
  for (;;) {
    sum = 0u; cnt = 0u; mine = 0u;
#pragma unroll
    for (unsigned j = 0; j < 16; ++j) { const unsigned c = xb_ld(&bar[XB_XCNT(j)]); sum += c; cnt += (c > 0u) ? 1u : 0u; mine = (j == x) ? c : mine; }
    if (sum == G) break;
    __builtin_amdgcn_s_sleep(1);
    if ((++sp & 255u) == 0u) { if (xb_ld(&bar[XB_TMO])) break; if (sp > XB_SPIN_CAP) { atomicAdd(&bar[XB_TMO], 1u); break; } }
  }
  nloc = mine > 0u ? mine : 1u; nx = cnt > 0u ? cnt : 1u;
}
DI void xcd_barrier(const XcdBarrier& b) {
  asm volatile("s_waitcnt vmcnt(0)" ::: "memory");
  __syncthreads();
  if (threadIdx.x == 0) {
    unsigned* bar = b.bar;
    __builtin_amdgcn_s_waitcnt(0);
    unsigned nloc = b.st[0], nx = b.st[1];
    if (nloc == 0u) { xcd_barrier_complete(bar, b.x, nloc, nx); b.st[0] = nloc; b.st[1] = nx; }
    const unsigned old = xb_add(&bar[XB_XSUB(b.x)], 1u);
    const unsigned gen = old / nloc;
    if (old + 1u == (gen + 1u) * nloc) {
      __builtin_amdgcn_fence(__ATOMIC_RELEASE, "agent");
      asm volatile("s_waitcnt vmcnt(0)" ::: "memory");
      const unsigned og = xb_add(&bar[XB_TOP], 1u);
      const unsigned tg = og / nx;
      if (og + 1u == (tg + 1u) * nx) xb_add(&bar[XB_TOPGEN], 1u);
      else XB_SPIN(xb_ld(&bar[XB_TOPGEN]) == tg, bar);
      __builtin_amdgcn_fence(__ATOMIC_ACQUIRE, "agent");
      xb_add(&bar[XB_XGEN(b.x)], 1u);
      asm volatile("s_waitcnt vmcnt(0)" ::: "memory");
    } else {
      XB_SPIN(xb_ld(&bar[XB_XGEN(b.x)]) == gen, bar);
      __builtin_amdgcn_fence(__ATOMIC_ACQUIRE, "agent");
      asm volatile("s_waitcnt vmcnt(0)" ::: "memory");
    }
  }
  __syncthreads();
}

constexpr int LDS_ROW = 64;
struct SmemG { u16 A[2][256 * LDS_ROW]; u16 B[2][128 * LDS_ROW]; };
template <class AL>
DI void gemm_main(const AL& al, const u16* __restrict__ Bt, int ldb, int K, f32x4 (&acc)[4][4], char* smem) {
  SmemG& s = *(SmemG*)smem;
  const int tid = otid(), lane = tid & 63, wave = tid >> 6, wr = wave >> 1, wc = wave & 1, fr = lane & 15, fq = lane >> 4;
#pragma unroll
  for (int m = 0; m < 4; ++m)
#pragma unroll
    for (int n = 0; n < 4; ++n) acc[m][n] = (f32x4){0.f, 0.f, 0.f, 0.f};
  uint4 ra[4], rb[2];
  const int nk = K >> 6;
  const int lrow = tid >> 3, lkc = (tid & 7) * 8, lsw = ((tid & 7) ^ (lrow & 7)) * 8;
  __syncthreads();
#pragma unroll
  for (int i = 0; i < 4; ++i) ra[i] = al(lrow + i * 64, lkc);
#pragma unroll
  for (int i = 0; i < 2; ++i) rb[i] = *(const uint4*)(Bt + (size_t)(lrow + i * 64) * ldb + lkc);
#pragma unroll
  for (int i = 0; i < 4; ++i) *(uint4*)&s.A[0][(lrow + i * 64) * LDS_ROW + lsw] = al.post(ra[i], lrow + i * 64, lkc);
#pragma unroll
  for (int i = 0; i < 2; ++i) *(uint4*)&s.B[0][(lrow + i * 64) * LDS_ROW + lsw] = rb[i];
  __syncthreads();
  for (int kt = 0; kt < nk; ++kt) {
    const int buf = kt & 1;
    const int kn = (kt + 1 < nk ? kt + 1 : kt) * 64 + lkc;
#pragma unroll
    for (int i = 0; i < 2; ++i) {
      const u16* bp = Bt + (size_t)(lrow + i * 64) * ldb + kn;
      asm volatile("global_load_dwordx4 %0, %1, off" : "=v"(rb[i]) : "v"(bp) : "memory");
    }
#pragma unroll
    for (int i = 0; i < 4; ++i) ra[i] = al(lrow + i * 64, kn);
    __builtin_amdgcn_sched_barrier(0);
#pragma unroll
    for (int kh = 0; kh < 2; ++kh) {
      bf16x8 a[4], b[4];
#pragma unroll
      for (int m = 0; m < 4; ++m) a[m] = *(const bf16x8*)&s.A[buf][(wr * 64 + m * 16 + fr) * LDS_ROW + (((kh * 4 + fq) ^ (fr & 7)) << 3)];
#pragma unroll
      for (int n = 0; n < 4; ++n) b[n] = *(const bf16x8*)&s.B[buf][(wc * 64 + n * 16 + fr) * LDS_ROW + (((kh * 4 + fq) ^ (fr & 7)) << 3)];
      __builtin_amdgcn_s_setprio(1);
#pragma unroll
      for (int m = 0; m < 4; ++m)
#pragma unroll
        for (int n = 0; n < 4; ++n) acc[m][n] = MFMA(b[n], a[m], acc[m][n]);
      __builtin_amdgcn_s_setprio(0);
    }
    asm volatile("s_waitcnt vmcnt(0)" ::: "memory");
#pragma unroll
    for (int i = 0; i < 4; ++i) *(uint4*)&s.A[buf ^ 1][(lrow + i * 64) * LDS_ROW + lsw] = al.post(ra[i], lrow + i * 64, kn);
#pragma unroll
    for (int i = 0; i < 2; ++i) *(uint4*)&s.B[buf ^ 1][(lrow + i * 64) * LDS_ROW + lsw] = rb[i];
    __syncthreads();
  }
}

template <class AL>
DI void gemm_main3(const AL& al, const u16* __restrict__ Bt, int ldb, int K, f32x4 (&acc)[4][4], char* smem) {
  SmemG& s = *(SmemG*)smem;
  const int tid = otid(), lane = tid & 63, wave = tid >> 6, wr = wave >> 1, wc = wave & 1, fr = lane & 15, fq = lane >> 4;
  const bool grpY = __builtin_amdgcn_readfirstlane(wave) >= 4;
#pragma unroll
  for (int m = 0; m < 4; ++m)
#pragma unroll
    for (int n = 0; n < 4; ++n) acc[m][n] = (f32x4){0.f, 0.f, 0.f, 0.f};
  uint4 ra[4], rb[2];
  const int nk = K >> 6;
  const int lrow = tid >> 3, lkc = (tid & 7) * 8, lsw = ((tid & 7) ^ (lrow & 7)) * 8;
  __syncthreads();
#pragma unroll
  for (int i = 0; i < 4; ++i) ra[i] = al(lrow + i * 64, lkc);
#pragma unroll
  for (int i = 0; i < 2; ++i) rb[i] = *(const uint4*)(Bt + (size_t)(lrow + i * 64) * ldb + lkc);
#pragma unroll
  for (int i = 0; i < 4; ++i) *(uint4*)&s.A[0][(lrow + i * 64) * LDS_ROW + lsw] = al.post(ra[i], lrow + i * 64, lkc);
#pragma unroll
  for (int i = 0; i < 2; ++i) *(uint4*)&s.B[0][(lrow + i * 64) * LDS_ROW + lsw] = rb[i];
  __syncthreads();
  const u16* abase = &s.A[0][(wr * 64 + fr) * LDS_ROW];
  const u16* bbase = &s.B[0][(wc * 64 + fr) * LDS_ROW];
  bf16x8 fa[4], fb[4];
#define G3_RD(BUF, KH) do { \
    _Pragma("unroll") for (int m = 0; m < 4; ++m) fa[m] = *(const bf16x8*)(abase + (BUF) * 256 * LDS_ROW + m * 16 * LDS_ROW + ((((KH) * 4 + fq) ^ (fr & 7)) << 3)); \
    _Pragma("unroll") for (int n = 0; n < 4; ++n) fb[n] = *(const bf16x8*)(bbase + (BUF) * 128 * LDS_ROW + n * 16 * LDS_ROW + ((((KH) * 4 + fq) ^ (fr & 7)) << 3)); } while (0)
#define G3_MM() do { \
    _Pragma("unroll") for (int m = 0; m < 4; ++m) _Pragma("unroll") for (int n = 0; n < 4; ++n) acc[m][n] = MFMA(fb[n], fa[m], acc[m][n]); } while (0)
  int kn = (1 < nk ? 1 : 0) * 64 + lkc;
#pragma unroll
  for (int i = 0; i < 2; ++i) {
    const u16* bp = Bt + (size_t)(lrow + i * 64) * ldb + kn;
    asm volatile("global_load_dwordx4 %0, %1, off" : "=v"(rb[i]) : "v"(bp) : "memory");
  }
#pragma unroll
  for (int i = 0; i < 4; ++i) ra[i] = al(lrow + i * 64, kn);
  if (grpY) G3_RD(0, 0);
  __builtin_amdgcn_sched_barrier(0);
  for (int kt = 0; kt < nk; ++kt) {
    const int buf = kt & 1;
    if (!grpY) G3_RD(buf, 0);
    __builtin_amdgcn_sched_barrier(0);
    G3_MM();
    __builtin_amdgcn_sched_barrier(0);
    if (grpY) G3_RD(buf, 1);
    __builtin_amdgcn_sched_barrier(0);
    asm volatile("s_waitcnt vmcnt(0)" ::: "memory");
#pragma unroll
    for (int i = 0; i < 4; ++i) *(uint4*)&s.A[buf ^ 1][(lrow + i * 64) * LDS_ROW + lsw] = al.post(ra[i], lrow + i * 64, kn);
#pragma unroll
    for (int i = 0; i < 2; ++i) *(uint4*)&s.B[buf ^ 1][(lrow + i * 64) * LDS_ROW + lsw] = rb[i];
    if (kt + 2 < nk) {
      kn = (kt + 2) * 64 + lkc;
#pragma unroll
      for (int i = 0; i < 2; ++i) {
        const u16* bp = Bt + (size_t)(lrow + i * 64) * ldb + kn;
        asm volatile("global_load_dwordx4 %0, %1, off" : "=v"(rb[i]) : "v"(bp) : "memory");
      }
#pragma unroll
      for (int i = 0; i < 4; ++i) ra[i] = al(lrow + i * 64, kn);
    }
    __builtin_amdgcn_sched_barrier(0);
    lds_barrier();
    if (!grpY) G3_RD(buf, 1);
    __builtin_amdgcn_sched_barrier(0);
    G3_MM();
    __builtin_amdgcn_sched_barrier(0);
    if (grpY) G3_RD(buf ^ 1, 0);
    __builtin_amdgcn_sched_barrier(0);
    lds_barrier();
  }
  asm volatile("s_waitcnt vmcnt(0)" ::: "memory");
  __syncthreads();
}

template <class AL>
DI void gemm_main4(const AL& al, const u16* __restrict__ Bt, int ldb, int K, f32x4 (&acc)[4][4], char* smem) {
  SmemG& s = *(SmemG*)smem;
  const int tid = otid(), lane = tid & 63, wave = tid >> 6, wr = wave >> 1, wc = wave & 1, fr = lane & 15, fq = lane >> 4;
#pragma unroll
  for (int m = 0; m < 4; ++m)
#pragma unroll
    for (int n = 0; n < 4; ++n) acc[m][n] = (f32x4){0.f, 0.f, 0.f, 0.f};
  uint4 a0[4], a1[4], b00, b01, b10, b11;
  const int nk = K >> 6;
  const int lrow = tid >> 3, lkc = (tid & 7) * 8, lsw = ((tid & 7) ^ (lrow & 7)) * 8;
  __syncthreads();
#pragma unroll
  for (int i = 0; i < 4; ++i) a0[i] = al(lrow + i * 64, lkc);
#pragma unroll
  for (int i = 0; i < 1; ++i) { b00 = *(const uint4*)(Bt + (size_t)lrow * ldb + lkc); b01 = *(const uint4*)(Bt + (size_t)(lrow + 64) * ldb + lkc); }
#pragma unroll
  for (int i = 0; i < 4; ++i) *(uint4*)&s.A[0][(lrow + i * 64) * LDS_ROW + lsw] = al.post(a0[i], lrow + i * 64, lkc);
#pragma unroll
  for (int i = 0; i < 1; ++i) { *(uint4*)&s.B[0][lrow * LDS_ROW + lsw] = b00; *(uint4*)&s.B[0][(lrow + 64) * LDS_ROW + lsw] = b01; }
  __syncthreads();
  auto g4_load = [&](uint4 (&RA)[4], uint4& RB0, uint4& RB1, int KN) {
#pragma unroll
    for (int i = 0; i < 4; ++i) RA[i] = al(lrow + i * 64, KN);
    RB0 = *(const uint4*)(Bt + (size_t)lrow * ldb + KN);
    RB1 = *(const uint4*)(Bt + (size_t)(lrow + 64) * ldb + KN);
  };
  auto g4_store = [&](uint4 (&RA)[4], uint4& RB0, uint4& RB1, int BUF, int KN) {
#pragma unroll
    for (int i = 0; i < 4; ++i) *(uint4*)&s.A[BUF][(lrow + i * 64) * LDS_ROW + lsw] = al.post(RA[i], lrow + i * 64, KN);
    *(uint4*)&s.B[BUF][lrow * LDS_ROW + lsw] = RB0;
    *(uint4*)&s.B[BUF][(lrow + 64) * LDS_ROW + lsw] = RB1;
  };
#define G4_COMPUTE(BUF) do { \
    _Pragma("unroll") for (int kh = 0; kh < 2; ++kh) { \
      bf16x8 a[4], b[4]; \
      _Pragma("unroll") for (int m = 0; m < 4; ++m) a[m] = *(const bf16x8*)&s.A[BUF][(wr * 64 + m * 16 + fr) * LDS_ROW + (((kh * 4 + fq) ^ (fr & 7)) << 3)]; \
      _Pragma("unroll") for (int n = 0; n < 4; ++n) b[n] = *(const bf16x8*)&s.B[BUF][(wc * 64 + n * 16 + fr) * LDS_ROW + (((kh * 4 + fq) ^ (fr & 7)) << 3)]; \
      __builtin_amdgcn_s_setprio(1); \
      _Pragma("unroll") for (int m = 0; m < 4; ++m) _Pragma("unroll") for (int n = 0; n < 4; ++n) acc[m][n] = MFMA(b[n], a[m], acc[m][n]); \
      __builtin_amdgcn_s_setprio(0); } } while (0)
  int k1 = 64 + lkc, k2 = (2 < nk ? 2 : nk - 1) * 64 + lkc;
  g4_load(a0, b00, b01, k1);
  g4_load(a1, b10, b11, k2);
  __builtin_amdgcn_sched_barrier(0);
  for (int kt = 0; kt < nk; kt += 2) {
    G4_COMPUTE(0);
    __builtin_amdgcn_sched_barrier(0);
    g4_store(a0, b00, b01, 1, k1);
    k1 = (kt + 3 < nk ? kt + 3 : nk - 1) * 64 + lkc;
    g4_load(a0, b00, b01, k1);
    __builtin_amdgcn_sched_barrier(0);
    __syncthreads();
    G4_COMPUTE(1);
    __builtin_amdgcn_sched_barrier(0);
    g4_store(a1, b10, b11, 0, k2);
    k2 = (kt + 4 < nk ? kt + 4 : nk - 1) * 64 + lkc;
    g4_load(a1, b10, b11, k2);
    __builtin_amdgcn_sched_barrier(0);
    __syncthreads();
  }
}


struct SmemG2 { u16 A[2][256 * LDS_ROW]; u16 B[2][256 * LDS_ROW]; };
template <class AL>
DI void gemm_main2(const AL& al, const u16* __restrict__ Bt, int ldb, int K, f32x4 (&acc)[4][8], char* smem) {
  SmemG2& s = *(SmemG2*)smem;
  const int tid = otid(), lane = tid & 63, wave = tid >> 6, wr = wave >> 1, wc = wave & 1, fr = lane & 15, fq = lane >> 4;
#pragma unroll
  for (int m = 0; m < 4; ++m)
#pragma unroll
    for (int n = 0; n < 8; ++n) acc[m][n] = (f32x4){0.f, 0.f, 0.f, 0.f};
  uint4 ra[4], rb[4];
  const int nk = K >> 6;
  const int lrow = tid >> 3, lkc = (tid & 7) * 8, lsw = ((tid & 7) ^ (lrow & 7)) * 8;
  __syncthreads();
#pragma unroll
  for (int i = 0; i < 4; ++i) ra[i] = al(lrow + i * 64, lkc);
#pragma unroll
  for (int i = 0; i < 4; ++i) rb[i] = *(const uint4*)(Bt + (size_t)(lrow + i * 64) * ldb + lkc);
#pragma unroll
  for (int i = 0; i < 4; ++i) *(uint4*)&s.A[0][(lrow + i * 64) * LDS_ROW + lsw] = al.post(ra[i], lrow + i * 64, lkc);
#pragma unroll
  for (int i = 0; i < 4; ++i) *(uint4*)&s.B[0][(lrow + i * 64) * LDS_ROW + lsw] = rb[i];
  __syncthreads();
  for (int kt = 0; kt < nk; ++kt) {
    const int buf = kt & 1;
    const int kn = (kt + 1 < nk ? kt + 1 : kt) * 64 + lkc;
#pragma unroll
    for (int i = 0; i < 4; ++i) ra[i] = al(lrow + i * 64, kn);
    __builtin_amdgcn_sched_barrier(0);
#pragma unroll
    for (int kh = 0; kh < 2; ++kh) {
      bf16x8 a[4];
#pragma unroll
      for (int m = 0; m < 4; ++m) a[m] = *(const bf16x8*)&s.A[buf][(wr * 64 + m * 16 + fr) * LDS_ROW + (((kh * 4 + fq) ^ (fr & 7)) << 3)];
      bf16x8 bc = *(const bf16x8*)&s.B[buf][(wc * 128 + fr) * LDS_ROW + (((kh * 4 + fq) ^ (fr & 7)) << 3)];
#pragma unroll
      for (int n = 0; n < 8; ++n) {
        const bf16x8 bn = *(const bf16x8*)&s.B[buf][(wc * 128 + (n < 7 ? n + 1 : n) * 16 + fr) * LDS_ROW + (((kh * 4 + fq) ^ (fr & 7)) << 3)];
        __builtin_amdgcn_sched_barrier(0);
        __builtin_amdgcn_s_setprio(1);
#pragma unroll
        for (int m = 0; m < 4; ++m) acc[m][n] = MFMA(bc, a[m], acc[m][n]);
        __builtin_amdgcn_s_setprio(0);
        bc = bn;
      }
      __builtin_amdgcn_sched_barrier(0);
      if (kh == 0) {
#pragma unroll
        for (int i = 0; i < 4; ++i) *(uint4*)&s.A[buf ^ 1][(lrow + i * 64) * LDS_ROW + lsw] = al.post(ra[i], lrow + i * 64, kn);
#pragma unroll
        for (int i = 0; i < 4; ++i) {
          const u16* bp = Bt + (size_t)(lrow + i * 64) * ldb + kn;
          asm volatile("global_load_dwordx4 %0, %1, off" : "=v"(rb[i]) : "v"(bp) : "memory");
        }
        __builtin_amdgcn_sched_barrier(0);
      }
    }
    asm volatile("s_waitcnt vmcnt(0)" ::: "memory");
#pragma unroll
    for (int i = 0; i < 4; ++i) *(uint4*)&s.B[buf ^ 1][(lrow + i * 64) * LDS_ROW + lsw] = rb[i];
    __syncthreads();
  }
}

DI bool next_tile(int it, int MT, int NT, int GN, int& mt, int& nt) {
  const int xcd = blockIdx.x & 7, lb = blockIdx.x >> 3, GM = 8 / GN;
  const int gm = xcd / GN, gn = xcd - gm * GN;
  const int m0 = gm * MT / GM, m1 = (gm + 1) * MT / GM, n0 = gn * NT / GN, n1 = (gn + 1) * NT / GN;
  const int nl = n1 - n0, tl = lb + it * (gridDim.x >> 3);
  if (tl >= (m1 - m0) * nl) return false;
  const int q = tl / nl;
  mt = m0 + q; nt = n0 + (tl - q * nl);
  return true;
}
struct ALPlain {
  const u16* base; int ld;
  DI uint4 operator()(int i, int k) const { return *(const uint4*)(base + (size_t)i * ld + k); }
  DI uint4 post(uint4 v, int, int) const { return v; }
};

DI void ph_prologue(const Params& p, char* smem) {
  const int tid = otid();
  {
    const float4* x = (const float4*)p.in[IX]; float4* o = (float4*)p.out;
    const size_t n = (size_t)NBAT * T * D / 4;
    for (size_t i = (size_t)blockIdx.x * 512 + tid; i < n; i += (size_t)gridDim.x * 512) o[i] = x[i];
    const float4* c = (const float4*)p.in[ICTX]; float4* xc = (float4*)(p.ws + OFF_XC);
    const size_t nc = (size_t)NBAT * TC * D / 4;
    for (size_t i = (size_t)blockIdx.x * 512 + tid; i < nc; i += (size_t)gridDim.x * 512) xc[i] = c[i];
  }
  float* modp = (float*)(p.ws + OFF_MODP);
  float* sc = (float*)smem;
  __syncthreads();
  for (int e = tid; e < 3072; e += 512) { const float v = e < 2048 ? p.in[IC][e] : p.in[ICC][e - 2048]; sc[e] = siluf(v); }
  __syncthreads();
  const int half = tid >> 8, col = tid & 255;
  for (int it = blockIdx.x * 2 + half; it < 4 * 24 * 16; it += gridDim.x * 2) {
    int l = it / (24 * 16), rem = it - l * 24 * 16, cc = rem / 16, kc = rem & 15;
    int n = cc * 256 + col;
    const float* w = p.in[IADAW] + (size_t)l * 1024 * 6144 + (size_t)(kc * 64) * 6144 + n;
    float a0 = 0.f, a1 = 0.f, a2 = 0.f;
#pragma unroll
    for (int kb = 0; kb < 64; kb += 16) {
      float wv[16];
#pragma unroll
      for (int k = 0; k < 16; ++k) wv[k] = w[(size_t)(kb + k) * 6144];
#pragma unroll
      for (int k = 0; k < 16; ++k) {
        const int kk = kc * 64 + kb + k;
        a0 += sc[kk] * wv[k]; a1 += sc[1024 + kk] * wv[k]; a2 += sc[2048 + kk] * wv[k];
      }
    }
    size_t o = ((size_t)(kc * 4 + l) * 3) * 6144 + n;
    modp[o] = a0; modp[o + 6144] = a1; modp[o + 2 * 6144] = a2;
  }
}
DI void ph_modreduce(const Params& p) {
  const float* modp = (const float*)(p.ws + OFF_MODP); float* mod = (float*)(p.ws + OFF_MOD);
  for (int i = blockIdx.x * 512 + otid(); i < 4 * 3 * 6144; i += gridDim.x * 512) {
    int l = i / (3 * 6144), n = i % 6144;
    float a = p.in[IADAB][l * 6144 + n];
    float pv[16];
#pragma unroll
    for (int kc = 0; kc < 16; ++kc) pv[kc] = modp[(size_t)kc * 4 * 3 * 6144 + i];
#pragma unroll
    for (int kc = 0; kc < 16; ++kc) a += pv[kc];
    mod[i] = a;
  }
}

struct CvtJob { const float* src; u16* dst; int K, N, ld, ldd, mode; };
DI void cvt_run(const CvtJob& j, int& rot, char* smem) {
  float* tile = (float*)smem;
  const int tid = otid();
  if (j.mode == 4) {
    size_t n = (size_t)j.K * j.N;
    for (size_t i = (size_t)blockIdx.x * 512 + tid; i < n; i += (size_t)gridDim.x * 512) j.dst[i] = 0;
    return;
  }
  const int tk = j.K >> 6, tn = j.N >> 6, nt = tk * tn;
  int start = (blockIdx.x + gridDim.x - (rot % gridDim.x)) % gridDim.x;
  for (int t = start; t < nt; t += gridDim.x) {
    int kt = t / tn, ntl = t - kt * tn;
    __syncthreads();
    {
      f32x4 lv[2];
#pragma unroll
      for (int i = 0; i < 2; ++i) { const int e = tid + i * 512, kk = e >> 4, n4 = (e & 15) * 4; lv[i] = gload_f4(j.src + (size_t)(kt * 64 + kk) * j.ld + ntl * 64 + n4); }
      asm volatile("s_waitcnt vmcnt(0)" : "+v"(lv[0]), "+v"(lv[1]) :: "memory");
#pragma unroll
      for (int i = 0; i < 2; ++i) { const int e = tid + i * 512, kk = e >> 4, n4 = (e & 15) * 4; float* tp = tile + kk * 65 + n4; tp[0] = lv[i][0]; tp[1] = lv[i][1]; tp[2] = lv[i][2]; tp[3] = lv[i][3]; }
    }
    __syncthreads();
    for (int e = tid; e < 4096; e += 512) {
      int nn = e >> 6, kk = e & 63; float v = tile[kk * 65 + nn];
      int n = ntl * 64 + nn, k = kt * 64 + kk;
      if (j.mode == 0) j.dst[(size_t)n * j.ldd + k] = f2b(v);
      else if (j.mode == 1) { int rr = n < FF ? (n >> 7) * 256 + (n & 127) : ((n - FF) >> 7) * 256 + 128 + ((n - FF) & 127); j.dst[(size_t)rr * j.ldd + k] = f2b(v); }
      else {
        int h = n >> 6, c = n & 63, ty = j.mode - 2;
        u16* d = j.dst + (size_t)h * 128 * 128 + (size_t)((c >> 5) * 64 + ty * 32 + (c & 31)) * 128;
        d[ty * 64 + k] = f2b(v); d[(1 - ty) * 64 + k] = 0;
      }
    }
  }
  rot += nt;
}
DI void ph_convert(const Params& p, int l, char* smem) {
  u16* wt = (u16*)(p.ws + OFF_WT);
  int rot = 0;
  CvtJob j;
  j = {p.in[IFWIN] + (size_t)l * 1024 * 5632, wt + WT_W1T, 1024, 5632, 5632, 1024, 1}; cvt_run(j, rot, smem);
  j = {p.in[IFWOUT] + (size_t)l * FF * 1024, wt + WT_W2T, FF, 1024, 1024, FF, 0}; cvt_run(j, rot, smem);
  const int kind = l % 3, jj = l / 3;
  if (kind == 0) {
    j = {p.in[IRWR] + (size_t)jj * 1048576, wt + WT_R1T, 1024, 1024, 1024, 1024, 0}; cvt_run(j, rot, smem);
    j = {p.in[IRWK] + (size_t)jj * 1048576, wt + WT_R1T + (size_t)1024 * 1024, 1024, 1024, 1024, 1024, 0}; cvt_run(j, rot, smem);
    j = {p.in[IRWV] + (size_t)jj * 1048576, wt + WT_R1T + (size_t)2048 * 1024, 1024, 1024, 1024, 1024, 0}; cvt_run(j, rot, smem);
    for (int d = 0; d < 2; ++d) {
      j = {p.in[IRW1] + (size_t)(jj * 2 + d) * 65536, wt + WT_R1T + (size_t)(3072 + d * 64) * 1024, 1024, 64, 64, 1024, 0}; cvt_run(j, rot, smem);
      j = {p.in[IRA1] + (size_t)(jj * 2 + d) * 65536, wt + WT_R1T + (size_t)(3200 + d * 64) * 1024, 1024, 64, 64, 1024, 0}; cvt_run(j, rot, smem);
      j = {p.in[IRW2] + (size_t)(jj * 2 + d) * 65536, wt + WT_LUT + (size_t)d * 16 * 128 * 128, 64, 1024, 1024, 128, 2}; cvt_run(j, rot, smem);
      j = {p.in[IRA2] + (size_t)(jj * 2 + d) * 65536, wt + WT_LUT + (size_t)d * 16 * 128 * 128, 64, 1024, 1024, 128, 3}; cvt_run(j, rot, smem);
    }
    j = {p.in[IRG1] + (size_t)jj * 131072, wt + WT_R1T + (size_t)3328 * 1024, 1024, 128, 128, 1024, 0}; cvt_run(j, rot, smem);
    j = {p.in[IRG2] + (size_t)jj * 131072, wt + WT_G2T, 128, 1024, 1024, 128, 0}; cvt_run(j, rot, smem);
    j = {p.in[IRWO] + (size_t)jj * 1048576, wt + WT_RWO, 1024, 1024, 1024, 1024, 0}; cvt_run(j, rot, smem);
  } else if (kind == 1) {
    j = {p.in[ISWIN] + (size_t)jj * 1024 * 6208 + 2048, wt + WT_SX, 1024, 4160, 6208, 1024, 0}; cvt_run(j, rot, smem);
    j = {nullptr, wt + WT_SX + (size_t)4160 * 1024, 64, 1024, 0, 0, 4}; cvt_run(j, rot, smem);
    j = {p.in[ISWIN] + (size_t)jj * 1024 * 6208, wt + WT_SZ, 1024, 2048, 6208, 1024, 0}; cvt_run(j, rot, smem);
    j = {p.in[ISWOUT] + (size_t)jj * 2048 * 1024, wt + WT_SO, 2048, 1024, 1024, 2048, 0}; cvt_run(j, rot, smem);
    float* ssq = (float*)(p.ws + OFF_SSQ);
    for (int i = blockIdx.x * 512 + otid(); i < R * 8; i += gridDim.x * 512) ssq[i] = 0.f;
  } else {
    j = {p.in[IAQKV] + (size_t)jj * 1024 * 1536, wt + WT_AQ, 1024, 1536, 1536, 1024, 0}; cvt_run(j, rot, smem);
    j = {p.in[IAWO] + (size_t)jj * 1048576, wt + WT_AO, 1024, 1024, 1024, 1024, 0}; cvt_run(j, rot, smem);
  }
}

DI void ph_norm(const Params& p, int l, int which) {
  const int lane = otid() & 63, gw = blockIdx.x * 8 + (otid() >> 6), nw = gridDim.x * 8;
  const float* g = (which ? p.in[IN2] : p.in[IN1]) + l * 1024;
  u16* H = (u16*)(p.ws + OFF_H);
  float4 gg[4];
#pragma unroll
  for (int j = 0; j < 4; ++j) gg[j] = *(const float4*)(g + j * 256 + lane * 4);
  float4 v[4], vn[4];
  if (gw < R) {
    const float* xr = xrow_ptr(p, gw);
#pragma unroll
    for (int j = 0; j < 4; ++j) v[j] = *(const float4*)(xr + j * 256 + lane * 4);
  }
  for (int r = gw; r < R; r += nw) {
    {
      const float* xn = xrow_ptr(p, r + nw < R ? r + nw : r);
#pragma unroll
      for (int j = 0; j < 4; ++j) vn[j] = *(const float4*)(xn + j * 256 + lane * 4);
    }
    const float* md = mod_ptr(p, l, r) + which * 3072;
    float4 sh[4], sc[4];
#pragma unroll
    for (int j = 0; j < 4; ++j) { sh[j] = *(const float4*)(md + j * 256 + lane * 4); sc[j] = *(const float4*)(md + 1024 + j * 256 + lane * 4); }
    __builtin_amdgcn_sched_barrier(0);
    float ss = 0.f;
#pragma unroll
    for (int j = 0; j < 4; ++j) ss += v[j].x * v[j].x + v[j].y * v[j].y + v[j].z * v[j].z + v[j].w * v[j].w;
    ss = wsum(ss);
    const float rs = rsqrtf(ss * (1.f / 1024.f) + 1e-6f);
#pragma unroll
    for (int j = 0; j < 4; ++j) {
      const int c = j * 256 + lane * 4;
      float o0 = v[j].x * rs * gg[j].x * (1.f + sc[j].x) + sh[j].x, o1 = v[j].y * rs * gg[j].y * (1.f + sc[j].y) + sh[j].y;
      float o2 = v[j].z * rs * gg[j].z * (1.f + sc[j].z) + sh[j].z, o3 = v[j].w * rs * gg[j].w * (1.f + sc[j].w) + sh[j].w;
      uint2 w; w.x = pack2(o0, o1); w.y = pack2(o2, o3);
      *(uint2*)(H + (size_t)r * 1024 + c) = w;
    }
#pragma unroll
    for (int j = 0; j < 4; ++j) v[j] = vn[j];
  }
}
DI void ph_final(const Params& p) {
  const int lane = otid() & 63, gw = blockIdx.x * 8 + (otid() >> 6), nw = gridDim.x * 8;
  float4 g[4];
#pragma unroll
  for (int j = 0; j < 4; ++j) g[j] = *(const float4*)(p.in[IFINAL] + j * 256 + lane * 4);
  float4 v[4], vn[4];
  if (gw < NBAT * T) {
#pragma unroll
    for (int j = 0; j < 4; ++j) v[j] = *(const float4*)(p.out + (size_t)gw * 1024 + j * 256 + lane * 4);
  }
  for (int r = gw; r < NBAT * T; r += nw) {
    float* xr = p.out + (size_t)r * 1024;
    {
      const float* xn = p.out + (size_t)(r + nw < NBAT * T ? r + nw : r) * 1024;
#pragma unroll
      for (int j = 0; j < 4; ++j) vn[j] = *(const float4*)(xn + j * 256 + lane * 4);
    }
    __builtin_amdgcn_sched_barrier(0);
    float ss = 0.f;
#pragma unroll
    for (int j = 0; j < 4; ++j) ss += v[j].x * v[j].x + v[j].y * v[j].y + v[j].z * v[j].z + v[j].w * v[j].w;
    ss = wsum(ss);
    const float rs = rsqrtf(ss * (1.f / 1024.f) + 1e-6f);
#pragma unroll
    for (int j = 0; j < 4; ++j) {
      float4 w = v[j]; w.x *= rs * g[j].x; w.y *= rs * g[j].y; w.z *= rs * g[j].z; w.w *= rs * g[j].w;
      *(float4*)(xr + j * 256 + lane * 4) = w;
    }
#pragma unroll
    for (int j = 0; j < 4; ++j) v[j] = vn[j];
  }
}

template <class AL>
DI void resid_tile(const Params& p, const AL& al, const u16* Bt, int K, int l, int gi, int mt, int nt, char* smem) {
  f32x4 acc[4][4];
  gemm_main4(al, Bt + (size_t)nt * 128 * K, K, K, acc, smem);
  const int lane = otid() & 63, wave = otid() >> 6, wr = wave >> 1, wc = wave & 1, fr = lane & 15, fq = lane >> 4;
  const int row0 = mt * 256;
  const float* md = mod_ptr(p, l, row0) + gi * 1024;
  float4 g[4];
#pragma unroll
  for (int n = 0; n < 4; ++n) g[n] = *(const float4*)(md + nt * 128 + wc * 64 + n * 16 + fq * 4);
  float* xr0 = xrow_ptr(p, row0) + (size_t)(wr * 64 + fr) * 1024 + nt * 128 + wc * 64 + fq * 4;
#pragma unroll
  for (int mh = 0; mh < 2; ++mh) {
    f32x4 x[2][4];
#pragma unroll
    for (int m2 = 0; m2 < 2; ++m2)
#pragma unroll
      for (int n = 0; n < 4; ++n) x[m2][n] = gload_f4(xr0 + (size_t)((mh * 2 + m2) * 16) * 1024 + n * 16);
    asm volatile("s_waitcnt vmcnt(0)" : "+v"(x[0][0]), "+v"(x[0][1]), "+v"(x[0][2]), "+v"(x[0][3]), "+v"(x[1][0]), "+v"(x[1][1]), "+v"(x[1][2]), "+v"(x[1][3]) :: "memory");
#pragma unroll
    for (int m2 = 0; m2 < 2; ++m2)
#pragma unroll
      for (int n = 0; n < 4; ++n) {
        const int m = mh * 2 + m2;
        f32x4 v = x[m2][n];
        v[0] += g[n].x * acc[m][n][0]; v[1] += g[n].y * acc[m][n][1]; v[2] += g[n].z * acc[m][n][2]; v[3] += g[n].w * acc[m][n][3];
        *(f32x4*)(xr0 + (size_t)(m * 16) * 1024 + n * 16) = v;
      }
  }
}
DI void ph_resid_gemm(const Params& p, const u16* A, int lda, const u16* Bt, int K, int l, int gi, char* smem) {
  const bool skip_ctx = (l == 3);
  for (int it = 0;; ++it) {
    int mt, nt; if (!next_tile(it, skip_ctx ? 128 : 130, 8, 1, mt, nt)) break;
    if (skip_ctx) mt = mt + 1 + (mt >> 6);
    ALPlain al{A + (size_t)mt * 256 * lda, lda};
    resid_tile(p, al, Bt, K, l, gi, mt, nt, smem);
  }
}

struct ALHalo {
  const u16* base; int t0m1, len;
  DI uint4 operator()(int i, int k) const {
    int t = t0m1 + i;
    if (t < 0 || t >= len) return make_uint4(0, 0, 0, 0);
    return *(const uint4*)(base + (size_t)t * 1024 + k);
  }
  DI uint4 post(uint4 v, int, int) const { return v; }
};
DI void ph_ffn1(const Params& p, int l, char* smem) {
  const u16* H = (const u16*)(p.ws + OFF_H);
  const u16* W1T = (const u16*)(p.ws + OFF_WT) + WT_W1T;
  u16* G = (u16*)(p.ws + OFF_SCR);
  const int tid = otid(), lane = tid & 63, wave = tid >> 6, wr = wave >> 1, wc = wave & 1, fr = lane & 15, fq = lane >> 4;
  for (int it = 0;; ++it) {
    int mt, nt; if (!next_tile(it, 134, 22, 2, mt, nt)) break;
    const int b = mt / 67, ml = mt - b * 67;
    int rowbase, t0, len;
    if (ml < 2) { rowbase = b * TS; t0 = ml * 254; len = TC; } else { rowbase = b * TS + TC; t0 = (ml - 2) * 254; len = T; }
    ALHalo al{H + (size_t)rowbase * 1024, t0 - 1, len};
    f32x4 acc[4][8];
    gemm_main2(al, W1T + (size_t)nt * 256 * 1024, 1024, 1024, acc, smem);
    u16* P16 = (u16*)smem;
#pragma unroll
    for (int m = 0; m < 4; ++m)
#pragma unroll
      for (int n = 0; n < 8; ++n) {
        uint2 w; w.x = pack2(acc[m][n][0], acc[m][n][1]); w.y = pack2(acc[m][n][2], acc[m][n][3]);
        *(uint2*)&P16[(wr * 64 + m * 16 + fr) * 264 + wc * 128 + n * 16 + fq * 4] = w;
      }
    __syncthreads();
    {
      const int c2 = (tid & 63) * 2, rg = tid >> 6;
      const float* cw = p.in[IFCONV] + (size_t)l * 3 * 5632;
      const int ca = nt * 128 + c2, cg2 = FF + ca;
      const float2 a0 = *(const float2*)(cw + ca), a1 = *(const float2*)(cw + 5632 + ca), a2 = *(const float2*)(cw + 2 * 5632 + ca);
      const float2 g0 = *(const float2*)(cw + cg2), g1 = *(const float2*)(cw + 5632 + cg2), g2 = *(const float2*)(cw + 2 * 5632 + cg2);
      const int i0 = 1 + rg * 32, i1 = min(i0 + 32, 255);
      unsigned pa = *(const unsigned*)&P16[(i0 - 1) * 264 + c2], ca_ = *(const unsigned*)&P16[i0 * 264 + c2];
      unsigned pg = *(const unsigned*)&P16[(i0 - 1) * 264 + 128 + c2], cgv = *(const unsigned*)&P16[i0 * 264 + 128 + c2];
      for (int i = i0; i < i1; ++i) {
        const unsigned na = *(const unsigned*)&P16[(i + 1) * 264 + c2], ng = *(const unsigned*)&P16[(i + 1) * 264 + 128 + c2];
        const float ua0 = a0.x * blo(pa) + a1.x * blo(ca_) + a2.x * blo(na), ua1 = a0.y * bhi(pa) + a1.y * bhi(ca_) + a2.y * bhi(na);
        const float ug0 = g0.x * blo(pg) + g1.x * blo(cgv) + g2.x * blo(ng), ug1 = g0.y * bhi(pg) + g1.y * bhi(cgv) + g2.y * bhi(ng);
        const int tt = t0 - 1 + i;
        if (tt < len) *(unsigned*)&G[(size_t)(rowbase + tt) * FF + ca] = pack2(ua0 * siluf(ug0), ua1 * siluf(ug1));
        pa = ca_; ca_ = na; pg = cgv; cgv = ng;
      }
    }
  }
}

struct ALMix {
  const u16* H; int row0; const float* mu;
  DI uint4 operator()(int i, int k) const {
    const int row = row0 + i, q = row % TS;
    const bool hp = (q != 0) && (q != TC), hn = (q != TC - 1) && (q != TS - 1);
    const u16* pc = H + (size_t)row * 1024 + k;
    uint4 c = *(const uint4*)pc;
    uint4 a = hp ? *(const uint4*)(pc - 1024) : make_uint4(0, 0, 0, 0);
    uint4 b = hn ? *(const uint4*)(pc + 1024) : make_uint4(0, 0, 0, 0);
    float4 m0 = *(const float4*)(mu + k), m1 = *(const float4*)(mu + k + 4);
    uint4 o;
#define MIX1(cc, aa, bb, mlo, mhi) pack2(blo(cc) + (0.5f * (blo(aa) + blo(bb)) - blo(cc)) * (mlo), bhi(cc) + (0.5f * (bhi(aa) + bhi(bb)) - bhi(cc)) * (mhi))
    o.x = MIX1(c.x, a.x, b.x, m0.x, m0.y); o.y = MIX1(c.y, a.y, b.y, m0.z, m0.w);
    o.z = MIX1(c.z, a.z, b.z, m1.x, m1.y); o.w = MIX1(c.w, a.w, b.w, m1.z, m1.w);
    return o;
  }
  DI uint4 post(uint4 v, int, int) const { return v; }
};
constexpr int P1LD = 3456;
DI void ph_rw_r1(const Params& p, int jj, char* smem) {
  const u16* H = (const u16*)(p.ws + OFF_H);
  const u16* BT = (const u16*)(p.ws + OFF_WT) + WT_R1T;
  u16* P1 = (u16*)(p.ws + OFF_SCR);
  const int lane = otid() & 63, wave = otid() >> 6, wr = wave >> 1, wc = wave & 1, fr = lane & 15, fq = lane >> 4;
  for (int it = 0;; ++it) {
    int mt, nt; if (!next_tile(it, 130, 27, 1, mt, nt)) break;
    const int mi = nt < 8 ? 0 : nt < 16 ? 2 : nt < 24 ? 3 : nt == 24 ? 1 : nt == 25 ? 4 : 5;
    ALMix al{H, mt * 256, p.in[IRMU] + (size_t)(jj * 6 + mi) * 1024};
    f32x4 acc[4][4];
    gemm_main3(al, BT + (size_t)nt * 128 * 1024, 1024, 1024, acc, smem);
#pragma unroll
    for (int m = 0; m < 4; ++m) {
      const int row = mt * 256 + wr * 64 + m * 16 + fr;
#pragma unroll
      for (int n = 0; n < 4; ++n) {
        const int c = nt * 128 + wc * 64 + n * 16 + fq * 4;
        float v0 = acc[m][n][0], v1 = acc[m][n][1], v2 = acc[m][n][2], v3 = acc[m][n][3];
        if (nt == 24) { v0 = tanhf(v0); v1 = tanhf(v1); v2 = tanhf(v2); v3 = tanhf(v3); }
        else if (nt == 26) { v0 = sigmf(v0); v1 = sigmf(v1); v2 = sigmf(v2); v3 = sigmf(v3); }
        uint2 w; w.x = pack2(v0, v1); w.y = pack2(v2, v3);
        *(uint2*)(P1 + (size_t)row * P1LD + c) = w;
      }
    }
  }
}
DI int scan_row(int b, int d, int pos) { return d == 0 ? b * TS + pos : (pos < TC ? b * TS + TC - 1 - pos : b * TS + (TS + TC - 1) - pos); }

struct ALLora {
  const u16* P1; int rowbase, rowstep, d;
  DI uint4 operator()(int i, int k) const {
    const int row = rowbase + i * rowstep;
    const int col = k < 64 ? 3072 + d * 64 + k : 3200 + d * 64 + (k - 64);
    return *(const uint4*)(P1 + (size_t)row * P1LD + col);
  }
  DI uint4 post(uint4 v, int, int) const { return v; }
};
DI uint2 pack4h(float a, float b, float c, float d) {
  __half2 x = __floats2half2_rn(a, b), y = __floats2half2_rn(c, d);
  uint2 r; r.x = *(unsigned*)&x; r.y = *(unsigned*)&y; return r;
}
DI void ph_rw_produce(const Params& p, int jj, int s, char* smem) {
  const u16* P1 = (const u16*)(p.ws + OFF_SCR);
  const u16* LUT = (const u16*)(p.ws + OFF_WT) + WT_LUT;
  __half* ring = (__half*)(p.ws + OFF_RING) + (size_t)(s & 1) * ((size_t)2 * 2 * 1024 * 16 * 256);
  float* bonus = (float*)(p.ws + OFF_BONUS);
  float* red = (float*)(smem + sizeof(SmemG));
  const int lane = otid() & 63, wave = otid() >> 6, wr = wave >> 1, wc = wave & 1, fr = lane & 15, fq = lane >> 4;
  const int npt = min(4, 65 - s * 4);
  for (int t = blockIdx.x; t < 2 * 2 * npt * 16; t += gridDim.x) {
    const int h = t & 15, ptl = (t >> 4) % npt, bd = (t >> 4) / npt, d = bd & 1, b = bd >> 1;
    const int pos0 = (s * 4 + ptl) * 256;
    const int rowbase = scan_row(b, d, pos0), rowstep = d ? -1 : 1;
    ALLora al{P1, rowbase, rowstep, d};
    f32x4 acc[4][4];
    gemm_main3(al, LUT + (size_t)(d * 16 + h) * 128 * 128, 128, 128, acc, smem);
    float4 kkw[2], kaw[2], rkw[2], w0v[2], a0v[2];
#pragma unroll
    for (int nn = 0; nn < 2; ++nn) {
      const int ch = h * 64 + wc * 32 + nn * 16 + fq * 4;
      kkw[nn] = *(const float4*)(p.in[IRKK] + jj * 1024 + ch); kaw[nn] = *(const float4*)(p.in[IRKA] + jj * 1024 + ch);
      rkw[nn] = *(const float4*)(p.in[IRRK] + jj * 1024 + ch);
      w0v[nn] = *(const float4*)(p.in[IRW0] + (jj * 2 + d) * 1024 + ch); a0v[nn] = *(const float4*)(p.in[IRA0] + (jj * 2 + d) * 1024 + ch);
    }
    float ssk[4];
    uint2 kreg[4][2], rreg[4][2];
#pragma unroll
    for (int m = 0; m < 4; ++m) {
      const int row = rowbase + (wr * 64 + m * 16 + fr) * rowstep;
#pragma unroll
      for (int nn = 0; nn < 2; ++nn) {
        const int ch = h * 64 + wc * 32 + nn * 16 + fq * 4;
        kreg[m][nn] = *(const uint2*)(P1 + (size_t)row * P1LD + 1024 + ch);
        rreg[m][nn] = *(const uint2*)(P1 + (size_t)row * P1LD + ch);
      }
    }
    __builtin_amdgcn_sched_barrier(0);
#pragma unroll
    for (int m = 0; m < 4; ++m) {
      float s1 = 0.f;
#pragma unroll
      for (int nn = 0; nn < 2; ++nn) {
        const uint2 k2 = kreg[m][nn];
        float q0 = blo(k2.x) * kkw[nn].x, q1 = bhi(k2.x) * kkw[nn].y, q2 = blo(k2.y) * kkw[nn].z, q3 = bhi(k2.y) * kkw[nn].w;
        s1 += q0 * q0 + q1 * q1 + q2 * q2 + q3 * q3;
      }
      s1 += __shfl_xor(s1, 16); s1 += __shfl_xor(s1, 32);
      ssk[m] = s1;
    }
    if (fq == 0) {
#pragma unroll
      for (int m = 0; m < 4; ++m) red[(wr * 64 + m * 16 + fr) * 2 + wc] = ssk[m];
    }
    __syncthreads();
    float c3[4];
#pragma unroll
    for (int m = 0; m < 4; ++m) {
      const int pi = wr * 64 + m * 16 + fr;
      const float rs = rsqrtf(red[pi * 2] + red[pi * 2 + 1] + 1e-12f);
      const int posl = ptl * 256 + pi;
      __half* rp = ring + ((((size_t)(b * 2 + d) * 1024 + posl) * 16 + h) * 256);
      float cc = 0.f;
#pragma unroll
      for (int nn = 0; nn < 2; ++nn) {
        const int chl = wc * 32 + nn * 16 + fq * 4;
        const float kq[4] = {kkw[nn].x, kkw[nn].y, kkw[nn].z, kkw[nn].w}, ka[4] = {kaw[nn].x, kaw[nn].y, kaw[nn].z, kaw[nn].w};
        const float rk[4] = {rkw[nn].x, rkw[nn].y, rkw[nn].z, rkw[nn].w}, w0[4] = {w0v[nn].x, w0v[nn].y, w0v[nn].z, w0v[nn].w};
        const float a0[4] = {a0v[nn].x, a0v[nn].y, a0v[nn].z, a0v[nn].w};
        float okk[4], owm[4], oka[4], okd[4];
        const int rowm = rowbase + pi * rowstep;
        const uint2 r2 = rreg[m][nn], k2 = kreg[m][nn];
        const float rvv[4] = {blo(r2.x), bhi(r2.x), blo(r2.y), bhi(r2.y)}, kvv[4] = {blo(k2.x), bhi(k2.x), blo(k2.y), bhi(k2.y)};
#pragma unroll
        for (int j = 0; j < 4; ++j) {
          const float k = kvv[j];
          const float kk = k * kq[j] * rs;
          const float a = sigmf(a0[j] + acc[m][nn + 2][j]);
          const float wlog = -__logf(1.f + __expf(-(w0[j] + acc[m][nn][j]))) - 0.5f;
          const float ew = -__expf(wlog);
          const float wm1 = ew * (1.f + ew * (0.5f + ew * (0.16666667f + ew * (0.041666668f + ew * (0.0083333338f + ew * (0.0013888889f + ew * 0.0001984127f))))));
          const float kd = k * (1.f + (a - 1.f) * ka[j]);
          okk[j] = kk; owm[j] = wm1; oka[j] = kk * a; okd[j] = kd;
          cc += rvv[j] * kd * rk[j];
        }
        *(uint2*)(rp + chl) = pack4h(okk[0], okk[1], okk[2], okk[3]);
        *(uint2*)(rp + 64 + chl) = pack4h(owm[0], owm[1], owm[2], owm[3]);
        *(uint2*)(rp + 128 + chl) = pack4h(oka[0], oka[1], oka[2], oka[3]);
        *(uint2*)(rp + 192 + chl) = pack4h(okd[0], okd[1], okd[2], okd[3]);
      }
      cc += __shfl_xor(cc, 16); cc += __shfl_xor(cc, 32);
      c3[m] = cc;
    }
    __syncthreads();
    if (fq == 0) {
#pragma unroll
      for (int m = 0; m < 4; ++m) red[(wr * 64 + m * 16 + fr) * 2 + wc] = c3[m];
    }
    __syncthreads();
    if (wc == 0 && fq == 0) {
#pragma unroll
      for (int m = 0; m < 4; ++m) {
        const int pi = wr * 64 + m * 16 + fr;
        bonus[(size_t)(rowbase + pi * rowstep) * 32 + h * 2 + d] = red[pi * 2] + red[pi * 2 + 1];
      }
    }
  }
}
DI float ror_add16(float x) {
  x += __int_as_float(__builtin_amdgcn_update_dpp(0, __float_as_int(x), 0x128, 0xf, 0xf, false));
  x += __int_as_float(__builtin_amdgcn_update_dpp(0, __float_as_int(x), 0x124, 0xf, 0xf, false));
  x += __int_as_float(__builtin_amdgcn_update_dpp(0, __float_as_int(x), 0x122, 0xf, 0xf, false));
  x += __int_as_float(__builtin_amdgcn_update_dpp(0, __float_as_int(x), 0x121, 0xf, 0xf, false));
  return x;
}
constexpr int SCH = 32, STEPF = 336;
DI void ph_rw_scan(const Params& p, int s, char* smem, bool save = true) {
  if (blockIdx.x >= 256) return;
  const u16* P1 = (const u16*)(p.ws + OFF_SCR);
  const __half* ring = (const __half*)(p.ws + OFF_RING) + (size_t)(s & 1) * ((size_t)2 * 2 * 1024 * 16 * 256);
  u16* Y = (u16*)(p.ws + OFF_SCR) + (size_t)R * P1LD;
  float* st = (float*)(p.ws + OFF_RWST);
  float* buf = (float*)smem;
  float* ybuf = buf + 2 * SCH * STEPF;
  const int tid = otid(), lane = tid & 63, wave = tid >> 6;
  const int xcd_ = blockIdx.x & 7, slot_ = blockIdx.x >> 3;
  const int bh_ = xcd_ * 4 + (slot_ >> 3), rq = slot_ & 3;
  const int b = bh_ >> 4, h = bh_ & 15, d = (slot_ >> 2) & 1;
  const int npos = min(1024, TS - s * 1024), nch = npos / SCH;
  const int rl = (wave & 3) * 4 + (lane >> 4), q = lane & 15;
  f32x2 sa = (f32x2){0.f, 0.f}, sb = (f32x2){0.f, 0.f};
  if (wave < 4 && s > 0) { float4 v = *(const float4*)(st + ((size_t)blockIdx.x * 256 + tid) * 4); sa = (f32x2){v.x, v.y}; sb = (f32x2){v.z, v.w}; }
  u16* Yd = Y + (size_t)d * R * 1024;
  uint4 lr[4], lrr = make_uint4(0, 0, 0, 0), lrv = make_uint4(0, 0, 0, 0);
  auto gload = [&](int c) {
    const int lt = tid - 256;
#pragma unroll
    for (int i = 0; i < 4; ++i) {
      const int cidx = lt + i * 256, stp = cidx >> 5, off = (cidx & 31) * 8;
      const int posl = c * SCH + stp;
      lr[i] = *(const uint4*)(ring + ((((size_t)(b * 2 + d) * 1024 + posl) * 16 + h) * 256) + off);
    }
    {
      const int stp = lt >> 3, off = (lt & 7) * 8;
      const int row = scan_row(b, d, s * 1024 + c * SCH + stp);
      lrr = *(const uint4*)(P1 + (size_t)row * P1LD + h * 64 + off);
    }
    {
      const int l2 = lt & 63, stp = l2 >> 1, off = (l2 & 1) * 8;
      const int row = scan_row(b, d, s * 1024 + c * SCH + stp);
      lrv = *(const uint4*)(P1 + (size_t)row * P1LD + 2048 + h * 64 + rq * 16 + off);
    }
  };
  auto swrite = [&](int c) {
    const int lt = tid - 256;
    float* bb = buf + (c & 1) * SCH * STEPF;
#pragma unroll
    for (int i = 0; i < 4; ++i) {
      const int cidx = lt + i * 256, stp = cidx >> 5, off = (cidx & 31) * 8;
      const __half2* hp = (const __half2*)&lr[i];
      float2 f0 = __half22float2(hp[0]), f1 = __half22float2(hp[1]), f2 = __half22float2(hp[2]), f3 = __half22float2(hp[3]);
      float* dst = bb + stp * STEPF + off;
      *(float4*)dst = make_float4(f0.x, f0.y, f1.x, f1.y);
      *(float4*)(dst + 4) = make_float4(f2.x, f2.y, f3.x, f3.y);
    }
    {
      const int stp = lt >> 3, off = (lt & 7) * 8;
      float* dst = bb + stp * STEPF + 256 + off;
      *(float4*)dst = make_float4(blo(lrr.x), bhi(lrr.x), blo(lrr.y), bhi(lrr.y));
      *(float4*)(dst + 4) = make_float4(blo(lrr.z), bhi(lrr.z), blo(lrr.w), bhi(lrr.w));
    }
    if (lt < 64) {
      const int stp = lt >> 1, off = (lt & 1) * 8;
      float* dst = bb + stp * STEPF + 320 + off;
      *(float4*)dst = make_float4(blo(lrv.x), bhi(lrv.x), blo(lrv.y), bhi(lrv.y));
      *(float4*)(dst + 4) = make_float4(blo(lrv.z), bhi(lrv.z), blo(lrv.w), bhi(lrv.w));
    }
  };
  if (wave >= 4) { gload(0); swrite(0); if (nch > 1) gload(1); }
  lds_barrier();
  for (int c = 0; c < nch; ++c) {
    if (wave < 4) {
      const float* bb = buf + (c & 1) * SCH * STEPF;
      const int pos0 = s * 1024 + c * SCH;
      const int row0 = scan_row(b, d, pos0), rstep = d ? -1 : 1;
      u16* yp = Yd + (size_t)row0 * 1024 + h * 64 + rq * 16 + rl;
      float4 kk = *(const float4*)(bb + q * 4), wm = *(const float4*)(bb + 64 + q * 4), ka = *(const float4*)(bb + 128 + q * 4);
      float4 kd = *(const float4*)(bb + 192 + q * 4), rr = *(const float4*)(bb + 256 + q * 4);
      float vv = bb[320 + rl];
      float yv[16];
#pragma unroll
      for (int stp = 0; stp < SCH; ++stp) {
        const float* sn = bb + (stp + 1 < SCH ? stp + 1 : stp) * STEPF;
        const float4 kkn = *(const float4*)(sn + q * 4), wmn = *(const float4*)(sn + 64 + q * 4), kan = *(const float4*)(sn + 128 + q * 4);
        const float4 kdn = *(const float4*)(sn + 192 + q * 4), rrn = *(const float4*)(sn + 256 + q * 4);
        const float vvn = sn[320 + rl];
        __builtin_amdgcn_sched_barrier(0);
        const f32x2 vv2 = (f32x2){vv, vv};
        f32x2 ta = sa * (f32x2){wm.x, wm.y} + sa, tb = sb * (f32x2){wm.z, wm.w} + sb;
        ta = vv2 * (f32x2){kd.x, kd.y} + ta; tb = vv2 * (f32x2){kd.z, kd.w} + tb;
        f32x2 ud = sa * (f32x2){kk.x, kk.y}; ud = sb * (f32x2){kk.z, kk.w} + ud;
        float u = ror_add16(ud.x + ud.y);
        const f32x2 nu = (f32x2){-u, -u};
        sa = nu * (f32x2){ka.x, ka.y} + ta; sb = nu * (f32x2){ka.z, ka.w} + tb;
        f32x2 yd2 = sa * (f32x2){rr.x, rr.y}; yd2 = sb * (f32x2){rr.z, rr.w} + yd2;
        yv[stp & 15] = yd2.x + yd2.y;
        if ((stp & 15) == 15) {
          const bool b3 = q & 8, b2 = q & 4, b1 = q & 2, b0 = q & 1;
          float z8[8], z4[4], z2[2];
#pragma unroll
          for (int i = 0; i < 8; ++i) { const float kp = b3 ? yv[i + 8] : yv[i], sd = b3 ? yv[i] : yv[i + 8]; z8[i] = kp + __int_as_float(__builtin_amdgcn_update_dpp(0, __float_as_int(sd), 0x140, 0xf, 0xf, false)); }
#pragma unroll
          for (int i = 0; i < 4; ++i) { const float kp = b2 ? z8[i + 4] : z8[i], sd = b2 ? z8[i] : z8[i + 4]; z4[i] = kp + __int_as_float(__builtin_amdgcn_update_dpp(0, __float_as_int(sd), 0x141, 0xf, 0xf, false)); }
#pragma unroll
          for (int i = 0; i < 2; ++i) { const float kp = b1 ? z4[i + 2] : z4[i], sd = b1 ? z4[i] : z4[i + 2]; z2[i] = kp + __int_as_float(__builtin_amdgcn_update_dpp(0, __float_as_int(sd), 0x1B, 0xf, 0xf, false)); }
          const float kp = b0 ? z2[1] : z2[0], sd = b0 ? z2[0] : z2[1];
          const float yq = kp + __int_as_float(__builtin_amdgcn_update_dpp(0, __float_as_int(sd), 0xB1, 0xf, 0xf, false));
          yp[(ptrdiff_t)((stp & ~15) + q) * rstep * 1024] = f2b(yq);
        }
        kk = kkn; wm = wmn; ka = kan; kd = kdn; rr = rrn; vv = vvn;
      }
    } else {
      if (c + 1 < nch) swrite(c + 1);
      if (c + 2 < nch) gload(c + 2);
    }
    lds_barrier();
  }
  if (wave < 4 && save) *(float4*)(st + ((size_t)blockIdx.x * 256 + tid) * 4) = make_float4(sa.x, sa.y, sb.x, sb.y);
  __syncthreads();
}
DI void ph_rw_finish(const Params& p, int jj, char* smem) {
  const u16* P1 = (const u16*)(p.ws + OFF_SCR);
  const u16* G2T = (const u16*)(p.ws + OFF_WT) + WT_G2T;
  u16* Y0 = (u16*)(p.ws + OFF_SCR) + (size_t)R * P1LD;
  const u16* Y1 = Y0 + (size_t)R * 1024;
  const float* bonus = (const float*)(p.ws + OFF_BONUS);
  const int lane = otid() & 63, wave = otid() >> 6, wr = wave >> 1, wc = wave & 1, fr = lane & 15, fq = lane >> 4;
  for (int it = 0;; ++it) {
    int mt, nt; if (!next_tile(it, 130, 8, 1, mt, nt)) break;
    ALPlain al{P1 + (size_t)mt * 256 * P1LD + 3328, P1LD};
    f32x4 acc[4][4];
    gemm_main3(al, G2T + (size_t)nt * 128 * 128, 128, 128, acc, smem);
    const int h = nt * 2 + wc;
#pragma unroll
    for (int m = 0; m < 4; ++m) {
      const int row = mt * 256 + wr * 64 + m * 16 + fr;
      float y[4][4]; float sm = 0.f;
#pragma unroll
      for (int n = 0; n < 4; ++n) {
        const int c = h * 64 + n * 16 + fq * 4;
        uint2 a = *(const uint2*)(Y0 + (size_t)row * 1024 + c), b2 = *(const uint2*)(Y1 + (size_t)row * 1024 + c);
        y[n][0] = blo(a.x) + blo(b2.x); y[n][1] = bhi(a.x) + bhi(b2.x); y[n][2] = blo(a.y) + blo(b2.y); y[n][3] = bhi(a.y) + bhi(b2.y);
        sm += y[n][0] + y[n][1] + y[n][2] + y[n][3];
      }
      sm += __shfl_xor(sm, 16); sm += __shfl_xor(sm, 32);
      const float mean = sm * (1.f / 64.f);
      float vs = 0.f;
#pragma unroll
      for (int n = 0; n < 4; ++n)
#pragma unroll
        for (int j = 0; j < 4; ++j) { float dlt = y[n][j] - mean; vs += dlt * dlt; }
      vs += __shfl_xor(vs, 16); vs += __shfl_xor(vs, 32);
      const float rs = rsqrtf(vs * (1.f / 64.f) + 64e-5f);
      const float bn = bonus[(size_t)row * 32 + h * 2] + bonus[(size_t)row * 32 + h * 2 + 1];
#pragma unroll
      for (int n = 0; n < 4; ++n) {
        const int c = h * 64 + n * 16 + fq * 4;
        float4 lg = *(const float4*)(p.in[IRLNG] + jj * 1024 + c), lb = *(const float4*)(p.in[IRLNB] + jj * 1024 + c);
        uint2 v2 = *(const uint2*)(P1 + (size_t)row * P1LD + 2048 + c);
        float o0 = ((y[n][0] - mean) * rs * lg.x + lb.x + bn * blo(v2.x)) * acc[m][n][0];
        float o1 = ((y[n][1] - mean) * rs * lg.y + lb.y + bn * bhi(v2.x)) * acc[m][n][1];
        float o2 = ((y[n][2] - mean) * rs * lg.z + lb.z + bn * blo(v2.y)) * acc[m][n][2];
        float o3 = ((y[n][3] - mean) * rs * lg.w + lb.w + bn * bhi(v2.y)) * acc[m][n][3];
        uint2 w; w.x = pack2(o0, o1); w.y = pack2(o2, o3);
        *(uint2*)(Y0 + (size_t)row * 1024 + c) = w;
      }
    }
  }
}

DI void ph_ssd_s1(const Params& p, int jj, char* smem) {
  const u16* H = (const u16*)(p.ws + OFF_H);
  const u16* BT = (const u16*)(p.ws + OFF_WT) + WT_SX;
  u16* XBC = (u16*)(p.ws + OFF_SCR);
  float* DTg = (float*)(p.ws + OFF_DT);
  float* P = (float*)smem;
  const float* cw = p.in[ISCONVW] + (size_t)jj * 3 * 4096;
  const float* cb = p.in[ISCONVB] + (size_t)jj * 4096;
  const int tid = otid(), lane = tid & 63, wave = tid >> 6, wr = wave >> 1, wc = wave & 1, fr = lane & 15, fq = lane >> 4;
  for (int it = 0;; ++it) {
    int mt, nt; if (!next_tile(it, 134, 33, 1, mt, nt)) break;
    const int b = mt / 67, ml = mt - b * 67;
    int rowbase, t0, len;
    if (ml < 2) { rowbase = b * TS; t0 = ml * 254; len = TC; } else { rowbase = b * TS + TC; t0 = (ml - 2) * 254; len = T; }
    ALHalo al{H + (size_t)rowbase * 1024, t0 - 1, len};
    f32x4 acc[4][4];
    gemm_main3(al, BT + (size_t)nt * 128 * 1024, 1024, 1024, acc, smem);
#pragma unroll
    for (int m = 0; m < 4; ++m)
#pragma unroll
      for (int n = 0; n < 4; ++n) *(f32x4*)&P[(wr * 64 + m * 16 + fr) * 132 + wc * 64 + n * 16 + fq * 4] = acc[m][n];
    __syncthreads();
    if (nt < 32) {
      const int col = tid & 127, rg = tid >> 7, ch = nt * 128 + col;
      const float w0 = cw[ch], w1 = cw[4096 + ch], w2 = cw[8192 + ch], bias = cb[ch];
      const int i0 = 1 + rg * 64, i1 = min(i0 + 64, 255);
      float pv = P[(i0 - 1) * 132 + col], cv = P[i0 * 132 + col];
      for (int i = i0; i < i1; ++i) {
        const float nv = P[(i + 1) * 132 + col];
        const float v = w0 * pv + w1 * cv + w2 * nv + bias;
        const int tt = t0 - 1 + i;
        if (tt < len) XBC[(size_t)(rowbase + tt) * 4096 + ch] = f2b(siluf(v));
        pv = cv; cv = nv;
      }
    } else {
      const int col = tid & 63, rg = tid >> 6;
      const int i0 = 1 + rg * 32, i1 = min(i0 + 32, 255);
      for (int i = i0; i < i1; ++i) { const int tt = t0 - 1 + i; if (tt < len) DTg[(size_t)(rowbase + tt) * 64 + col] = P[i * 132 + col]; }
    }
  }
}
DI void ph_ssd_scan(const Params& p, int jj, char* smem) {
  if (blockIdx.x >= 256) return;
  const u16* XBC = (const u16*)(p.ws + OFF_SCR);
  u16* Y = (u16*)(p.ws + OFF_SCR) + (size_t)R * 4096;
  const float* DTg = (const float*)(p.ws + OFF_DT);
  const int tid = otid(), lane = tid & 63, wave = tid >> 6, fr = lane & 15, fq = lane >> 4;
  const int xcd_ = blockIdx.x & 7, slot_ = blockIdx.x >> 3, gid_ = xcd_ * 2 + (slot_ >> 4), mem_ = slot_ & 15;
  const int b = gid_ >> 3, g = gid_ & 7, head = g * 4 + (mem_ >> 2), pq = mem_ & 3;
  constexpr int DIRB = 80896;
  const int xp_ = tid & 15, xj0 = (tid >> 4) & 15;
  float Aneg[2], dtb[2];
#pragma unroll
  for (int d = 0; d < 2; ++d) { Aneg[d] = -__expf(p.in[ISALOG][(jj * 2 + d) * 32 + head]); dtb[d] = p.in[ISDTB][(jj * 2 + d) * 32 + head]; }
  const float Dsk = p.in[ISD][jj * 32 + head];
  f32x4 hst[2] = {(f32x4){0.f, 0.f, 0.f, 0.f}, (f32x4){0.f, 0.f, 0.f, 0.f}};
  uint4 pre[2][5];
  float dtpre[2] = {0.f, 0.f};
  auto gl_raw = [&](int ci, int d, uint4 (&pr)[5], float& dtp) {
    const int r0 = scan_row(b, d, ci * 64), r63 = scan_row(b, d, ci * 64 + 63);
    const int rmin = min(r0, r63);
    const int cc = tid & 31, rrb = tid >> 5;
    const int gcb = cc < 16 ? 2048 + g * 128 + cc * 8 : 3072 + g * 128 + (cc - 16) * 8;
    const u16* src = XBC + (size_t)(rmin + rrb) * 4096 + gcb;
#pragma unroll
    for (int i = 0; i < 4; ++i) pr[i] = *(const uint4*)(src + (size_t)i * 16 * 4096);
    pr[4] = *(const uint4*)(XBC + (size_t)(rmin + ((tid & 127) >> 1)) * 4096 + head * 64 + pq * 16 + (tid & 1) * 8);
    dtp = DTg[(size_t)(r0 + lane * (d ? -1 : 1)) * 64 + d * 32 + head];
  };
  __syncthreads();
  gl_raw(0, 0, pre[0], dtpre[0]);
  gl_raw(0, 1, pre[1], dtpre[1]);
  for (int ci = 0; ci < 260; ++ci) {
    const bool second = ci < 4 ? (ci >= 2) : (ci - 4 >= 128);
    unsigned ypre[2][2];
#pragma unroll
    for (int d = 0; d < 2; ++d) {
      u16* Cs = (u16*)(smem + d * DIRB); u16* Bs = Cs + 64 * 144; u16* BsT = Bs + 64 * 144; u16* Ms = BsT + 128 * 80;
      u16* XdtT = Ms + 64 * 72; u16* XwT = XdtT + 16 * 80; u16* Hs = XwT + 16 * 80;
      float* Xp = (float*)(Hs + 16 * 144); float* dts = Xp + 64 * 16; float* css = dts + 64;
      const int r0 = scan_row(b, d, ci * 64), rstep = d ? -1 : 1;
      {
        int t2 = tid; asm volatile("" : "+v"(t2));
        const int cc = t2 & 31;
#pragma unroll
        for (int i = 0; i < 4; ++i) {
          const int rr = (t2 >> 5) + 16 * i, j = d ? 63 - rr : rr;
          if (cc < 16) {
            *(uint4*)&Bs[j * 144 + cc * 8] = pre[d][i];
            const u16* hv = (const u16*)&pre[d][i];
#pragma unroll
            for (int e = 0; e < 8; ++e) BsT[(cc * 8 + e) * 80 + (j ^ ((cc & 7) << 3))] = hv[e];
          } else *(uint4*)&Cs[j * 144 + (cc - 16) * 8] = pre[d][i];
        }
        if (t2 < 128) {
          const int rr = t2 >> 1, j = d ? 63 - rr : rr;
          const u16* hv = (const u16*)&pre[d][4];
#pragma unroll
          for (int e = 0; e < 8; ++e) Xp[j * 16 + (tid & 1) * 8 + e] = b2f(hv[e]);
        }
      }
      if (wave == d) {
        const float dt = softplusf(dtpre[d] + dtb[d]);
        float a = dt * Aneg[d];
#pragma unroll
        for (int o = 1; o < 64; o <<= 1) { float tv = __shfl_up(a, o); if (lane >= o) a += tv; }
        dts[lane] = dt; css[lane] = a;
      }
#pragma unroll
      for (int e = 0; e < 4; ++e) Hs[(fq * 4 + e) * 144 + wave * 16 + fr] = f2b(hst[d][e]);
#pragma unroll
      for (int e = 0; e < 2; ++e) {
        const u16* yb = Y + (size_t)(r0 + ((wave & 3) * 16 + fq * 4 + 2 * e) * rstep) * 2048 + head * 64 + pq * 16 + fr;
        ypre[d][e] = (unsigned)yb[0] | ((unsigned)yb[(ptrdiff_t)rstep * 2048] << 16);
      }
      __builtin_amdgcn_sched_barrier(0);
    }
    __builtin_amdgcn_sched_barrier(0);
    if (ci + 1 < 260) { gl_raw(ci + 1, 0, pre[0], dtpre[0]); gl_raw(ci + 1, 1, pre[1], dtpre[1]); }
    lds_barrier();
#pragma unroll
    for (int d = 0; d < 2; ++d) {
      u16* Cs = (u16*)(smem + d * DIRB); u16* Bs = Cs + 64 * 144; u16* BsT = Bs + 64 * 144; u16* Ms = BsT + 128 * 80;
      u16* XdtT = Ms + 64 * 72; u16* XwT = XdtT + 16 * 80; u16* Hs = XwT + 16 * 80;
      float* Xp = (float*)(Hs + 16 * 144); float* dts = Xp + 64 * 16; float* css = dts + 64;
      const float cs63 = css[63];
      if (tid < 256) {
#pragma unroll
        for (int i = 0; i < 4; ++i) {
          const int j = xj0 + 16 * i;
          const float xv = Xp[j * 16 + xp_];
          const float dt = dts[j];
          XdtT[xp_ * 80 + j] = f2b(xv * dt);
          XwT[xp_ * 80 + j] = f2b(xv * dt * __expf(cs63 - css[j]));
        }
      }
      const int ib = wave >> 1;
#pragma unroll
      for (int jb2 = 0; jb2 < 2; ++jb2) {
        const int jb = (wave & 1) * 2 + jb2;
        f32x4 acc = (f32x4){0.f, 0.f, 0.f, 0.f};
#pragma unroll
        for (int ks = 0; ks < 4; ++ks) {
          const bf16x8 bfr = *(const bf16x8*)&Bs[(jb * 16 + fr) * 144 + ks * 32 + fq * 8];
          const bf16x8 cfr = *(const bf16x8*)&Cs[(ib * 16 + fr) * 144 + ks * 32 + fq * 8];
          acc = MFMA(bfr, cfr, acc);
        }
        const int i = ib * 16 + fr;
        const float csi = css[i];
        float mv[4];
#pragma unroll
        for (int e = 0; e < 4; ++e) { const int j = jb * 16 + fq * 4 + e; mv[e] = (j <= i) ? acc[e] * __expf(csi - css[j]) : 0.f; }
        uint2 w; w.x = pack2(mv[0], mv[1]); w.y = pack2(mv[2], mv[3]);
        *(uint2*)&Ms[i * 72 + jb * 16 + fq * 4] = w;
      }
      __builtin_amdgcn_sched_barrier(0);
    }
    lds_barrier();
#pragma unroll
    for (int d = 0; d < 2; ++d) {
      u16* Cs = (u16*)(smem + d * DIRB); u16* Bs = Cs + 64 * 144; u16* BsT = Bs + 64 * 144; u16* Ms = BsT + 128 * 80;
      u16* XdtT = Ms + 64 * 72; u16* XwT = XdtT + 16 * 80; u16* Hs = XwT + 16 * 80;
      float* Xp = (float*)(Hs + 16 * 144); float* dts = Xp + 64 * 16; float* css = dts + 64;
      const int r0 = scan_row(b, d, ci * 64), rstep = d ? -1 : 1;
      const float cs63 = css[63];
      if (wave < 4) {
        const int ib = wave;
        f32x4 yd = (f32x4){0.f, 0.f, 0.f, 0.f}, yo = (f32x4){0.f, 0.f, 0.f, 0.f};
#pragma unroll
        for (int ks = 0; ks < 2; ++ks) {
          const bf16x8 mf = *(const bf16x8*)&Ms[(ib * 16 + fr) * 72 + ks * 32 + fq * 8];
          const bf16x8 xf = *(const bf16x8*)&XdtT[fr * 80 + ks * 32 + fq * 8];
          yd = MFMA(mf, xf, yd);
        }
#pragma unroll
        for (int ks = 0; ks < 4; ++ks) {
          const bf16x8 cf = *(const bf16x8*)&Cs[(ib * 16 + fr) * 144 + ks * 32 + fq * 8];
          const bf16x8 hf = *(const bf16x8*)&Hs[fr * 144 + ks * 32 + fq * 8];
          yo = MFMA(cf, hf, yo);
        }
#pragma unroll
        for (int e = 0; e < 4; ++e) {
          const int i = ib * 16 + fq * 4 + e;
          float y = yd[e] + __expf(css[i]) * yo[e];
          u16* ya = Y + (size_t)(r0 + i * rstep) * 2048 + head * 64 + pq * 16 + fr;
          if (second) y += ((e & 1) ? bhi(ypre[d][e >> 1]) : blo(ypre[d][e >> 1])) + Xp[i * 16 + fr] * Dsk;
          *ya = f2b(y);
        }
      }
      {
        const float dec = __expf(cs63);
        hst[d][0] *= dec; hst[d][1] *= dec; hst[d][2] *= dec; hst[d][3] *= dec;
#pragma unroll
        for (int ks = 0; ks < 2; ++ks) {
          const bf16x8 xf = *(const bf16x8*)&XwT[fr * 80 + ks * 32 + fq * 8];
          const bf16x8 bf = *(const bf16x8*)&BsT[(wave * 16 + fr) * 80 + (((ks * 4 + fq) ^ ((wave * 2 + (fr >> 3)) & 7)) << 3)];
          hst[d] = MFMA(xf, bf, hst[d]);
        }
      }
      __builtin_amdgcn_sched_barrier(0);
    }
    if (ci == 1 || ci == 131) asm volatile("s_waitcnt vmcnt(0)" ::: "memory");
    lds_barrier();
  }
}
DI void ph_ssd_s3(const Params& p, char* smem) {
  const u16* H = (const u16*)(p.ws + OFF_H);
  const u16* BT = (const u16*)(p.ws + OFF_WT) + WT_SZ;
  u16* Y = (u16*)(p.ws + OFF_SCR) + (size_t)R * 4096;
  float* ssq = (float*)(p.ws + OFF_SSQ);
  const int lane = otid() & 63, wave = otid() >> 6, wr = wave >> 1, wc = wave & 1, fr = lane & 15, fq = lane >> 4;
  for (int it = 0;; ++it) {
    int mt, nt; if (!next_tile(it, 130, 16, 1, mt, nt)) break;
    ALPlain al{H + (size_t)mt * 256 * 1024, 1024};
    f32x4 acc[4][4];
    gemm_main3(al, BT + (size_t)nt * 128 * 1024, 1024, 1024, acc, smem);
#pragma unroll
    for (int m = 0; m < 4; ++m) {
      const int row = mt * 256 + wr * 64 + m * 16 + fr;
      float sq = 0.f;
#pragma unroll
      for (int n = 0; n < 4; ++n) {
        const int c = nt * 128 + wc * 64 + n * 16 + fq * 4;
        uint2 yv = *(const uint2*)(Y + (size_t)row * 2048 + c);
        const float o0 = blo(yv.x) * siluf(acc[m][n][0]), o1 = bhi(yv.x) * siluf(acc[m][n][1]);
        const float o2 = blo(yv.y) * siluf(acc[m][n][2]), o3 = bhi(yv.y) * siluf(acc[m][n][3]);
        sq += o0 * o0 + o1 * o1 + o2 * o2 + o3 * o3;
        uint2 w; w.x = pack2(o0, o1); w.y = pack2(o2, o3);
        *(uint2*)(Y + (size_t)row * 2048 + c) = w;
      }
      sq += __shfl_xor(sq, 16); sq += __shfl_xor(sq, 32);
      if (fq == 0) atomicAdd(ssq + (size_t)row * 8 + (nt >> 1), sq);
    }
  }
}
struct ALScale {
  const u16* Y; int row0; const float* rsT; const float* ngT;
  DI uint4 operator()(int i, int k) const { return *(const uint4*)(Y + (size_t)(row0 + i) * 2048 + k); }
  DI uint4 post(uint4 c, int i, int k) const {
    const float rs = rsT[i * 8 + (k >> 8)];
    const float4 g0 = *(const float4*)(ngT + k), g1 = *(const float4*)(ngT + k + 4);
    uint4 o;
    o.x = pack2(blo(c.x) * rs * g0.x, bhi(c.x) * rs * g0.y); o.y = pack2(blo(c.y) * rs * g0.z, bhi(c.y) * rs * g0.w);
    o.z = pack2(blo(c.z) * rs * g1.x, bhi(c.z) * rs * g1.y); o.w = pack2(blo(c.w) * rs * g1.z, bhi(c.w) * rs * g1.w);
    return o;
  }
};
DI void ph_ssd_s4(const Params& p, int l, int jj, char* smem) {
  const u16* Y = (const u16*)(p.ws + OFF_SCR) + (size_t)R * 4096;
  const u16* BT = (const u16*)(p.ws + OFF_WT) + WT_SO;
  for (int it = 0;; ++it) {
    int mt, nt; if (!next_tile(it, 130, 8, 1, mt, nt)) break;
    float* rsT = (float*)(smem + 112640); float* ngT = rsT + 2048;
    {
      const float* ssq = (const float*)(p.ws + OFF_SSQ) + (size_t)mt * 256 * 8;
      const float* ng = p.in[ISNG] + jj * 2048;
      for (int e = otid(); e < 2048; e += 512) { rsT[e] = rsqrtf(ssq[e] * (1.f / 256.f) + 1e-6f); ngT[e] = ng[e]; }
    }
    ALScale al{Y, mt * 256, rsT, ngT};
    resid_tile(p, al, BT, 2048, l, 2, mt, nt, smem);
  }
}

DI void ph_at_qkv(const Params& p, char* smem) {
  const u16* H = (const u16*)(p.ws + OFF_H);
  const u16* BT = (const u16*)(p.ws + OFF_WT) + WT_AQ;
  u16* QKV = (u16*)(p.ws + OFF_SCR);
  const int lane = otid() & 63, wave = otid() >> 6, wr = wave >> 1, wc = wave & 1, fr = lane & 15, fq = lane >> 4;
  for (int it = 0;; ++it) {
    int mt, nt; if (!next_tile(it, 130, 12, 1, mt, nt)) break;
    ALPlain al{H + (size_t)mt * 256 * 1024, 1024};
    f32x4 acc[4][4];
    gemm_main3(al, BT + (size_t)nt * 128 * 1024, 1024, 1024, acc, smem);
    const int q0 = (mt * 256) % TS;
    const bool rope = (q0 >= TC) && (nt < 10);
#pragma unroll
    for (int m = 0; m < 4; ++m) {
      const int rl = wr * 64 + m * 16 + fr;
      const int row = mt * 256 + rl;
      if (rope) {
        const int tt = q0 - TC + rl;
        const float prow = (float)(tt >> 6), pcol = (float)(tt & 63);
#pragma unroll
        for (int e = 0; e < 4; ++e) {
          const float inv = exp2f(-13.287712379549449f * (float)(fq * 4 + e) * (1.f / 16.f));
          float sn, cs;
          sincosf(prow * inv, &sn, &cs);
          float x1 = acc[m][0][e], x2 = acc[m][1][e];
          acc[m][0][e] = x1 * cs - x2 * sn; acc[m][1][e] = x1 * sn + x2 * cs;
          sincosf(pcol * inv, &sn, &cs);
          x1 = acc[m][2][e]; x2 = acc[m][3][e];
          acc[m][2][e] = x1 * cs - x2 * sn; acc[m][3][e] = x1 * sn + x2 * cs;
        }
      }
#pragma unroll
      for (int n = 0; n < 4; ++n) {
        const int c = nt * 128 + wc * 64 + n * 16 + fq * 4;
        uint2 w; w.x = pack2(acc[m][n][0], acc[m][n][1]); w.y = pack2(acc[m][n][2], acc[m][n][3]);
        *(uint2*)(QKV + (size_t)row * 1536 + c) = w;
      }
    }
  }
}
DI void ph_attn(const Params& p, int jj, char* smem) {
  const u16* QKV = (const u16*)(p.ws + OFF_SCR);
  u16* O = (u16*)(p.ws + OFF_SCR) + (size_t)R * 1536;
  u16* Ks = (u16*)smem;
  u16* Vt = Ks + 64 * 80;
  u16* Ps = Vt + 64 * 80;
  const int tid = otid(), lane = tid & 63, wave = tid >> 6, fr = lane & 15, fq = lane >> 4;
  const int g = wave >> 1, th = (wave & 1) * 32;
  u16* Pw = Ps + wave * 32 * 80;
  for (int tl = (int)(blockIdx.x >> 3); tl < 260; tl += (int)(gridDim.x >> 3)) {
    const int kvh = blockIdx.x & 3, b = (blockIdx.x >> 2) & 1;
    const int isctx = tl >= 256 ? 1 : 0, qb = isctx ? tl - 256 : tl;
    const int t0 = qb * 64, qrow0 = b * TS + (isctx ? 0 : TC) + t0;
    const int head = kvh * 4 + g;
    bf16x8 qf[2][2];
#pragma unroll
    for (int m = 0; m < 2; ++m)
#pragma unroll
      for (int kh = 0; kh < 2; ++kh) {
        uint4 v = *(const uint4*)(QKV + (size_t)(qrow0 + th + m * 16 + fr) * 1536 + head * 64 + kh * 32 + fq * 8);
        uint4 o;
        o.x = pack2(blo(v.x) * 0.125f, bhi(v.x) * 0.125f); o.y = pack2(blo(v.y) * 0.125f, bhi(v.y) * 0.125f);
        o.z = pack2(blo(v.z) * 0.125f, bhi(v.z) * 0.125f); o.w = pack2(blo(v.w) * 0.125f, bhi(v.w) * 0.125f);
        qf[m][kh] = *(bf16x8*)&o;
      }
    const float sink = p.in[IASINK][jj * 16 + head];
    float mrun[2] = {sink, sink}, lrun[2] = {1.f, 1.f};
    f32x4 o[2][4];
#pragma unroll
    for (int m = 0; m < 2; ++m)
#pragma unroll
      for (int n = 0; n < 4; ++n) o[m][n] = (f32x4){0.f, 0.f, 0.f, 0.f};
    const int i_lo = t0 >= 128 ? 0 : (t0 >= 64 ? 1 : 2);
    const int i_hi = t0 == T - 64 ? 2 : (t0 == T - 128 ? 3 : 4);
    const int nkt = isctx ? 4 : 4 + (i_hi - i_lo + 1);
    const int skey = tid >> 3, sdc = (tid & 7) * 8;
    uint4 kreg, vreg;
    auto kv_load = [&](int idx) {
      int krow0;
      if (idx < 4) krow0 = b * TS + idx * 64; else krow0 = b * TS + TC + t0 - 128 + 64 * (i_lo + idx - 4);
      const u16* src = QKV + (size_t)(krow0 + skey) * 1536 + 1024 + kvh * 64 + sdc;
      kreg = *(const uint4*)src; vreg = *(const uint4*)(src + 256);
    };
    kv_load(0);
    for (int kt = 0; kt < nkt; ++kt) {
      const int li = i_lo + kt - 4;
      const int mode = kt < 4 ? 0 : (li == 0 ? 1 : (li == 4 ? 2 : 0));
      lds_barrier();
      {
        *(uint4*)&Ks[skey * 80 + sdc] = kreg;
        const u16* vv = (const u16*)&vreg;
#pragma unroll
        for (int e = 0; e < 8; ++e) Vt[(sdc + e) * 80 + (skey ^ ((tid & 7) << 3))] = vv[e];
      }
      lds_barrier();
      if (kt + 1 < nkt) kv_load(kt + 1);
      f32x4 sacc[2][4];
#pragma unroll
      for (int m = 0; m < 2; ++m)
#pragma unroll
        for (int n = 0; n < 4; ++n) sacc[m][n] = (f32x4){0.f, 0.f, 0.f, 0.f};
#pragma unroll
      for (int kh = 0; kh < 2; ++kh)
#pragma unroll
        for (int n = 0; n < 4; ++n) {
          const bf16x8 kf = *(const bf16x8*)&Ks[(n * 16 + fr) * 80 + kh * 32 + fq * 8];
#pragma unroll
          for (int m = 0; m < 2; ++m) sacc[m][n] = MFMA(kf, qf[m][kh], sacc[m][n]);
        }
#pragma unroll
      for (int m = 0; m < 2; ++m) {
        const int qi = th + m * 16 + fr;
        float mx = -3.0e38f;
#pragma unroll
        for (int n = 0; n < 4; ++n)
#pragma unroll
          for (int e = 0; e < 4; ++e) {
            const int ki = n * 16 + fq * 4 + e;
            if ((mode == 1 && ki < qi) || (mode == 2 && ki > qi)) sacc[m][n][e] = -INFINITY;
            mx = fmaxf(mx, sacc[m][n][e]);
          }
        mx = fmaxf(mx, __shfl_xor(mx, 16)); mx = fmaxf(mx, __shfl_xor(mx, 32));
        const float mnew = fmaxf(mrun[m], mx);
        const float alpha = __expf(mrun[m] - mnew);
        float ps = 0.f;
#pragma unroll
        for (int n = 0; n < 4; ++n) {
          const float p0 = __expf(sacc[m][n][0] - mnew), p1 = __expf(sacc[m][n][1] - mnew), p2 = __expf(sacc[m][n][2] - mnew), p3 = __expf(sacc[m][n][3] - mnew);
          ps += p0 + p1 + p2 + p3;
          uint2 w; w.x = pack2(p0, p1); w.y = pack2(p2, p3);
          *(uint2*)&Pw[(m * 16 + fr) * 80 + n * 16 + fq * 4] = w;
        }
        ps += __shfl_xor(ps, 16); ps += __shfl_xor(ps, 32);
        lrun[m] = lrun[m] * alpha + ps; mrun[m] = mnew;
#pragma unroll
        for (int n = 0; n < 4; ++n) { o[m][n][0] *= alpha; o[m][n][1] *= alpha; o[m][n][2] *= alpha; o[m][n][3] *= alpha; }
      }
      __builtin_amdgcn_fence(__ATOMIC_RELEASE, "wavefront");
      __builtin_amdgcn_wave_barrier();
      __builtin_amdgcn_fence(__ATOMIC_ACQUIRE, "wavefront");
#pragma unroll
      for (int ks = 0; ks < 2; ++ks) {
        bf16x8 pf[2];
#pragma unroll
        for (int m = 0; m < 2; ++m) pf[m] = *(const bf16x8*)&Pw[(m * 16 + fr) * 80 + ks * 32 + fq * 8];
#pragma unroll
        for (int nd = 0; nd < 4; ++nd) {
          const bf16x8 vf = *(const bf16x8*)&Vt[(nd * 16 + fr) * 80 + (((ks * 4 + fq) ^ ((nd * 2 + (fr >> 3)) & 7)) << 3)];
#pragma unroll
          for (int m = 0; m < 2; ++m) o[m][nd] = MFMA(vf, pf[m], o[m][nd]);
        }
      }
    }
#pragma unroll
    for (int m = 0; m < 2; ++m) {
      const float il = 1.f / lrun[m];
      const int row = qrow0 + th + m * 16 + fr;
#pragma unroll
      for (int nd = 0; nd < 4; ++nd) {
        uint2 w; w.x = pack2(o[m][nd][0] * il, o[m][nd][1] * il); w.y = pack2(o[m][nd][2] * il, o[m][nd][3] * il);
        *(uint2*)(O + (size_t)row * 1024 + head * 64 + nd * 16 + fq * 4) = w;
      }
    }
  }
}

#define DBL_A 0
#define DBL_B 0
#define DBL_C 0
#define DBL_D 0
#define DBL_E 0
DI int layer_phases(int l) { int k = l % 3; return k == 0 ? 25 : (k == 1 ? 8 : 7); }
constexpr int N_PHASES = 2 + 25 + 8 + 7 + 25 + 1;

DI void run_phase(const Params& p, int ph, char* smem) {
  if (ph == 0) { ph_prologue(p, smem); ph_convert(p, 0, smem); return; }
  if (ph == 1) { ph_modreduce(p); return; }
  int q = ph - 2, l = 0;
  while (l < 4 && q >= layer_phases(l)) { q -= layer_phases(l); ++l; }
  if (l == 4) { ph_final(p); return; }
  const int kind = l % 3, jj = l / 3;
  const int np = layer_phases(l);
  const u16* wt = (const u16*)(p.ws + OFF_WT);
  if (q == 0) { ph_norm(p, l, 0); if (l > 0) ph_convert(p, l, smem); return; }
  if (q == np - 3) { ph_norm(p, l, 1); return; }
  if (q == np - 2) { ph_ffn1(p, l, smem);
#if DBL_A
    ph_ffn1(p, l, smem);
#endif
    return; }
  if (q == np - 1) { ph_resid_gemm(p, (const u16*)(p.ws + OFF_SCR), FF, wt + WT_W2T, FF, l, 5, smem); return; }
  if (kind == 0) {
    if (q == 1) { ph_rw_r1(p, jj, smem);
#if DBL_A
    ph_rw_r1(p, jj, smem);
#endif
    return; }
    if (q >= 2 && q <= 19) { int s = q - 2; if (s >= 1) {
#if DBL_D
      ph_rw_scan(p, s - 1, smem, false);
#endif
      ph_rw_scan(p, s - 1, smem); }
      if (s < 17) { ph_rw_produce(p, jj, s, smem);
#if DBL_E
      ph_rw_produce(p, jj, s, smem);
#endif
      } return; }
    if (q == 20) { ph_rw_finish(p, jj, smem); return; }
    if (q == 21) { ph_resid_gemm(p, (const u16*)(p.ws + OFF_SCR) + (size_t)R * P1LD, 1024, wt + WT_RWO, 1024, l, 2, smem); return; }
  } else if (kind == 1) {
    if (q == 1) { ph_ssd_s1(p, jj, smem); return; }
    if (q == 2) { ph_ssd_scan(p, jj, smem);
#if DBL_B
    ph_ssd_scan(p, jj, smem);
#endif
    return; }
    if (q == 3) { ph_ssd_s3(p, smem); return; }
    if (q == 4) { ph_ssd_s4(p, l, jj, smem); return; }
  } else {
    if (q == 1) { ph_at_qkv(p, smem);
#if DBL_A
    ph_at_qkv(p, smem);
#endif
    return; }
    if (q == 2) { ph_attn(p, jj, smem);
#if DBL_C
    ph_attn(p, jj, smem);
#endif
    return; }
    if (q == 3) { ph_resid_gemm(p, (const u16*)(p.ws + OFF_SCR) + (size_t)R * 1536, 1024, wt + WT_AO, 1024, l, 2, smem); return; }
  }
}

extern "C" __global__ void __launch_bounds__(512) mega(Params p, int ph_lo, int ph_hi) {
  extern __shared__ __attribute__((aligned(16))) char smem[];
  cg::grid_group grid = cg::this_grid();
#ifndef PROBE
#define PROBE 0
#endif
#if PROBE
  unsigned long long* tsb = (unsigned long long*)(p.ws + OFF_MODP);
#endif
  __shared__ uint4 xb_words;
  if (threadIdx.x == 0) xb_words = make_uint4(0u, 0u, 0u, 0u);
  __syncthreads();
  XcdBarrier xb = xcd_barrier_post((unsigned*)(p.ws + OFF_BAR), (volatile LAS unsigned*)&xb_words);
  for (int ph = ph_lo; ph < ph_hi; ++ph) {
    run_phase(p, ph, smem);
    if (ph + 1 < ph_hi) { if (ph == ph_lo) grid.sync(); else xcd_barrier(xb); }
  }
#if PROBE
  grid.sync();
  if (blockIdx.x == 0) {
    const float t1 = (float)(tsb[PA1] - tsb[PA0]) * 1e-5f, t2 = (float)(tsb[PB1] - tsb[PB0]) * 1e-5f;
    for (int i = threadIdx.x; i < (1 << 23); i += 512) p.out[i] = t2;
    __syncthreads();
    if (threadIdx.x == 0) p.out[0] = 64.f * t1;
  }
#endif
}

extern "C" void kernel_launch(void* const* d_in, const int* in_sizes, int n_in, void* d_out, int out_size, void* d_ws, size_t ws_size, hipStream_t stream) {
  Params p{};
  for (int i = 0; i < 41; ++i) p.in[i] = (const float*)d_in[i];
  p.out = (float*)d_out; p.ws = (char*)d_ws;
  constexpr size_t kLds = 162048;
  hipFuncSetAttribute((const void*)mega, hipFuncAttributeMaxDynamicSharedMemorySize, (int)kLds);
  hipMemsetAsync((char*)d_ws + OFF_BAR, 0, XCD_BAR_WORDS * 4, stream);
  int lo = 0, hi = N_PHASES;
  void* args[] = {&p, &lo, &hi};
  hipError_t e = hipLaunchCooperativeKernel((void*)mega, dim3(256), dim3(512), args, kLds, stream);
  if (e != hipSuccess) fprintf(stderr, "coop launch failed: %s\n", hipGetErrorString(e));
}
```

```cpp
#include <hip/hip_runtime.h>
#include <hip/hip_cooperative_groups.h>
#include <hip/hip_fp16.h>
#include <cstdio>
namespace cg = cooperative_groups;

typedef unsigned short u16;
typedef short bf16x8 __attribute__((ext_vector_type(8)));
typedef float f32x4 __attribute__((ext_vector_type(4)));
typedef float f32x2 __attribute__((ext_vector_type(2)));
#define MFMA(a, b, c) __builtin_amdgcn_mfma_f32_16x16x32_bf16(a, b, c, 0, 0, 0)
#define DI __device__ __forceinline__

constexpr int D = 1024, NBAT = 2, T = 16384, TC = 256, TS = T + TC, R = NBAT * TS, FF = 2816;
enum { IX = 0, IC, ICTX, ICC, IADAW, IADAB, IN1, IN2, IFWIN, IFCONV, IFWOUT, IFINAL, IRMU, IRWR, IRWK, IRWV, IRWO, IRW0, IRW1, IRW2, IRA0, IRA1,
       IRA2, IRG1, IRG2, IRKK, IRKA, IRRK, IRLNG, IRLNB, ISWIN, ISCONVW, ISCONVB, ISDTB, ISALOG, ISD, ISNG, ISWOUT, IAQKV, IAWO, IASINK };

__device__ __forceinline__ unsigned long long rfl64(unsigned long long v) {
  unsigned lo = __builtin_amdgcn_readfirstlane((unsigned)v), hi = __builtin_amdgcn_readfirstlane((unsigned)(v >> 32));
  return ((unsigned long long)hi << 32) | lo;
}
struct Params {
  const float* in[41]; float* out; char* ws;
  __device__ __forceinline__ const float* inp(int i) const { return (const float*)rfl64((unsigned long long)in[i]); }
  __device__ __forceinline__ float* outp() const { return (float*)rfl64((unsigned long long)out); }
  __device__ __forceinline__ char* wsp() const { return (char*)rfl64((unsigned long long)ws); }
};

constexpr size_t alup(size_t x) { return (x + 255) & ~(size_t)255; }
constexpr size_t OFF_XC = 0;
constexpr size_t OFF_BAR = OFF_XC + alup((size_t)512 * 1024 * 4);
constexpr size_t OFF_MODP = OFF_BAR + 16384;
constexpr size_t OFF_MOD = OFF_MODP + alup((size_t)16 * 4 * 3 * 6144 * 4);
constexpr size_t OFF_SSQ = OFF_MOD + alup((size_t)4 * 3 * 6144 * 4);
constexpr size_t OFF_DT = OFF_SSQ + alup((size_t)R * 8 * 4);
constexpr size_t OFF_BONUS = OFF_DT;
constexpr size_t OFF_RWST = OFF_DT + alup((size_t)R * 64 * 4);
constexpr size_t OFF_H = OFF_RWST + alup((size_t)256 * 256 * 4 * 4);
constexpr size_t OFF_RING = OFF_H;
constexpr size_t OFF_WT = OFF_H + alup((size_t)R * 1024 * 2);
constexpr size_t WT_ELEMS = 17170432;
constexpr size_t OFF_SCR = OFF_WT + alup(WT_ELEMS * 2);
constexpr size_t SCR_BYTES = (size_t)R * 4096 * 2 + (size_t)R * 2048 * 2;
static_assert(OFF_SCR + SCR_BYTES <= (size_t)536870912, "workspace too large");
constexpr size_t WT_W1T = 0, WT_W2T = (size_t)5632 * 1024, WT_MIX = WT_W2T + (size_t)1024 * 2816;
constexpr size_t WT_R1T = WT_MIX, WT_LUT = WT_R1T + (size_t)3456 * 1024, WT_G2T = WT_LUT + (size_t)2 * 16 * 128 * 128, WT_RWO = WT_G2T + (size_t)1024 * 128;
constexpr size_t WT_SX = WT_MIX, WT_SZ = WT_SX + (size_t)4224 * 1024, WT_SO = WT_SZ + (size_t)2048 * 1024;
constexpr size_t WT_AQ = WT_MIX, WT_AO = WT_AQ + (size_t)1536 * 1024;
static_assert(WT_SO + (size_t)1024 * 2048 <= WT_ELEMS, "wt");
static_assert((size_t)2 * 2 * 2 * 1024 * 16 * 512 <= (size_t)R * 1024 * 2, "ring");

DI u16 f2b(float f) { unsigned u = __float_as_uint(f); u += 0x7fffu + ((u >> 16) & 1u); return (u16)(u >> 16); }
DI float b2f(u16 h) { return __uint_as_float(((unsigned)h) << 16); }
DI unsigned pack2(float a, float b) { return (unsigned)f2b(a) | ((unsigned)f2b(b) << 16); }
DI float blo(unsigned u) { return __uint_as_float(u << 16); }
DI float bhi(unsigned u) { return __uint_as_float(u & 0xffff0000u); }
DI float siluf(float x) { return x / (1.f + __expf(-x)); }
DI float sigmf(float x) { return 1.f / (1.f + __expf(-x)); }
DI float softplusf(float x) { return x > 20.f ? x : log1pf(__expf(x)); }
DI int otid() { int t = threadIdx.x; asm volatile("" : "+v"(t)); return t; }
DI void lds_barrier() { asm volatile("s_waitcnt lgkmcnt(0)\n\ts_barrier" ::: "memory"); }
DI f32x4 gload_f4(const float* p) { f32x4 v; asm volatile("global_load_dwordx4 %0, %1, off" : "=v"(v) : "v"(p) : "memory"); return v; }
DI void vm_wait0() { asm volatile("s_waitcnt vmcnt(0)" ::: "memory"); }
DI float wsum(float v) { for (int o = 32; o; o >>= 1) v += __shfl_xor(v, o); return v; }
DI float* xrow_ptr(const Params& p, int r) {
  int b = r / TS, q = r - b * TS;
  return q < TC ? (float*)(p.ws + OFF_XC) + ((size_t)(b * TC + q) << 10) : p.out + ((size_t)(b * T + q - TC) << 10);
}
DI const float* mod_ptr(const Params& p, int l, int r) {
  int b = r / TS, q = r - b * TS;
  int v = q < TC ? 2 : b;
  return (const float*)(p.ws + OFF_MOD) + (size_t)(l * 3 + v) * 6144;
}


#define XB_TMO      128
#define XB_XCNT(j)  (256  + 64 * (j))
#define XB_XSUB(j)  (1280 + 64 * (j))
#define XB_XGEN(j)  (2304 + 64 * (j))
#define XB_TOP      3328
#define XB_TOPGEN   3392
#define XCD_BAR_WORDS 3456
#define XB_SPIN_CAP (1u << 18)
#define LAS __attribute__((address_space(3)))
DI unsigned xb_ld(unsigned* p) { return __hip_atomic_load(p, __ATOMIC_RELAXED, __HIP_MEMORY_SCOPE_AGENT); }
DI unsigned xb_add(unsigned* p, unsigned v) { return __hip_atomic_fetch_add(p, v, __ATOMIC_RELAXED, __HIP_MEMORY_SCOPE_AGENT); }
DI unsigned xb_xcc_id() { return (unsigned)__builtin_amdgcn_s_getreg((3 << 11) | 20) & 0xFu; }
#define XB_SPIN(cond, bar) do { unsigned _sp = 0; while (cond) { __builtin_amdgcn_s_sleep(1); \
    if ((++_sp & 255u) == 0u) { if (xb_ld(&(bar)[XB_TMO])) break; if (_sp > XB_SPIN_CAP) { atomicAdd(&(bar)[XB_TMO], 1u); break; } } } } while (0)
struct XcdBarrier { unsigned* bar; unsigned x; volatile LAS unsigned* st; };
DI XcdBarrier xcd_barrier_post(unsigned* bar, volatile LAS unsigned* st) {
  XcdBarrier b; b.bar = bar; b.x = xb_xcc_id(); b.st = st;
  if (threadIdx.x == 0) (void)xb_add(&bar[XB_XCNT(b.x)], 1u);
  return b;
}
DI void xcd_barrier_complete(unsigned* bar, unsigned x, unsigned& nloc, unsigned& nx) {
  const unsigned G = gridDim.x * gridDim.y * gridDim.z;
  unsigned sum, cnt, mine, sp = 0u;
  for (;;) {
    sum = 0u; cnt = 0u; mine = 0u;
#pragma unroll
    for (unsigned j = 0; j < 16; ++j) { const unsigned c = xb_ld(&bar[XB_XCNT(j)]); sum += c; cnt += (c > 0u) ? 1u : 0u; mine = (j == x) ? c : mine; }
    if (sum == G) break;
    __builtin_amdgcn_s_sleep(1);
    if ((++sp & 255u) == 0u) { if (xb_ld(&bar[XB_TMO])) break; if (sp > XB_SPIN_CAP) { atomicAdd(&bar[XB_TMO], 1u); break; } }
  }
  nloc = mine > 0u ? mine : 1u; nx = cnt > 0u ? cnt : 1u;
}
DI void xcd_barrier(const XcdBarrier& b) {
  asm volatile("s_waitcnt vmcnt(0)" ::: "memory");
  __syncthreads();
  if (threadIdx.x == 0) {
    unsigned* bar = b.bar;
    __builtin_amdgcn_s_waitcnt(0);
    unsigned nloc = b.st[0], nx = b.st[1];
    if (nloc == 0u) { xcd_barrier_complete(bar, b.x, nloc, nx); b.st[0] = nloc; b.st[1] = nx; }
    const unsigned old = xb_add(&bar[XB_XSUB(b.x)], 1u);
    const unsigned gen = old / nloc;
    if (old + 1u == (gen + 1u) * nloc) {
      __builtin_amdgcn_fence(__ATOMIC_RELEASE, "agent");
      asm volatile("s_waitcnt vmcnt(0)" ::: "memory");
      const unsigned og = xb_add(&bar[XB_TOP], 1u);
      const unsigned tg = og / nx;
      if (og + 1u == (tg + 1u) * nx) xb_add(&bar[XB_TOPGEN], 1u);
      else XB_SPIN(xb_ld(&bar[XB_TOPGEN]) == tg, bar);
      __builtin_amdgcn_fence(__ATOMIC_ACQUIRE, "agent");
      xb_add(&bar[XB_XGEN(b.x)], 1u);
      asm volatile("s_waitcnt vmcnt(0)" ::: "memory");
    } else {
      XB_SPIN(xb_ld(&bar[XB_XGEN(b.x)]) == gen, bar);
      __builtin_amdgcn_fence(__ATOMIC_ACQUIRE, "agent");
      asm volatile("s_waitcnt vmcnt(0)" ::: "memory");
    }
  }
  __syncthreads();
}

constexpr int LDS_ROW = 64;
struct SmemG { u16 A[2][256 * LDS_ROW]; u16 B[2][128 * LDS_ROW]; };
template <class AL>
DI void gemm_main(const AL& al, const u16* __restrict__ Bt, int ldb, int K, f32x4 (&acc)[4][4], char* smem) {
  SmemG& s = *(SmemG*)smem;
  const int tid = otid(), lane = tid & 63, wave = tid >> 6, wr = wave >> 1, wc = wave & 1, fr = lane & 15, fq = lane >> 4;
#pragma unroll
  for (int m = 0; m < 4; ++m)
#pragma unroll
    for (int n = 0; n < 4; ++n) acc[m][n] = (f32x4){0.f, 0.f, 0.f, 0.f};
  uint4 ra[4], rb[2];
  const int nk = K >> 6;
  const int lrow = tid >> 3, lkc = (tid & 7) * 8, lsw = ((tid & 7) ^ (lrow & 7)) * 8;
  __syncthreads();
#pragma unroll
  for (int i = 0; i < 4; ++i) ra[i] = al(lrow + i * 64, lkc);
#pragma unroll
  for (int i = 0; i < 2; ++i) rb[i] = *(const uint4*)(Bt + (size_t)(lrow + i * 64) * ldb + lkc);
#pragma unroll
  for (int i = 0; i < 4; ++i) *(uint4*)&s.A[0][(lrow + i * 64) * LDS_ROW + lsw] = al.post(ra[i], lrow + i * 64, lkc);
#pragma unroll
  for (int i = 0; i < 2; ++i) *(uint4*)&s.B[0][(lrow + i * 64) * LDS_ROW + lsw] = rb[i];
  __syncthreads();
  for (int kt = 0; kt < nk; ++kt) {
    const int buf = kt & 1;
    const int kn = (kt + 1 < nk ? kt + 1 : kt) * 64 + lkc;
#pragma unroll
    for (int i = 0; i < 2; ++i) {
      const u16* bp = Bt + (size_t)(lrow + i * 64) * ldb + kn;
      asm volatile("global_load_dwordx4 %0, %1, off" : "=v"(rb[i]) : "v"(bp) : "memory");
    }
#pragma unroll
    for (int i = 0; i < 4; ++i) ra[i] = al(lrow + i * 64, kn);
    __builtin_amdgcn_sched_barrier(0);
#pragma unroll
    for (int kh = 0; kh < 2; ++kh) {
      bf16x8 a[4], b[4];
#pragma unroll
      for (int m = 0; m < 4; ++m) a[m] = *(const bf16x8*)&s.A[buf][(wr * 64 + m * 16 + fr) * LDS_ROW + (((kh * 4 + fq) ^ (fr & 7)) << 3)];
#pragma unroll
      for (int n = 0; n < 4; ++n) b[n] = *(const bf16x8*)&s.B[buf][(wc * 64 + n * 16 + fr) * LDS_ROW + (((kh * 4 + fq) ^ (fr & 7)) << 3)];
      __builtin_amdgcn_s_setprio(1);
#pragma unroll
      for (int m = 0; m < 4; ++m)
#pragma unroll
        for (int n = 0; n < 4; ++n) acc[m][n] = MFMA(b[n], a[m], acc[m][n]);
      __builtin_amdgcn_s_setprio(0);
    }
    asm volatile("s_waitcnt vmcnt(0)" ::: "memory");
#pragma unroll
    for (int i = 0; i < 4; ++i) *(uint4*)&s.A[buf ^ 1][(lrow + i * 64) * LDS_ROW + lsw] = al.post(ra[i], lrow + i * 64, kn);
#pragma unroll
    for (int i = 0; i < 2; ++i) *(uint4*)&s.B[buf ^ 1][(lrow + i * 64) * LDS_ROW + lsw] = rb[i];
    __syncthreads();
  }
}

template <class AL>
DI void gemm_main3(const AL& al, const u16* __restrict__ Bt, int ldb, int K, f32x4 (&acc)[4][4], char* smem) {
  SmemG& s = *(SmemG*)smem;
  const int tid = otid(), lane = tid & 63, wave = tid >> 6, wr = wave >> 1, wc = wave & 1, fr = lane & 15, fq = lane >> 4;
  const bool grpY = __builtin_amdgcn_readfirstlane(wave) >= 4;
#pragma unroll
  for (int m = 0; m < 4; ++m)
#pragma unroll
    for (int n = 0; n < 4; ++n) acc[m][n] = (f32x4){0.f, 0.f, 0.f, 0.f};
  uint4 ra[4], rb[2];
  const int nk = K >> 6;
  const int lrow = tid >> 3, lkc = (tid & 7) * 8, lsw = ((tid & 7) ^ (lrow & 7)) * 8;
  __syncthreads();
#pragma unroll
  for (int i = 0; i < 4; ++i) ra[i] = al(lrow + i * 64, lkc);
#pragma unroll
  for (int i = 0; i < 2; ++i) rb[i] = *(const uint4*)(Bt + (size_t)(lrow + i * 64) * ldb + lkc);
#pragma unroll
  for (int i = 0; i < 4; ++i) *(uint4*)&s.A[0][(lrow + i * 64) * LDS_ROW + lsw] = al.post(ra[i], lrow + i * 64, lkc);
#pragma unroll
  for (int i = 0; i < 2; ++i) *(uint4*)&s.B[0][(lrow + i * 64) * LDS_ROW + lsw] = rb[i];
  __syncthreads();
  const u16* abase = &s.A[0][(wr * 64 + fr) * LDS_ROW];
  const u16* bbase = &s.B[0][(wc * 64 + fr) * LDS_ROW];
  bf16x8 fa[4], fb[4];
#define G3_RD(BUF, KH) do { \
    _Pragma("unroll") for (int m = 0; m < 4; ++m) fa[m] = *(const bf16x8*)(abase + (BUF) * 256 * LDS_ROW + m * 16 * LDS_ROW + ((((KH) * 4 + fq) ^ (fr & 7)) << 3)); \
    _Pragma("unroll") for (int n = 0; n < 4; ++n) fb[n] = *(const bf16x8*)(bbase + (BUF) * 128 * LDS_ROW + n * 16 * LDS_ROW + ((((KH) * 4 + fq) ^ (fr & 7)) << 3)); } while (0)
#define G3_MM() do { \
    _Pragma("unroll") for (int m = 0; m < 4; ++m) _Pragma("unroll") for (int n = 0; n < 4; ++n) acc[m][n] = MFMA(fb[n], fa[m], acc[m][n]); } while (0)
  int kn = (1 < nk ? 1 : 0) * 64 + lkc;
#pragma unroll
  for (int i = 0; i < 2; ++i) {
    const u16* bp = Bt + (size_t)(lrow + i * 64) * ldb + kn;
    asm volatile("global_load_dwordx4 %0, %1, off" : "=v"(rb[i]) : "v"(bp) : "memory");
  }
#pragma unroll
  for (int i = 0; i < 4; ++i) ra[i] = al(lrow + i * 64, kn);
  if (grpY) G3_RD(0, 0);
  __builtin_amdgcn_sched_barrier(0);
  for (int kt = 0; kt < nk; ++kt) {
    const int buf = kt & 1;
    if (!grpY) G3_RD(buf, 0);
    __builtin_amdgcn_sched_barrier(0);
    G3_MM();
    __builtin_amdgcn_sched_barrier(0);
    if (grpY) G3_RD(buf, 1);
    __builtin_amdgcn_sched_barrier(0);
    asm volatile("s_waitcnt vmcnt(0)" ::: "memory");
#pragma unroll
    for (int i = 0; i < 4; ++i) *(uint4*)&s.A[buf ^ 1][(lrow + i * 64) * LDS_ROW + lsw] = al.post(ra[i], lrow + i * 64, kn);
#pragma unroll
    for (int i = 0; i < 2; ++i) *(uint4*)&s.B[buf ^ 1][(lrow + i * 64) * LDS_ROW + lsw] = rb[i];
    if (kt + 2 < nk) {
      kn = (kt + 2) * 64 + lkc;
#pragma unroll
      for (int i = 0; i < 2; ++i) {
        const u16* bp = Bt + (size_t)(lrow + i * 64) * ldb + kn;
        asm volatile("global_load_dwordx4 %0, %1, off" : "=v"(rb[i]) : "v"(bp) : "memory");
      }
#pragma unroll
      for (int i = 0; i < 4; ++i) ra[i] = al(lrow + i * 64, kn);
    }
    __builtin_amdgcn_sched_barrier(0);
    lds_barrier();
    if (!grpY) G3_RD(buf, 1);
    __builtin_amdgcn_sched_barrier(0);
    G3_MM();
    __builtin_amdgcn_sched_barrier(0);
    if (grpY) G3_RD(buf ^ 1, 0);
    __builtin_amdgcn_sched_barrier(0);
    lds_barrier();
  }
  asm volatile("s_waitcnt vmcnt(0)" ::: "memory");
  __syncthreads();
}

template <class AL>
DI void gemm_main4(const AL& al, const u16* __restrict__ Bt, int ldb, int K, f32x4 (&acc)[4][4], char* smem) {
  SmemG& s = *(SmemG*)smem;
  const int tid = otid(), lane = tid & 63, wave = tid >> 6, wr = wave >> 1, wc = wave & 1, fr = lane & 15, fq = lane >> 4;
#pragma unroll
  for (int m = 0; m < 4; ++m)
#pragma unroll
    for (int n = 0; n < 4; ++n) acc[m][n] = (f32x4){0.f, 0.f, 0.f, 0.f};
  uint4 a0[4], a1[4], b00, b01, b10, b11;
  const int nk = K >> 6;
  const int lrow = tid >> 3, lkc = (tid & 7) * 8, lsw = ((tid & 7) ^ (lrow & 7)) * 8;
  __syncthreads();
#pragma unroll
  for (int i = 0; i < 4; ++i) a0[i] = al(lrow + i * 64, lkc);
#pragma unroll
  for (int i = 0; i < 1; ++i) { b00 = *(const uint4*)(Bt + (size_t)lrow * ldb + lkc); b01 = *(const uint4*)(Bt + (size_t)(lrow + 64) * ldb + lkc); }
#pragma unroll
  for (int i = 0; i < 4; ++i) *(uint4*)&s.A[0][(lrow + i * 64) * LDS_ROW + lsw] = al.post(a0[i], lrow + i * 64, lkc);
#pragma unroll
  for (int i = 0; i < 1; ++i) { *(uint4*)&s.B[0][lrow * LDS_ROW + lsw] = b00; *(uint4*)&s.B[0][(lrow + 64) * LDS_ROW + lsw] = b01; }
  __syncthreads();
  auto g4_load = [&](uint4 (&RA)[4], uint4& RB0, uint4& RB1, int KN) {
#pragma unroll
    for (int i = 0; i < 4; ++i) RA[i] = al(lrow + i * 64, KN);
    RB0 = *(const uint4*)(Bt + (size_t)lrow * ldb + KN);
    RB1 = *(const uint4*)(Bt + (size_t)(lrow + 64) * ldb + KN);
  };
  auto g4_store = [&](uint4 (&RA)[4], uint4& RB0, uint4& RB1, int BUF, int KN) {
#pragma unroll
    for (int i = 0; i < 4; ++i) *(uint4*)&s.A[BUF][(lrow + i * 64) * LDS_ROW + lsw] = al.post(RA[i], lrow + i * 64, KN);
    *(uint4*)&s.B[BUF][lrow * LDS_ROW + lsw] = RB0;
    *(uint4*)&s.B[BUF][(lrow + 64) * LDS_ROW + lsw] = RB1;
  };
#define G4_COMPUTE(BUF) do { \
    _Pragma("unroll") for (int kh = 0; kh < 2; ++kh) { \
      bf16x8 a[4], b[4]; \
      _Pragma("unroll") for (int m = 0; m < 4; ++m) a[m] = *(const bf16x8*)&s.A[BUF][(wr * 64 + m * 16 + fr) * LDS_ROW + (((kh * 4 + fq) ^ (fr & 7)) << 3)]; \
      _Pragma("unroll") for (int n = 0; n < 4; ++n) b[n] = *(const bf16x8*)&s.B[BUF][(wc * 64 + n * 16 + fr) * LDS_ROW + (((kh * 4 + fq) ^ (fr & 7)) << 3)]; \
      __builtin_amdgcn_s_setprio(1); \
      _Pragma("unroll") for (int m = 0; m < 4; ++m) _Pragma("unroll") for (int n = 0; n < 4; ++n) acc[m][n] = MFMA(b[n], a[m], acc[m][n]); \
      __builtin_amdgcn_s_setprio(0); } } while (0)
  int k1 = 64 + lkc, k2 = (2 < nk ? 2 : nk - 1) * 64 + lkc;
  g4_load(a0, b00, b01, k1);
  g4_load(a1, b10, b11, k2);
  __builtin_amdgcn_sched_barrier(0);
  for (int kt = 0; kt < nk; kt += 2) {
    G4_COMPUTE(0);
    __builtin_amdgcn_sched_barrier(0);
    g4_store(a0, b00, b01, 1, k1);
    k1 = (kt + 3 < nk ? kt + 3 : nk - 1) * 64 + lkc;
    g4_load(a0, b00, b01, k1);
    __builtin_amdgcn_sched_barrier(0);
    __syncthreads();
    G4_COMPUTE(1);
    __builtin_amdgcn_sched_barrier(0);
    g4_store(a1, b10, b11, 0, k2);
    k2 = (kt + 4 < nk ? kt + 4 : nk - 1) * 64 + lkc;
    g4_load(a1, b10, b11, k2);
    __builtin_amdgcn_sched_barrier(0);
    __syncthreads();
  }
}


struct SmemG2 { u16 A[2][256 * LDS_ROW]; u16 B[2][256 * LDS_ROW]; };
template <class AL>
DI void gemm_main2(const AL& al, const u16* __restrict__ Bt, int ldb, int K, f32x4 (&acc)[4][8], char* smem) {
  SmemG2& s = *(SmemG2*)smem;
  const int tid = otid(), lane = tid & 63, wave = tid >> 6, wr = wave >> 1, wc = wave & 1, fr = lane & 15, fq = lane >> 4;
#pragma unroll
  for (int m = 0; m < 4; ++m)
#pragma unroll
    for (int n = 0; n < 8; ++n) acc[m][n] = (f32x4){0.f, 0.f, 0.f, 0.f};
  uint4 ra[4], rb[4];
  const int nk = K >> 6;
  const int lrow = tid >> 3, lkc = (tid & 7) * 8, lsw = ((tid & 7) ^ (lrow & 7)) * 8;
  __syncthreads();
#pragma unroll
  for (int i = 0; i < 4; ++i) ra[i] = al(lrow + i * 64, lkc);
#pragma unroll
  for (int i = 0; i < 4; ++i) rb[i] = *(const uint4*)(Bt + (size_t)(lrow + i * 64) * ldb + lkc);
#pragma unroll
  for (int i = 0; i < 4; ++i) *(uint4*)&s.A[0][(lrow + i * 64) * LDS_ROW + lsw] = al.post(ra[i], lrow + i * 64, lkc);
#pragma unroll
  for (int i = 0; i < 4; ++i) *(uint4*)&s.B[0][(lrow + i * 64) * LDS_ROW + lsw] = rb[i];
  __syncthreads();
  for (int kt = 0; kt < nk; ++kt) {
    const int buf = kt & 1;
    const int kn = (kt + 1 < nk ? kt + 1 : kt) * 64 + lkc;
#pragma unroll
    for (int i = 0; i < 4; ++i) ra[i] = al(lrow + i * 64, kn);
    __builtin_amdgcn_sched_barrier(0);
#pragma unroll
    for (int kh = 0; kh < 2; ++kh) {
      bf16x8 a[4];
#pragma unroll
      for (int m = 0; m < 4; ++m) a[m] = *(const bf16x8*)&s.A[buf][(wr * 64 + m * 16 + fr) * LDS_ROW + (((kh * 4 + fq) ^ (fr & 7)) << 3)];
      bf16x8 bc = *(const bf16x8*)&s.B[buf][(wc * 128 + fr) * LDS_ROW + (((kh * 4 + fq) ^ (fr & 7)) << 3)];
#pragma unroll
      for (int n = 0; n < 8; ++n) {
        const bf16x8 bn = *(const bf16x8*)&s.B[buf][(wc * 128 + (n < 7 ? n + 1 : n) * 16 + fr) * LDS_ROW + (((kh * 4 + fq) ^ (fr & 7)) << 3)];
        __builtin_amdgcn_sched_barrier(0);
        __builtin_amdgcn_s_setprio(1);
#pragma unroll
        for (int m = 0; m < 4; ++m) acc[m][n] = MFMA(bc, a[m], acc[m][n]);
        __builtin_amdgcn_s_setprio(0);
        bc = bn;
      }
      __builtin_amdgcn_sched_barrier(0);
      if (kh == 0) {
#pragma unroll
        for (int i = 0; i < 4; ++i) *(uint4*)&s.A[buf ^ 1][(lrow + i * 64) * LDS_ROW + lsw] = al.post(ra[i], lrow + i * 64, kn);
#pragma unroll
        for (int i = 0; i < 4; ++i) {
          const u16* bp = Bt + (size_t)(lrow + i * 64) * ldb + kn;
          asm volatile("global_load_dwordx4 %0, %1, off" : "=v"(rb[i]) : "v"(bp) : "memory");
        }
        __builtin_amdgcn_sched_barrier(0);
      }
    }
    asm volatile("s_waitcnt vmcnt(0)" ::: "memory");
#pragma unroll
    for (int i = 0; i < 4; ++i) *(uint4*)&s.B[buf ^ 1][(lrow + i * 64) * LDS_ROW + lsw] = rb[i];
    __syncthreads();
  }
}

DI bool next_tile(int it, int MT, int NT, int GN, int& mt, int& nt) {
  const int xcd = blockIdx.x & 7, lb = blockIdx.x >> 3, GM = 8 / GN;
  const int gm = xcd / GN, gn = xcd - gm * GN;
  const int m0 = gm * MT / GM, m1 = (gm + 1) * MT / GM, n0 = gn * NT / GN, n1 = (gn + 1) * NT / GN;
  const int nl = n1 - n0, tl = lb + it * (gridDim.x >> 3);
  if (tl >= (m1 - m0) * nl) return false;
  const int q = tl / nl;
  mt = m0 + q; nt = n0 + (tl - q * nl);
  return true;
}
struct ALPlain {
  const u16* base; int ld;
  DI uint4 operator()(int i, int k) const { return *(const uint4*)(base + (size_t)i * ld + k); }
  DI uint4 post(uint4 v, int, int) const { return v; }
};

DI void ph_prologue(const Params& p, char* smem) {
  const int tid = otid();
  {
    const float4* x = (const float4*)p.in[IX]; float4* o = (float4*)p.out;
    const size_t n = (size_t)NBAT * T * D / 4;
    for (size_t i = (size_t)blockIdx.x * 512 + tid; i < n; i += (size_t)gridDim.x * 512) o[i] = x[i];
    const float4* c = (const float4*)p.in[ICTX]; float4* xc = (float4*)(p.ws + OFF_XC);
    const size_t nc = (size_t)NBAT * TC * D / 4;
    for (size_t i = (size_t)blockIdx.x * 512 + tid; i < nc; i += (size_t)gridDim.x * 512) xc[i] = c[i];
  }
  float* modp = (float*)(p.ws + OFF_MODP);
  float* sc = (float*)smem;
  __syncthreads();
  for (int e = tid; e < 3072; e += 512) { const float v = e < 2048 ? p.in[IC][e] : p.in[ICC][e - 2048]; sc[e] = siluf(v); }
  __syncthreads();
  const int half = tid >> 8, col = tid & 255;
  for (int it = blockIdx.x * 2 + half; it < 4 * 24 * 16; it += gridDim.x * 2) {
    int l = it / (24 * 16), rem = it - l * 24 * 16, cc = rem / 16, kc = rem & 15;
    int n = cc * 256 + col;
    const float* w = p.in[IADAW] + (size_t)l * 1024 * 6144 + (size_t)(kc * 64) * 6144 + n;
    float a0 = 0.f, a1 = 0.f, a2 = 0.f;
#pragma unroll
    for (int kb = 0; kb < 64; kb += 16) {
      float wv[16];
#pragma unroll
      for (int k = 0; k < 16; ++k) wv[k] = w[(size_t)(kb + k) * 6144];
#pragma unroll
      for (int k = 0; k < 16; ++k) {
        const int kk = kc * 64 + kb + k;
        a0 += sc[kk] * wv[k]; a1 += sc[1024 + kk] * wv[k]; a2 += sc[2048 + kk] * wv[k];
      }
    }
    size_t o = ((size_t)(kc * 4 + l) * 3) * 6144 + n;
    modp[o] = a0; modp[o + 6144] = a1; modp[o + 2 * 6144] = a2;
  }
}
DI void ph_modreduce(const Params& p) {
  const float* modp = (const float*)(p.ws + OFF_MODP); float* mod = (float*)(p.ws + OFF_MOD);
  for (int i = blockIdx.x * 512 + otid(); i < 4 * 3 * 6144; i += gridDim.x * 512) {
    int l = i / (3 * 6144), n = i % 6144;
    float a = p.in[IADAB][l * 6144 + n];
    float pv[16];
#pragma unroll
    for (int kc = 0; kc < 16; ++kc) pv[kc] = modp[(size_t)kc * 4 * 3 * 6144 + i];
#pragma unroll
    for (int kc = 0; kc < 16; ++kc) a += pv[kc];
    mod[i] = a;
  }
}

struct CvtJob { const float* src; u16* dst; int K, N, ld, ldd, mode; };
DI void cvt_run(const CvtJob& j, int& rot, char* smem) {
  float* tile = (float*)smem;
  const int tid = otid();
  if (j.mode == 4) {
    size_t n = (size_t)j.K * j.N;
    for (size_t i = (size_t)blockIdx.x * 512 + tid; i < n; i += (size_t)gridDim.x * 512) j.dst[i] = 0;
    return;
  }
  const int tk = j.K >> 6, tn = j.N >> 6, nt = tk * tn;
  int start = (blockIdx.x + gridDim.x - (rot % gridDim.x)) % gridDim.x;
  for (int t = start; t < nt; t += gridDim.x) {
    int kt = t / tn, ntl = t - kt * tn;
    __syncthreads();
    {
      f32x4 lv[2];
#pragma unroll
      for (int i = 0; i < 2; ++i) { const int e = tid + i * 512, kk = e >> 4, n4 = (e & 15) * 4; lv[i] = gload_f4(j.src + (size_t)(kt * 64 + kk) * j.ld + ntl * 64 + n4); }
      asm volatile("s_waitcnt vmcnt(0)" : "+v"(lv[0]), "+v"(lv[1]) :: "memory");
#pragma unroll
      for (int i = 0; i < 2; ++i) { const int e = tid + i * 512, kk = e >> 4, n4 = (e & 15) * 4; float* tp = tile + kk * 65 + n4; tp[0] = lv[i][0]; tp[1] = lv[i][1]; tp[2] = lv[i][2]; tp[3] = lv[i][3]; }
    }
    __syncthreads();
    for (int e = tid; e < 4096; e += 512) {
      int nn = e >> 6, kk = e & 63; float v = tile[kk * 65 + nn];
      int n = ntl * 64 + nn, k = kt * 64 + kk;
      if (j.mode == 0) j.dst[(size_t)n * j.ldd + k] = f2b(v);
      else if (j.mode == 1) { int rr = n < FF ? (n >> 7) * 256 + (n & 127) : ((n - FF) >> 7) * 256 + 128 + ((n - FF) & 127); j.dst[(size_t)rr * j.ldd + k] = f2b(v); }
      else {
        int h = n >> 6, c = n & 63, ty = j.mode - 2;
        u16* d = j.dst + (size_t)h * 128 * 128 + (size_t)((c >> 5) * 64 + ty * 32 + (c & 31)) * 128;
        d[ty * 64 + k] = f2b(v); d[(1 - ty) * 64 + k] = 0;
      }
    }
  }
  rot += nt;
}
DI void ph_convert(const Params& p, int l, char* smem) {
  u16* wt = (u16*)(p.ws + OFF_WT);
  int rot = 0;
  CvtJob j;
  j = {p.in[IFWIN] + (size_t)l * 1024 * 5632, wt + WT_W1T, 1024, 5632, 5632, 1024, 1}; cvt_run(j, rot, smem);
  j = {p.in[IFWOUT] + (size_t)l * FF * 1024, wt + WT_W2T, FF, 1024, 1024, FF, 0}; cvt_run(j, rot, smem);
  const int kind = l % 3, jj = l / 3;
  if (kind == 0) {
    j = {p.in[IRWR] + (size_t)jj * 1048576, wt + WT_R1T, 1024, 1024, 1024, 1024, 0}; cvt_run(j, rot, smem);
    j = {p.in[IRWK] + (size_t)jj * 1048576, wt + WT_R1T + (size_t)1024 * 1024, 1024, 1024, 1024, 1024, 0}; cvt_run(j, rot, smem);
    j = {p.in[IRWV] + (size_t)jj * 1048576, wt + WT_R1T + (size_t)2048 * 1024, 1024, 1024, 1024, 1024, 0}; cvt_run(j, rot, smem);
    for (int d = 0; d < 2; ++d) {
      j = {p.in[IRW1] + (size_t)(jj * 2 + d) * 65536, wt + WT_R1T + (size_t)(3072 + d * 64) * 1024, 1024, 64, 64, 1024, 0}; cvt_run(j, rot, smem);
      j = {p.in[IRA1] + (size_t)(jj * 2 + d) * 65536, wt + WT_R1T + (size_t)(3200 + d * 64) * 1024, 1024, 64, 64, 1024, 0}; cvt_run(j, rot, smem);
      j = {p.in[IRW2] + (size_t)(jj * 2 + d) * 65536, wt + WT_LUT + (size_t)d * 16 * 128 * 128, 64, 1024, 1024, 128, 2}; cvt_run(j, rot, smem);
      j = {p.in[IRA2] + (size_t)(jj * 2 + d) * 65536, wt + WT_LUT + (size_t)d * 16 * 128 * 128, 64, 1024, 1024, 128, 3}; cvt_run(j, rot, smem);
    }
    j = {p.in[IRG1] + (size_t)jj * 131072, wt + WT_R1T + (size_t)3328 * 1024, 1024, 128, 128, 1024, 0}; cvt_run(j, rot, smem);
    j = {p.in[IRG2] + (size_t)jj * 131072, wt + WT_G2T, 128, 1024, 1024, 128, 0}; cvt_run(j, rot, smem);
    j = {p.in[IRWO] + (size_t)jj * 1048576, wt + WT_RWO, 1024, 1024, 1024, 1024, 0}; cvt_run(j, rot, smem);
  } else if (kind == 1) {
    j = {p.in[ISWIN] + (size_t)jj * 1024 * 6208 + 2048, wt + WT_SX, 1024, 4160, 6208, 1024, 0}; cvt_run(j, rot, smem);
    j = {nullptr, wt + WT_SX + (size_t)4160 * 1024, 64, 1024, 0, 0, 4}; cvt_run(j, rot, smem);
    j = {p.in[ISWIN] + (size_t)jj * 1024 * 6208, wt + WT_SZ, 1024, 2048, 6208, 1024, 0}; cvt_run(j, rot, smem);
    j = {p.in[ISWOUT] + (size_t)jj * 2048 * 1024, wt + WT_SO, 2048, 1024, 1024, 2048, 0}; cvt_run(j, rot, smem);
    float* ssq = (float*)(p.ws + OFF_SSQ);
    for (int i = blockIdx.x * 512 + otid(); i < R * 8; i += gridDim.x * 512) ssq[i] = 0.f;
  } else {
    j = {p.in[IAQKV] + (size_t)jj * 1024 * 1536, wt + WT_AQ, 1024, 1536, 1536, 1024, 0}; cvt_run(j, rot, smem);
    j = {p.in[IAWO] + (size_t)jj * 1048576, wt + WT_AO, 1024, 1024, 1024, 1024, 0}; cvt_run(j, rot, smem);
  }
}

DI void ph_norm(const Params& p, int l, int which) {
  const int lane = otid() & 63, gw = blockIdx.x * 8 + (otid() >> 6), nw = gridDim.x * 8;
  const float* g = (which ? p.in[IN2] : p.in[IN1]) + l * 1024;
  u16* H = (u16*)(p.ws + OFF_H);
  float4 gg[4];
#pragma unroll
  for (int j = 0; j < 4; ++j) gg[j] = *(const float4*)(g + j * 256 + lane * 4);
  float4 v[4], vn[4];
  if (gw < R) {
    const float* xr = xrow_ptr(p, gw);
#pragma unroll
    for (int j = 0; j < 4; ++j) v[j] = *(const float4*)(xr + j * 256 + lane * 4);
  }
  for (int r = gw; r < R; r += nw) {
    {
      const float* xn = xrow_ptr(p, r + nw < R ? r + nw : r);
#pragma unroll
      for (int j = 0; j < 4; ++j) vn[j] = *(const float4*)(xn + j * 256 + lane * 4);
    }
    const float* md = mod_ptr(p, l, r) + which * 3072;
    float4 sh[4], sc[4];
#pragma unroll
    for (int j = 0; j < 4; ++j) { sh[j] = *(const float4*)(md + j * 256 + lane * 4); sc[j] = *(const float4*)(md + 1024 + j * 256 + lane * 4); }
    __builtin_amdgcn_sched_barrier(0);
    float ss = 0.f;
#pragma unroll
    for (int j = 0; j < 4; ++j) ss += v[j].x * v[j].x + v[j].y * v[j].y + v[j].z * v[j].z + v[j].w * v[j].w;
    ss = wsum(ss);
    const float rs = rsqrtf(ss * (1.f / 1024.f) + 1e-6f);
#pragma unroll
    for (int j = 0; j < 4; ++j) {
      const int c = j * 256 + lane * 4;
      float o0 = v[j].x * rs * gg[j].x * (1.f + sc[j].x) + sh[j].x, o1 = v[j].y * rs * gg[j].y * (1.f + sc[j].y) + sh[j].y;
      float o2 = v[j].z * rs * gg[j].z * (1.f + sc[j].z) + sh[j].z, o3 = v[j].w * rs * gg[j].w * (1.f + sc[j].w) + sh[j].w;
      uint2 w; w.x = pack2(o0, o1); w.y = pack2(o2, o3);
      *(uint2*)(H + (size_t)r * 1024 + c) = w;
    }
#pragma unroll
    for (int j = 0; j < 4; ++j) v[j] = vn[j];
  }
}
DI void ph_final(const Params& p) {
  const int lane = otid() & 63, gw = blockIdx.x * 8 + (otid() >> 6), nw = gridDim.x * 8;
  float4 g[4];
#pragma unroll
  for (int j = 0; j < 4; ++j) g[j] = *(const float4*)(p.in[IFINAL] + j * 256 + lane * 4);
  float4 v[4], vn[4];
  if (gw < NBAT * T) {
#pragma unroll
    for (int j = 0; j < 4; ++j) v[j] = *(const float4*)(p.out + (size_t)gw * 1024 + j * 256 + lane * 4);
  }
  for (int r = gw; r < NBAT * T; r += nw) {
    float* xr = p.out + (size_t)r * 1024;
    {
      const float* xn = p.out + (size_t)(r + nw < NBAT * T ? r + nw : r) * 1024;
#pragma unroll
      for (int j = 0; j < 4; ++j) vn[j] = *(const float4*)(xn + j * 256 + lane * 4);
    }
    __builtin_amdgcn_sched_barrier(0);
    float ss = 0.f;
#pragma unroll
    for (int j = 0; j < 4; ++j) ss += v[j].x * v[j].x + v[j].y * v[j].y + v[j].z * v[j].z + v[j].w * v[j].w;
    ss = wsum(ss);
    const float rs = rsqrtf(ss * (1.f / 1024.f) + 1e-6f);
#pragma unroll
    for (int j = 0; j < 4; ++j) {
      float4 w = v[j]; w.x *= rs * g[j].x; w.y *= rs * g[j].y; w.z *= rs * g[j].z; w.w *= rs * g[j].w;
      *(float4*)(xr + j * 256 + lane * 4) = w;
    }
#pragma unroll
    for (int j = 0; j < 4; ++j) v[j] = vn[j];
  }
}

template <class AL>
DI void resid_tile(const Params& p, const AL& al, const u16* Bt, int K, int l, int gi, int mt, int nt, char* smem) {
  f32x4 acc[4][4];
  gemm_main4(al, Bt + (size_t)nt * 128 * K, K, K, acc, smem);
  const int lane = otid() & 63, wave = otid() >> 6, wr = wave >> 1, wc = wave & 1, fr = lane & 15, fq = lane >> 4;
  const int row0 = mt * 256;
  const float* md = mod_ptr(p, l, row0) + gi * 1024;
  float4 g[4];
#pragma unroll
  for (int n = 0; n < 4; ++n) g[n] = *(const float4*)(md + nt * 128 + wc * 64 + n * 16 + fq * 4);
  float* xr0 = xrow_ptr(p, row0) + (size_t)(wr * 64 + fr) * 1024 + nt * 128 + wc * 64 + fq * 4;
#pragma unroll
  for (int mh = 0; mh < 2; ++mh) {
    f32x4 x[2][4];
#pragma unroll
    for (int m2 = 0; m2 < 2; ++m2)
#pragma unroll
      for (int n = 0; n < 4; ++n) x[m2][n] = gload_f4(xr0 + (size_t)((mh * 2 + m2) * 16) * 1024 + n * 16);
    asm volatile("s_waitcnt vmcnt(0)" : "+v"(x[0][0]), "+v"(x[0][1]), "+v"(x[0][2]), "+v"(x[0][3]), "+v"(x[1][0]), "+v"(x[1][1]), "+v"(x[1][2]), "+v"(x[1][3]) :: "memory");
#pragma unroll
    for (int m2 = 0; m2 < 2; ++m2)
#pragma unroll
      for (int n = 0; n < 4; ++n) {
        const int m = mh * 2 + m2;
        f32x4 v = x[m2][n];
        v[0] += g[n].x * acc[m][n][0]; v[1] += g[n].y * acc[m][n][1]; v[2] += g[n].z * acc[m][n][2]; v[3] += g[n].w * acc[m][n][3];
        *(f32x4*)(xr0 + (size_t)(m * 16) * 1024 + n * 16) = v;
      }
  }
}
DI void ph_resid_gemm(const Params& p, const u16* A, int lda, const u16* Bt, int K, int l, int gi, char* smem) {
  const bool skip_ctx = (l == 3);
  for (int it = 0;; ++it) {
    int mt, nt; if (!next_tile(it, skip_ctx ? 128 : 130, 8, 1, mt, nt)) break;
    if (skip_ctx) mt = mt + 1 + (mt >> 6);
    ALPlain al{A + (size_t)mt * 256 * lda, lda};
    resid_tile(p, al, Bt, K, l, gi, mt, nt, smem);
  }
}

struct ALHalo {
  const u16* base; int t0m1, len;
  DI uint4 operator()(int i, int k) const {
    int t = t0m1 + i;
    if (t < 0 || t >= len) return make_uint4(0, 0, 0, 0);
    return *(const uint4*)(base + (size_t)t * 1024 + k);
  }
  DI uint4 post(uint4 v, int, int) const { return v; }
};
DI void ph_ffn1(const Params& p, int l, char* smem) {
  const u16* H = (const u16*)(p.ws + OFF_H);
  const u16* W1T = (const u16*)(p.ws + OFF_WT) + WT_W1T;
  u16* G = (u16*)(p.ws + OFF_SCR);
  const int tid = otid(), lane = tid & 63, wave = tid >> 6, wr = wave >> 1, wc = wave & 1, fr = lane & 15, fq = lane >> 4;
  for (int it = 0;; ++it) {
    int mt, nt; if (!next_tile(it, 134, 22, 2, mt, nt)) break;
    const int b = mt / 67, ml = mt - b * 67;
    int rowbase, t0, len;
    if (ml < 2) { rowbase = b * TS; t0 = ml * 254; len = TC; } else { rowbase = b * TS + TC; t0 = (ml - 2) * 254; len = T; }
    ALHalo al{H + (size_t)rowbase * 1024, t0 - 1, len};
    f32x4 acc[4][8];
    gemm_main2(al, W1T + (size_t)nt * 256 * 1024, 1024, 1024, acc, smem);
    u16* P16 = (u16*)smem;
#pragma unroll
    for (int m = 0; m < 4; ++m)
#pragma unroll
      for (int n = 0; n < 8; ++n) {
        uint2 w; w.x = pack2(acc[m][n][0], acc[m][n][1]); w.y = pack2(acc[m][n][2], acc[m][n][3]);
        *(uint2*)&P16[(wr * 64 + m * 16 + fr) * 264 + wc * 128 + n * 16 + fq * 4] = w;
      }
    __syncthreads();
    {
      const int c2 = (tid & 63) * 2, rg = tid >> 6;
      const float* cw = p.in[IFCONV] + (size_t)l * 3 * 5632;
      const int ca = nt * 128 + c2, cg2 = FF + ca;
      const float2 a0 = *(const float2*)(cw + ca), a1 = *(const float2*)(cw + 5632 + ca), a2 = *(const float2*)(cw + 2 * 5632 + ca);
      const float2 g0 = *(const float2*)(cw + cg2), g1 = *(const float2*)(cw + 5632 + cg2), g2 = *(const float2*)(cw + 2 * 5632 + cg2);
      const int i0 = 1 + rg * 32, i1 = min(i0 + 32, 255);
      unsigned pa = *(const unsigned*)&P16[(i0 - 1) * 264 + c2], ca_ = *(const unsigned*)&P16[i0 * 264 + c2];
      unsigned pg = *(const unsigned*)&P16[(i0 - 1) * 264 + 128 + c2], cgv = *(const unsigned*)&P16[i0 * 264 + 128 + c2];
      for (int i = i0; i < i1; ++i) {
        const unsigned na = *(const unsigned*)&P16[(i + 1) * 264 + c2], ng = *(const unsigned*)&P16[(i + 1) * 264 + 128 + c2];
        const float ua0 = a0.x * blo(pa) + a1.x * blo(ca_) + a2.x * blo(na), ua1 = a0.y * bhi(pa) + a1.y * bhi(ca_) + a2.y * bhi(na);
        const float ug0 = g0.x * blo(pg) + g1.x * blo(cgv) + g2.x * blo(ng), ug1 = g0.y * bhi(pg) + g1.y * bhi(cgv) + g2.y * bhi(ng);
        const int tt = t0 - 1 + i;
        if (tt < len) *(unsigned*)&G[(size_t)(rowbase + tt) * FF + ca] = pack2(ua0 * siluf(ug0), ua1 * siluf(ug1));
        pa = ca_; ca_ = na; pg = cgv; cgv = ng;
      }
    }
  }
}

struct ALMix {
  const u16* H; int row0; const float* mu;
  DI uint4 operator()(int i, int k) const {
    const int row = row0 + i, q = row % TS;
    const bool hp = (q != 0) && (q != TC), hn = (q != TC - 1) && (q != TS - 1);
    const u16* pc = H + (size_t)row * 1024 + k;
    uint4 c = *(const uint4*)pc;
    uint4 a = hp ? *(const uint4*)(pc - 1024) : make_uint4(0, 0, 0, 0);
    uint4 b = hn ? *(const uint4*)(pc + 1024) : make_uint4(0, 0, 0, 0);
    float4 m0 = *(const float4*)(mu + k), m1 = *(const float4*)(mu + k + 4);
    uint4 o;
#define MIX1(cc, aa, bb, mlo, mhi) pack2(blo(cc) + (0.5f * (blo(aa) + blo(bb)) - blo(cc)) * (mlo), bhi(cc) + (0.5f * (bhi(aa) + bhi(bb)) - bhi(cc)) * (mhi))
    o.x = MIX1(c.x, a.x, b.x, m0.x, m0.y); o.y = MIX1(c.y, a.y, b.y, m0.z, m0.w);
    o.z = MIX1(c.z, a.z, b.z, m1.x, m1.y); o.w = MIX1(c.w, a.w, b.w, m1.z, m1.w);
    return o;
  }
  DI uint4 post(uint4 v, int, int) const { return v; }
};
constexpr int P1LD = 3456;
DI void ph_rw_r1(const Params& p, int jj, char* smem) {
  const u16* H = (const u16*)(p.ws + OFF_H);
  const u16* BT = (const u16*)(p.ws + OFF_WT) + WT_R1T;
  u16* P1 = (u16*)(p.ws + OFF_SCR);
  const int lane = otid() & 63, wave = otid() >> 6, wr = wave >> 1, wc = wave & 1, fr = lane & 15, fq = lane >> 4;
  for (int it = 0;; ++it) {
    int mt, nt; if (!next_tile(it, 130, 27, 1, mt, nt)) break;
    const int mi = nt < 8 ? 0 : nt < 16 ? 2 : nt < 24 ? 3 : nt == 24 ? 1 : nt == 25 ? 4 : 5;
    ALMix al{H, mt * 256, p.in[IRMU] + (size_t)(jj * 6 + mi) * 1024};
    f32x4 acc[4][4];
    gemm_main3(al, BT + (size_t)nt * 128 * 1024, 1024, 1024, acc, smem);
#pragma unroll
    for (int m = 0; m < 4; ++m) {
      const int row = mt * 256 + wr * 64 + m * 16 + fr;
#pragma unroll
      for (int n = 0; n < 4; ++n) {
        const int c = nt * 128 + wc * 64 + n * 16 + fq * 4;
        float v0 = acc[m][n][0], v1 = acc[m][n][1], v2 = acc[m][n][2], v3 = acc[m][n][3];
        if (nt == 24) { v0 = tanhf(v0); v1 = tanhf(v1); v2 = tanhf(v2); v3 = tanhf(v3); }
        else if (nt == 26) { v0 = sigmf(v0); v1 = sigmf(v1); v2 = sigmf(v2); v3 = sigmf(v3); }
        uint2 w; w.x = pack2(v0, v1); w.y = pack2(v2, v3);
        *(uint2*)(P1 + (size_t)row * P1LD + c) = w;
      }
    }
  }
}
DI int scan_row(int b, int d, int pos) { return d == 0 ? b * TS + pos : (pos < TC ? b * TS + TC - 1 - pos : b * TS + (TS + TC - 1) - pos); }

struct ALLora {
  const u16* P1; int rowbase, rowstep, d;
  DI uint4 operator()(int i, int k) const {
    const int row = rowbase + i * rowstep;
    const int col = k < 64 ? 3072 + d * 64 + k : 3200 + d * 64 + (k - 64);
    return *(const uint4*)(P1 + (size_t)row * P1LD + col);
  }
  DI uint4 post(uint4 v, int, int) const { return v; }
};
DI uint2 pack4h(float a, float b, float c, float d) {
  __half2 x = __floats2half2_rn(a, b), y = __floats2half2_rn(c, d);
  uint2 r; r.x = *(unsigned*)&x; r.y = *(unsigned*)&y; return r;
}
DI void ph_rw_produce(const Params& p, int jj, int s, char* smem) {
  const u16* P1 = (const u16*)(p.ws + OFF_SCR);
  const u16* LUT = (const u16*)(p.ws + OFF_WT) + WT_LUT;
  __half* ring = (__half*)(p.ws + OFF_RING) + (size_t)(s & 1) * ((size_t)2 * 2 * 1024 * 16 * 256);
  float* bonus = (float*)(p.ws + OFF_BONUS);
  float* red = (float*)(smem + sizeof(SmemG));
  const int lane = otid() & 63, wave = otid() >> 6, wr = wave >> 1, wc = wave & 1, fr = lane & 15, fq = lane >> 4;
  const int npt = min(4, 65 - s * 4);
  for (int t = blockIdx.x; t < 2 * 2 * npt * 16; t += gridDim.x) {
    const int h = t & 15, ptl = (t >> 4) % npt, bd = (t >> 4) / npt, d = bd & 1, b = bd >> 1;
    const int pos0 = (s * 4 + ptl) * 256;
    const int rowbase = scan_row(b, d, pos0), rowstep = d ? -1 : 1;
    ALLora al{P1, rowbase, rowstep, d};
    f32x4 acc[4][4];
    gemm_main3(al, LUT + (size_t)(d * 16 + h) * 128 * 128, 128, 128, acc, smem);
    float4 kkw[2], kaw[2], rkw[2], w0v[2], a0v[2];
#pragma unroll
    for (int nn = 0; nn < 2; ++nn) {
      const int ch = h * 64 + wc * 32 + nn * 16 + fq * 4;
      kkw[nn] = *(const float4*)(p.in[IRKK] + jj * 1024 + ch); kaw[nn] = *(const float4*)(p.in[IRKA] + jj * 1024 + ch);
      rkw[nn] = *(const float4*)(p.in[IRRK] + jj * 1024 + ch);
      w0v[nn] = *(const float4*)(p.in[IRW0] + (jj * 2 + d) * 1024 + ch); a0v[nn] = *(const float4*)(p.in[IRA0] + (jj * 2 + d) * 1024 + ch);
    }
    float ssk[4];
    uint2 kreg[4][2], rreg[4][2];
#pragma unroll
    for (int m = 0; m < 4; ++m) {
      const int row = rowbase + (wr * 64 + m * 16 + fr) * rowstep;
#pragma unroll
      for (int nn = 0; nn < 2; ++nn) {
        const int ch = h * 64 + wc * 32 + nn * 16 + fq * 4;
        kreg[m][nn] = *(const uint2*)(P1 + (size_t)row * P1LD + 1024 + ch);
        rreg[m][nn] = *(const uint2*)(P1 + (size_t)row * P1LD + ch);
      }
    }
    __builtin_amdgcn_sched_barrier(0);
#pragma unroll
    for (int m = 0; m < 4; ++m) {
      float s1 = 0.f;
#pragma unroll
      for (int nn = 0; nn < 2; ++nn) {
        const uint2 k2 = kreg[m][nn];
        float q0 = blo(k2.x) * kkw[nn].x, q1 = bhi(k2.x) * kkw[nn].y, q2 = blo(k2.y) * kkw[nn].z, q3 = bhi(k2.y) * kkw[nn].w;
        s1 += q0 * q0 + q1 * q1 + q2 * q2 + q3 * q3;
      }
      s1 += __shfl_xor(s1, 16); s1 += __shfl_xor(s1, 32);
      ssk[m] = s1;
    }
    if (fq == 0) {
#pragma unroll
      for (int m = 0; m < 4; ++m) red[(wr * 64 + m * 16 + fr) * 2 + wc] = ssk[m];
    }
    __syncthreads();
    float c3[4];
#pragma unroll
    for (int m = 0; m < 4; ++m) {
      const int pi = wr * 64 + m * 16 + fr;
      const float rs = rsqrtf(red[pi * 2] + red[pi * 2 + 1] + 1e-12f);
      const int posl = ptl * 256 + pi;
      __half* rp = ring + ((((size_t)(b * 2 + d) * 1024 + posl) * 16 + h) * 256);
      float cc = 0.f;
#pragma unroll
      for (int nn = 0; nn < 2; ++nn) {
        const int chl = wc * 32 + nn * 16 + fq * 4;
        const float kq[4] = {kkw[nn].x, kkw[nn].y, kkw[nn].z, kkw[nn].w}, ka[4] = {kaw[nn].x, kaw[nn].y, kaw[nn].z, kaw[nn].w};
        const float rk[4] = {rkw[nn].x, rkw[nn].y, rkw[nn].z, rkw[nn].w}, w0[4] = {w0v[nn].x, w0v[nn].y, w0v[nn].z, w0v[nn].w};
        const float a0[4] = {a0v[nn].x, a0v[nn].y, a0v[nn].z, a0v[nn].w};
        float okk[4], owm[4], oka[4], okd[4];
        const int rowm = rowbase + pi * rowstep;
        const uint2 r2 = rreg[m][nn], k2 = kreg[m][nn];
        const float rvv[4] = {blo(r2.x), bhi(r2.x), blo(r2.y), bhi(r2.y)}, kvv[4] = {blo(k2.x), bhi(k2.x), blo(k2.y), bhi(k2.y)};
#pragma unroll
        for (int j = 0; j < 4; ++j) {
          const float k = kvv[j];
          const float kk = k * kq[j] * rs;
          const float a = sigmf(a0[j] + acc[m][nn + 2][j]);
          const float wlog = -__logf(1.f + __expf(-(w0[j] + acc[m][nn][j]))) - 0.5f;
          const float ew = -__expf(wlog);
          const float wm1 = ew * (1.f + ew * (0.5f + ew * (0.16666667f + ew * (0.041666668f + ew * (0.0083333338f + ew * (0.0013888889f + ew * 0.0001984127f))))));
          const float kd = k * (1.f + (a - 1.f) * ka[j]);
          okk[j] = kk; owm[j] = wm1; oka[j] = kk * a; okd[j] = kd;
          cc += rvv[j] * kd * rk[j];
        }
        *(uint2*)(rp + chl) = pack4h(okk[0], okk[1], okk[2], okk[3]);
        *(uint2*)(rp + 64 + chl) = pack4h(owm[0], owm[1], owm[2], owm[3]);
        *(uint2*)(rp + 128 + chl) = pack4h(oka[0], oka[1], oka[2], oka[3]);
        *(uint2*)(rp + 192 + chl) = pack4h(okd[0], okd[1], okd[2], okd[3]);
      }
      cc += __shfl_xor(cc, 16); cc += __shfl_xor(cc, 32);
      c3[m] = cc;
    }
    __syncthreads();
    if (fq == 0) {
#pragma unroll
      for (int m = 0; m < 4; ++m) red[(wr * 64 + m * 16 + fr) * 2 + wc] = c3[m];
    }
    __syncthreads();
    if (wc == 0 && fq == 0) {
#pragma unroll
      for (int m = 0; m < 4; ++m) {
        const int pi = wr * 64 + m * 16 + fr;
        bonus[(size_t)(rowbase + pi * rowstep) * 32 + h * 2 + d] = red[pi * 2] + red[pi * 2 + 1];
      }
    }
  }
}
DI float ror_add16(float x) {
  x += __int_as_float(__builtin_amdgcn_update_dpp(0, __float_as_int(x), 0x128, 0xf, 0xf, false));
  x += __int_as_float(__builtin_amdgcn_update_dpp(0, __float_as_int(x), 0x124, 0xf, 0xf, false));
  x += __int_as_float(__builtin_amdgcn_update_dpp(0, __float_as_int(x), 0x122, 0xf, 0xf, false));
  x += __int_as_float(__builtin_amdgcn_update_dpp(0, __float_as_int(x), 0x121, 0xf, 0xf, false));
  return x;
}
constexpr int SCH = 32, STEPF = 336;
DI void ph_rw_scan(const Params& p, int s, char* smem, bool save = true) {
  if (blockIdx.x >= 256) return;
  const u16* P1 = (const u16*)(p.ws + OFF_SCR);
  const __half* ring = (const __half*)(p.ws + OFF_RING) + (size_t)(s & 1) * ((size_t)2 * 2 * 1024 * 16 * 256);
  u16* Y = (u16*)(p.ws + OFF_SCR) + (size_t)R * P1LD;
  float* st = (float*)(p.ws + OFF_RWST);
  float* buf = (float*)smem;
  float* ybuf = buf + 2 * SCH * STEPF;
  const int tid = otid(), lane = tid & 63, wave = tid >> 6;
  const int xcd_ = blockIdx.x & 7, slot_ = blockIdx.x >> 3;
  const int bh_ = xcd_ * 4 + (slot_ >> 3), rq = slot_ & 3;
  const int b = bh_ >> 4, h = bh_ & 15, d = (slot_ >> 2) & 1;
  const int npos = min(1024, TS - s * 1024), nch = npos / SCH;
  const int rl = (wave & 3) * 4 + (lane >> 4), q = lane & 15;
  f32x2 sa = (f32x2){0.f, 0.f}, sb = (f32x2){0.f, 0.f};
  if (wave < 4 && s > 0) { float4 v = *(const float4*)(st + ((size_t)blockIdx.x * 256 + tid) * 4); sa = (f32x2){v.x, v.y}; sb = (f32x2){v.z, v.w}; }
  u16* Yd = Y + (size_t)d * R * 1024;
  uint4 lr[4], lrr = make_uint4(0, 0, 0, 0), lrv = make_uint4(0, 0, 0, 0);
  auto gload = [&](int c) {
    const int lt = tid - 256;
#pragma unroll
    for (int i = 0; i < 4; ++i) {
      const int cidx = lt + i * 256, stp = cidx >> 5, off = (cidx & 31) * 8;
      const int posl = c * SCH + stp;
      lr[i] = *(const uint4*)(ring + ((((size_t)(b * 2 + d) * 1024 + posl) * 16 + h) * 256) + off);
    }
    {
      const int stp = lt >> 3, off = (lt & 7) * 8;
      const int row = scan_row(b, d, s * 1024 + c * SCH + stp);
      lrr = *(const uint4*)(P1 + (size_t)row * P1LD + h * 64 + off);
    }
    {
      const int l2 = lt & 63, stp = l2 >> 1, off = (l2 & 1) * 8;
      const int row = scan_row(b, d, s * 1024 + c * SCH + stp);
      lrv = *(const uint4*)(P1 + (size_t)row * P1LD + 2048 + h * 64 + rq * 16 + off);
    }
  };
  auto swrite = [&](int c) {
    const int lt = tid - 256;
    float* bb = buf + (c & 1) * SCH * STEPF;
#pragma unroll
    for (int i = 0; i < 4; ++i) {
      const int cidx = lt + i * 256, stp = cidx >> 5, off = (cidx & 31) * 8;
      const __half2* hp = (const __half2*)&lr[i];
      float2 f0 = __half22float2(hp[0]), f1 = __half22float2(hp[1]), f2 = __half22float2(hp[2]), f3 = __half22float2(hp[3]);
      float* dst = bb + stp * STEPF + off;
      *(float4*)dst = make_float4(f0.x, f0.y, f1.x, f1.y);
      *(float4*)(dst + 4) = make_float4(f2.x, f2.y, f3.x, f3.y);
    }
    {
      const int stp = lt >> 3, off = (lt & 7) * 8;
      float* dst = bb + stp * STEPF + 256 + off;
      *(float4*)dst = make_float4(blo(lrr.x), bhi(lrr.x), blo(lrr.y), bhi(lrr.y));
      *(float4*)(dst + 4) = make_float4(blo(lrr.z), bhi(lrr.z), blo(lrr.w), bhi(lrr.w));
    }
    if (lt < 64) {
      const int stp = lt >> 1, off = (lt & 1) * 8;
      float* dst = bb + stp * STEPF + 320 + off;
      *(float4*)dst = make_float4(blo(lrv.x), bhi(lrv.x), blo(lrv.y), bhi(lrv.y));
      *(float4*)(dst + 4) = make_float4(blo(lrv.z), bhi(lrv.z), blo(lrv.w), bhi(lrv.w));
    }
  };
  if (wave >= 4) { gload(0); swrite(0); if (nch > 1) gload(1); }
  lds_barrier();
  for (int c = 0; c < nch; ++c) {
    if (wave < 4) {
      const float* bb = buf + (c & 1) * SCH * STEPF;
      const int pos0 = s * 1024 + c * SCH;
      const int row0 = scan_row(b, d, pos0), rstep = d ? -1 : 1;
      u16* yp = Yd + (size_t)row0 * 1024 + h * 64 + rq * 16 + rl;
      float4 kk = *(const float4*)(bb + q * 4), wm = *(const float4*)(bb + 64 + q * 4), ka = *(const float4*)(bb + 128 + q * 4);
      float4 kd = *(const float4*)(bb + 192 + q * 4), rr = *(const float4*)(bb + 256 + q * 4);
      float vv = bb[320 + rl];
      float yv[16];
#pragma unroll
      for (int stp = 0; stp < SCH; ++stp) {
        const float* sn = bb + (stp + 1 < SCH ? stp + 1 : stp) * STEPF;
        const float4 kkn = *(const float4*)(sn + q * 4), wmn = *(const float4*)(sn + 64 + q * 4), kan = *(const float4*)(sn + 128 + q * 4);
        const float4 kdn = *(const float4*)(sn + 192 + q * 4), rrn = *(const float4*)(sn + 256 + q * 4);
        const float vvn = sn[320 + rl];
        __builtin_amdgcn_sched_barrier(0);
        const f32x2 vv2 = (f32x2){vv, vv};
        f32x2 ta = sa * (f32x2){wm.x, wm.y} + sa, tb = sb * (f32x2){wm.z, wm.w} + sb;
        ta = vv2 * (f32x2){kd.x, kd.y} + ta; tb = vv2 * (f32x2){kd.z, kd.w} + tb;
        f32x2 ud = sa * (f32x2){kk.x, kk.y}; ud = sb * (f32x2){kk.z, kk.w} + ud;
        float u = ror_add16(ud.x + ud.y);
        const f32x2 nu = (f32x2){-u, -u};
        sa = nu * (f32x2){ka.x, ka.y} + ta; sb = nu * (f32x2){ka.z, ka.w} + tb;
        f32x2 yd2 = sa * (f32x2){rr.x, rr.y}; yd2 = sb * (f32x2){rr.z, rr.w} + yd2;
        yv[stp & 15] = yd2.x + yd2.y;
        if ((stp & 15) == 15) {
          const bool b3 = q & 8, b2 = q & 4, b1 = q & 2, b0 = q & 1;
          float z8[8], z4[4], z2[2];
#pragma unroll
          for (int i = 0; i < 8; ++i) { const float kp = b3 ? yv[i + 8] : yv[i], sd = b3 ? yv[i] : yv[i + 8]; z8[i] = kp + __int_as_float(__builtin_amdgcn_update_dpp(0, __float_as_int(sd), 0x140, 0xf, 0xf, false)); }
#pragma unroll
          for (int i = 0; i < 4; ++i) { const float kp = b2 ? z8[i + 4] : z8[i], sd = b2 ? z8[i] : z8[i + 4]; z4[i] = kp + __int_as_float(__builtin_amdgcn_update_dpp(0, __float_as_int(sd), 0x141, 0xf, 0xf, false)); }
#pragma unroll
          for (int i = 0; i < 2; ++i) { const float kp = b1 ? z4[i + 2] : z4[i], sd = b1 ? z4[i] : z4[i + 2]; z2[i] = kp + __int_as_float(__builtin_amdgcn_update_dpp(0, __float_as_int(sd), 0x1B, 0xf, 0xf, false)); }
          const float kp = b0 ? z2[1] : z2[0], sd = b0 ? z2[0] : z2[1];
          const float yq = kp + __int_as_float(__builtin_amdgcn_update_dpp(0, __float_as_int(sd), 0xB1, 0xf, 0xf, false));
          yp[(ptrdiff_t)((stp & ~15) + q) * rstep * 1024] = f2b(yq);
        }
        kk = kkn; wm = wmn; ka = kan; kd = kdn; rr = rrn; vv = vvn;
      }
    } else {
      if (c + 1 < nch) swrite(c + 1);
      if (c + 2 < nch) gload(c + 2);
    }
    lds_barrier();
  }
  if (wave < 4 && save) *(float4*)(st + ((size_t)blockIdx.x * 256 + tid) * 4) = make_float4(sa.x, sa.y, sb.x, sb.y);
  __syncthreads();
}
DI void ph_rw_finish(const Params& p, int jj, char* smem) {
  const u16* P1 = (const u16*)(p.ws + OFF_SCR);
  const u16* G2T = (const u16*)(p.ws + OFF_WT) + WT_G2T;
  u16* Y0 = (u16*)(p.ws + OFF_SCR) + (size_t)R * P1LD;
  const u16* Y1 = Y0 + (size_t)R * 1024;
  const float* bonus = (const float*)(p.ws + OFF_BONUS);
  const int lane = otid() & 63, wave = otid() >> 6, wr = wave >> 1, wc = wave & 1, fr = lane & 15, fq = lane >> 4;
  for (int it = 0;; ++it) {
    int mt, nt; if (!next_tile(it, 130, 8, 1, mt, nt)) break;
    ALPlain al{P1 + (size_t)mt * 256 * P1LD + 3328, P1LD};
    f32x4 acc[4][4];
    gemm_main3(al, G2T + (size_t)nt * 128 * 128, 128, 128, acc, smem);
    const int h = nt * 2 + wc;
#pragma unroll
    for (int m = 0; m < 4; ++m) {
      const int row = mt * 256 + wr * 64 + m * 16 + fr;
      float y[4][4]; float sm = 0.f;
#pragma unroll
      for (int n = 0; n < 4; ++n) {
        const int c = h * 64 + n * 16 + fq * 4;
        uint2 a = *(const uint2*)(Y0 + (size_t)row * 1024 + c), b2 = *(const uint2*)(Y1 + (size_t)row * 1024 + c);
        y[n][0] = blo(a.x) + blo(b2.x); y[n][1] = bhi(a.x) + bhi(b2.x); y[n][2] = blo(a.y) + blo(b2.y); y[n][3] = bhi(a.y) + bhi(b2.y);
        sm += y[n][0] + y[n][1] + y[n][2] + y[n][3];
      }
      sm += __shfl_xor(sm, 16); sm += __shfl_xor(sm, 32);
      const float mean = sm * (1.f / 64.f);
      float vs = 0.f;
#pragma unroll
      for (int n = 0; n < 4; ++n)
#pragma unroll
        for (int j = 0; j < 4; ++j) { float dlt = y[n][j] - mean; vs += dlt * dlt; }
      vs += __shfl_xor(vs, 16); vs += __shfl_xor(vs, 32);
      const float rs = rsqrtf(vs * (1.f / 64.f) + 64e-5f);
      const float bn = bonus[(size_t)row * 32 + h * 2] + bonus[(size_t)row * 32 + h * 2 + 1];
#pragma unroll
      for (int n = 0; n < 4; ++n) {
        const int c = h * 64 + n * 16 + fq * 4;
        float4 lg = *(const float4*)(p.in[IRLNG] + jj * 1024 + c), lb = *(const float4*)(p.in[IRLNB] + jj * 1024 + c);
        uint2 v2 = *(const uint2*)(P1 + (size_t)row * P1LD + 2048 + c);
        float o0 = ((y[n][0] - mean) * rs * lg.x + lb.x + bn * blo(v2.x)) * acc[m][n][0];
        float o1 = ((y[n][1] - mean) * rs * lg.y + lb.y + bn * bhi(v2.x)) * acc[m][n][1];
        float o2 = ((y[n][2] - mean) * rs * lg.z + lb.z + bn * blo(v2.y)) * acc[m][n][2];
        float o3 = ((y[n][3] - mean) * rs * lg.w + lb.w + bn * bhi(v2.y)) * acc[m][n][3];
        uint2 w; w.x = pack2(o0, o1); w.y = pack2(o2, o3);
        *(uint2*)(Y0 + (size_t)row * 1024 + c) = w;
      }
    }
  }
}

DI void ph_ssd_s1(const Params& p, int jj, char* smem) {
  const u16* H = (const u16*)(p.ws + OFF_H);
  const u16* BT = (const u16*)(p.ws + OFF_WT) + WT_SX;
  u16* XBC = (u16*)(p.ws + OFF_SCR);
  float* DTg = (float*)(p.ws + OFF_DT);
  float* P = (float*)smem;
  const float* cw = p.in[ISCONVW] + (size_t)jj * 3 * 4096;
  const float* cb = p.in[ISCONVB] + (size_t)jj * 4096;
  const int tid = otid(), lane = tid & 63, wave = tid >> 6, wr = wave >> 1, wc = wave & 1, fr = lane & 15, fq = lane >> 4;
  for (int it = 0;; ++it) {
    int mt, nt; if (!next_tile(it, 134, 33, 1, mt, nt)) break;
    const int b = mt / 67, ml = mt - b * 67;
    int rowbase, t0, len;
    if (ml < 2) { rowbase = b * TS; t0 = ml * 254; len = TC; } else { rowbase = b * TS + TC; t0 = (ml - 2) * 254; len = T; }
    ALHalo al{H + (size_t)rowbase * 1024, t0 - 1, len};
    f32x4 acc[4][4];
    gemm_main3(al, BT + (size_t)nt * 128 * 1024, 1024, 1024, acc, smem);
#pragma unroll
    for (int m = 0; m < 4; ++m)
#pragma unroll
      for (int n = 0; n < 4; ++n) *(f32x4*)&P[(wr * 64 + m * 16 + fr) * 132 + wc * 64 + n * 16 + fq * 4] = acc[m][n];
    __syncthreads();
    if (nt < 32) {
      const int col = tid & 127, rg = tid >> 7, ch = nt * 128 + col;
      const float w0 = cw[ch], w1 = cw[4096 + ch], w2 = cw[8192 + ch], bias = cb[ch];
      const int i0 = 1 + rg * 64, i1 = min(i0 + 64, 255);
      float pv = P[(i0 - 1) * 132 + col], cv = P[i0 * 132 + col];
      for (int i = i0; i < i1; ++i) {
        const float nv = P[(i + 1) * 132 + col];
        const float v = w0 * pv + w1 * cv + w2 * nv + bias;
        const int tt = t0 - 1 + i;
        if (tt < len) XBC[(size_t)(rowbase + tt) * 4096 + ch] = f2b(siluf(v));
        pv = cv; cv = nv;
      }
    } else {
      const int col = tid & 63, rg = tid >> 6;
      const int i0 = 1 + rg * 32, i1 = min(i0 + 32, 255);
      for (int i = i0; i < i1; ++i) { const int tt = t0 - 1 + i; if (tt < len) DTg[(size_t)(rowbase + tt) * 64 + col] = P[i * 132 + col]; }
    }
  }
}
DI void ph_ssd_scan(const Params& p, int jj, char* smem) {
  if (blockIdx.x >= 256) return;
  const u16* XBC = (const u16*)(p.ws + OFF_SCR);
  u16* Y = (u16*)(p.ws + OFF_SCR) + (size_t)R * 4096;
  const float* DTg = (const float*)(p.ws + OFF_DT);
  const int tid = otid(), lane = tid & 63, wave = tid >> 6, fr = lane & 15, fq = lane >> 4;
  const int xcd_ = blockIdx.x & 7, slot_ = blockIdx.x >> 3, gid_ = xcd_ * 2 + (slot_ >> 4), mem_ = slot_ & 15;
  const int b = gid_ >> 3, g = gid_ & 7, head = g * 4 + (mem_ >> 2), pq = mem_ & 3;
  constexpr int DIRB = 80896;
  const int xp_ = tid & 15, xj0 = (tid >> 4) & 15;
  float Aneg[2], dtb[2];
#pragma unroll
  for (int d = 0; d < 2; ++d) { Aneg[d] = -__expf(p.in[ISALOG][(jj * 2 + d) * 32 + head]); dtb[d] = p.in[ISDTB][(jj * 2 + d) * 32 + head]; }
  const float Dsk = p.in[ISD][jj * 32 + head];
  f32x4 hst[2] = {(f32x4){0.f, 0.f, 0.f, 0.f}, (f32x4){0.f, 0.f, 0.f, 0.f}};
  uint4 pre[2][5];
  float dtpre[2] = {0.f, 0.f};
  auto gl_raw = [&](int ci, int d, uint4 (&pr)[5], float& dtp) {
    const int r0 = scan_row(b, d, ci * 64), r63 = scan_row(b, d, ci * 64 + 63);
    const int rmin = min(r0, r63);
    const int cc = tid & 31, rrb = tid >> 5;
    const int gcb = cc < 16 ? 2048 + g * 128 + cc * 8 : 3072 + g * 128 + (cc - 16) * 8;
    const u16* src = XBC + (size_t)(rmin + rrb) * 4096 + gcb;
#pragma unroll
    for (int i = 0; i < 4; ++i) pr[i] = *(const uint4*)(src + (size_t)i * 16 * 4096);
    pr[4] = *(const uint4*)(XBC + (size_t)(rmin + ((tid & 127) >> 1)) * 4096 + head * 64 + pq * 16 + (tid & 1) * 8);
    dtp = DTg[(size_t)(r0 + lane * (d ? -1 : 1)) * 64 + d * 32 + head];
  };
  __syncthreads();
  gl_raw(0, 0, pre[0], dtpre[0]);
  gl_raw(0, 1, pre[1], dtpre[1]);
  for (int ci = 0; ci < 260; ++ci) {
    const bool second = ci < 4 ? (ci >= 2) : (ci - 4 >= 128);
    unsigned ypre[2][2];
#pragma unroll
    for (int d = 0; d < 2; ++d) {
      u16* Cs = (u16*)(smem + d * DIRB); u16* Bs = Cs + 64 * 144; u16* BsT = Bs + 64 * 144; u16* Ms = BsT + 128 * 80;
      u16* XdtT = Ms + 64 * 72; u16* XwT = XdtT + 16 * 80; u16* Hs = XwT + 16 * 80;
      float* Xp = (float*)(Hs + 16 * 144); float* dts = Xp + 64 * 16; float* css = dts + 64;
      const int r0 = scan_row(b, d, ci * 64), rstep = d ? -1 : 1;
      {
        int t2 = tid; asm volatile("" : "+v"(t2));
        const int cc = t2 & 31;
#pragma unroll
        for (int i = 0; i < 4; ++i) {
          const int rr = (t2 >> 5) + 16 * i, j = d ? 63 - rr : rr;
          if (cc < 16) {
            *(uint4*)&Bs[j * 144 + cc * 8] = pre[d][i];
            const u16* hv = (const u16*)&pre[d][i];
#pragma unroll
            for (int e = 0; e < 8; ++e) BsT[(cc * 8 + e) * 80 + (j ^ ((cc & 7) << 3))] = hv[e];
          } else *(uint4*)&Cs[j * 144 + (cc - 16) * 8] = pre[d][i];
        }
        if (t2 < 128) {
          const int rr = t2 >> 1, j = d ? 63 - rr : rr;
          const u16* hv = (const u16*)&pre[d][4];
#pragma unroll
          for (int e = 0; e < 8; ++e) Xp[j * 16 + (tid & 1) * 8 + e] = b2f(hv[e]);
        }
      }
      if (wave == d) {
        const float dt = softplusf(dtpre[d] + dtb[d]);
        float a = dt * Aneg[d];
#pragma unroll
        for (int o = 1; o < 64; o <<= 1) { float tv = __shfl_up(a, o); if (lane >= o) a += tv; }
        dts[lane] = dt; css[lane] = a;
      }
#pragma unroll
      for (int e = 0; e < 4; ++e) Hs[(fq * 4 + e) * 144 + wave * 16 + fr] = f2b(hst[d][e]);
#pragma unroll
      for (int e = 0; e < 2; ++e) {
        const u16* yb = Y + (size_t)(r0 + ((wave & 3) * 16 + fq * 4 + 2 * e) * rstep) * 2048 + head * 64 + pq * 16 + fr;
        ypre[d][e] = (unsigned)yb[0] | ((unsigned)yb[(ptrdiff_t)rstep * 2048] << 16);
      }
      __builtin_amdgcn_sched_barrier(0);
    }
    __builtin_amdgcn_sched_barrier(0);
    if (ci + 1 < 260) { gl_raw(ci + 1, 0, pre[0], dtpre[0]); gl_raw(ci + 1, 1, pre[1], dtpre[1]); }
    lds_barrier();
#pragma unroll
    for (int d = 0; d < 2; ++d) {
      u16* Cs = (u16*)(smem + d * DIRB); u16* Bs = Cs + 64 * 144; u16* BsT = Bs + 64 * 144; u16* Ms = BsT + 128 * 80;
      u16* XdtT = Ms + 64 * 72; u16* XwT = XdtT + 16 * 80; u16* Hs = XwT + 16 * 80;
      float* Xp = (float*)(Hs + 16 * 144); float* dts = Xp + 64 * 16; float* css = dts + 64;
      const float cs63 = css[63];
      if (tid < 256) {
#pragma unroll
        for (int i = 0; i < 4; ++i) {
          const int j = xj0 + 16 * i;
          const float xv = Xp[j * 16 + xp_];
          const float dt = dts[j];
          XdtT[xp_ * 80 + j] = f2b(xv * dt);
          XwT[xp_ * 80 + j] = f2b(xv * dt * __expf(cs63 - css[j]));
        }
      }
      const int ib = wave >> 1;
#pragma unroll
      for (int jb2 = 0; jb2 < 2; ++jb2) {
        const int jb = (wave & 1) * 2 + jb2;
        f32x4 acc = (f32x4){0.f, 0.f, 0.f, 0.f};
#pragma unroll
        for (int ks = 0; ks < 4; ++ks) {
          const bf16x8 bfr = *(const bf16x8*)&Bs[(jb * 16 + fr) * 144 + ks * 32 + fq * 8];
          const bf16x8 cfr = *(const bf16x8*)&Cs[(ib * 16 + fr) * 144 + ks * 32 + fq * 8];
          acc = MFMA(bfr, cfr, acc);
        }
        const int i = ib * 16 + fr;
        const float csi = css[i];
        float mv[4];
#pragma unroll
        for (int e = 0; e < 4; ++e) { const int j = jb * 16 + fq * 4 + e; mv[e] = (j <= i) ? acc[e] * __expf(csi - css[j]) : 0.f; }
        uint2 w; w.x = pack2(mv[0], mv[1]); w.y = pack2(mv[2], mv[3]);
        *(uint2*)&Ms[i * 72 + jb * 16 + fq * 4] = w;
      }
      __builtin_amdgcn_sched_barrier(0);
    }
    lds_barrier();
#pragma unroll
    for (int d = 0; d < 2; ++d) {
      u16* Cs = (u16*)(smem + d * DIRB); u16* Bs = Cs + 64 * 144; u16* BsT = Bs + 64 * 144; u16* Ms = BsT + 128 * 80;
      u16* XdtT = Ms + 64 * 72; u16* XwT = XdtT + 16 * 80; u16* Hs = XwT + 16 * 80;
      float* Xp = (float*)(Hs + 16 * 144); float* dts = Xp + 64 * 16; float* css = dts + 64;
      const int r0 = scan_row(b, d, ci * 64), rstep = d ? -1 : 1;
      const float cs63 = css[63];
      if (wave < 4) {
        const int ib = wave;
        f32x4 yd = (f32x4){0.f, 0.f, 0.f, 0.f}, yo = (f32x4){0.f, 0.f, 0.f, 0.f};
#pragma unroll
        for (int ks = 0; ks < 2; ++ks) {
          const bf16x8 mf = *(const bf16x8*)&Ms[(ib * 16 + fr) * 72 + ks * 32 + fq * 8];
          const bf16x8 xf = *(const bf16x8*)&XdtT[fr * 80 + ks * 32 + fq * 8];
          yd = MFMA(mf, xf, yd);
        }
#pragma unroll
        for (int ks = 0; ks < 4; ++ks) {
          const bf16x8 cf = *(const bf16x8*)&Cs[(ib * 16 + fr) * 144 + ks * 32 + fq * 8];
          const bf16x8 hf = *(const bf16x8*)&Hs[fr * 144 + ks * 32 + fq * 8];
          yo = MFMA(cf, hf, yo);
        }
#pragma unroll
        for (int e = 0; e < 4; ++e) {
          const int i = ib * 16 + fq * 4 + e;
          float y = yd[e] + __expf(css[i]) * yo[e];
          u16* ya = Y + (size_t)(r0 + i * rstep) * 2048 + head * 64 + pq * 16 + fr;
          if (second) y += ((e & 1) ? bhi(ypre[d][e >> 1]) : blo(ypre[d][e >> 1])) + Xp[i * 16 + fr] * Dsk;
          *ya = f2b(y);
        }
      }
      {
        const float dec = __expf(cs63);
        hst[d][0] *= dec; hst[d][1] *= dec; hst[d][2] *= dec; hst[d][3] *= dec;
#pragma unroll
        for (int ks = 0; ks < 2; ++ks) {
          const bf16x8 xf = *(const bf16x8*)&XwT[fr * 80 + ks * 32 + fq * 8];
          const bf16x8 bf = *(const bf16x8*)&BsT[(wave * 16 + fr) * 80 + (((ks * 4 + fq) ^ ((wave * 2 + (fr >> 3)) & 7)) << 3)];
          hst[d] = MFMA(xf, bf, hst[d]);
        }
      }
      __builtin_amdgcn_sched_barrier(0);
    }
    if (ci == 1 || ci == 131) asm volatile("s_waitcnt vmcnt(0)" ::: "memory");
    lds_barrier();
  }
}
DI void ph_ssd_s3(const Params& p, char* smem) {
  const u16* H = (const u16*)(p.ws + OFF_H);
  const u16* BT = (const u16*)(p.ws + OFF_WT) + WT_SZ;
  u16* Y = (u16*)(p.ws + OFF_SCR) + (size_t)R * 4096;
  float* ssq = (float*)(p.ws + OFF_SSQ);
  const int lane = otid() & 63, wave = otid() >> 6, wr = wave >> 1, wc = wave & 1, fr = lane & 15, fq = lane >> 4;
  for (int it = 0;; ++it) {
    int mt, nt; if (!next_tile(it, 130, 16, 1, mt, nt)) break;
    ALPlain al{H + (size_t)mt * 256 * 1024, 1024};
    f32x4 acc[4][4];
    gemm_main3(al, BT + (size_t)nt * 128 * 1024, 1024, 1024, acc, smem);
#pragma unroll
    for (int m = 0; m < 4; ++m) {
      const int row = mt * 256 + wr * 64 + m * 16 + fr;
      float sq = 0.f;
#pragma unroll
      for (int n = 0; n < 4; ++n) {
        const int c = nt * 128 + wc * 64 + n * 16 + fq * 4;
        uint2 yv = *(const uint2*)(Y + (size_t)row * 2048 + c);
        const float o0 = blo(yv.x) * siluf(acc[m][n][0]), o1 = bhi(yv.x) * siluf(acc[m][n][1]);
        const float o2 = blo(yv.y) * siluf(acc[m][n][2]), o3 = bhi(yv.y) * siluf(acc[m][n][3]);
        sq += o0 * o0 + o1 * o1 + o2 * o2 + o3 * o3;
        uint2 w; w.x = pack2(o0, o1); w.y = pack2(o2, o3);
        *(uint2*)(Y + (size_t)row * 2048 + c) = w;
      }
      sq += __shfl_xor(sq, 16); sq += __shfl_xor(sq, 32);
      if (fq == 0) atomicAdd(ssq + (size_t)row * 8 + (nt >> 1), sq);
    }
  }
}
struct ALScale {
  const u16* Y; int row0; const float* rsT; const float* ngT;
  DI uint4 operator()(int i, int k) const { return *(const uint4*)(Y + (size_t)(row0 + i) * 2048 + k); }
  DI uint4 post(uint4 c, int i, int k) const {
    const float rs = rsT[i * 8 + (k >> 8)];
    const float4 g0 = *(const float4*)(ngT + k), g1 = *(const float4*)(ngT + k + 4);
    uint4 o;
    o.x = pack2(blo(c.x) * rs * g0.x, bhi(c.x) * rs * g0.y); o.y = pack2(blo(c.y) * rs * g0.z, bhi(c.y) * rs * g0.w);
    o.z = pack2(blo(c.z) * rs * g1.x, bhi(c.z) * rs * g1.y); o.w = pack2(blo(c.w) * rs * g1.z, bhi(c.w) * rs * g1.w);
    return o;
  }
};
DI void ph_ssd_s4(const Params& p, int l, int jj, char* smem) {
  const u16* Y = (const u16*)(p.ws + OFF_SCR) + (size_t)R * 4096;
  const u16* BT = (const u16*)(p.ws + OFF_WT) + WT_SO;
  for (int it = 0;; ++it) {
    int mt, nt; if (!next_tile(it, 130, 8, 1, mt, nt)) break;
    float* rsT = (float*)(smem + 112640); float* ngT = rsT + 2048;
    {
      const float* ssq = (const float*)(p.ws + OFF_SSQ) + (size_t)mt * 256 * 8;
      const float* ng = p.in[ISNG] + jj * 2048;
      for (int e = otid(); e < 2048; e += 512) { rsT[e] = rsqrtf(ssq[e] * (1.f / 256.f) + 1e-6f); ngT[e] = ng[e]; }
    }
    ALScale al{Y, mt * 256, rsT, ngT};
    resid_tile(p, al, BT, 2048, l, 2, mt, nt, smem);
  }
}

DI void ph_at_qkv(const Params& p, char* smem) {
  const u16* H = (const u16*)(p.ws + OFF_H);
  const u16* BT = (const u16*)(p.ws + OFF_WT) + WT_AQ;
  u16* QKV = (u16*)(p.ws + OFF_SCR);
  const int lane = otid() & 63, wave = otid() >> 6, wr = wave >> 1, wc = wave & 1, fr = lane & 15, fq = lane >> 4;
  for (int it = 0;; ++it) {
    int mt, nt; if (!next_tile(it, 130, 12, 1, mt, nt)) break;
    ALPlain al{H + (size_t)mt * 256 * 1024, 1024};
    f32x4 acc[4][4];
    gemm_main3(al, BT + (size_t)nt * 128 * 1024, 1024, 1024, acc, smem);
    const int q0 = (mt * 256) % TS;
    const bool rope = (q0 >= TC) && (nt < 10);
#pragma unroll
    for (int m = 0; m < 4; ++m) {
      const int rl = wr * 64 + m * 16 + fr;
      const int row = mt * 256 + rl;
      if (rope) {
        const int tt = q0 - TC + rl;
        const float prow = (float)(tt >> 6), pcol = (float)(tt & 63);
#pragma unroll
        for (int e = 0; e < 4; ++e) {
          const float inv = exp2f(-13.287712379549449f * (float)(fq * 4 + e) * (1.f / 16.f));
          float sn, cs;
          sn = __sinf(prow * inv); cs = __cosf(prow * inv);
          float x1 = acc[m][0][e], x2 = acc[m][1][e];
          acc[m][0][e] = x1 * cs - x2 * sn; acc[m][1][e] = x1 * sn + x2 * cs;
          sn = __sinf(pcol * inv); cs = __cosf(pcol * inv);
          x1 = acc[m][2][e]; x2 = acc[m][3][e];
          acc[m][2][e] = x1 * cs - x2 * sn; acc[m][3][e] = x1 * sn + x2 * cs;
        }
      }
#pragma unroll
      for (int n = 0; n < 4; ++n) {
        const int c = nt * 128 + wc * 64 + n * 16 + fq * 4;
        uint2 w; w.x = pack2(acc[m][n][0], acc[m][n][1]); w.y = pack2(acc[m][n][2], acc[m][n][3]);
        *(uint2*)(QKV + (size_t)row * 1536 + c) = w;
      }
    }
  }
}
DI void ph_attn(const Params& p, int jj, char* smem) {
  const u16* QKV = (const u16*)(p.ws + OFF_SCR);
  u16* O = (u16*)(p.ws + OFF_SCR) + (size_t)R * 1536;
  u16* Ks = (u16*)smem;
  u16* Vt = Ks + 64 * 80;
  u16* Ps = Vt + 64 * 80;
  const int tid = otid(), lane = tid & 63, wave = tid >> 6, fr = lane & 15, fq = lane >> 4;
  const int g = wave >> 1, th = (wave & 1) * 32;
  u16* Pw = Ps + wave * 32 * 80;
  for (int tl = (int)(blockIdx.x >> 3); tl < 260; tl += (int)(gridDim.x >> 3)) {
    const int kvh = blockIdx.x & 3, b = (blockIdx.x >> 2) & 1;
    const int isctx = tl >= 256 ? 1 : 0, qb = isctx ? tl - 256 : tl;
    const int t0 = qb * 64, qrow0 = b * TS + (isctx ? 0 : TC) + t0;
    const int head = kvh * 4 + g;
    bf16x8 qf[2][2];
#pragma unroll
    for (int m = 0; m < 2; ++m)
#pragma unroll
      for (int kh = 0; kh < 2; ++kh) {
        uint4 v = *(const uint4*)(QKV + (size_t)(qrow0 + th + m * 16 + fr) * 1536 + head * 64 + kh * 32 + fq * 8);
        uint4 o;
        o.x = pack2(blo(v.x) * 0.125f, bhi(v.x) * 0.125f); o.y = pack2(blo(v.y) * 0.125f, bhi(v.y) * 0.125f);
        o.z = pack2(blo(v.z) * 0.125f, bhi(v.z) * 0.125f); o.w = pack2(blo(v.w) * 0.125f, bhi(v.w) * 0.125f);
        qf[m][kh] = *(bf16x8*)&o;
      }
    const float sink = p.in[IASINK][jj * 16 + head];
    float mrun[2] = {sink, sink}, lrun[2] = {1.f, 1.f};
    f32x4 o[2][4];
#pragma unroll
    for (int m = 0; m < 2; ++m)
#pragma unroll
      for (int n = 0; n < 4; ++n) o[m][n] = (f32x4){0.f, 0.f, 0.f, 0.f};
    const int i_lo = t0 >= 128 ? 0 : (t0 >= 64 ? 1 : 2);
    const int i_hi = t0 == T - 64 ? 2 : (t0 == T - 128 ? 3 : 4);
    const int nkt = isctx ? 4 : 4 + (i_hi - i_lo + 1);
    const int skey = tid >> 3, sdc = (tid & 7) * 8;
    uint4 kreg, vreg;
    auto kv_load = [&](int idx) {
      int krow0;
      if (idx < 4) krow0 = b * TS + idx * 64; else krow0 = b * TS + TC + t0 - 128 + 64 * (i_lo + idx - 4);
      const u16* src = QKV + (size_t)(krow0 + skey) * 1536 + 1024 + kvh * 64 + sdc;
      kreg = *(const uint4*)src; vreg = *(const uint4*)(src + 256);
    };
    kv_load(0);
    for (int kt = 0; kt < nkt; ++kt) {
      const int li = i_lo + kt - 4;
      const int mode = kt < 4 ? 0 : (li == 0 ? 1 : (li == 4 ? 2 : 0));
      lds_barrier();
      {
        *(uint4*)&Ks[skey * 80 + sdc] = kreg;
        const u16* vv = (const u16*)&vreg;
#pragma unroll
        for (int e = 0; e < 8; ++e) Vt[(sdc + e) * 80 + (skey ^ ((tid & 7) << 3))] = vv[e];
      }
      lds_barrier();
      if (kt + 1 < nkt) kv_load(kt + 1);
      f32x4 sacc[2][4];
#pragma unroll
      for (int m = 0; m < 2; ++m)
#pragma unroll
        for (int n = 0; n < 4; ++n) sacc[m][n] = (f32x4){0.f, 0.f, 0.f, 0.f};
#pragma unroll
      for (int kh = 0; kh < 2; ++kh)
#pragma unroll
        for (int n = 0; n < 4; ++n) {
          const bf16x8 kf = *(const bf16x8*)&Ks[(n * 16 + fr) * 80 + kh * 32 + fq * 8];
#pragma unroll
          for (int m = 0; m < 2; ++m) sacc[m][n] = MFMA(kf, qf[m][kh], sacc[m][n]);
        }
#pragma unroll
      for (int m = 0; m < 2; ++m) {
        const int qi = th + m * 16 + fr;
        float mx = -3.0e38f;
#pragma unroll
        for (int n = 0; n < 4; ++n)
#pragma unroll
          for (int e = 0; e < 4; ++e) {
            const int ki = n * 16 + fq * 4 + e;
            if ((mode == 1 && ki < qi) || (mode == 2 && ki > qi)) sacc[m][n][e] = -INFINITY;
            mx = fmaxf(mx, sacc[m][n][e]);
          }
        mx = fmaxf(mx, __shfl_xor(mx, 16)); mx = fmaxf(mx, __shfl_xor(mx, 32));
        const float mnew = fmaxf(mrun[m], mx);
        const float alpha = __expf(mrun[m] - mnew);
        float ps = 0.f;
#pragma unroll
        for (int n = 0; n < 4; ++n) {
          const float p0 = __expf(sacc[m][n][0] - mnew), p1 = __expf(sacc[m][n][1] - mnew), p2 = __expf(sacc[m][n][2] - mnew), p3 = __expf(sacc[m][n][3] - mnew);
          ps += p0 + p1 + p2 + p3;
          uint2 w; w.x = pack2(p0, p1); w.y = pack2(p2, p3);
          *(uint2*)&Pw[(m * 16 + fr) * 80 + n * 16 + fq * 4] = w;
        }
        ps += __shfl_xor(ps, 16); ps += __shfl_xor(ps, 32);
        lrun[m] = lrun[m] * alpha + ps; mrun[m] = mnew;
#pragma unroll
        for (int n = 0; n < 4; ++n) { o[m][n][0] *= alpha; o[m][n][1] *= alpha; o[m][n][2] *= alpha; o[m][n][3] *= alpha; }
      }
      __builtin_amdgcn_fence(__ATOMIC_RELEASE, "wavefront");
      __builtin_amdgcn_wave_barrier();
      __builtin_amdgcn_fence(__ATOMIC_ACQUIRE, "wavefront");
#pragma unroll
      for (int ks = 0; ks < 2; ++ks) {
        bf16x8 pf[2];
#pragma unroll
        for (int m = 0; m < 2; ++m) pf[m] = *(const bf16x8*)&Pw[(m * 16 + fr) * 80 + ks * 32 + fq * 8];
#pragma unroll
        for (int nd = 0; nd < 4; ++nd) {
          const bf16x8 vf = *(const bf16x8*)&Vt[(nd * 16 + fr) * 80 + (((ks * 4 + fq) ^ ((nd * 2 + (fr >> 3)) & 7)) << 3)];
#pragma unroll
          for (int m = 0; m < 2; ++m) o[m][nd] = MFMA(vf, pf[m], o[m][nd]);
        }
      }
    }
#pragma unroll
    for (int m = 0; m < 2; ++m) {
      const float il = 1.f / lrun[m];
      const int row = qrow0 + th + m * 16 + fr;
#pragma unroll
      for (int nd = 0; nd < 4; ++nd) {
        uint2 w; w.x = pack2(o[m][nd][0] * il, o[m][nd][1] * il); w.y = pack2(o[m][nd][2] * il, o[m][nd][3] * il);
        *(uint2*)(O + (size_t)row * 1024 + head * 64 + nd * 16 + fq * 4) = w;
      }
    }
  }
}

#define DBL_A 0
#define DBL_B 0
#define DBL_C 0
#define DBL_D 0
#define DBL_E 0
DI int layer_phases(int l) { int k = l % 3; return k == 0 ? 25 : (k == 1 ? 8 : 7); }
constexpr int N_PHASES = 2 + 25 + 8 + 7 + 25 + 1;

DI void run_phase(const Params& p, int ph, char* smem) {
  if (ph == 0) { ph_prologue(p, smem); ph_convert(p, 0, smem); return; }
  if (ph == 1) { ph_modreduce(p); return; }
  int q = ph - 2, l = 0;
  while (l < 4 && q >= layer_phases(l)) { q -= layer_phases(l); ++l; }
  if (l == 4) { ph_final(p); return; }
  const int kind = l % 3, jj = l / 3;
  const int np = layer_phases(l);
  const u16* wt = (const u16*)(p.ws + OFF_WT);
  if (q == 0) { ph_norm(p, l, 0); if (l > 0) ph_convert(p, l, smem); return; }
  if (q == np - 3) { ph_norm(p, l, 1); return; }
  if (q == np - 2) { ph_ffn1(p, l, smem);
#if DBL_A
    ph_ffn1(p, l, smem);
#endif
    return; }
  if (q == np - 1) { ph_resid_gemm(p, (const u16*)(p.ws + OFF_SCR), FF, wt + WT_W2T, FF, l, 5, smem); return; }
  if (kind == 0) {
    if (q == 1) { ph_rw_r1(p, jj, smem);
#if DBL_A
    ph_rw_r1(p, jj, smem);
#endif
    return; }
    if (q >= 2 && q <= 19) { int s = q - 2; if (s >= 1) {
#if DBL_D
      ph_rw_scan(p, s - 1, smem, false);
#endif
      ph_rw_scan(p, s - 1, smem); }
      if (s < 17) { ph_rw_produce(p, jj, s, smem);
#if DBL_E
      ph_rw_produce(p, jj, s, smem);
#endif
      } return; }
    if (q == 20) { ph_rw_finish(p, jj, smem); return; }
    if (q == 21) { ph_resid_gemm(p, (const u16*)(p.ws + OFF_SCR) + (size_t)R * P1LD, 1024, wt + WT_RWO, 1024, l, 2, smem); return; }
  } else if (kind == 1) {
    if (q == 1) { ph_ssd_s1(p, jj, smem); return; }
    if (q == 2) { ph_ssd_scan(p, jj, smem);
#if DBL_B
    ph_ssd_scan(p, jj, smem);
#endif
    return; }
    if (q == 3) { ph_ssd_s3(p, smem); return; }
    if (q == 4) { ph_ssd_s4(p, l, jj, smem); return; }
  } else {
    if (q == 1) { ph_at_qkv(p, smem);
#if DBL_A
    ph_at_qkv(p, smem);
#endif
    return; }
    if (q == 2) { ph_attn(p, jj, smem);
#if DBL_C
    ph_attn(p, jj, smem);
#endif
    return; }
    if (q == 3) { ph_resid_gemm(p, (const u16*)(p.ws + OFF_SCR) + (size_t)R * 1536, 1024, wt + WT_AO, 1024, l, 2, smem); return; }
  }
}

extern "C" __global__ void __launch_bounds__(512) mega(Params p, int ph_lo, int ph_hi) {
  extern __shared__ __attribute__((aligned(16))) char smem[];
  cg::grid_group grid = cg::this_grid();
#ifndef PROBE
#define PROBE 0
#endif
#if PROBE
  unsigned long long* tsb = (unsigned long long*)(p.ws + OFF_MODP);
#endif
  __shared__ uint4 xb_words;
  if (threadIdx.x == 0) xb_words = make_uint4(0u, 0u, 0u, 0u);
  __syncthreads();
  XcdBarrier xb = xcd_barrier_post((unsigned*)(p.ws + OFF_BAR), (volatile LAS unsigned*)&xb_words);
  for (int ph = ph_lo; ph < ph_hi; ++ph) {
    run_phase(p, ph, smem);
    if (ph + 1 < ph_hi) { if (ph == ph_lo) grid.sync(); else xcd_barrier(xb); }
  }
#if PROBE
  grid.sync();
  if (blockIdx.x == 0) {
    const float t1 = (float)(tsb[PA1] - tsb[PA0]) * 1e-5f, t2 = (float)(tsb[PB1] - tsb[PB0]) * 1e-5f;
    for (int i = threadIdx.x; i < (1 << 23); i += 512) p.out[i] = t2;
    __syncthreads();
    if (threadIdx.x == 0) p.out[0] = 64.f * t1;
  }
#endif
}

extern "C" void kernel_launch(void* const* d_in, const int* in_sizes, int n_in, void* d_out, int out_size, void* d_ws, size_t ws_size, hipStream_t stream) {
  Params p{};
  for (int i = 0; i < 41; ++i) p.in[i] = (const float*)d_in[i];
  p.out = (float*)d_out; p.ws = (char*)d_ws;
  constexpr size_t kLds = 162048;
  hipFuncSetAttribute((const void*)mega, hipFuncAttributeMaxDynamicSharedMemorySize, (int)kLds);
  hipMemsetAsync((char*)d_ws + OFF_BAR, 0, XCD_BAR_WORDS * 4, stream);
  int lo = 0, hi = N_PHASES;
  void* args[] = {&p, &lo, &hi};
  hipError_t e = hipLaunchCooperativeKernel((void*)mega, dim3(256), dim3(512), args, kLds, stream);
  if (e != hipSuccess) fprintf(stderr, "coop launch failed: %s\n", hipGetErrorString(e));
}
```

```cpp
#include <hip/hip_runtime.h>
#include <hip/hip_cooperative_groups.h>
#include <hip/hip_fp16.h>
#include <cstdio>
namespace cg = cooperative_groups;

typedef unsigned short u16;
typedef short bf16x8 __attribute__((ext_vector_type(8)));
typedef float f32x4 __attribute__((ext_vector_type(4)));
typedef float f32x2 __attribute__((ext_vector_type(2)));
#define MFMA(a, b, c) __builtin_amdgcn_mfma_f32_16x16x32_bf16(a, b, c, 0, 0, 0)
#define DI __device__ __forceinline__

constexpr int D = 1024, NBAT = 2, T = 16384, TC = 256, TS = T + TC, R = NBAT * TS, FF = 2816;
enum { IX = 0, IC, ICTX, ICC, IADAW, IADAB, IN1, IN2, IFWIN, IFCONV, IFWOUT, IFINAL, IRMU, IRWR, IRWK, IRWV, IRWO, IRW0, IRW1, IRW2, IRA0, IRA1,
       IRA2, IRG1, IRG2, IRKK, IRKA, IRRK, IRLNG, IRLNB, ISWIN, ISCONVW, ISCONVB, ISDTB, ISALOG, ISD, ISNG, ISWOUT, IAQKV, IAWO, IASINK };

__device__ __forceinline__ unsigned long long rfl64(unsigned long long v) {
  unsigned lo = __builtin_amdgcn_readfirstlane((unsigned)v), hi = __builtin_amdgcn_readfirstlane((unsigned)(v >> 32));
  return ((unsigned long long)hi << 32) | lo;
}
struct Params {
  const float* in[41]; float* out; char* ws;
  __device__ __forceinline__ const float* inp(int i) const { return (const float*)rfl64((unsigned long long)in[i]); }
  __device__ __forceinline__ float* outp() const { return (float*)rfl64((unsigned long long)out); }
  __device__ __forceinline__ char* wsp() const { return (char*)rfl64((unsigned long long)ws); }
};

constexpr size_t alup(size_t x) { return (x + 255) & ~(size_t)255; }
constexpr size_t OFF_XC = 0;
constexpr size_t OFF_BAR = OFF_XC + alup((size_t)512 * 1024 * 4);
constexpr size_t OFF_MODP = OFF_BAR + 16384;
constexpr size_t OFF_MOD = OFF_MODP + alup((size_t)16 * 4 * 3 * 6144 * 4);
constexpr size_t OFF_SSQ = OFF_MOD + alup((size_t)4 * 3 * 6144 * 4);
constexpr size_t OFF_DT = OFF_SSQ + alup((size_t)R * 8 * 4);
constexpr size_t OFF_BONUS = OFF_DT;
constexpr size_t OFF_RWST = OFF_DT + alup((size_t)R * 64 * 4);
constexpr size_t OFF_H = OFF_RWST + alup((size_t)256 * 256 * 4 * 4);
constexpr size_t OFF_RING = OFF_H;
constexpr size_t OFF_WT = OFF_H + alup((size_t)R * 1024 * 2);
constexpr size_t WT_ELEMS = 17170432;
constexpr size_t OFF_SCR = OFF_WT + alup(WT_ELEMS * 2);
constexpr size_t SCR_BYTES = (size_t)R * 4096 * 2 + (size_t)R * 2048 * 2;
static_assert(OFF_SCR + SCR_BYTES <= (size_t)536870912, "workspace too large");
constexpr size_t WT_W1T = 0, WT_W2T = (size_t)5632 * 1024, WT_MIX = WT_W2T + (size_t)1024 * 2816;
constexpr size_t WT_R1T = WT_MIX, WT_LUT = WT_R1T + (size_t)3456 * 1024, WT_G2T = WT_LUT + (size_t)2 * 16 * 128 * 128, WT_RWO = WT_G2T + (size_t)1024 * 128;
constexpr size_t WT_SX = WT_MIX, WT_SZ = WT_SX + (size_t)4224 * 1024, WT_SO = WT_SZ + (size_t)2048 * 1024;
constexpr size_t WT_AQ = WT_MIX, WT_AO = WT_AQ + (size_t)1536 * 1024;
static_assert(WT_SO + (size_t)1024 * 2048 <= WT_ELEMS, "wt");
static_assert((size_t)2 * 2 * 2 * 1024 * 16 * 512 <= (size_t)R * 1024 * 2, "ring");

DI u16 f2b(float f) { unsigned u = __float_as_uint(f); u += 0x7fffu + ((u >> 16) & 1u); return (u16)(u >> 16); }
DI float b2f(u16 h) { return __uint_as_float(((unsigned)h) << 16); }
DI unsigned pack2(float a, float b) { return (unsigned)f2b(a) | ((unsigned)f2b(b) << 16); }
DI float blo(unsigned u) { return __uint_as_float(u << 16); }
DI float bhi(unsigned u) { return __uint_as_float(u & 0xffff0000u); }
DI float siluf(float x) { return x / (1.f + __expf(-x)); }
DI float sigmf(float x) { return 1.f / (1.f + __expf(-x)); }
DI float softplusf(float x) { return x > 20.f ? x : log1pf(__expf(x)); }
DI int otid() { int t = threadIdx.x; asm volatile("" : "+v"(t)); return t; }
DI void lds_barrier() { asm volatile("s_waitcnt lgkmcnt(0)\n\ts_barrier" ::: "memory"); }
DI f32x4 gload_f4(const float* p) { f32x4 v; asm volatile("global_load_dwordx4 %0, %1, off" : "=v"(v) : "v"(p) : "memory"); return v; }
DI void vm_wait0() { asm volatile("s_waitcnt vmcnt(0)" ::: "memory"); }
DI float wsum(float v) { for (int o = 32; o; o >>= 1) v += __shfl_xor(v, o); return v; }
DI float* xrow_ptr(const Params& p, int r) {
  int b = r / TS, q = r - b * TS;
  return q < TC ? (float*)(p.ws + OFF_XC) + ((size_t)(b * TC + q) << 10) : p.out + ((size_t)(b * T + q - TC) << 10);
}
DI const float* xin_ptr(const Params& p, int r) {
  int b = r / TS, q = r - b * TS;
  return q < TC ? p.in[ICTX] + ((size_t)(b * TC + q) << 10) : p.in[IX] + ((size_t)(b * T + q - TC) << 10);
}
DI const float* mod_ptr(const Params& p, int l, int r) {
  int b = r / TS, q = r - b * TS;
  int v = q < TC ? 2 : b;
  return (const float*)(p.ws + OFF_MOD) + (size_t)(l * 3 + v) * 6144;
}


#define XB_TMO      128
#define XB_XCNT(j)  (256  + 64 * (j))
#define XB_XSUB(j)  (1280 + 64 * (j))
#define XB_XGEN(j)  (2304 + 64 * (j))
#define XB_TOP      3328
#define XB_TOPGEN   3392
#define XCD_BAR_WORDS 3456
#define XB_SPIN_CAP (1u << 18)
#define LAS __attribute__((address_space(3)))
DI unsigned xb_ld(unsigned* p) { return __hip_atomic_load(p, __ATOMIC_RELAXED, __HIP_MEMORY_SCOPE_AGENT); }
DI unsigned xb_add(unsigned* p, unsigned v) { return __hip_atomic_fetch_add(p, v, __ATOMIC_RELAXED, __HIP_MEMORY_SCOPE_AGENT); }
DI unsigned xb_xcc_id() { return (unsigned)__builtin_amdgcn_s_getreg((3 << 11) | 20) & 0xFu; }
#define XB_SPIN(cond, bar) do { unsigned _sp = 0; while (cond) { __builtin_amdgcn_s_sleep(1); \
    if ((++_sp & 255u) == 0u) { if (xb_ld(&(bar)[XB_TMO])) break; if (_sp > XB_SPIN_CAP) { atomicAdd(&(bar)[XB_TMO], 1u); break; } } } } while (0)
struct XcdBarrier { unsigned* bar; unsigned x; volatile LAS unsigned* st; };
DI XcdBarrier xcd_barrier_post(unsigned* bar, volatile LAS unsigned* st) {
  XcdBarrier b; b.bar = bar; b.x = xb_xcc_id(); b.st = st;
  if (threadIdx.x == 0) (void)xb_add(&bar[XB_XCNT(b.x)], 1u);
  return b;
}
DI void xcd_barrier_complete(unsigned* bar, unsigned x, unsigned& nloc, unsigned& nx) {
  const unsigned G = gridDim.x * gridDim.y * gridDim.z;
  unsigned sum, cnt, mine, sp = 0u;
  for (;;) {
    sum = 0u; cnt = 0u; mine = 0u;
#pragma unroll
    for (unsigned j = 0; j < 16; ++j) { const unsigned c = xb_ld(&bar[XB_XCNT(j)]); sum += c; cnt += (c > 0u) ? 1u : 0u; mine = (j == x) ? c : mine; }
    if (sum == G) break;
    __builtin_amdgcn_s_sleep(1);
    if ((++sp & 255u) == 0u) { if (xb_ld(&bar[XB_TMO])) break; if (sp > XB_SPIN_CAP) { atomicAdd(&bar[XB_TMO], 1u); break; } }
  }
  nloc = mine > 0u ? mine : 1u; nx = cnt > 0u ? cnt : 1u;
}
DI void xcd_barrier(const XcdBarrier& b) {
  asm volatile("s_waitcnt vmcnt(0)" ::: "memory");
  __syncthreads();
  if (threadIdx.x == 0) {
    unsigned* bar = b.bar;
    __builtin_amdgcn_s_waitcnt(0);
    unsigned nloc = b.st[0], nx = b.st[1];
    if (nloc == 0u) { xcd_barrier_complete(bar, b.x, nloc, nx); b.st[0] = nloc; b.st[1] = nx; }
    const unsigned old = xb_add(&bar[XB_XSUB(b.x)], 1u);
    const unsigned gen = old / nloc;
    if (old + 1u == (gen + 1u) * nloc) {
      __builtin_amdgcn_fence(__ATOMIC_RELEASE, "agent");
      asm volatile("s_waitcnt vmcnt(0)" ::: "memory");
      const unsigned og = xb_add(&bar[XB_TOP], 1u);
      const unsigned tg = og / nx;
      if (og + 1u == (tg + 1u) * nx) xb_add(&bar[XB_TOPGEN], 1u);
      else XB_SPIN(xb_ld(&bar[XB_TOPGEN]) == tg, bar);
      __builtin_amdgcn_fence(__ATOMIC_ACQUIRE, "agent");
      xb_add(&bar[XB_XGEN(b.x)], 1u);
      asm volatile("s_waitcnt vmcnt(0)" ::: "memory");
    } else {
      XB_SPIN(xb_ld(&bar[XB_XGEN(b.x)]) == gen, bar);
      __builtin_amdgcn_fence(__ATOMIC_ACQUIRE, "agent");
      asm volatile("s_waitcnt vmcnt(0)" ::: "memory");
    }
  }
  __syncthreads();
}

constexpr int LDS_ROW = 64;
struct SmemG { u16 A[2][256 * LDS_ROW]; u16 B[2][128 * LDS_ROW]; };
template <class AL>
DI void gemm_main(const AL& al, const u16* __restrict__ Bt, int ldb, int K, f32x4 (&acc)[4][4], char* smem) {
  SmemG& s = *(SmemG*)smem;
  const int tid = otid(), lane = tid & 63, wave = tid >> 6, wr = wave >> 1, wc = wave & 1, fr = lane & 15, fq = lane >> 4;
#pragma unroll
  for (int m = 0; m < 4; ++m)
#pragma unroll
    for (int n = 0; n < 4; ++n) acc[m][n] = (f32x4){0.f, 0.f, 0.f, 0.f};
  uint4 ra[4], rb[2];
  const int nk = K >> 6;
  const int lrow = tid >> 3, lkc = (tid & 7) * 8, lsw = ((tid & 7) ^ (lrow & 7)) * 8;
  __syncthreads();
#pragma unroll
  for (int i = 0; i < 4; ++i) ra[i] = al(lrow + i * 64, lkc);
#pragma unroll
  for (int i = 0; i < 2; ++i) rb[i] = *(const uint4*)(Bt + (size_t)(lrow + i * 64) * ldb + lkc);
#pragma unroll
  for (int i = 0; i < 4; ++i) *(uint4*)&s.A[0][(lrow + i * 64) * LDS_ROW + lsw] = al.post(ra[i], lrow + i * 64, lkc);
#pragma unroll
  for (int i = 0; i < 2; ++i) *(uint4*)&s.B[0][(lrow + i * 64) * LDS_ROW + lsw] = rb[i];
  __syncthreads();
  for (int kt = 0; kt < nk; ++kt) {
    const int buf = kt & 1;
    const int kn = (kt + 1 < nk ? kt + 1 : kt) * 64 + lkc;
#pragma unroll
    for (int i = 0; i < 2; ++i) {
      const u16* bp = Bt + (size_t)(lrow + i * 64) * ldb + kn;
      asm volatile("global_load_dwordx4 %0, %1, off" : "=v"(rb[i]) : "v"(bp) : "memory");
    }
#pragma unroll
    for (int i = 0; i < 4; ++i) ra[i] = al(lrow + i * 64, kn);
    __builtin_amdgcn_sched_barrier(0);
#pragma unroll
    for (int kh = 0; kh < 2; ++kh) {
      bf16x8 a[4], b[4];
#pragma unroll
      for (int m = 0; m < 4; ++m) a[m] = *(const bf16x8*)&s.A[buf][(wr * 64 + m * 16 + fr) * LDS_ROW + (((kh * 4 + fq) ^ (fr & 7)) << 3)];
#pragma unroll
      for (int n = 0; n < 4; ++n) b[n] = *(const bf16x8*)&s.B[buf][(wc * 64 + n * 16 + fr) * LDS_ROW + (((kh * 4 + fq) ^ (fr & 7)) << 3)];
      __builtin_amdgcn_s_setprio(1);
#pragma unroll
      for (int m = 0; m < 4; ++m)
#pragma unroll
        for (int n = 0; n < 4; ++n) acc[m][n] = MFMA(b[n], a[m], acc[m][n]);
      __builtin_amdgcn_s_setprio(0);
    }
    asm volatile("s_waitcnt vmcnt(0)" ::: "memory");
#pragma unroll
    for (int i = 0; i < 4; ++i) *(uint4*)&s.A[buf ^ 1][(lrow + i * 64) * LDS_ROW + lsw] = al.post(ra[i], lrow + i * 64, kn);
#pragma unroll
    for (int i = 0; i < 2; ++i) *(uint4*)&s.B[buf ^ 1][(lrow + i * 64) * LDS_ROW + lsw] = rb[i];
    __syncthreads();
  }
}

template <class AL>
DI void gemm_main3(const AL& al, const u16* __restrict__ Bt, int ldb, int K, f32x4 (&acc)[4][4], char* smem) {
  SmemG& s = *(SmemG*)smem;
  const int tid = otid(), lane = tid & 63, wave = tid >> 6, wr = wave >> 1, wc = wave & 1, fr = lane & 15, fq = lane >> 4;
  const bool grpY = __builtin_amdgcn_readfirstlane(wave) >= 4;
#pragma unroll
  for (int m = 0; m < 4; ++m)
#pragma unroll
    for (int n = 0; n < 4; ++n) acc[m][n] = (f32x4){0.f, 0.f, 0.f, 0.f};
  uint4 ra[4], rb[2];
  const int nk = K >> 6;
  const int lrow = tid >> 3, lkc = (tid & 7) * 8, lsw = ((tid & 7) ^ (lrow & 7)) * 8;
  __syncthreads();
#pragma unroll
  for (int i = 0; i < 4; ++i) ra[i] = al(lrow + i * 64, lkc);
#pragma unroll
  for (int i = 0; i < 2; ++i) rb[i] = *(const uint4*)(Bt + (size_t)(lrow + i * 64) * ldb + lkc);
#pragma unroll
  for (int i = 0; i < 4; ++i) *(uint4*)&s.A[0][(lrow + i * 64) * LDS_ROW + lsw] = al.post(ra[i], lrow + i * 64, lkc);
#pragma unroll
  for (int i = 0; i < 2; ++i) *(uint4*)&s.B[0][(lrow + i * 64) * LDS_ROW + lsw] = rb[i];
  __syncthreads();
  const u16* abase = &s.A[0][(wr * 64 + fr) * LDS_ROW];
  const u16* bbase = &s.B[0][(wc * 64 + fr) * LDS_ROW];
  bf16x8 fa[4], fb[4];
#define G3_RD(BUF, KH) do { \
    _Pragma("unroll") for (int m = 0; m < 4; ++m) fa[m] = *(const bf16x8*)(abase + (BUF) * 256 * LDS_ROW + m * 16 * LDS_ROW + ((((KH) * 4 + fq) ^ (fr & 7)) << 3)); \
    _Pragma("unroll") for (int n = 0; n < 4; ++n) fb[n] = *(const bf16x8*)(bbase + (BUF) * 128 * LDS_ROW + n * 16 * LDS_ROW + ((((KH) * 4 + fq) ^ (fr & 7)) << 3)); } while (0)
#define G3_MM() do { \
    _Pragma("unroll") for (int m = 0; m < 4; ++m) _Pragma("unroll") for (int n = 0; n < 4; ++n) acc[m][n] = MFMA(fb[n], fa[m], acc[m][n]); } while (0)
  int kn = (1 < nk ? 1 : 0) * 64 + lkc;
#pragma unroll
  for (int i = 0; i < 2; ++i) {
    const u16* bp = Bt + (size_t)(lrow + i * 64) * ldb + kn;
    asm volatile("global_load_dwordx4 %0, %1, off" : "=v"(rb[i]) : "v"(bp) : "memory");
  }
#pragma unroll
  for (int i = 0; i < 4; ++i) ra[i] = al(lrow + i * 64, kn);
  if (grpY) G3_RD(0, 0);
  __builtin_amdgcn_sched_barrier(0);
  for (int kt = 0; kt < nk; ++kt) {
    const int buf = kt & 1;
    if (!grpY) G3_RD(buf, 0);
    __builtin_amdgcn_sched_barrier(0);
    G3_MM();
    __builtin_amdgcn_sched_barrier(0);
    if (grpY) G3_RD(buf, 1);
    __builtin_amdgcn_sched_barrier(0);
    asm volatile("s_waitcnt vmcnt(0)" ::: "memory");
#pragma unroll
    for (int i = 0; i < 4; ++i) *(uint4*)&s.A[buf ^ 1][(lrow + i * 64) * LDS_ROW + lsw] = al.post(ra[i], lrow + i * 64, kn);
#pragma unroll
    for (int i = 0; i < 2; ++i) *(uint4*)&s.B[buf ^ 1][(lrow + i * 64) * LDS_ROW + lsw] = rb[i];
    if (kt + 2 < nk) {
      kn = (kt + 2) * 64 + lkc;
#pragma unroll
      for (int i = 0; i < 2; ++i) {
        const u16* bp = Bt + (size_t)(lrow + i * 64) * ldb + kn;
        asm volatile("global_load_dwordx4 %0, %1, off" : "=v"(rb[i]) : "v"(bp) : "memory");
      }
#pragma unroll
      for (int i = 0; i < 4; ++i) ra[i] = al(lrow + i * 64, kn);
    }
    __builtin_amdgcn_sched_barrier(0);
    lds_barrier();
    if (!grpY) G3_RD(buf, 1);
    __builtin_amdgcn_sched_barrier(0);
    G3_MM();
    __builtin_amdgcn_sched_barrier(0);
    if (grpY) G3_RD(buf ^ 1, 0);
    __builtin_amdgcn_sched_barrier(0);
    lds_barrier();
  }
  asm volatile("s_waitcnt vmcnt(0)" ::: "memory");
  __syncthreads();
}

template <class AL>
DI void gemm_main4(const AL& al, const u16* __restrict__ Bt, int ldb, int K, f32x4 (&acc)[4][4], char* smem) {
  SmemG& s = *(SmemG*)smem;
  const int tid = otid(), lane = tid & 63, wave = tid >> 6, wr = wave >> 1, wc = wave & 1, fr = lane & 15, fq = lane >> 4;
#pragma unroll
  for (int m = 0; m < 4; ++m)
#pragma unroll
    for (int n = 0; n < 4; ++n) acc[m][n] = (f32x4){0.f, 0.f, 0.f, 0.f};
  uint4 a0[4], a1[4], b00, b01, b10, b11;
  const int nk = K >> 6;
  const int lrow = tid >> 3, lkc = (tid & 7) * 8, lsw = ((tid & 7) ^ (lrow & 7)) * 8;
  __syncthreads();
#pragma unroll
  for (int i = 0; i < 4; ++i) a0[i] = al(lrow + i * 64, lkc);
#pragma unroll
  for (int i = 0; i < 1; ++i) { b00 = *(const uint4*)(Bt + (size_t)lrow * ldb + lkc); b01 = *(const uint4*)(Bt + (size_t)(lrow + 64) * ldb + lkc); }
#pragma unroll
  for (int i = 0; i < 4; ++i) *(uint4*)&s.A[0][(lrow + i * 64) * LDS_ROW + lsw] = al.post(a0[i], lrow + i * 64, lkc);
#pragma unroll
  for (int i = 0; i < 1; ++i) { *(uint4*)&s.B[0][lrow * LDS_ROW + lsw] = b00; *(uint4*)&s.B[0][(lrow + 64) * LDS_ROW + lsw] = b01; }
  __syncthreads();
  auto g4_load = [&](uint4 (&RA)[4], uint4& RB0, uint4& RB1, int KN) {
#pragma unroll
    for (int i = 0; i < 4; ++i) RA[i] = al(lrow + i * 64, KN);
    RB0 = *(const uint4*)(Bt + (size_t)lrow * ldb + KN);
    RB1 = *(const uint4*)(Bt + (size_t)(lrow + 64) * ldb + KN);
  };
  auto g4_store = [&](uint4 (&RA)[4], uint4& RB0, uint4& RB1, int BUF, int KN) {
#pragma unroll
    for (int i = 0; i < 4; ++i) *(uint4*)&s.A[BUF][(lrow + i * 64) * LDS_ROW + lsw] = al.post(RA[i], lrow + i * 64, KN);
    *(uint4*)&s.B[BUF][lrow * LDS_ROW + lsw] = RB0;
    *(uint4*)&s.B[BUF][(lrow + 64) * LDS_ROW + lsw] = RB1;
  };
#define G4_COMPUTE(BUF) do { \
    _Pragma("unroll") for (int kh = 0; kh < 2; ++kh) { \
      bf16x8 a[4], b[4]; \
      _Pragma("unroll") for (int m = 0; m < 4; ++m) a[m] = *(const bf16x8*)&s.A[BUF][(wr * 64 + m * 16 + fr) * LDS_ROW + (((kh * 4 + fq) ^ (fr & 7)) << 3)]; \
      _Pragma("unroll") for (int n = 0; n < 4; ++n) b[n] = *(const bf16x8*)&s.B[BUF][(wc * 64 + n * 16 + fr) * LDS_ROW + (((kh * 4 + fq) ^ (fr & 7)) << 3)]; \
      __builtin_amdgcn_s_setprio(1); \
      _Pragma("unroll") for (int m = 0; m < 4; ++m) _Pragma("unroll") for (int n = 0; n < 4; ++n) acc[m][n] = MFMA(b[n], a[m], acc[m][n]); \
      __builtin_amdgcn_s_setprio(0); } } while (0)
  int k1 = 64 + lkc, k2 = (2 < nk ? 2 : nk - 1) * 64 + lkc;
  g4_load(a0, b00, b01, k1);
  g4_load(a1, b10, b11, k2);
  __builtin_amdgcn_sched_barrier(0);
  for (int kt = 0; kt < nk; kt += 2) {
    G4_COMPUTE(0);
    __builtin_amdgcn_sched_barrier(0);
    g4_store(a0, b00, b01, 1, k1);
    k1 = (kt + 3 < nk ? kt + 3 : nk - 1) * 64 + lkc;
    g4_load(a0, b00, b01, k1);
    __builtin_amdgcn_sched_barrier(0);
    __syncthreads();
    G4_COMPUTE(1);
    __builtin_amdgcn_sched_barrier(0);
    g4_store(a1, b10, b11, 0, k2);
    k2 = (kt + 4 < nk ? kt + 4 : nk - 1) * 64 + lkc;
    g4_load(a1, b10, b11, k2);
    __builtin_amdgcn_sched_barrier(0);
    __syncthreads();
  }
}


struct SmemG2 { u16 A[2][256 * LDS_ROW]; u16 B[2][256 * LDS_ROW]; };
template <class AL>
DI void gemm_main2(const AL& al, const u16* __restrict__ Bt, int ldb, int K, f32x4 (&acc)[4][8], char* smem) {
  SmemG2& s = *(SmemG2*)smem;
  const int tid = otid(), lane = tid & 63, wave = tid >> 6, wr = wave >> 1, wc = wave & 1, fr = lane & 15, fq = lane >> 4;
#pragma unroll
  for (int m = 0; m < 4; ++m)
#pragma unroll
    for (int n = 0; n < 8; ++n) acc[m][n] = (f32x4){0.f, 0.f, 0.f, 0.f};
  uint4 ra[4], rb[4];
  const int nk = K >> 6;
  const int lrow = tid >> 3, lkc = (tid & 7) * 8, lsw = ((tid & 7) ^ (lrow & 7)) * 8;
  __syncthreads();
#pragma unroll
  for (int i = 0; i < 4; ++i) ra[i] = al(lrow + i * 64, lkc);
#pragma unroll
  for (int i = 0; i < 4; ++i) rb[i] = *(const uint4*)(Bt + (size_t)(lrow + i * 64) * ldb + lkc);
#pragma unroll
  for (int i = 0; i < 4; ++i) *(uint4*)&s.A[0][(lrow + i * 64) * LDS_ROW + lsw] = al.post(ra[i], lrow + i * 64, lkc);
#pragma unroll
  for (int i = 0; i < 4; ++i) *(uint4*)&s.B[0][(lrow + i * 64) * LDS_ROW + lsw] = rb[i];
  __syncthreads();
  for (int kt = 0; kt < nk; ++kt) {
    const int buf = kt & 1;
    const int kn = (kt + 1 < nk ? kt + 1 : kt) * 64 + lkc;
#pragma unroll
    for (int i = 0; i < 4; ++i) ra[i] = al(lrow + i * 64, kn);
    __builtin_amdgcn_sched_barrier(0);
#pragma unroll
    for (int kh = 0; kh < 2; ++kh) {
      bf16x8 a[4];
#pragma unroll
      for (int m = 0; m < 4; ++m) a[m] = *(const bf16x8*)&s.A[buf][(wr * 64 + m * 16 + fr) * LDS_ROW + (((kh * 4 + fq) ^ (fr & 7)) << 3)];
      bf16x8 bc = *(const bf16x8*)&s.B[buf][(wc * 128 + fr) * LDS_ROW + (((kh * 4 + fq) ^ (fr & 7)) << 3)];
#pragma unroll
      for (int n = 0; n < 8; ++n) {
        const bf16x8 bn = *(const bf16x8*)&s.B[buf][(wc * 128 + (n < 7 ? n + 1 : n) * 16 + fr) * LDS_ROW + (((kh * 4 + fq) ^ (fr & 7)) << 3)];
        __builtin_amdgcn_sched_barrier(0);
        __builtin_amdgcn_s_setprio(1);
#pragma unroll
        for (int m = 0; m < 4; ++m) acc[m][n] = MFMA(bc, a[m], acc[m][n]);
        __builtin_amdgcn_s_setprio(0);
        bc = bn;
      }
      __builtin_amdgcn_sched_barrier(0);
      if (kh == 0) {
#pragma unroll
        for (int i = 0; i < 4; ++i) *(uint4*)&s.A[buf ^ 1][(lrow + i * 64) * LDS_ROW + lsw] = al.post(ra[i], lrow + i * 64, kn);
#pragma unroll
        for (int i = 0; i < 4; ++i) {
          const u16* bp = Bt + (size_t)(lrow + i * 64) * ldb + kn;
          asm volatile("global_load_dwordx4 %0, %1, off" : "=v"(rb[i]) : "v"(bp) : "memory");
        }
        __builtin_amdgcn_sched_barrier(0);
      }
    }
    asm volatile("s_waitcnt vmcnt(0)" ::: "memory");
#pragma unroll
    for (int i = 0; i < 4; ++i) *(uint4*)&s.B[buf ^ 1][(lrow + i * 64) * LDS_ROW + lsw] = rb[i];
    __syncthreads();
  }
}

DI bool next_tile(int it, int MT, int NT, int GN, int& mt, int& nt) {
  const int xcd = blockIdx.x & 7, lb = blockIdx.x >> 3, GM = 8 / GN;
  const int gm = xcd / GN, gn = xcd - gm * GN;
  const int m0 = gm * MT / GM, m1 = (gm + 1) * MT / GM, n0 = gn * NT / GN, n1 = (gn + 1) * NT / GN;
  const int nl = n1 - n0, tl = lb + it * (gridDim.x >> 3);
  if (tl >= (m1 - m0) * nl) return false;
  const int q = tl / nl;
  mt = m0 + q; nt = n0 + (tl - q * nl);
  return true;
}
struct ALPlain {
  const u16* base; int ld;
  DI uint4 operator()(int i, int k) const { return *(const uint4*)(base + (size_t)i * ld + k); }
  DI uint4 post(uint4 v, int, int) const { return v; }
};

DI void ph_prologue(const Params& p, char* smem) {
  const int tid = otid();
  float* modp = (float*)(p.ws + OFF_MODP);
  float* sc = (float*)smem;
  __syncthreads();
  for (int e = tid; e < 3072; e += 512) { const float v = e < 2048 ? p.in[IC][e] : p.in[ICC][e - 2048]; sc[e] = siluf(v); }
  __syncthreads();
  const int half = tid >> 8, col = tid & 255;
  for (int it = blockIdx.x * 2 + half; it < 4 * 24 * 16; it += gridDim.x * 2) {
    int l = it / (24 * 16), rem = it - l * 24 * 16, cc = rem / 16, kc = rem & 15;
    int n = cc * 256 + col;
    const float* w = p.in[IADAW] + (size_t)l * 1024 * 6144 + (size_t)(kc * 64) * 6144 + n;
    float a0 = 0.f, a1 = 0.f, a2 = 0.f;
#pragma unroll
    for (int kb = 0; kb < 64; kb += 16) {
      float wv[16];
#pragma unroll
      for (int k = 0; k < 16; ++k) wv[k] = w[(size_t)(kb + k) * 6144];
#pragma unroll
      for (int k = 0; k < 16; ++k) {
        const int kk = kc * 64 + kb + k;
        a0 += sc[kk] * wv[k]; a1 += sc[1024 + kk] * wv[k]; a2 += sc[2048 + kk] * wv[k];
      }
    }
    size_t o = ((size_t)(kc * 4 + l) * 3) * 6144 + n;
    modp[o] = a0; modp[o + 6144] = a1; modp[o + 2 * 6144] = a2;
  }
}
DI void ph_modreduce(const Params& p) {
  const float* modp = (const float*)(p.ws + OFF_MODP); float* mod = (float*)(p.ws + OFF_MOD);
  for (int i = blockIdx.x * 512 + otid(); i < 4 * 3 * 6144; i += gridDim.x * 512) {
    int l = i / (3 * 6144), n = i % 6144;
    float a = p.in[IADAB][l * 6144 + n];
    float pv[16];
#pragma unroll
    for (int kc = 0; kc < 16; ++kc) pv[kc] = modp[(size_t)kc * 4 * 3 * 6144 + i];
#pragma unroll
    for (int kc = 0; kc < 16; ++kc) a += pv[kc];
    mod[i] = a;
  }
}

struct CvtJob { const float* src; u16* dst; int K, N, ld, ldd, mode; };
DI void cvt_run(const CvtJob& j, int& rot, char* smem) {
  float* tile = (float*)smem;
  const int tid = otid();
  if (j.mode == 4) {
    size_t n = (size_t)j.K * j.N;
    for (size_t i = (size_t)blockIdx.x * 512 + tid; i < n; i += (size_t)gridDim.x * 512) j.dst[i] = 0;
    return;
  }
  const int tk = j.K >> 6, tn = j.N >> 6, nt = tk * tn;
  int start = (blockIdx.x + gridDim.x - (rot % gridDim.x)) % gridDim.x;
  for (int t = start; t < nt; t += gridDim.x) {
    int kt = t / tn, ntl = t - kt * tn;
    __syncthreads();
    {
      f32x4 lv[2];
#pragma unroll
      for (int i = 0; i < 2; ++i) { const int e = tid + i * 512, kk = e >> 4, n4 = (e & 15) * 4; lv[i] = gload_f4(j.src + (size_t)(kt * 64 + kk) * j.ld + ntl * 64 + n4); }
      asm volatile("s_waitcnt vmcnt(0)" : "+v"(lv[0]), "+v"(lv[1]) :: "memory");
#pragma unroll
      for (int i = 0; i < 2; ++i) { const int e = tid + i * 512, kk = e >> 4, n4 = (e & 15) * 4; float* tp = tile + kk * 65 + n4; tp[0] = lv[i][0]; tp[1] = lv[i][1]; tp[2] = lv[i][2]; tp[3] = lv[i][3]; }
    }
    __syncthreads();
    for (int e = tid; e < 4096; e += 512) {
      int nn = e >> 6, kk = e & 63; float v = tile[kk * 65 + nn];
      int n = ntl * 64 + nn, k = kt * 64 + kk;
      if (j.mode == 0) j.dst[(size_t)n * j.ldd + k] = f2b(v);
      else if (j.mode == 1) { int rr = n < FF ? (n >> 7) * 256 + (n & 127) : ((n - FF) >> 7) * 256 + 128 + ((n - FF) & 127); j.dst[(size_t)rr * j.ldd + k] = f2b(v); }
      else {
        int h = n >> 6, c = n & 63, ty = j.mode - 2;
        u16* d = j.dst + (size_t)h * 128 * 128 + (size_t)((c >> 5) * 64 + ty * 32 + (c & 31)) * 128;
        d[ty * 64 + k] = f2b(v); d[(1 - ty) * 64 + k] = 0;
      }
    }
  }
  rot += nt;
}
DI void ph_convert(const Params& p, int l, char* smem) {
  u16* wt = (u16*)(p.ws + OFF_WT);
  int rot = 0;
  CvtJob j;
  j = {p.in[IFWIN] + (size_t)l * 1024 * 5632, wt + WT_W1T, 1024, 5632, 5632, 1024, 1}; cvt_run(j, rot, smem);
  j = {p.in[IFWOUT] + (size_t)l * FF * 1024, wt + WT_W2T, FF, 1024, 1024, FF, 0}; cvt_run(j, rot, smem);
  const int kind = l % 3, jj = l / 3;
  if (kind == 0) {
    j = {p.in[IRWR] + (size_t)jj * 1048576, wt + WT_R1T, 1024, 1024, 1024, 1024, 0}; cvt_run(j, rot, smem);
    j = {p.in[IRWK] + (size_t)jj * 1048576, wt + WT_R1T + (size_t)1024 * 1024, 1024, 1024, 1024, 1024, 0}; cvt_run(j, rot, smem);
    j = {p.in[IRWV] + (size_t)jj * 1048576, wt + WT_R1T + (size_t)2048 * 1024, 1024, 1024, 1024, 1024, 0}; cvt_run(j, rot, smem);
    for (int d = 0; d < 2; ++d) {
      j = {p.in[IRW1] + (size_t)(jj * 2 + d) * 65536, wt + WT_R1T + (size_t)(3072 + d * 64) * 1024, 1024, 64, 64, 1024, 0}; cvt_run(j, rot, smem);
      j = {p.in[IRA1] + (size_t)(jj * 2 + d) * 65536, wt + WT_R1T + (size_t)(3200 + d * 64) * 1024, 1024, 64, 64, 1024, 0}; cvt_run(j, rot, smem);
      j = {p.in[IRW2] + (size_t)(jj * 2 + d) * 65536, wt + WT_LUT + (size_t)d * 16 * 128 * 128, 64, 1024, 1024, 128, 2}; cvt_run(j, rot, smem);
      j = {p.in[IRA2] + (size_t)(jj * 2 + d) * 65536, wt + WT_LUT + (size_t)d * 16 * 128 * 128, 64, 1024, 1024, 128, 3}; cvt_run(j, rot, smem);
    }
    j = {p.in[IRG1] + (size_t)jj * 131072, wt + WT_R1T + (size_t)3328 * 1024, 1024, 128, 128, 1024, 0}; cvt_run(j, rot, smem);
    j = {p.in[IRG2] + (size_t)jj * 131072, wt + WT_G2T, 128, 1024, 1024, 128, 0}; cvt_run(j, rot, smem);
    j = {p.in[IRWO] + (size_t)jj * 1048576, wt + WT_RWO, 1024, 1024, 1024, 1024, 0}; cvt_run(j, rot, smem);
  } else if (kind == 1) {
    j = {p.in[ISWIN] + (size_t)jj * 1024 * 6208 + 2048, wt + WT_SX, 1024, 4160, 6208, 1024, 0}; cvt_run(j, rot, smem);
    j = {nullptr, wt + WT_SX + (size_t)4160 * 1024, 64, 1024, 0, 0, 4}; cvt_run(j, rot, smem);
    j = {p.in[ISWIN] + (size_t)jj * 1024 * 6208, wt + WT_SZ, 1024, 2048, 6208, 1024, 0}; cvt_run(j, rot, smem);
    j = {p.in[ISWOUT] + (size_t)jj * 2048 * 1024, wt + WT_SO, 2048, 1024, 1024, 2048, 0}; cvt_run(j, rot, smem);
    float* ssq = (float*)(p.ws + OFF_SSQ);
    for (int i = blockIdx.x * 512 + otid(); i < R * 8; i += gridDim.x * 512) ssq[i] = 0.f;
  } else {
    j = {p.in[IAQKV] + (size_t)jj * 1024 * 1536, wt + WT_AQ, 1024, 1536, 1536, 1024, 0}; cvt_run(j, rot, smem);
    j = {p.in[IAWO] + (size_t)jj * 1048576, wt + WT_AO, 1024, 1024, 1024, 1024, 0}; cvt_run(j, rot, smem);
  }
}

DI void ph_norm(const Params& p, int l, int which) {
  const int lane = otid() & 63, gw = blockIdx.x * 8 + (otid() >> 6), nw = gridDim.x * 8;
  const float* g = (which ? p.in[IN2] : p.in[IN1]) + l * 1024;
  u16* H = (u16*)(p.ws + OFF_H);
  float4 gg[4];
#pragma unroll
  for (int j = 0; j < 4; ++j) gg[j] = *(const float4*)(g + j * 256 + lane * 4);
  float4 v[4], vn[4];
  const bool from_in = (l == 0 && which == 0);
  if (gw < R) {
    const float* xr = from_in ? xin_ptr(p, gw) : xrow_ptr(p, gw);
#pragma unroll
    for (int j = 0; j < 4; ++j) v[j] = *(const float4*)(xr + j * 256 + lane * 4);
  }
  for (int r = gw; r < R; r += nw) {
    {
      const int rn = r + nw < R ? r + nw : r;
      const float* xn = from_in ? xin_ptr(p, rn) : xrow_ptr(p, rn);
#pragma unroll
      for (int j = 0; j < 4; ++j) vn[j] = *(const float4*)(xn + j * 256 + lane * 4);
    }
    const float* md = mod_ptr(p, l, r) + which * 3072;
    float4 sh[4], sc[4];
#pragma unroll
    for (int j = 0; j < 4; ++j) { sh[j] = *(const float4*)(md + j * 256 + lane * 4); sc[j] = *(const float4*)(md + 1024 + j * 256 + lane * 4); }
    __builtin_amdgcn_sched_barrier(0);
    float ss = 0.f;
#pragma unroll
    for (int j = 0; j < 4; ++j) ss += v[j].x * v[j].x + v[j].y * v[j].y + v[j].z * v[j].z + v[j].w * v[j].w;
    ss = wsum(ss);
    const float rs = rsqrtf(ss * (1.f / 1024.f) + 1e-6f);
#pragma unroll
    for (int j = 0; j < 4; ++j) {
      const int c = j * 256 + lane * 4;
      float o0 = v[j].x * rs * gg[j].x * (1.f + sc[j].x) + sh[j].x, o1 = v[j].y * rs * gg[j].y * (1.f + sc[j].y) + sh[j].y;
      float o2 = v[j].z * rs * gg[j].z * (1.f + sc[j].z) + sh[j].z, o3 = v[j].w * rs * gg[j].w * (1.f + sc[j].w) + sh[j].w;
      uint2 w; w.x = pack2(o0, o1); w.y = pack2(o2, o3);
      *(uint2*)(H + (size_t)r * 1024 + c) = w;
    }
#pragma unroll
    for (int j = 0; j < 4; ++j) v[j] = vn[j];
  }
}
DI void ph_final(const Params& p) {
  const int lane = otid() & 63, gw = blockIdx.x * 8 + (otid() >> 6), nw = gridDim.x * 8;
  float4 g[4];
#pragma unroll
  for (int j = 0; j < 4; ++j) g[j] = *(const float4*)(p.in[IFINAL] + j * 256 + lane * 4);
  float4 v[4], vn[4];
  if (gw < NBAT * T) {
#pragma unroll
    for (int j = 0; j < 4; ++j) v[j] = *(const float4*)(p.out + (size_t)gw * 1024 + j * 256 + lane * 4);
  }
  for (int r = gw; r < NBAT * T; r += nw) {
    float* xr = p.out + (size_t)r * 1024;
    {
      const float* xn = p.out + (size_t)(r + nw < NBAT * T ? r + nw : r) * 1024;
#pragma unroll
      for (int j = 0; j < 4; ++j) vn[j] = *(const float4*)(xn + j * 256 + lane * 4);
    }
    __builtin_amdgcn_sched_barrier(0);
    float ss = 0.f;
#pragma unroll
    for (int j = 0; j < 4; ++j) ss += v[j].x * v[j].x + v[j].y * v[j].y + v[j].z * v[j].z + v[j].w * v[j].w;
    ss = wsum(ss);
    const float rs = rsqrtf(ss * (1.f / 1024.f) + 1e-6f);
#pragma unroll
    for (int j = 0; j < 4; ++j) {
      float4 w = v[j]; w.x *= rs * g[j].x; w.y *= rs * g[j].y; w.z *= rs * g[j].z; w.w *= rs * g[j].w;
      *(float4*)(xr + j * 256 + lane * 4) = w;
    }
#pragma unroll
    for (int j = 0; j < 4; ++j) v[j] = vn[j];
  }
}

template <class AL>
DI void resid_tile(const Params& p, const AL& al, const u16* Bt, int K, int l, int gi, int mt, int nt, char* smem) {
  f32x4 acc[4][4];
  gemm_main4(al, Bt + (size_t)nt * 128 * K, K, K, acc, smem);
  const int lane = otid() & 63, wave = otid() >> 6, wr = wave >> 1, wc = wave & 1, fr = lane & 15, fq = lane >> 4;
  const int row0 = mt * 256;
  const float* md = mod_ptr(p, l, row0) + gi * 1024;
  float4 g[4];
#pragma unroll
  for (int n = 0; n < 4; ++n) g[n] = *(const float4*)(md + nt * 128 + wc * 64 + n * 16 + fq * 4);
  float* xr0 = xrow_ptr(p, row0) + (size_t)(wr * 64 + fr) * 1024 + nt * 128 + wc * 64 + fq * 4;
  const float* xl0 = (l == 0 && gi == 2) ? xin_ptr(p, row0) + (size_t)(wr * 64 + fr) * 1024 + nt * 128 + wc * 64 + fq * 4 : xr0;
#pragma unroll
  for (int mh = 0; mh < 2; ++mh) {
    f32x4 x[2][4];
#pragma unroll
    for (int m2 = 0; m2 < 2; ++m2)
#pragma unroll
      for (int n = 0; n < 4; ++n) x[m2][n] = gload_f4(xl0 + (size_t)((mh * 2 + m2) * 16) * 1024 + n * 16);
    asm volatile("s_waitcnt vmcnt(0)" : "+v"(x[0][0]), "+v"(x[0][1]), "+v"(x[0][2]), "+v"(x[0][3]), "+v"(x[1][0]), "+v"(x[1][1]), "+v"(x[1][2]), "+v"(x[1][3]) :: "memory");
#pragma unroll
    for (int m2 = 0; m2 < 2; ++m2)
#pragma unroll
      for (int n = 0; n < 4; ++n) {
        const int m = mh * 2 + m2;
        f32x4 v = x[m2][n];
        v[0] += g[n].x * acc[m][n][0]; v[1] += g[n].y * acc[m][n][1]; v[2] += g[n].z * acc[m][n][2]; v[3] += g[n].w * acc[m][n][3];
        *(f32x4*)(xr0 + (size_t)(m * 16) * 1024 + n * 16) = v;
      }
  }
}
DI void ph_resid_gemm(const Params& p, const u16* A, int lda, const u16* Bt, int K, int l, int gi, char* smem) {
  const bool skip_ctx = (l == 3);
  for (int it = 0;; ++it) {
    int mt, nt; if (!next_tile(it, skip_ctx ? 128 : 130, 8, 1, mt, nt)) break;
    if (skip_ctx) mt = mt + 1 + (mt >> 6);
    ALPlain al{A + (size_t)mt * 256 * lda, lda};
    resid_tile(p, al, Bt, K, l, gi, mt, nt, smem);
  }
}

struct ALHalo {
  const u16* base; int t0m1, len;
  DI uint4 operator()(int i, int k) const {
    int t = t0m1 + i;
    if (t < 0 || t >= len) return make_uint4(0, 0, 0, 0);
    return *(const uint4*)(base + (size_t)t * 1024 + k);
  }
  DI uint4 post(uint4 v, int, int) const { return v; }
};
DI void ph_ffn1(const Params& p, int l, char* smem) {
  const u16* H = (const u16*)(p.ws + OFF_H);
  const u16* W1T = (const u16*)(p.ws + OFF_WT) + WT_W1T;
  u16* G = (u16*)(p.ws + OFF_SCR);
  const int tid = otid(), lane = tid & 63, wave = tid >> 6, wr = wave >> 1, wc = wave & 1, fr = lane & 15, fq = lane >> 4;
  for (int it = 0;; ++it) {
    int mt, nt; if (!next_tile(it, 134, 22, 2, mt, nt)) break;
    const int b = mt / 67, ml = mt - b * 67;
    int rowbase, t0, len;
    if (ml < 2) { rowbase = b * TS; t0 = ml * 254; len = TC; } else { rowbase = b * TS + TC; t0 = (ml - 2) * 254; len = T; }
    ALHalo al{H + (size_t)rowbase * 1024, t0 - 1, len};
    f32x4 acc[4][8];
    gemm_main2(al, W1T + (size_t)nt * 256 * 1024, 1024, 1024, acc, smem);
    u16* P16 = (u16*)smem;
#pragma unroll
    for (int m = 0; m < 4; ++m)
#pragma unroll
      for (int n = 0; n < 8; ++n) {
        uint2 w; w.x = pack2(acc[m][n][0], acc[m][n][1]); w.y = pack2(acc[m][n][2], acc[m][n][3]);
        *(uint2*)&P16[(wr * 64 + m * 16 + fr) * 264 + wc * 128 + n * 16 + fq * 4] = w;
      }
    __syncthreads();
    {
      const int c2 = (tid & 63) * 2, rg = tid >> 6;
      const float* cw = p.in[IFCONV] + (size_t)l * 3 * 5632;
      const int ca = nt * 128 + c2, cg2 = FF + ca;
      const float2 a0 = *(const float2*)(cw + ca), a1 = *(const float2*)(cw + 5632 + ca), a2 = *(const float2*)(cw + 2 * 5632 + ca);
      const float2 g0 = *(const float2*)(cw + cg2), g1 = *(const float2*)(cw + 5632 + cg2), g2 = *(const float2*)(cw + 2 * 5632 + cg2);
      const int i0 = 1 + rg * 32, i1 = min(i0 + 32, 255);
      unsigned pa = *(const unsigned*)&P16[(i0 - 1) * 264 + c2], ca_ = *(const unsigned*)&P16[i0 * 264 + c2];
      unsigned pg = *(const unsigned*)&P16[(i0 - 1) * 264 + 128 + c2], cgv = *(const unsigned*)&P16[i0 * 264 + 128 + c2];
      for (int i = i0; i < i1; ++i) {
        const unsigned na = *(const unsigned*)&P16[(i + 1) * 264 + c2], ng = *(const unsigned*)&P16[(i + 1) * 264 + 128 + c2];
        const float ua0 = a0.x * blo(pa) + a1.x * blo(ca_) + a2.x * blo(na), ua1 = a0.y * bhi(pa) + a1.y * bhi(ca_) + a2.y * bhi(na);
        const float ug0 = g0.x * blo(pg) + g1.x * blo(cgv) + g2.x * blo(ng), ug1 = g0.y * bhi(pg) + g1.y * bhi(cgv) + g2.y * bhi(ng);
        const int tt = t0 - 1 + i;
        if (tt < len) *(unsigned*)&G[(size_t)(rowbase + tt) * FF + ca] = pack2(ua0 * siluf(ug0), ua1 * siluf(ug1));
        pa = ca_; ca_ = na; pg = cgv; cgv = ng;
      }
    }
  }
}

struct ALMix {
  const u16* H; int row0; const float* mu;
  DI uint4 operator()(int i, int k) const {
    const int row = row0 + i, q = row % TS;
    const bool hp = (q != 0) && (q != TC), hn = (q != TC - 1) && (q != TS - 1);
    const u16* pc = H + (size_t)row * 1024 + k;
    uint4 c = *(const uint4*)pc;
    uint4 a = hp ? *(const uint4*)(pc - 1024) : make_uint4(0, 0, 0, 0);
    uint4 b = hn ? *(const uint4*)(pc + 1024) : make_uint4(0, 0, 0, 0);
    float4 m0 = *(const float4*)(mu + k), m1 = *(const float4*)(mu + k + 4);
    uint4 o;
#define MIX1(cc, aa, bb, mlo, mhi) pack2(blo(cc) + (0.5f * (blo(aa) + blo(bb)) - blo(cc)) * (mlo), bhi(cc) + (0.5f * (bhi(aa) + bhi(bb)) - bhi(cc)) * (mhi))
    o.x = MIX1(c.x, a.x, b.x, m0.x, m0.y); o.y = MIX1(c.y, a.y, b.y, m0.z, m0.w);
    o.z = MIX1(c.z, a.z, b.z, m1.x, m1.y); o.w = MIX1(c.w, a.w, b.w, m1.z, m1.w);
    return o;
  }
  DI uint4 post(uint4 v, int, int) const { return v; }
};
constexpr int P1LD = 3456;
DI void ph_rw_r1(const Params& p, int jj, char* smem) {
  const u16* H = (const u16*)(p.ws + OFF_H);
  const u16* BT = (const u16*)(p.ws + OFF_WT) + WT_R1T;
  u16* P1 = (u16*)(p.ws + OFF_SCR);
  const int lane = otid() & 63, wave = otid() >> 6, wr = wave >> 1, wc = wave & 1, fr = lane & 15, fq = lane >> 4;
  for (int it = 0;; ++it) {
    int mt, nt; if (!next_tile(it, 130, 27, 1, mt, nt)) break;
    const int mi = nt < 8 ? 0 : nt < 16 ? 2 : nt < 24 ? 3 : nt == 24 ? 1 : nt == 25 ? 4 : 5;
    ALMix al{H, mt * 256, p.in[IRMU] + (size_t)(jj * 6 + mi) * 1024};
    f32x4 acc[4][4];
    gemm_main3(al, BT + (size_t)nt * 128 * 1024, 1024, 1024, acc, smem);
#pragma unroll
    for (int m = 0; m < 4; ++m) {
      const int row = mt * 256 + wr * 64 + m * 16 + fr;
#pragma unroll
      for (int n = 0; n < 4; ++n) {
        const int c = nt * 128 + wc * 64 + n * 16 + fq * 4;
        float v0 = acc[m][n][0], v1 = acc[m][n][1], v2 = acc[m][n][2], v3 = acc[m][n][3];
        if (nt == 24) { v0 = tanhf(v0); v1 = tanhf(v1); v2 = tanhf(v2); v3 = tanhf(v3); }
        else if (nt == 26) { v0 = sigmf(v0); v1 = sigmf(v1); v2 = sigmf(v2); v3 = sigmf(v3); }
        uint2 w; w.x = pack2(v0, v1); w.y = pack2(v2, v3);
        *(uint2*)(P1 + (size_t)row * P1LD + c) = w;
      }
    }
  }
}
DI int scan_row(int b, int d, int pos) { return d == 0 ? b * TS + pos : (pos < TC ? b * TS + TC - 1 - pos : b * TS + (TS + TC - 1) - pos); }

struct ALLora {
  const u16* P1; int rowbase, rowstep, d;
  DI uint4 operator()(int i, int k) const {
    const int row = rowbase + i * rowstep;
    const int col = k < 64 ? 3072 + d * 64 + k : 3200 + d * 64 + (k - 64);
    return *(const uint4*)(P1 + (size_t)row * P1LD + col);
  }
  DI uint4 post(uint4 v, int, int) const { return v; }
};
DI uint2 pack4h(float a, float b, float c, float d) {
  __half2 x = __floats2half2_rn(a, b), y = __floats2half2_rn(c, d);
  uint2 r; r.x = *(unsigned*)&x; r.y = *(unsigned*)&y; return r;
}
DI void ph_rw_produce(const Params& p, int jj, int s, char* smem) {
  const u16* P1 = (const u16*)(p.ws + OFF_SCR);
  const u16* LUT = (const u16*)(p.ws + OFF_WT) + WT_LUT;
  __half* ring = (__half*)(p.ws + OFF_RING) + (size_t)(s & 1) * ((size_t)2 * 2 * 1024 * 16 * 256);
  float* bonus = (float*)(p.ws + OFF_BONUS);
  float* red = (float*)(smem + sizeof(SmemG));
  const int lane = otid() & 63, wave = otid() >> 6, wr = wave >> 1, wc = wave & 1, fr = lane & 15, fq = lane >> 4;
  const int npt = min(4, 65 - s * 4);
  for (int t = blockIdx.x; t < 2 * 2 * npt * 16; t += gridDim.x) {
    const int h = t & 15, ptl = (t >> 4) % npt, bd = (t >> 4) / npt, d = bd & 1, b = bd >> 1;
    const int pos0 = (s * 4 + ptl) * 256;
    const int rowbase = scan_row(b, d, pos0), rowstep = d ? -1 : 1;
    ALLora al{P1, rowbase, rowstep, d};
    f32x4 acc[4][4];
    gemm_main3(al, LUT + (size_t)(d * 16 + h) * 128 * 128, 128, 128, acc, smem);
    float4 kkw[2], kaw[2], rkw[2], w0v[2], a0v[2];
#pragma unroll
    for (int nn = 0; nn < 2; ++nn) {
      const int ch = h * 64 + wc * 32 + nn * 16 + fq * 4;
      kkw[nn] = *(const float4*)(p.in[IRKK] + jj * 1024 + ch); kaw[nn] = *(const float4*)(p.in[IRKA] + jj * 1024 + ch);
      rkw[nn] = *(const float4*)(p.in[IRRK] + jj * 1024 + ch);
      w0v[nn] = *(const float4*)(p.in[IRW0] + (jj * 2 + d) * 1024 + ch); a0v[nn] = *(const float4*)(p.in[IRA0] + (jj * 2 + d) * 1024 + ch);
    }
    float ssk[4];
    uint2 kreg[4][2], rreg[4][2];
#pragma unroll
    for (int m = 0; m < 4; ++m) {
      const int row = rowbase + (wr * 64 + m * 16 + fr) * rowstep;
#pragma unroll
      for (int nn = 0; nn < 2; ++nn) {
        const int ch = h * 64 + wc * 32 + nn * 16 + fq * 4;
        kreg[m][nn] = *(const uint2*)(P1 + (size_t)row * P1LD + 1024 + ch);
        rreg[m][nn] = *(const uint2*)(P1 + (size_t)row * P1LD + ch);
      }
    }
    __builtin_amdgcn_sched_barrier(0);
#pragma unroll
    for (int m = 0; m < 4; ++m) {
      float s1 = 0.f;
#pragma unroll
      for (int nn = 0; nn < 2; ++nn) {
        const uint2 k2 = kreg[m][nn];
        float q0 = blo(k2.x) * kkw[nn].x, q1 = bhi(k2.x) * kkw[nn].y, q2 = blo(k2.y) * kkw[nn].z, q3 = bhi(k2.y) * kkw[nn].w;
        s1 += q0 * q0 + q1 * q1 + q2 * q2 + q3 * q3;
      }
      s1 += __shfl_xor(s1, 16); s1 += __shfl_xor(s1, 32);
      ssk[m] = s1;
    }
    if (fq == 0) {
#pragma unroll
      for (int m = 0; m < 4; ++m) red[(wr * 64 + m * 16 + fr) * 2 + wc] = ssk[m];
    }
    __syncthreads();
    float c3[4];
#pragma unroll
    for (int m = 0; m < 4; ++m) {
      const int pi = wr * 64 + m * 16 + fr;
      const float rs = rsqrtf(red[pi * 2] + red[pi * 2 + 1] + 1e-12f);
      const int posl = ptl * 256 + pi;
      __half* rp = ring + ((((size_t)(b * 2 + d) * 1024 + posl) * 16 + h) * 256);
      float cc = 0.f;
#pragma unroll
      for (int nn = 0; nn < 2; ++nn) {
        const int chl = wc * 32 + nn * 16 + fq * 4;
        const float kq[4] = {kkw[nn].x, kkw[nn].y, kkw[nn].z, kkw[nn].w}, ka[4] = {kaw[nn].x, kaw[nn].y, kaw[nn].z, kaw[nn].w};
        const float rk[4] = {rkw[nn].x, rkw[nn].y, rkw[nn].z, rkw[nn].w}, w0[4] = {w0v[nn].x, w0v[nn].y, w0v[nn].z, w0v[nn].w};
        const float a0[4] = {a0v[nn].x, a0v[nn].y, a0v[nn].z, a0v[nn].w};
        float okk[4], owm[4], oka[4], okd[4];
        const int rowm = rowbase + pi * rowstep;
        const uint2 r2 = rreg[m][nn], k2 = kreg[m][nn];
        const float rvv[4] = {blo(r2.x), bhi(r2.x), blo(r2.y), bhi(r2.y)}, kvv[4] = {blo(k2.x), bhi(k2.x), blo(k2.y), bhi(k2.y)};
#pragma unroll
        for (int j = 0; j < 4; ++j) {
          const float k = kvv[j];
          const float kk = k * kq[j] * rs;
          const float a = sigmf(a0[j] + acc[m][nn + 2][j]);
          const float wlog = -__logf(1.f + __expf(-(w0[j] + acc[m][nn][j]))) - 0.5f;
          const float ew = -__expf(wlog);
          const float wm1 = ew * (1.f + ew * (0.5f + ew * (0.16666667f + ew * (0.041666668f + ew * (0.0083333338f + ew * (0.0013888889f + ew * 0.0001984127f))))));
          const float kd = k * (1.f + (a - 1.f) * ka[j]);
          okk[j] = kk; owm[j] = wm1; oka[j] = kk * a; okd[j] = kd;
          cc += rvv[j] * kd * rk[j];
        }
        *(uint2*)(rp + chl) = pack4h(okk[0], okk[1], okk[2], okk[3]);
        *(uint2*)(rp + 64 + chl) = pack4h(owm[0], owm[1], owm[2], owm[3]);
        *(uint2*)(rp + 128 + chl) = pack4h(oka[0], oka[1], oka[2], oka[3]);
        *(uint2*)(rp + 192 + chl) = pack4h(okd[0], okd[1], okd[2], okd[3]);
      }
      cc += __shfl_xor(cc, 16); cc += __shfl_xor(cc, 32);
      c3[m] = cc;
    }
    __syncthreads();
    if (fq == 0) {
#pragma unroll
      for (int m = 0; m < 4; ++m) red[(wr * 64 + m * 16 + fr) * 2 + wc] = c3[m];
    }
    __syncthreads();
    if (wc == 0 && fq == 0) {
#pragma unroll
      for (int m = 0; m < 4; ++m) {
        const int pi = wr * 64 + m * 16 + fr;
        bonus[(size_t)(rowbase + pi * rowstep) * 32 + h * 2 + d] = red[pi * 2] + red[pi * 2 + 1];
      }
    }
  }
}
DI float ror_add16(float x) {
  x += __int_as_float(__builtin_amdgcn_update_dpp(0, __float_as_int(x), 0x128, 0xf, 0xf, false));
  x += __int_as_float(__builtin_amdgcn_update_dpp(0, __float_as_int(x), 0x124, 0xf, 0xf, false));
  x += __int_as_float(__builtin_amdgcn_update_dpp(0, __float_as_int(x), 0x122, 0xf, 0xf, false));
  x += __int_as_float(__builtin_amdgcn_update_dpp(0, __float_as_int(x), 0x121, 0xf, 0xf, false));
  return x;
}
constexpr int SCH = 32, STEPF = 336;
DI void ph_rw_scan(const Params& p, int s, char* smem, bool save = true) {
  if (blockIdx.x >= 256) return;
  const u16* P1 = (const u16*)(p.ws + OFF_SCR);
  const __half* ring = (const __half*)(p.ws + OFF_RING) + (size_t)(s & 1) * ((size_t)2 * 2 * 1024 * 16 * 256);
  u16* Y = (u16*)(p.ws + OFF_SCR) + (size_t)R * P1LD;
  float* st = (float*)(p.ws + OFF_RWST);
  float* buf = (float*)smem;
  float* ybuf = buf + 2 * SCH * STEPF;
  const int tid = otid(), lane = tid & 63, wave = tid >> 6;
  const int xcd_ = blockIdx.x & 7, slot_ = blockIdx.x >> 3;
  const int bh_ = xcd_ * 4 + (slot_ >> 3), rq = slot_ & 3;
  const int b = bh_ >> 4, h = bh_ & 15, d = (slot_ >> 2) & 1;
  const int npos = min(1024, TS - s * 1024), nch = npos / SCH;
  const int rl = (wave & 3) * 4 + (lane >> 4), q = lane & 15;
  f32x2 sa = (f32x2){0.f, 0.f}, sb = (f32x2){0.f, 0.f};
  if (wave < 4 && s > 0) { float4 v = *(const float4*)(st + ((size_t)blockIdx.x * 256 + tid) * 4); sa = (f32x2){v.x, v.y}; sb = (f32x2){v.z, v.w}; }
  u16* Yd = Y + (size_t)d * R * 1024;
  uint4 lr[4], lrr = make_uint4(0, 0, 0, 0), lrv = make_uint4(0, 0, 0, 0);
  auto gload = [&](int c) {
    const int lt = tid - 256;
#pragma unroll
    for (int i = 0; i < 4; ++i) {
      const int cidx = lt + i * 256, stp = cidx >> 5, off = (cidx & 31) * 8;
      const int posl = c * SCH + stp;
      lr[i] = *(const uint4*)(ring + ((((size_t)(b * 2 + d) * 1024 + posl) * 16 + h) * 256) + off);
    }
    {
      const int stp = lt >> 3, off = (lt & 7) * 8;
      const int row = scan_row(b, d, s * 1024 + c * SCH + stp);
      lrr = *(const uint4*)(P1 + (size_t)row * P1LD + h * 64 + off);
    }
    {
      const int l2 = lt & 63, stp = l2 >> 1, off = (l2 & 1) * 8;
      const int row = scan_row(b, d, s * 1024 + c * SCH + stp);
      lrv = *(const uint4*)(P1 + (size_t)row * P1LD + 2048 + h * 64 + rq * 16 + off);
    }
  };
  auto swrite = [&](int c) {
    const int lt = tid - 256;
    float* bb = buf + (c & 1) * SCH * STEPF;
#pragma unroll
    for (int i = 0; i < 4; ++i) {
      const int cidx = lt + i * 256, stp = cidx >> 5, off = (cidx & 31) * 8;
      const __half2* hp = (const __half2*)&lr[i];
      float2 f0 = __half22float2(hp[0]), f1 = __half22float2(hp[1]), f2 = __half22float2(hp[2]), f3 = __half22float2(hp[3]);
      float* dst = bb + stp * STEPF + off;
      *(float4*)dst = make_float4(f0.x, f0.y, f1.x, f1.y);
      *(float4*)(dst + 4) = make_float4(f2.x, f2.y, f3.x, f3.y);
    }
    {
      const int stp = lt >> 3, off = (lt & 7) * 8;
      float* dst = bb + stp * STEPF + 256 + off;
      *(float4*)dst = make_float4(blo(lrr.x), bhi(lrr.x), blo(lrr.y), bhi(lrr.y));
      *(float4*)(dst + 4) = make_float4(blo(lrr.z), bhi(lrr.z), blo(lrr.w), bhi(lrr.w));
    }
    if (lt < 64) {
      const int stp = lt >> 1, off = (lt & 1) * 8;
      float* dst = bb + stp * STEPF + 320 + off;
      *(float4*)dst = make_float4(blo(lrv.x), bhi(lrv.x), blo(lrv.y), bhi(lrv.y));
      *(float4*)(dst + 4) = make_float4(blo(lrv.z), bhi(lrv.z), blo(lrv.w), bhi(lrv.w));
    }
  };
  if (wave >= 4) { gload(0); swrite(0); if (nch > 1) gload(1); }
  lds_barrier();
  for (int c = 0; c < nch; ++c) {
    if (wave < 4) {
      const float* bb = buf + (c & 1) * SCH * STEPF;
      const int pos0 = s * 1024 + c * SCH;
      const int row0 = scan_row(b, d, pos0), rstep = d ? -1 : 1;
      u16* yp = Yd + (size_t)row0 * 1024 + h * 64 + rq * 16 + rl;
      float4 kk = *(const float4*)(bb + q * 4), wm = *(const float4*)(bb + 64 + q * 4), ka = *(const float4*)(bb + 128 + q * 4);
      float4 kd = *(const float4*)(bb + 192 + q * 4), rr = *(const float4*)(bb + 256 + q * 4);
      float vv = bb[320 + rl];
      float yv[16];
#pragma unroll
      for (int stp = 0; stp < SCH; ++stp) {
        const float* sn = bb + (stp + 1 < SCH ? stp + 1 : stp) * STEPF;
        const float4 kkn = *(const float4*)(sn + q * 4), wmn = *(const float4*)(sn + 64 + q * 4), kan = *(const float4*)(sn + 128 + q * 4);
        const float4 kdn = *(const float4*)(sn + 192 + q * 4), rrn = *(const float4*)(sn + 256 + q * 4);
        const float vvn = sn[320 + rl];
        __builtin_amdgcn_sched_barrier(0);
        const f32x2 vv2 = (f32x2){vv, vv};
        f32x2 ta = sa * (f32x2){wm.x, wm.y} + sa, tb = sb * (f32x2){wm.z, wm.w} + sb;
        ta = vv2 * (f32x2){kd.x, kd.y} + ta; tb = vv2 * (f32x2){kd.z, kd.w} + tb;
        f32x2 ud = sa * (f32x2){kk.x, kk.y}; ud = sb * (f32x2){kk.z, kk.w} + ud;
        float u = ror_add16(ud.x + ud.y);
        const f32x2 nu = (f32x2){-u, -u};
        sa = nu * (f32x2){ka.x, ka.y} + ta; sb = nu * (f32x2){ka.z, ka.w} + tb;
        f32x2 yd2 = sa * (f32x2){rr.x, rr.y}; yd2 = sb * (f32x2){rr.z, rr.w} + yd2;
        yv[stp & 15] = yd2.x + yd2.y;
        if ((stp & 15) == 15) {
          const bool b3 = q & 8, b2 = q & 4, b1 = q & 2, b0 = q & 1;
          float z8[8], z4[4], z2[2];
#pragma unroll
          for (int i = 0; i < 8; ++i) { const float kp = b3 ? yv[i + 8] : yv[i], sd = b3 ? yv[i] : yv[i + 8]; z8[i] = kp + __int_as_float(__builtin_amdgcn_update_dpp(0, __float_as_int(sd), 0x140, 0xf, 0xf, false)); }
#pragma unroll
          for (int i = 0; i < 4; ++i) { const float kp = b2 ? z8[i + 4] : z8[i], sd = b2 ? z8[i] : z8[i + 4]; z4[i] = kp + __int_as_float(__builtin_amdgcn_update_dpp(0, __float_as_int(sd), 0x141, 0xf, 0xf, false)); }
#pragma unroll
          for (int i = 0; i < 2; ++i) { const float kp = b1 ? z4[i + 2] : z4[i], sd = b1 ? z4[i] : z4[i + 2]; z2[i] = kp + __int_as_float(__builtin_amdgcn_update_dpp(0, __float_as_int(sd), 0x1B, 0xf, 0xf, false)); }
          const float kp = b0 ? z2[1] : z2[0], sd = b0 ? z2[0] : z2[1];
          const float yq = kp + __int_as_float(__builtin_amdgcn_update_dpp(0, __float_as_int(sd), 0xB1, 0xf, 0xf, false));
          yp[(ptrdiff_t)((stp & ~15) + q) * rstep * 1024] = f2b(yq);
        }
        kk = kkn; wm = wmn; ka = kan; kd = kdn; rr = rrn; vv = vvn;
      }
    } else {
      if (c + 1 < nch) swrite(c + 1);
      if (c + 2 < nch) gload(c + 2);
    }
    lds_barrier();
  }
  if (wave < 4 && save) *(float4*)(st + ((size_t)blockIdx.x * 256 + tid) * 4) = make_float4(sa.x, sa.y, sb.x, sb.y);
  __syncthreads();
}
DI void ph_rw_finish(const Params& p, int jj, char* smem) {
  const u16* P1 = (const u16*)(p.ws + OFF_SCR);
  const u16* G2T = (const u16*)(p.ws + OFF_WT) + WT_G2T;
  u16* Y0 = (u16*)(p.ws + OFF_SCR) + (size_t)R * P1LD;
  const u16* Y1 = Y0 + (size_t)R * 1024;
  const float* bonus = (const float*)(p.ws + OFF_BONUS);
  const int lane = otid() & 63, wave = otid() >> 6, wr = wave >> 1, wc = wave & 1, fr = lane & 15, fq = lane >> 4;
  for (int it = 0;; ++it) {
    int mt, nt; if (!next_tile(it, 130, 8, 1, mt, nt)) break;
    ALPlain al{P1 + (size_t)mt * 256 * P1LD + 3328, P1LD};
    f32x4 acc[4][4];
    gemm_main3(al, G2T + (size_t)nt * 128 * 128, 128, 128, acc, smem);
    const int h = nt * 2 + wc;
#pragma unroll
    for (int m = 0; m < 4; ++m) {
      const int row = mt * 256 + wr * 64 + m * 16 + fr;
      float y[4][4]; float sm = 0.f;
#pragma unroll
      for (int n = 0; n < 4; ++n) {
        const int c = h * 64 + n * 16 + fq * 4;
        uint2 a = *(const uint2*)(Y0 + (size_t)row * 1024 + c), b2 = *(const uint2*)(Y1 + (size_t)row * 1024 + c);
        y[n][0] = blo(a.x) + blo(b2.x); y[n][1] = bhi(a.x) + bhi(b2.x); y[n][2] = blo(a.y) + blo(b2.y); y[n][3] = bhi(a.y) + bhi(b2.y);
        sm += y[n][0] + y[n][1] + y[n][2] + y[n][3];
      }
      sm += __shfl_xor(sm, 16); sm += __shfl_xor(sm, 32);
      const float mean = sm * (1.f / 64.f);
      float vs = 0.f;
#pragma unroll
      for (int n = 0; n < 4; ++n)
#pragma unroll
        for (int j = 0; j < 4; ++j) { float dlt = y[n][j] - mean; vs += dlt * dlt; }
      vs += __shfl_xor(vs, 16); vs += __shfl_xor(vs, 32);
      const float rs = rsqrtf(vs * (1.f / 64.f) + 64e-5f);
      const float bn = bonus[(size_t)row * 32 + h * 2] + bonus[(size_t)row * 32 + h * 2 + 1];
#pragma unroll
      for (int n = 0; n < 4; ++n) {
        const int c = h * 64 + n * 16 + fq * 4;
        float4 lg = *(const float4*)(p.in[IRLNG] + jj * 1024 + c), lb = *(const float4*)(p.in[IRLNB] + jj * 1024 + c);
        uint2 v2 = *(const uint2*)(P1 + (size_t)row * P1LD + 2048 + c);
        float o0 = ((y[n][0] - mean) * rs * lg.x + lb.x + bn * blo(v2.x)) * acc[m][n][0];
        float o1 = ((y[n][1] - mean) * rs * lg.y + lb.y + bn * bhi(v2.x)) * acc[m][n][1];
        float o2 = ((y[n][2] - mean) * rs * lg.z + lb.z + bn * blo(v2.y)) * acc[m][n][2];
        float o3 = ((y[n][3] - mean) * rs * lg.w + lb.w + bn * bhi(v2.y)) * acc[m][n][3];
        uint2 w; w.x = pack2(o0, o1); w.y = pack2(o2, o3);
        *(uint2*)(Y0 + (size_t)row * 1024 + c) = w;
      }
    }
  }
}

DI void ph_ssd_s1(const Params& p, int jj, char* smem) {
  const u16* H = (const u16*)(p.ws + OFF_H);
  const u16* BT = (const u16*)(p.ws + OFF_WT) + WT_SX;
  u16* XBC = (u16*)(p.ws + OFF_SCR);
  float* DTg = (float*)(p.ws + OFF_DT);
  float* P = (float*)smem;
  const float* cw = p.in[ISCONVW] + (size_t)jj * 3 * 4096;
  const float* cb = p.in[ISCONVB] + (size_t)jj * 4096;
  const int tid = otid(), lane = tid & 63, wave = tid >> 6, wr = wave >> 1, wc = wave & 1, fr = lane & 15, fq = lane >> 4;
  for (int it = 0;; ++it) {
    int mt, nt; if (!next_tile(it, 134, 33, 1, mt, nt)) break;
    const int b = mt / 67, ml = mt - b * 67;
    int rowbase, t0, len;
    if (ml < 2) { rowbase = b * TS; t0 = ml * 254; len = TC; } else { rowbase = b * TS + TC; t0 = (ml - 2) * 254; len = T; }
    ALHalo al{H + (size_t)rowbase * 1024, t0 - 1, len};
    f32x4 acc[4][4];
    gemm_main3(al, BT + (size_t)nt * 128 * 1024, 1024, 1024, acc, smem);
#pragma unroll
    for (int m = 0; m < 4; ++m)
#pragma unroll
      for (int n = 0; n < 4; ++n) *(f32x4*)&P[(wr * 64 + m * 16 + fr) * 132 + wc * 64 + n * 16 + fq * 4] = acc[m][n];
    __syncthreads();
    if (nt < 32) {
      const int col = tid & 127, rg = tid >> 7, ch = nt * 128 + col;
      const float w0 = cw[ch], w1 = cw[4096 + ch], w2 = cw[8192 + ch], bias = cb[ch];
      const int i0 = 1 + rg * 64, i1 = min(i0 + 64, 255);
      float pv = P[(i0 - 1) * 132 + col], cv = P[i0 * 132 + col];
      for (int i = i0; i < i1; ++i) {
        const float nv = P[(i + 1) * 132 + col];
        const float v = w0 * pv + w1 * cv + w2 * nv + bias;
        const int tt = t0 - 1 + i;
        if (tt < len) XBC[(size_t)(rowbase + tt) * 4096 + ch] = f2b(siluf(v));
        pv = cv; cv = nv;
      }
    } else {
      const int col = tid & 63, rg = tid >> 6;
      const int i0 = 1 + rg * 32, i1 = min(i0 + 32, 255);
      for (int i = i0; i < i1; ++i) { const int tt = t0 - 1 + i; if (tt < len) DTg[(size_t)(rowbase + tt) * 64 + col] = P[i * 132 + col]; }
    }
  }
}
DI void ph_ssd_scan(const Params& p, int jj, char* smem) {
  if (blockIdx.x >= 256) return;
  const u16* XBC = (const u16*)(p.ws + OFF_SCR);
  u16* Y = (u16*)(p.ws + OFF_SCR) + (size_t)R * 4096;
  const float* DTg = (const float*)(p.ws + OFF_DT);
  const int tid = otid(), lane = tid & 63, wave = tid >> 6, fr = lane & 15, fq = lane >> 4;
  const int xcd_ = blockIdx.x & 7, slot_ = blockIdx.x >> 3, gid_ = xcd_ * 2 + (slot_ >> 4), mem_ = slot_ & 15;
  const int b = gid_ >> 3, g = gid_ & 7, head = g * 4 + (mem_ >> 2), pq = mem_ & 3;
  constexpr int DIRB = 80896;
  const int xp_ = tid & 15, xj0 = (tid >> 4) & 15;
  float Aneg[2], dtb[2];
#pragma unroll
  for (int d = 0; d < 2; ++d) { Aneg[d] = -__expf(p.in[ISALOG][(jj * 2 + d) * 32 + head]); dtb[d] = p.in[ISDTB][(jj * 2 + d) * 32 + head]; }
  const float Dsk = p.in[ISD][jj * 32 + head];
  f32x4 hst[2] = {(f32x4){0.f, 0.f, 0.f, 0.f}, (f32x4){0.f, 0.f, 0.f, 0.f}};
  uint4 pre[2][5];
  float dtpre[2] = {0.f, 0.f};
  auto gl_raw = [&](int ci, int d, uint4 (&pr)[5], float& dtp) {
    const int r0 = scan_row(b, d, ci * 64), r63 = scan_row(b, d, ci * 64 + 63);
    const int rmin = min(r0, r63);
    const int cc = tid & 31, rrb = tid >> 5;
    const int gcb = cc < 16 ? 2048 + g * 128 + cc * 8 : 3072 + g * 128 + (cc - 16) * 8;
    const u16* src = XBC + (size_t)(rmin + rrb) * 4096 + gcb;
#pragma unroll
    for (int i = 0; i < 4; ++i) pr[i] = *(const uint4*)(src + (size_t)i * 16 * 4096);
    pr[4] = *(const uint4*)(XBC + (size_t)(rmin + ((tid & 127) >> 1)) * 4096 + head * 64 + pq * 16 + (tid & 1) * 8);
    dtp = DTg[(size_t)(r0 + lane * (d ? -1 : 1)) * 64 + d * 32 + head];
  };
  __syncthreads();
  gl_raw(0, 0, pre[0], dtpre[0]);
  gl_raw(0, 1, pre[1], dtpre[1]);
  for (int ci = 0; ci < 260; ++ci) {
    const bool second = ci < 4 ? (ci >= 2) : (ci - 4 >= 128);
    unsigned ypre[2][2];
#pragma unroll
    for (int d = 0; d < 2; ++d) {
      u16* Cs = (u16*)(smem + d * DIRB); u16* Bs = Cs + 64 * 144; u16* BsT = Bs + 64 * 144; u16* Ms = BsT + 128 * 80;
      u16* XdtT = Ms + 64 * 72; u16* XwT = XdtT + 16 * 80; u16* Hs = XwT + 16 * 80;
      float* Xp = (float*)(Hs + 16 * 144); float* dts = Xp + 64 * 16; float* css = dts + 64;
      const int r0 = scan_row(b, d, ci * 64), rstep = d ? -1 : 1;
      {
        int t2 = tid; asm volatile("" : "+v"(t2));
        const int cc = t2 & 31;
#pragma unroll
        for (int i = 0; i < 4; ++i) {
          const int rr = (t2 >> 5) + 16 * i, j = d ? 63 - rr : rr;
          if (cc < 16) {
            *(uint4*)&Bs[j * 144 + cc * 8] = pre[d][i];
            const u16* hv = (const u16*)&pre[d][i];
#pragma unroll
            for (int e = 0; e < 8; ++e) BsT[(cc * 8 + e) * 80 + (j ^ ((cc & 7) << 3))] = hv[e];
          } else *(uint4*)&Cs[j * 144 + (cc - 16) * 8] = pre[d][i];
        }
        if (t2 < 128) {
          const int rr = t2 >> 1, j = d ? 63 - rr : rr;
          const u16* hv = (const u16*)&pre[d][4];
#pragma unroll
          for (int e = 0; e < 8; ++e) Xp[j * 16 + (tid & 1) * 8 + e] = b2f(hv[e]);
        }
      }
      if (wave == d) {
        const float dt = softplusf(dtpre[d] + dtb[d]);
        float a = dt * Aneg[d];
#pragma unroll
        for (int o = 1; o < 64; o <<= 1) { float tv = __shfl_up(a, o); if (lane >= o) a += tv; }
        dts[lane] = dt; css[lane] = a;
      }
#pragma unroll
      for (int e = 0; e < 4; ++e) Hs[(fq * 4 + e) * 144 + wave * 16 + fr] = f2b(hst[d][e]);
#pragma unroll
      for (int e = 0; e < 2; ++e) {
        const u16* yb = Y + (size_t)(r0 + ((wave & 3) * 16 + fq * 4 + 2 * e) * rstep) * 2048 + head * 64 + pq * 16 + fr;
        ypre[d][e] = (unsigned)yb[0] | ((unsigned)yb[(ptrdiff_t)rstep * 2048] << 16);
      }
      __builtin_amdgcn_sched_barrier(0);
    }
    __builtin_amdgcn_sched_barrier(0);
    if (ci + 1 < 260) { gl_raw(ci + 1, 0, pre[0], dtpre[0]); gl_raw(ci + 1, 1, pre[1], dtpre[1]); }
    lds_barrier();
#pragma unroll
    for (int d = 0; d < 2; ++d) {
      u16* Cs = (u16*)(smem + d * DIRB); u16* Bs = Cs + 64 * 144; u16* BsT = Bs + 64 * 144; u16* Ms = BsT + 128 * 80;
      u16* XdtT = Ms + 64 * 72; u16* XwT = XdtT + 16 * 80; u16* Hs = XwT + 16 * 80;
      float* Xp = (float*)(Hs + 16 * 144); float* dts = Xp + 64 * 16; float* css = dts + 64;
      const float cs63 = css[63];
      if (tid < 256) {
#pragma unroll
        for (int i = 0; i < 4; ++i) {
          const int j = xj0 + 16 * i;
          const float xv = Xp[j * 16 + xp_];
          const float dt = dts[j];
          XdtT[xp_ * 80 + j] = f2b(xv * dt);
          XwT[xp_ * 80 + j] = f2b(xv * dt * __expf(cs63 - css[j]));
        }
      }
      const int ib = wave >> 1;
#pragma unroll
      for (int jb2 = 0; jb2 < 2; ++jb2) {
        const int jb = (wave & 1) * 2 + jb2;
        f32x4 acc = (f32x4){0.f, 0.f, 0.f, 0.f};
#pragma unroll
        for (int ks = 0; ks < 4; ++ks) {
          const bf16x8 bfr = *(const bf16x8*)&Bs[(jb * 16 + fr) * 144 + ks * 32 + fq * 8];
          const bf16x8 cfr = *(const bf16x8*)&Cs[(ib * 16 + fr) * 144 + ks * 32 + fq * 8];
          acc = MFMA(bfr, cfr, acc);
        }
        const int i = ib * 16 + fr;
        const float csi = css[i];
        float mv[4];
#pragma unroll
        for (int e = 0; e < 4; ++e) { const int j = jb * 16 + fq * 4 + e; mv[e] = (j <= i) ? acc[e] * __expf(csi - css[j]) : 0.f; }
        uint2 w; w.x = pack2(mv[0], mv[1]); w.y = pack2(mv[2], mv[3]);
        *(uint2*)&Ms[i * 72 + jb * 16 + fq * 4] = w;
      }
      __builtin_amdgcn_sched_barrier(0);
    }
    lds_barrier();
#pragma unroll
    for (int d = 0; d < 2; ++d) {
      u16* Cs = (u16*)(smem + d * DIRB); u16* Bs = Cs + 64 * 144; u16* BsT = Bs + 64 * 144; u16* Ms = BsT + 128 * 80;
      u16* XdtT = Ms + 64 * 72; u16* XwT = XdtT + 16 * 80; u16* Hs = XwT + 16 * 80;
      float* Xp = (float*)(Hs + 16 * 144); float* dts = Xp + 64 * 16; float* css = dts + 64;
      const int r0 = scan_row(b, d, ci * 64), rstep = d ? -1 : 1;
      const float cs63 = css[63];
      if (wave < 4) {
        const int ib = wave;
        f32x4 yd = (f32x4){0.f, 0.f, 0.f, 0.f}, yo = (f32x4){0.f, 0.f, 0.f, 0.f};
#pragma unroll
        for (int ks = 0; ks < 2; ++ks) {
          const bf16x8 mf = *(const bf16x8*)&Ms[(ib * 16 + fr) * 72 + ks * 32 + fq * 8];
          const bf16x8 xf = *(const bf16x8*)&XdtT[fr * 80 + ks * 32 + fq * 8];
          yd = MFMA(mf, xf, yd);
        }
#pragma unroll
        for (int ks = 0; ks < 4; ++ks) {
          const bf16x8 cf = *(const bf16x8*)&Cs[(ib * 16 + fr) * 144 + ks * 32 + fq * 8];
          const bf16x8 hf = *(const bf16x8*)&Hs[fr * 144 + ks * 32 + fq * 8];
          yo = MFMA(cf, hf, yo);
        }
#pragma unroll
        for (int e = 0; e < 4; ++e) {
          const int i = ib * 16 + fq * 4 + e;
          float y = yd[e] + __expf(css[i]) * yo[e];
          u16* ya = Y + (size_t)(r0 + i * rstep) * 2048 + head * 64 + pq * 16 + fr;
          if (second) y += ((e & 1) ? bhi(ypre[d][e >> 1]) : blo(ypre[d][e >> 1])) + Xp[i * 16 + fr] * Dsk;
          *ya = f2b(y);
        }
      }
      {
        const float dec = __expf(cs63);
        hst[d][0] *= dec; hst[d][1] *= dec; hst[d][2] *= dec; hst[d][3] *= dec;
#pragma unroll
        for (int ks = 0; ks < 2; ++ks) {
          const bf16x8 xf = *(const bf16x8*)&XwT[fr * 80 + ks * 32 + fq * 8];
          const bf16x8 bf = *(const bf16x8*)&BsT[(wave * 16 + fr) * 80 + (((ks * 4 + fq) ^ ((wave * 2 + (fr >> 3)) & 7)) << 3)];
          hst[d] = MFMA(xf, bf, hst[d]);
        }
      }
      __builtin_amdgcn_sched_barrier(0);
    }
    if (ci == 1 || ci == 131) asm volatile("s_waitcnt vmcnt(0)" ::: "memory");
    lds_barrier();
  }
}
DI void ph_ssd_s3(const Params& p, char* smem) {
  const u16* H = (const u16*)(p.ws + OFF_H);
  const u16* BT = (const u16*)(p.ws + OFF_WT) + WT_SZ;
  u16* Y = (u16*)(p.ws + OFF_SCR) + (size_t)R * 4096;
  float* ssq = (float*)(p.ws + OFF_SSQ);
  const int lane = otid() & 63, wave = otid() >> 6, wr = wave >> 1, wc = wave & 1, fr = lane & 15, fq = lane >> 4;
  for (int it = 0;; ++it) {
    int mt, nt; if (!next_tile(it, 130, 16, 1, mt, nt)) break;
    ALPlain al{H + (size_t)mt * 256 * 1024, 1024};
    f32x4 acc[4][4];
    gemm_main3(al, BT + (size_t)nt * 128 * 1024, 1024, 1024, acc, smem);
#pragma unroll
    for (int m = 0; m < 4; ++m) {
      const int row = mt * 256 + wr * 64 + m * 16 + fr;
      float sq = 0.f;
#pragma unroll
      for (int n = 0; n < 4; ++n) {
        const int c = nt * 128 + wc * 64 + n * 16 + fq * 4;
        uint2 yv = *(const uint2*)(Y + (size_t)row * 2048 + c);
        const float o0 = blo(yv.x) * siluf(acc[m][n][0]), o1 = bhi(yv.x) * siluf(acc[m][n][1]);
        const float o2 = blo(yv.y) * siluf(acc[m][n][2]), o3 = bhi(yv.y) * siluf(acc[m][n][3]);
        sq += o0 * o0 + o1 * o1 + o2 * o2 + o3 * o3;
        uint2 w; w.x = pack2(o0, o1); w.y = pack2(o2, o3);
        *(uint2*)(Y + (size_t)row * 2048 + c) = w;
      }
      sq += __shfl_xor(sq, 16); sq += __shfl_xor(sq, 32);
      if (fq == 0) atomicAdd(ssq + (size_t)row * 8 + (nt >> 1), sq);
    }
  }
}
struct ALScale {
  const u16* Y; int row0; const float* rsT; const float* ngT;
  DI uint4 operator()(int i, int k) const { return *(const uint4*)(Y + (size_t)(row0 + i) * 2048 + k); }
  DI uint4 post(uint4 c, int i, int k) const {
    const float rs = rsT[i * 8 + (k >> 8)];
    const float4 g0 = *(const float4*)(ngT + k), g1 = *(const float4*)(ngT + k + 4);
    uint4 o;
    o.x = pack2(blo(c.x) * rs * g0.x, bhi(c.x) * rs * g0.y); o.y = pack2(blo(c.y) * rs * g0.z, bhi(c.y) * rs * g0.w);
    o.z = pack2(blo(c.z) * rs * g1.x, bhi(c.z) * rs * g1.y); o.w = pack2(blo(c.w) * rs * g1.z, bhi(c.w) * rs * g1.w);
    return o;
  }
};
DI void ph_ssd_s4(const Params& p, int l, int jj, char* smem) {
  const u16* Y = (const u16*)(p.ws + OFF_SCR) + (size_t)R * 4096;
  const u16* BT = (const u16*)(p.ws + OFF_WT) + WT_SO;
  for (int it = 0;; ++it) {
    int mt, nt; if (!next_tile(it, 130, 8, 1, mt, nt)) break;
    float* rsT = (float*)(smem + 112640); float* ngT = rsT + 2048;
    {
      const float* ssq = (const float*)(p.ws + OFF_SSQ) + (size_t)mt * 256 * 8;
      const float* ng = p.in[ISNG] + jj * 2048;
      for (int e = otid(); e < 2048; e += 512) { rsT[e] = rsqrtf(ssq[e] * (1.f / 256.f) + 1e-6f); ngT[e] = ng[e]; }
    }
    ALScale al{Y, mt * 256, rsT, ngT};
    resid_tile(p, al, BT, 2048, l, 2, mt, nt, smem);
  }
}

DI void ph_at_qkv(const Params& p, char* smem) {
  const u16* H = (const u16*)(p.ws + OFF_H);
  const u16* BT = (const u16*)(p.ws + OFF_WT) + WT_AQ;
  u16* QKV = (u16*)(p.ws + OFF_SCR);
  const int lane = otid() & 63, wave = otid() >> 6, wr = wave >> 1, wc = wave & 1, fr = lane & 15, fq = lane >> 4;
  for (int it = 0;; ++it) {
    int mt, nt; if (!next_tile(it, 130, 12, 1, mt, nt)) break;
    ALPlain al{H + (size_t)mt * 256 * 1024, 1024};
    f32x4 acc[4][4];
    gemm_main3(al, BT + (size_t)nt * 128 * 1024, 1024, 1024, acc, smem);
    const int q0 = (mt * 256) % TS;
    const bool rope = (q0 >= TC) && (nt < 10);
#pragma unroll
    for (int m = 0; m < 4; ++m) {
      const int rl = wr * 64 + m * 16 + fr;
      const int row = mt * 256 + rl;
      if (rope) {
        const int tt = q0 - TC + rl;
        const float prow = (float)(tt >> 6), pcol = (float)(tt & 63);
#pragma unroll
        for (int e = 0; e < 4; ++e) {
          const float inv = exp2f(-13.287712379549449f * (float)(fq * 4 + e) * (1.f / 16.f));
          float sn, cs;
          sn = __sinf(prow * inv); cs = __cosf(prow * inv);
          float x1 = acc[m][0][e], x2 = acc[m][1][e];
          acc[m][0][e] = x1 * cs - x2 * sn; acc[m][1][e] = x1 * sn + x2 * cs;
          sn = __sinf(pcol * inv); cs = __cosf(pcol * inv);
          x1 = acc[m][2][e]; x2 = acc[m][3][e];
          acc[m][2][e] = x1 * cs - x2 * sn; acc[m][3][e] = x1 * sn + x2 * cs;
        }
      }
#pragma unroll
      for (int n = 0; n < 4; ++n) {
        const int c = nt * 128 + wc * 64 + n * 16 + fq * 4;
        uint2 w; w.x = pack2(acc[m][n][0], acc[m][n][1]); w.y = pack2(acc[m][n][2], acc[m][n][3]);
        *(uint2*)(QKV + (size_t)row * 1536 + c) = w;
      }
    }
  }
}
DI void ph_attn(const Params& p, int jj, char* smem) {
  const u16* QKV = (const u16*)(p.ws + OFF_SCR);
  u16* O = (u16*)(p.ws + OFF_SCR) + (size_t)R * 1536;
  u16* Ks = (u16*)smem;
  u16* Vt = Ks + 64 * 80;
  u16* Ps = Vt + 64 * 80;
  const int tid = otid(), lane = tid & 63, wave = tid >> 6, fr = lane & 15, fq = lane >> 4;
  const int g = wave >> 1, th = (wave & 1) * 32;
  u16* Pw = Ps + wave * 32 * 80;
  for (int tl = (int)(blockIdx.x >> 3); tl < 260; tl += (int)(gridDim.x >> 3)) {
    const int kvh = blockIdx.x & 3, b = (blockIdx.x >> 2) & 1;
    const int isctx = tl >= 256 ? 1 : 0, qb = isctx ? tl - 256 : tl;
    const int t0 = qb * 64, qrow0 = b * TS + (isctx ? 0 : TC) + t0;
    const int head = kvh * 4 + g;
    bf16x8 qf[2][2];
#pragma unroll
    for (int m = 0; m < 2; ++m)
#pragma unroll
      for (int kh = 0; kh < 2; ++kh) {
        uint4 v = *(const uint4*)(QKV + (size_t)(qrow0 + th + m * 16 + fr) * 1536 + head * 64 + kh * 32 + fq * 8);
        uint4 o;
        o.x = pack2(blo(v.x) * 0.125f, bhi(v.x) * 0.125f); o.y = pack2(blo(v.y) * 0.125f, bhi(v.y) * 0.125f);
        o.z = pack2(blo(v.z) * 0.125f, bhi(v.z) * 0.125f); o.w = pack2(blo(v.w) * 0.125f, bhi(v.w) * 0.125f);
        qf[m][kh] = *(bf16x8*)&o;
      }
    const float sink = p.in[IASINK][jj * 16 + head];
    float mrun[2] = {sink, sink}, lrun[2] = {1.f, 1.f};
    f32x4 o[2][4];
#pragma unroll
    for (int m = 0; m < 2; ++m)
#pragma unroll
      for (int n = 0; n < 4; ++n) o[m][n] = (f32x4){0.f, 0.f, 0.f, 0.f};
    const int i_lo = t0 >= 128 ? 0 : (t0 >= 64 ? 1 : 2);
    const int i_hi = t0 == T - 64 ? 2 : (t0 == T - 128 ? 3 : 4);
    const int nkt = isctx ? 4 : 4 + (i_hi - i_lo + 1);
    const int skey = tid >> 3, sdc = (tid & 7) * 8;
    uint4 kreg, vreg;
    auto kv_load = [&](int idx) {
      int krow0;
      if (idx < 4) krow0 = b * TS + idx * 64; else krow0 = b * TS + TC + t0 - 128 + 64 * (i_lo + idx - 4);
      const u16* src = QKV + (size_t)(krow0 + skey) * 1536 + 1024 + kvh * 64 + sdc;
      kreg = *(const uint4*)src; vreg = *(const uint4*)(src + 256);
    };
    kv_load(0);
    for (int kt = 0; kt < nkt; ++kt) {
      const int li = i_lo + kt - 4;
      const int mode = kt < 4 ? 0 : (li == 0 ? 1 : (li == 4 ? 2 : 0));
      lds_barrier();
      {
        *(uint4*)&Ks[skey * 80 + sdc] = kreg;
        const u16* vv = (const u16*)&vreg;
#pragma unroll
        for (int e = 0; e < 8; ++e) Vt[(sdc + e) * 80 + (skey ^ ((tid & 7) << 3))] = vv[e];
      }
      lds_barrier();
      if (kt + 1 < nkt) kv_load(kt + 1);
      f32x4 sacc[2][4];
#pragma unroll
      for (int m = 0; m < 2; ++m)
#pragma unroll
        for (int n = 0; n < 4; ++n) sacc[m][n] = (f32x4){0.f, 0.f, 0.f, 0.f};
#pragma unroll
      for (int kh = 0; kh < 2; ++kh)
#pragma unroll
        for (int n = 0; n < 4; ++n) {
          const bf16x8 kf = *(const bf16x8*)&Ks[(n * 16 + fr) * 80 + kh * 32 + fq * 8];
#pragma unroll
          for (int m = 0; m < 2; ++m) sacc[m][n] = MFMA(kf, qf[m][kh], sacc[m][n]);
        }
#pragma unroll
      for (int m = 0; m < 2; ++m) {
        const int qi = th + m * 16 + fr;
        float mx = -3.0e38f;
#pragma unroll
        for (int n = 0; n < 4; ++n)
#pragma unroll
          for (int e = 0; e < 4; ++e) {
            const int ki = n * 16 + fq * 4 + e;
            if ((mode == 1 && ki < qi) || (mode == 2 && ki > qi)) sacc[m][n][e] = -INFINITY;
            mx = fmaxf(mx, sacc[m][n][e]);
          }
        mx = fmaxf(mx, __shfl_xor(mx, 16)); mx = fmaxf(mx, __shfl_xor(mx, 32));
        const float mnew = fmaxf(mrun[m], mx);
        const float alpha = __expf(mrun[m] - mnew);
        float ps = 0.f;
#pragma unroll
        for (int n = 0; n < 4; ++n) {
          const float p0 = __expf(sacc[m][n][0] - mnew), p1 = __expf(sacc[m][n][1] - mnew), p2 = __expf(sacc[m][n][2] - mnew), p3 = __expf(sacc[m][n][3] - mnew);
          ps += p0 + p1 + p2 + p3;
          uint2 w; w.x = pack2(p0, p1); w.y = pack2(p2, p3);
          *(uint2*)&Pw[(m * 16 + fr) * 80 + n * 16 + fq * 4] = w;
        }
        ps += __shfl_xor(ps, 16); ps += __shfl_xor(ps, 32);
        lrun[m] = lrun[m] * alpha + ps; mrun[m] = mnew;
#pragma unroll
        for (int n = 0; n < 4; ++n) { o[m][n][0] *= alpha; o[m][n][1] *= alpha; o[m][n][2] *= alpha; o[m][n][3] *= alpha; }
      }
      __builtin_amdgcn_fence(__ATOMIC_RELEASE, "wavefront");
      __builtin_amdgcn_wave_barrier();
      __builtin_amdgcn_fence(__ATOMIC_ACQUIRE, "wavefront");
#pragma unroll
      for (int ks = 0; ks < 2; ++ks) {
        bf16x8 pf[2];
#pragma unroll
        for (int m = 0; m < 2; ++m) pf[m] = *(const bf16x8*)&Pw[(m * 16 + fr) * 80 + ks * 32 + fq * 8];
#pragma unroll
        for (int nd = 0; nd < 4; ++nd) {
          const bf16x8 vf = *(const bf16x8*)&Vt[(nd * 16 + fr) * 80 + (((ks * 4 + fq) ^ ((nd * 2 + (fr >> 3)) & 7)) << 3)];
#pragma unroll
          for (int m = 0; m < 2; ++m) o[m][nd] = MFMA(vf, pf[m], o[m][nd]);
        }
      }
    }
#pragma unroll
    for (int m = 0; m < 2; ++m) {
      const float il = 1.f / lrun[m];
      const int row = qrow0 + th + m * 16 + fr;
#pragma unroll
      for (int nd = 0; nd < 4; ++nd) {
        uint2 w; w.x = pack2(o[m][nd][0] * il, o[m][nd][1] * il); w.y = pack2(o[m][nd][2] * il, o[m][nd][3] * il);
        *(uint2*)(O + (size_t)row * 1024 + head * 64 + nd * 16 + fq * 4) = w;
      }
    }
  }
}

#define DBL_A 0
#define DBL_B 0
#define DBL_C 0
#define DBL_D 0
#define DBL_E 0
DI int layer_phases(int l) { int k = l % 3; return k == 0 ? 25 : (k == 1 ? 8 : 7); }
constexpr int N_PHASES = 2 + 25 + 8 + 7 + 25 + 1;

DI void run_phase(const Params& p, int ph, char* smem) {
  if (ph == 0) { ph_prologue(p, smem); ph_convert(p, 0, smem); return; }
  if (ph == 1) { ph_modreduce(p); return; }
  int q = ph - 2, l = 0;
  while (l < 4 && q >= layer_phases(l)) { q -= layer_phases(l); ++l; }
  if (l == 4) { ph_final(p); return; }
  const int kind = l % 3, jj = l / 3;
  const int np = layer_phases(l);
  const u16* wt = (const u16*)(p.ws + OFF_WT);
  if (q == 0) { ph_norm(p, l, 0); if (l > 0) ph_convert(p, l, smem); return; }
  if (q == np - 3) { ph_norm(p, l, 1); return; }
  if (q == np - 2) { ph_ffn1(p, l, smem);
#if DBL_A
    ph_ffn1(p, l, smem);
#endif
    return; }
  if (q == np - 1) { ph_resid_gemm(p, (const u16*)(p.ws + OFF_SCR), FF, wt + WT_W2T, FF, l, 5, smem); return; }
  if (kind == 0) {
    if (q == 1) { ph_rw_r1(p, jj, smem);
#if DBL_A
    ph_rw_r1(p, jj, smem);
#endif
    return; }
    if (q >= 2 && q <= 19) { int s = q - 2; if (s >= 1) {
#if DBL_D
      ph_rw_scan(p, s - 1, smem, false);
#endif
      ph_rw_scan(p, s - 1, smem); }
      if (s < 17) { ph_rw_produce(p, jj, s, smem);
#if DBL_E
      ph_rw_produce(p, jj, s, smem);
#endif
      } return; }
    if (q == 20) { ph_rw_finish(p, jj, smem); return; }
    if (q == 21) { ph_resid_gemm(p, (const u16*)(p.ws + OFF_SCR) + (size_t)R * P1LD, 1024, wt + WT_RWO, 1024, l, 2, smem); return; }
  } else if (kind == 1) {
    if (q == 1) { ph_ssd_s1(p, jj, smem); return; }
    if (q == 2) { ph_ssd_scan(p, jj, smem);
#if DBL_B
    ph_ssd_scan(p, jj, smem);
#endif
    return; }
    if (q == 3) { ph_ssd_s3(p, smem); return; }
    if (q == 4) { ph_ssd_s4(p, l, jj, smem); return; }
  } else {
    if (q == 1) { ph_at_qkv(p, smem);
#if DBL_A
    ph_at_qkv(p, smem);
#endif
    return; }
    if (q == 2) { ph_attn(p, jj, smem);
#if DBL_C
    ph_attn(p, jj, smem);
#endif
    return; }
    if (q == 3) { ph_resid_gemm(p, (const u16*)(p.ws + OFF_SCR) + (size_t)R * 1536, 1024, wt + WT_AO, 1024, l, 2, smem); return; }
  }
}

extern "C" __global__ void __launch_bounds__(512) mega(Params p, int ph_lo, int ph_hi) {
  extern __shared__ __attribute__((aligned(16))) char smem[];
  cg::grid_group grid = cg::this_grid();
#ifndef PROBE
#define PROBE 0
#endif
#if PROBE
  unsigned long long* tsb = (unsigned long long*)(p.ws + OFF_MODP);
#endif
  __shared__ uint4 xb_words;
  if (threadIdx.x == 0) xb_words = make_uint4(0u, 0u, 0u, 0u);
  __syncthreads();
  XcdBarrier xb = xcd_barrier_post((unsigned*)(p.ws + OFF_BAR), (volatile LAS unsigned*)&xb_words);
  for (int ph = ph_lo; ph < ph_hi; ++ph) {
    run_phase(p, ph, smem);
    if (ph + 1 < ph_hi) { if (ph == ph_lo) grid.sync(); else xcd_barrier(xb); }
  }
#if PROBE
  grid.sync();
  if (blockIdx.x == 0) {
    const float t1 = (float)(tsb[PA1] - tsb[PA0]) * 1e-5f, t2 = (float)(tsb[PB1] - tsb[PB0]) * 1e-5f;
    for (int i = threadIdx.x; i < (1 << 23); i += 512) p.out[i] = t2;
    __syncthreads();
    if (threadIdx.x == 0) p.out[0] = 64.f * t1;
  }
#endif
}

extern "C" void kernel_launch(void* const* d_in, const int* in_sizes, int n_in, void* d_out, int out_size, void* d_ws, size_t ws_size, hipStream_t stream) {
  Params p{};
  for (int i = 0; i < 41; ++i) p.in[i] = (const float*)d_in[i];
  p.out = (float*)d_out; p.ws = (char*)d_ws;
  constexpr size_t kLds = 162048;
  hipFuncSetAttribute((const void*)mega, hipFuncAttributeMaxDynamicSharedMemorySize, (int)kLds);
  hipMemsetAsync((char*)d_ws + OFF_BAR, 0, XCD_BAR_WORDS * 4, stream);
  int lo = 0, hi = N_PHASES;
  void* args[] = {&p, &lo, &hi};
  hipError_t e = hipLaunchCooperativeKernel((void*)mega, dim3(256), dim3(512), args, kLds, stream);
  if (e != hipSuccess) fprintf(stderr, "coop launch failed: %s\n", hipGetErrorString(e));
}
```

```cpp
#include <hip/hip_runtime.h>
#include <hip/hip_cooperative_groups.h>
#include <hip/hip_fp16.h>
#include <cstdio>
namespace cg = cooperative_groups;

typedef unsigned short u16;
typedef short bf16x8 __attribute__((ext_vector_type(8)));
typedef float f32x4 __attribute__((ext_vector_type(4)));
typedef float f32x2 __attribute__((ext_vector_type(2)));
#define MFMA(a, b, c) __builtin_amdgcn_mfma_f32_16x16x32_bf16(a, b, c, 0, 0, 0)
#define DI __device__ __forceinline__

constexpr int D = 1024, NBAT = 2, T = 16384, TC = 256, TS = T + TC, R = NBAT * TS, FF = 2816;
enum { IX = 0, IC, ICTX, ICC, IADAW, IADAB, IN1, IN2, IFWIN, IFCONV, IFWOUT, IFINAL, IRMU, IRWR, IRWK, IRWV, IRWO, IRW0, IRW1, IRW2, IRA0, IRA1,
       IRA2, IRG1, IRG2, IRKK, IRKA, IRRK, IRLNG, IRLNB, ISWIN, ISCONVW, ISCONVB, ISDTB, ISALOG, ISD, ISNG, ISWOUT, IAQKV, IAWO, IASINK };

__device__ __forceinline__ unsigned long long rfl64(unsigned long long v) {
  unsigned lo = __builtin_amdgcn_readfirstlane((unsigned)v), hi = __builtin_amdgcn_readfirstlane((unsigned)(v >> 32));
  return ((unsigned long long)hi << 32) | lo;
}
struct Params {
  const float* in[41]; float* out; char* ws;
  __device__ __forceinline__ const float* inp(int i) const { return (const float*)rfl64((unsigned long long)in[i]); }
  __device__ __forceinline__ float* outp() const { return (float*)rfl64((unsigned long long)out); }
  __device__ __forceinline__ char* wsp() const { return (char*)rfl64((unsigned long long)ws); }
};

constexpr size_t alup(size_t x) { return (x + 255) & ~(size_t)255; }
constexpr size_t OFF_XC = 0;
constexpr size_t OFF_BAR = OFF_XC + alup((size_t)512 * 1024 * 4);
constexpr size_t OFF_MODP = OFF_BAR + 16384;
constexpr size_t OFF_MOD = OFF_MODP + alup((size_t)16 * 4 * 3 * 6144 * 4);
constexpr size_t OFF_SSQ = OFF_MOD + alup((size_t)4 * 3 * 6144 * 4);
constexpr size_t OFF_DT = OFF_SSQ + alup((size_t)R * 8 * 4);
constexpr size_t OFF_BONUS = OFF_DT;
constexpr size_t OFF_RWST = OFF_DT + alup((size_t)R * 64 * 4);
constexpr size_t OFF_H = OFF_RWST + alup((size_t)256 * 256 * 4 * 4);
constexpr size_t OFF_RING = OFF_H;
constexpr size_t OFF_WT = OFF_H + alup((size_t)R * 1024 * 2);
constexpr size_t WT_ELEMS = 17170432;
constexpr size_t OFF_SCR = OFF_WT + alup(WT_ELEMS * 2);
constexpr size_t SCR_BYTES = (size_t)R * 4096 * 2 + (size_t)R * 2048 * 2;
static_assert(OFF_SCR + SCR_BYTES <= (size_t)536870912, "workspace too large");
constexpr size_t WT_W1T = 0, WT_W2T = (size_t)5632 * 1024, WT_MIX = WT_W2T + (size_t)1024 * 2816;
constexpr size_t WT_R1T = WT_MIX, WT_LUT = WT_R1T + (size_t)3456 * 1024, WT_G2T = WT_LUT + (size_t)2 * 16 * 128 * 128, WT_RWO = WT_G2T + (size_t)1024 * 128;
constexpr size_t WT_SX = WT_MIX, WT_SZ = WT_SX + (size_t)4224 * 1024, WT_SO = WT_SZ + (size_t)2048 * 1024;
constexpr size_t WT_AQ = WT_MIX, WT_AO = WT_AQ + (size_t)1536 * 1024;
static_assert(WT_SO + (size_t)1024 * 2048 <= WT_ELEMS, "wt");
static_assert((size_t)2 * 2 * 2 * 1024 * 16 * 512 <= (size_t)R * 1024 * 2, "ring");

DI u16 f2b(float f) { unsigned u = __float_as_uint(f); u += 0x7fffu + ((u >> 16) & 1u); return (u16)(u >> 16); }
DI float b2f(u16 h) { return __uint_as_float(((unsigned)h) << 16); }
DI unsigned pack2(float a, float b) { return (unsigned)f2b(a) | ((unsigned)f2b(b) << 16); }
DI float blo(unsigned u) { return __uint_as_float(u << 16); }
DI float bhi(unsigned u) { return __uint_as_float(u & 0xffff0000u); }
DI float siluf(float x) { return x / (1.f + __expf(-x)); }
DI float sigmf(float x) { return 1.f / (1.f + __expf(-x)); }
DI float softplusf(float x) { return x > 20.f ? x : log1pf(__expf(x)); }
DI int otid() { int t = threadIdx.x; asm volatile("" : "+v"(t)); return t; }
DI void lds_barrier() { asm volatile("s_waitcnt lgkmcnt(0)\n\ts_barrier" ::: "memory"); }
DI f32x4 gload_f4(const float* p) { f32x4 v; asm volatile("global_load_dwordx4 %0, %1, off" : "=v"(v) : "v"(p) : "memory"); return v; }
DI void vm_wait0() { asm volatile("s_waitcnt vmcnt(0)" ::: "memory"); }
DI float wsum(float v) { for (int o = 32; o; o >>= 1) v += __shfl_xor(v, o); return v; }
DI float* xrow_ptr(const Params& p, int r) {
  int b = r / TS, q = r - b * TS;
  return q < TC ? (float*)(p.ws + OFF_XC) + ((size_t)(b * TC + q) << 10) : p.out + ((size_t)(b * T + q - TC) << 10);
}
DI const float* xin_ptr(const Params& p, int r) {
  int b = r / TS, q = r - b * TS;
  return q < TC ? p.in[ICTX] + ((size_t)(b * TC + q) << 10) : p.in[IX] + ((size_t)(b * T + q - TC) << 10);
}
DI const float* mod_ptr(const Params& p, int l, int r) {
  int b = r / TS, q = r - b * TS;
  int v = q < TC ? 2 : b;
  return (const float*)(p.ws + OFF_MOD) + (size_t)(l * 3 + v) * 6144;
}


#define XB_TMO      128
#define XB_XCNT(j)  (256  + 64 * (j))
#define XB_XSUB(j)  (1280 + 64 * (j))
#define XB_XGEN(j)  (2304 + 64 * (j))
#define XB_TOP      3328
#define XB_TOPGEN   3392
#define XCD_BAR_WORDS 3456
#define XB_SPIN_CAP (1u << 18)
#define LAS __attribute__((address_space(3)))
DI unsigned xb_ld(unsigned* p) { return __hip_atomic_load(p, __ATOMIC_RELAXED, __HIP_MEMORY_SCOPE_AGENT); }
DI unsigned xb_add(unsigned* p, unsigned v) { return __hip_atomic_fetch_add(p, v, __ATOMIC_RELAXED, __HIP_MEMORY_SCOPE_AGENT); }
DI unsigned xb_xcc_id() { return (unsigned)__builtin_amdgcn_s_getreg((3 << 11) | 20) & 0xFu; }
#define XB_SPIN(cond, bar) do { unsigned _sp = 0; while (cond) { __builtin_amdgcn_s_sleep(1); \
    if ((++_sp & 255u) == 0u) { if (xb_ld(&(bar)[XB_TMO])) break; if (_sp > XB_SPIN_CAP) { atomicAdd(&(bar)[XB_TMO], 1u); break; } } } } while (0)
struct XcdBarrier { unsigned* bar; unsigned x; volatile LAS unsigned* st; };
DI XcdBarrier xcd_barrier_post(unsigned* bar, volatile LAS unsigned* st) {
  XcdBarrier b; b.bar = bar; b.x = xb_xcc_id(); b.st = st;
  if (threadIdx.x == 0) (void)xb_add(&bar[XB_XCNT(b.x)], 1u);
  return b;
}
DI void xcd_barrier_complete(unsigned* bar, unsigned x, unsigned& nloc, unsigned& nx) {
  const unsigned G = gridDim.x * gridDim.y * gridDim.z;
  unsigned sum, cnt, mine, sp = 0u;
  for (;;) {
    sum = 0u; cnt = 0u; mine = 0u;
#pragma unroll
    for (unsigned j = 0; j < 16; ++j) { const unsigned c = xb_ld(&bar[XB_XCNT(j)]); sum += c; cnt += (c > 0u) ? 1u : 0u; mine = (j == x) ? c : mine; }
    if (sum == G) break;
    __builtin_amdgcn_s_sleep(1);
    if ((++sp & 255u) == 0u) { if (xb_ld(&bar[XB_TMO])) break; if (sp > XB_SPIN_CAP) { atomicAdd(&bar[XB_TMO], 1u); break; } }
  }
  nloc = mine > 0u ? mine : 1u; nx = cnt > 0u ? cnt : 1u;
}
DI void xcd_barrier(const XcdBarrier& b) {
  asm volatile("s_waitcnt vmcnt(0)" ::: "memory");
  __syncthreads();
  if (threadIdx.x == 0) {
    unsigned* bar = b.bar;
    __builtin_amdgcn_s_waitcnt(0);
    unsigned nloc = b.st[0], nx = b.st[1];
    if (nloc == 0u) { xcd_barrier_complete(bar, b.x, nloc, nx); b.st[0] = nloc; b.st[1] = nx; }
    const unsigned old = xb_add(&bar[XB_XSUB(b.x)], 1u);
    const unsigned gen = old / nloc;
    if (old + 1u == (gen + 1u) * nloc) {
      __builtin_amdgcn_fence(__ATOMIC_RELEASE, "agent");
      asm volatile("s_waitcnt vmcnt(0)" ::: "memory");
      const unsigned og = xb_add(&bar[XB_TOP], 1u);
      const unsigned tg = og / nx;
      if (og + 1u == (tg + 1u) * nx) xb_add(&bar[XB_TOPGEN], 1u);
      else XB_SPIN(xb_ld(&bar[XB_TOPGEN]) == tg, bar);
      __builtin_amdgcn_fence(__ATOMIC_ACQUIRE, "agent");
      xb_add(&bar[XB_XGEN(b.x)], 1u);
      asm volatile("s_waitcnt vmcnt(0)" ::: "memory");
    } else {
      XB_SPIN(xb_ld(&bar[XB_XGEN(b.x)]) == gen, bar);
      __builtin_amdgcn_fence(__ATOMIC_ACQUIRE, "agent");
      asm volatile("s_waitcnt vmcnt(0)" ::: "memory");
    }
  }
  __syncthreads();
}

constexpr int LDS_ROW = 64;
struct SmemG { u16 A[2][256 * LDS_ROW]; u16 B[2][128 * LDS_ROW]; };
template <class AL>
DI void gemm_main(const AL& al, const u16* __restrict__ Bt, int ldb, int K, f32x4 (&acc)[4][4], char* smem) {
  SmemG& s = *(SmemG*)smem;
  const int tid = otid(), lane = tid & 63, wave = tid >> 6, wr = wave >> 1, wc = wave & 1, fr = lane & 15, fq = lane >> 4;
#pragma unroll
  for (int m = 0; m < 4; ++m)
#pragma unroll
    for (int n = 0; n < 4; ++n) acc[m][n] = (f32x4){0.f, 0.f, 0.f, 0.f};
  uint4 ra[4], rb[2];
  const int nk = K >> 6;
  const int lrow = tid >> 3, lkc = (tid & 7) * 8, lsw = ((tid & 7) ^ (lrow & 7)) * 8;
  __syncthreads();
#pragma unroll
  for (int i = 0; i < 4; ++i) ra[i] = al(lrow + i * 64, lkc);
#pragma unroll
  for (int i = 0; i < 2; ++i) rb[i] = *(const uint4*)(Bt + (size_t)(lrow + i * 64) * ldb + lkc);
#pragma unroll
  for (int i = 0; i < 4; ++i) *(uint4*)&s.A[0][(lrow + i * 64) * LDS_ROW + lsw] = al.post(ra[i], lrow + i * 64, lkc);
#pragma unroll
  for (int i = 0; i < 2; ++i) *(uint4*)&s.B[0][(lrow + i * 64) * LDS_ROW + lsw] = rb[i];
  __syncthreads();
  for (int kt = 0; kt < nk; ++kt) {
    const int buf = kt & 1;
    const int kn = (kt + 1 < nk ? kt + 1 : kt) * 64 + lkc;
#pragma unroll
    for (int i = 0; i < 2; ++i) {
      const u16* bp = Bt + (size_t)(lrow + i * 64) * ldb + kn;
      asm volatile("global_load_dwordx4 %0, %1, off" : "=v"(rb[i]) : "v"(bp) : "memory");
    }
#pragma unroll
    for (int i = 0; i < 4; ++i) ra[i] = al(lrow + i * 64, kn);
    __builtin_amdgcn_sched_barrier(0);
#pragma unroll
    for (int kh = 0; kh < 2; ++kh) {
      bf16x8 a[4], b[4];
#pragma unroll
      for (int m = 0; m < 4; ++m) a[m] = *(const bf16x8*)&s.A[buf][(wr * 64 + m * 16 + fr) * LDS_ROW + (((kh * 4 + fq) ^ (fr & 7)) << 3)];
#pragma unroll
      for (int n = 0; n < 4; ++n) b[n] = *(const bf16x8*)&s.B[buf][(wc * 64 + n * 16 + fr) * LDS_ROW + (((kh * 4 + fq) ^ (fr & 7)) << 3)];
      __builtin_amdgcn_s_setprio(1);
#pragma unroll
      for (int m = 0; m < 4; ++m)
#pragma unroll
        for (int n = 0; n < 4; ++n) acc[m][n] = MFMA(b[n], a[m], acc[m][n]);
      __builtin_amdgcn_s_setprio(0);
    }
    asm volatile("s_waitcnt vmcnt(0)" ::: "memory");
#pragma unroll
    for (int i = 0; i < 4; ++i) *(uint4*)&s.A[buf ^ 1][(lrow + i * 64) * LDS_ROW + lsw] = al.post(ra[i], lrow + i * 64, kn);
#pragma unroll
    for (int i = 0; i < 2; ++i) *(uint4*)&s.B[buf ^ 1][(lrow + i * 64) * LDS_ROW + lsw] = rb[i];
    __syncthreads();
  }
}

template <class AL>
DI void gemm_main3(const AL& al, const u16* __restrict__ Bt, int ldb, int K, f32x4 (&acc)[4][4], char* smem) {
  SmemG& s = *(SmemG*)smem;
  const int tid = otid(), lane = tid & 63, wave = tid >> 6, wr = wave >> 1, wc = wave & 1, fr = lane & 15, fq = lane >> 4;
  const bool grpY = __builtin_amdgcn_readfirstlane(wave) >= 4;
#pragma unroll
  for (int m = 0; m < 4; ++m)
#pragma unroll
    for (int n = 0; n < 4; ++n) acc[m][n] = (f32x4){0.f, 0.f, 0.f, 0.f};
  uint4 ra[4], rb[2];
  const int nk = K >> 6;
  const int lrow = tid >> 3, lkc = (tid & 7) * 8, lsw = ((tid & 7) ^ (lrow & 7)) * 8;
  __syncthreads();
#pragma unroll
  for (int i = 0; i < 4; ++i) ra[i] = al(lrow + i * 64, lkc);
#pragma unroll
  for (int i = 0; i < 2; ++i) rb[i] = *(const uint4*)(Bt + (size_t)(lrow + i * 64) * ldb + lkc);
#pragma unroll
  for (int i = 0; i < 4; ++i) *(uint4*)&s.A[0][(lrow + i * 64) * LDS_ROW + lsw] = al.post(ra[i], lrow + i * 64, lkc);
#pragma unroll
  for (int i = 0; i < 2; ++i) *(uint4*)&s.B[0][(lrow + i * 64) * LDS_ROW + lsw] = rb[i];
  __syncthreads();
  const u16* abase = &s.A[0][(wr * 64 + fr) * LDS_ROW];
  const u16* bbase = &s.B[0][(wc * 64 + fr) * LDS_ROW];
  bf16x8 fa[4], fb[4];
#define G3_RD(BUF, KH) do { \
    _Pragma("unroll") for (int m = 0; m < 4; ++m) fa[m] = *(const bf16x8*)(abase + (BUF) * 256 * LDS_ROW + m * 16 * LDS_ROW + ((((KH) * 4 + fq) ^ (fr & 7)) << 3)); \
    _Pragma("unroll") for (int n = 0; n < 4; ++n) fb[n] = *(const bf16x8*)(bbase + (BUF) * 128 * LDS_ROW + n * 16 * LDS_ROW + ((((KH) * 4 + fq) ^ (fr & 7)) << 3)); } while (0)
#define G3_MM() do { \
    _Pragma("unroll") for (int m = 0; m < 4; ++m) _Pragma("unroll") for (int n = 0; n < 4; ++n) acc[m][n] = MFMA(fb[n], fa[m], acc[m][n]); } while (0)
  int kn = (1 < nk ? 1 : 0) * 64 + lkc;
#pragma unroll
  for (int i = 0; i < 2; ++i) {
    const u16* bp = Bt + (size_t)(lrow + i * 64) * ldb + kn;
    asm volatile("global_load_dwordx4 %0, %1, off" : "=v"(rb[i]) : "v"(bp) : "memory");
  }
#pragma unroll
  for (int i = 0; i < 4; ++i) ra[i] = al(lrow + i * 64, kn);
  if (grpY) G3_RD(0, 0);
  __builtin_amdgcn_sched_barrier(0);
  for (int kt = 0; kt < nk; ++kt) {
    const int buf = kt & 1;
    if (!grpY) G3_RD(buf, 0);
    __builtin_amdgcn_sched_barrier(0);
    G3_MM();
    __builtin_amdgcn_sched_barrier(0);
    if (grpY) G3_RD(buf, 1);
    __builtin_amdgcn_sched_barrier(0);
    asm volatile("s_waitcnt vmcnt(0)" ::: "memory");
#pragma unroll
    for (int i = 0; i < 4; ++i) *(uint4*)&s.A[buf ^ 1][(lrow + i * 64) * LDS_ROW + lsw] = al.post(ra[i], lrow + i * 64, kn);
#pragma unroll
    for (int i = 0; i < 2; ++i) *(uint4*)&s.B[buf ^ 1][(lrow + i * 64) * LDS_ROW + lsw] = rb[i];
    if (kt + 2 < nk) {
      kn = (kt + 2) * 64 + lkc;
#pragma unroll
      for (int i = 0; i < 2; ++i) {
        const u16* bp = Bt + (size_t)(lrow + i * 64) * ldb + kn;
        asm volatile("global_load_dwordx4 %0, %1, off" : "=v"(rb[i]) : "v"(bp) : "memory");
      }
#pragma unroll
      for (int i = 0; i < 4; ++i) ra[i] = al(lrow + i * 64, kn);
    }
    __builtin_amdgcn_sched_barrier(0);
    lds_barrier();
    if (!grpY) G3_RD(buf, 1);
    __builtin_amdgcn_sched_barrier(0);
    G3_MM();
    __builtin_amdgcn_sched_barrier(0);
    if (grpY) G3_RD(buf ^ 1, 0);
    __builtin_amdgcn_sched_barrier(0);
    lds_barrier();
  }
  asm volatile("s_waitcnt vmcnt(0)" ::: "memory");
  __syncthreads();
}

template <class AL>
DI void gemm_main4(const AL& al, const u16* __restrict__ Bt, int ldb, int K, f32x4 (&acc)[4][4], char* smem) {
  SmemG& s = *(SmemG*)smem;
  const int tid = otid(), lane = tid & 63, wave = tid >> 6, wr = wave >> 1, wc = wave & 1, fr = lane & 15, fq = lane >> 4;
#pragma unroll
  for (int m = 0; m < 4; ++m)
#pragma unroll
    for (int n = 0; n < 4; ++n) acc[m][n] = (f32x4){0.f, 0.f, 0.f, 0.f};
  uint4 a0[4], a1[4], b00, b01, b10, b11;
  const int nk = K >> 6;
  const int lrow = tid >> 3, lkc = (tid & 7) * 8, lsw = ((tid & 7) ^ (lrow & 7)) * 8;
  __syncthreads();
#pragma unroll
  for (int i = 0; i < 4; ++i) a0[i] = al(lrow + i * 64, lkc);
#pragma unroll
  for (int i = 0; i < 1; ++i) { b00 = *(const uint4*)(Bt + (size_t)lrow * ldb + lkc); b01 = *(const uint4*)(Bt + (size_t)(lrow + 64) * ldb + lkc); }
#pragma unroll
  for (int i = 0; i < 4; ++i) *(uint4*)&s.A[0][(lrow + i * 64) * LDS_ROW + lsw] = al.post(a0[i], lrow + i * 64, lkc);
#pragma unroll
  for (int i = 0; i < 1; ++i) { *(uint4*)&s.B[0][lrow * LDS_ROW + lsw] = b00; *(uint4*)&s.B[0][(lrow + 64) * LDS_ROW + lsw] = b01; }
  __syncthreads();
  auto g4_load = [&](uint4 (&RA)[4], uint4& RB0, uint4& RB1, int KN) {
#pragma unroll
    for (int i = 0; i < 4; ++i) RA[i] = al(lrow + i * 64, KN);
    RB0 = *(const uint4*)(Bt + (size_t)lrow * ldb + KN);
    RB1 = *(const uint4*)(Bt + (size_t)(lrow + 64) * ldb + KN);
  };
  auto g4_store = [&](uint4 (&RA)[4], uint4& RB0, uint4& RB1, int BUF, int KN) {
#pragma unroll
    for (int i = 0; i < 4; ++i) *(uint4*)&s.A[BUF][(lrow + i * 64) * LDS_ROW + lsw] = al.post(RA[i], lrow + i * 64, KN);
    *(uint4*)&s.B[BUF][lrow * LDS_ROW + lsw] = RB0;
    *(uint4*)&s.B[BUF][(lrow + 64) * LDS_ROW + lsw] = RB1;
  };
#define G4_COMPUTE(BUF) do { \
    _Pragma("unroll") for (int kh = 0; kh < 2; ++kh) { \
      bf16x8 a[4], b[4]; \
      _Pragma("unroll") for (int m = 0; m < 4; ++m) a[m] = *(const bf16x8*)&s.A[BUF][(wr * 64 + m * 16 + fr) * LDS_ROW + (((kh * 4 + fq) ^ (fr & 7)) << 3)]; \
      _Pragma("unroll") for (int n = 0; n < 4; ++n) b[n] = *(const bf16x8*)&s.B[BUF][(wc * 64 + n * 16 + fr) * LDS_ROW + (((kh * 4 + fq) ^ (fr & 7)) << 3)]; \
      __builtin_amdgcn_s_setprio(1); \
      _Pragma("unroll") for (int m = 0; m < 4; ++m) _Pragma("unroll") for (int n = 0; n < 4; ++n) acc[m][n] = MFMA(b[n], a[m], acc[m][n]); \
      __builtin_amdgcn_s_setprio(0); } } while (0)
  int k1 = 64 + lkc, k2 = (2 < nk ? 2 : nk - 1) * 64 + lkc;
  g4_load(a0, b00, b01, k1);
  g4_load(a1, b10, b11, k2);
  __builtin_amdgcn_sched_barrier(0);
  for (int kt = 0; kt < nk; kt += 2) {
    G4_COMPUTE(0);
    __builtin_amdgcn_sched_barrier(0);
    g4_store(a0, b00, b01, 1, k1);
    k1 = (kt + 3 < nk ? kt + 3 : nk - 1) * 64 + lkc;
    g4_load(a0, b00, b01, k1);
    __builtin_amdgcn_sched_barrier(0);
    __syncthreads();
    G4_COMPUTE(1);
    __builtin_amdgcn_sched_barrier(0);
    g4_store(a1, b10, b11, 0, k2);
    k2 = (kt + 4 < nk ? kt + 4 : nk - 1) * 64 + lkc;
    g4_load(a1, b10, b11, k2);
    __builtin_amdgcn_sched_barrier(0);
    __syncthreads();
  }
}


struct SmemG2 { u16 A[2][256 * LDS_ROW]; u16 B[2][256 * LDS_ROW]; };
template <class AL>
DI void gemm_main2(const AL& al, const u16* __restrict__ Bt, int ldb, int K, f32x4 (&acc)[4][8], char* smem) {
  SmemG2& s = *(SmemG2*)smem;
  const int tid = otid(), lane = tid & 63, wave = tid >> 6, wr = wave >> 1, wc = wave & 1, fr = lane & 15, fq = lane >> 4;
#pragma unroll
  for (int m = 0; m < 4; ++m)
#pragma unroll
    for (int n = 0; n < 8; ++n) acc[m][n] = (f32x4){0.f, 0.f, 0.f, 0.f};
  uint4 ra[4], rb[4];
  const int nk = K >> 6;
  const int lrow = tid >> 3, lkc = (tid & 7) * 8, lsw = ((tid & 7) ^ (lrow & 7)) * 8;
  __syncthreads();
#pragma unroll
  for (int i = 0; i < 4; ++i) ra[i] = al(lrow + i * 64, lkc);
#pragma unroll
  for (int i = 0; i < 4; ++i) rb[i] = *(const uint4*)(Bt + (size_t)(lrow + i * 64) * ldb + lkc);
#pragma unroll
  for (int i = 0; i < 4; ++i) *(uint4*)&s.A[0][(lrow + i * 64) * LDS_ROW + lsw] = al.post(ra[i], lrow + i * 64, lkc);
#pragma unroll
  for (int i = 0; i < 4; ++i) *(uint4*)&s.B[0][(lrow + i * 64) * LDS_ROW + lsw] = rb[i];
  __syncthreads();
  for (int kt = 0; kt < nk; ++kt) {
    const int buf = kt & 1;
    const int kn = (kt + 1 < nk ? kt + 1 : kt) * 64 + lkc;
#pragma unroll
    for (int i = 0; i < 4; ++i) ra[i] = al(lrow + i * 64, kn);
    __builtin_amdgcn_sched_barrier(0);
#pragma unroll
    for (int kh = 0; kh < 2; ++kh) {
      bf16x8 a[4];
#pragma unroll
      for (int m = 0; m < 4; ++m) a[m] = *(const bf16x8*)&s.A[buf][(wr * 64 + m * 16 + fr) * LDS_ROW + (((kh * 4 + fq) ^ (fr & 7)) << 3)];
      bf16x8 bc = *(const bf16x8*)&s.B[buf][(wc * 128 + fr) * LDS_ROW + (((kh * 4 + fq) ^ (fr & 7)) << 3)];
#pragma unroll
      for (int n = 0; n < 8; ++n) {
        const bf16x8 bn = *(const bf16x8*)&s.B[buf][(wc * 128 + (n < 7 ? n + 1 : n) * 16 + fr) * LDS_ROW + (((kh * 4 + fq) ^ (fr & 7)) << 3)];
        __builtin_amdgcn_sched_barrier(0);
        __builtin_amdgcn_s_setprio(1);
#pragma unroll
        for (int m = 0; m < 4; ++m) acc[m][n] = MFMA(bc, a[m], acc[m][n]);
        __builtin_amdgcn_s_setprio(0);
        bc = bn;
      }
      __builtin_amdgcn_sched_barrier(0);
      if (kh == 0) {
#pragma unroll
        for (int i = 0; i < 4; ++i) *(uint4*)&s.A[buf ^ 1][(lrow + i * 64) * LDS_ROW + lsw] = al.post(ra[i], lrow + i * 64, kn);
#pragma unroll
        for (int i = 0; i < 4; ++i) {
          const u16* bp = Bt + (size_t)(lrow + i * 64) * ldb + kn;
          asm volatile("global_load_dwordx4 %0, %1, off" : "=v"(rb[i]) : "v"(bp) : "memory");
        }
        __builtin_amdgcn_sched_barrier(0);
      }
    }
    asm volatile("s_waitcnt vmcnt(0)" ::: "memory");
#pragma unroll
    for (int i = 0; i < 4; ++i) *(uint4*)&s.B[buf ^ 1][(lrow + i * 64) * LDS_ROW + lsw] = rb[i];
    __syncthreads();
  }
}

DI bool next_tile(int it, int MT, int NT, int GN, int& mt, int& nt) {
  const int xcd = blockIdx.x & 7, lb = blockIdx.x >> 3, GM = 8 / GN;
  const int gm = xcd / GN, gn = xcd - gm * GN;
  const int m0 = gm * MT / GM, m1 = (gm + 1) * MT / GM, n0 = gn * NT / GN, n1 = (gn + 1) * NT / GN;
  const int nl = n1 - n0, tl = lb + it * (gridDim.x >> 3);
  if (tl >= (m1 - m0) * nl) return false;
  const int q = tl / nl;
  mt = m0 + q; nt = n0 + (tl - q * nl);
  return true;
}
struct ALPlain {
  const u16* base; int ld;
  DI uint4 operator()(int i, int k) const { return *(const uint4*)(base + (size_t)i * ld + k); }
  DI uint4 post(uint4 v, int, int) const { return v; }
};

DI void ph_prologue(const Params& p, char* smem) {
  const int tid = otid();
  float* modp = (float*)(p.ws + OFF_MODP);
  float* sc = (float*)smem;
  __syncthreads();
  for (int e = tid; e < 3072; e += 512) { const float v = e < 2048 ? p.in[IC][e] : p.in[ICC][e - 2048]; sc[e] = siluf(v); }
  __syncthreads();
  const int half = tid >> 8, col = tid & 255;
  for (int it = blockIdx.x * 2 + half; it < 4 * 24 * 16; it += gridDim.x * 2) {
    int l = it / (24 * 16), rem = it - l * 24 * 16, cc = rem / 16, kc = rem & 15;
    int n = cc * 256 + col;
    const float* w = p.in[IADAW] + (size_t)l * 1024 * 6144 + (size_t)(kc * 64) * 6144 + n;
    float a0 = 0.f, a1 = 0.f, a2 = 0.f;
#pragma unroll
    for (int kb = 0; kb < 64; kb += 16) {
      float wv[16];
#pragma unroll
      for (int k = 0; k < 16; ++k) wv[k] = w[(size_t)(kb + k) * 6144];
#pragma unroll
      for (int k = 0; k < 16; ++k) {
        const int kk = kc * 64 + kb + k;
        a0 += sc[kk] * wv[k]; a1 += sc[1024 + kk] * wv[k]; a2 += sc[2048 + kk] * wv[k];
      }
    }
    size_t o = ((size_t)(kc * 4 + l) * 3) * 6144 + n;
    modp[o] = a0; modp[o + 6144] = a1; modp[o + 2 * 6144] = a2;
  }
}
DI void ph_modreduce(const Params& p) {
  const float* modp = (const float*)(p.ws + OFF_MODP); float* mod = (float*)(p.ws + OFF_MOD);
  for (int i = blockIdx.x * 512 + otid(); i < 4 * 3 * 6144; i += gridDim.x * 512) {
    int l = i / (3 * 6144), n = i % 6144;
    float a = p.in[IADAB][l * 6144 + n];
    float pv[16];
#pragma unroll
    for (int kc = 0; kc < 16; ++kc) pv[kc] = modp[(size_t)kc * 4 * 3 * 6144 + i];
#pragma unroll
    for (int kc = 0; kc < 16; ++kc) a += pv[kc];
    mod[i] = a;
  }
}

struct CvtJob { const float* src; u16* dst; int K, N, ld, ldd, mode; };
DI void cvt_run(const CvtJob& j, int& rot, char* smem) {
  float* tile = (float*)smem;
  const int tid = otid();
  if (j.mode == 4) {
    size_t n = (size_t)j.K * j.N;
    for (size_t i = (size_t)blockIdx.x * 512 + tid; i < n; i += (size_t)gridDim.x * 512) j.dst[i] = 0;
    return;
  }
  const int tk = j.K >> 6, tn = j.N >> 6, nt = tk * tn;
  int start = (blockIdx.x + gridDim.x - (rot % gridDim.x)) % gridDim.x;
  for (int t = start; t < nt; t += gridDim.x) {
    int kt = t / tn, ntl = t - kt * tn;
    __syncthreads();
    {
      f32x4 lv[2];
#pragma unroll
      for (int i = 0; i < 2; ++i) { const int e = tid + i * 512, kk = e >> 4, n4 = (e & 15) * 4; lv[i] = gload_f4(j.src + (size_t)(kt * 64 + kk) * j.ld + ntl * 64 + n4); }
      asm volatile("s_waitcnt vmcnt(0)" : "+v"(lv[0]), "+v"(lv[1]) :: "memory");
#pragma unroll
      for (int i = 0; i < 2; ++i) { const int e = tid + i * 512, kk = e >> 4, n4 = (e & 15) * 4; float* tp = tile + kk * 65 + n4; tp[0] = lv[i][0]; tp[1] = lv[i][1]; tp[2] = lv[i][2]; tp[3] = lv[i][3]; }
    }
    __syncthreads();
    for (int e = tid; e < 4096; e += 512) {
      int nn = e >> 6, kk = e & 63; float v = tile[kk * 65 + nn];
      int n = ntl * 64 + nn, k = kt * 64 + kk;
      if (j.mode == 0) j.dst[(size_t)n * j.ldd + k] = f2b(v);
      else if (j.mode == 1) { int rr = n < FF ? (n >> 7) * 256 + (n & 127) : ((n - FF) >> 7) * 256 + 128 + ((n - FF) & 127); j.dst[(size_t)rr * j.ldd + k] = f2b(v); }
      else {
        int h = n >> 6, c = n & 63, ty = j.mode - 2;
        u16* d = j.dst + (size_t)h * 128 * 128 + (size_t)((c >> 5) * 64 + ty * 32 + (c & 31)) * 128;
        d[ty * 64 + k] = f2b(v); d[(1 - ty) * 64 + k] = 0;
      }
    }
  }
  rot += nt;
}
DI void ph_convert(const Params& p, int l, char* smem) {
  u16* wt = (u16*)(p.ws + OFF_WT);
  int rot = 0;
  CvtJob j;
  j = {p.in[IFWIN] + (size_t)l * 1024 * 5632, wt + WT_W1T, 1024, 5632, 5632, 1024, 1}; cvt_run(j, rot, smem);
  j = {p.in[IFWOUT] + (size_t)l * FF * 1024, wt + WT_W2T, FF, 1024, 1024, FF, 0}; cvt_run(j, rot, smem);
  const int kind = l % 3, jj = l / 3;
  if (kind == 0) {
    j = {p.in[IRWR] + (size_t)jj * 1048576, wt + WT_R1T, 1024, 1024, 1024, 1024, 0}; cvt_run(j, rot, smem);
    j = {p.in[IRWK] + (size_t)jj * 1048576, wt + WT_R1T + (size_t)1024 * 1024, 1024, 1024, 1024, 1024, 0}; cvt_run(j, rot, smem);
    j = {p.in[IRWV] + (size_t)jj * 1048576, wt + WT_R1T + (size_t)2048 * 1024, 1024, 1024, 1024, 1024, 0}; cvt_run(j, rot, smem);
    for (int d = 0; d < 2; ++d) {
      j = {p.in[IRW1] + (size_t)(jj * 2 + d) * 65536, wt + WT_R1T + (size_t)(3072 + d * 64) * 1024, 1024, 64, 64, 1024, 0}; cvt_run(j, rot, smem);
      j = {p.in[IRA1] + (size_t)(jj * 2 + d) * 65536, wt + WT_R1T + (size_t)(3200 + d * 64) * 1024, 1024, 64, 64, 1024, 0}; cvt_run(j, rot, smem);
      j = {p.in[IRW2] + (size_t)(jj * 2 + d) * 65536, wt + WT_LUT + (size_t)d * 16 * 128 * 128, 64, 1024, 1024, 128, 2}; cvt_run(j, rot, smem);
      j = {p.in[IRA2] + (size_t)(jj * 2 + d) * 65536, wt + WT_LUT + (size_t)d * 16 * 128 * 128, 64, 1024, 1024, 128, 3}; cvt_run(j, rot, smem);
    }
    j = {p.in[IRG1] + (size_t)jj * 131072, wt + WT_R1T + (size_t)3328 * 1024, 1024, 128, 128, 1024, 0}; cvt_run(j, rot, smem);
    j = {p.in[IRG2] + (size_t)jj * 131072, wt + WT_G2T, 128, 1024, 1024, 128, 0}; cvt_run(j, rot, smem);
    j = {p.in[IRWO] + (size_t)jj * 1048576, wt + WT_RWO, 1024, 1024, 1024, 1024, 0}; cvt_run(j, rot, smem);
  } else if (kind == 1) {
    j = {p.in[ISWIN] + (size_t)jj * 1024 * 6208 + 2048, wt + WT_SX, 1024, 4160, 6208, 1024, 0}; cvt_run(j, rot, smem);
    j = {nullptr, wt + WT_SX + (size_t)4160 * 1024, 64, 1024, 0, 0, 4}; cvt_run(j, rot, smem);
    j = {p.in[ISWIN] + (size_t)jj * 1024 * 6208, wt + WT_SZ, 1024, 2048, 6208, 1024, 0}; cvt_run(j, rot, smem);
    j = {p.in[ISWOUT] + (size_t)jj * 2048 * 1024, wt + WT_SO, 2048, 1024, 1024, 2048, 0}; cvt_run(j, rot, smem);
    float* ssq = (float*)(p.ws + OFF_SSQ);
    for (int i = blockIdx.x * 512 + otid(); i < R * 8; i += gridDim.x * 512) ssq[i] = 0.f;
  } else {
    j = {p.in[IAQKV] + (size_t)jj * 1024 * 1536, wt + WT_AQ, 1024, 1536, 1536, 1024, 0}; cvt_run(j, rot, smem);
    j = {p.in[IAWO] + (size_t)jj * 1048576, wt + WT_AO, 1024, 1024, 1024, 1024, 0}; cvt_run(j, rot, smem);
  }
}

DI void ph_norm(const Params& p, int l, int which) {
  const int lane = otid() & 63, gw = blockIdx.x * 8 + (otid() >> 6), nw = gridDim.x * 8;
  const float* g = (which ? p.in[IN2] : p.in[IN1]) + l * 1024;
  u16* H = (u16*)(p.ws + OFF_H);
  float4 gg[4];
#pragma unroll
  for (int j = 0; j < 4; ++j) gg[j] = *(const float4*)(g + j * 256 + lane * 4);
  float4 v[4], vn[4];
  const bool from_in = (l == 0 && which == 0);
  if (gw < R) {
    const float* xr = from_in ? xin_ptr(p, gw) : xrow_ptr(p, gw);
#pragma unroll
    for (int j = 0; j < 4; ++j) v[j] = *(const float4*)(xr + j * 256 + lane * 4);
  }
  for (int r = gw; r < R; r += nw) {
    {
      const int rn = r + nw < R ? r + nw : r;
      const float* xn = from_in ? xin_ptr(p, rn) : xrow_ptr(p, rn);
#pragma unroll
      for (int j = 0; j < 4; ++j) vn[j] = *(const float4*)(xn + j * 256 + lane * 4);
    }
    const float* md = mod_ptr(p, l, r) + which * 3072;
    float4 sh[4], sc[4];
#pragma unroll
    for (int j = 0; j < 4; ++j) { sh[j] = *(const float4*)(md + j * 256 + lane * 4); sc[j] = *(const float4*)(md + 1024 + j * 256 + lane * 4); }
    __builtin_amdgcn_sched_barrier(0);
    float ss = 0.f;
#pragma unroll
    for (int j = 0; j < 4; ++j) ss += v[j].x * v[j].x + v[j].y * v[j].y + v[j].z * v[j].z + v[j].w * v[j].w;
    ss = wsum(ss);
    const float rs = rsqrtf(ss * (1.f / 1024.f) + 1e-6f);
#pragma unroll
    for (int j = 0; j < 4; ++j) {
      const int c = j * 256 + lane * 4;
      float o0 = v[j].x * rs * gg[j].x * (1.f + sc[j].x) + sh[j].x, o1 = v[j].y * rs * gg[j].y * (1.f + sc[j].y) + sh[j].y;
      float o2 = v[j].z * rs * gg[j].z * (1.f + sc[j].z) + sh[j].z, o3 = v[j].w * rs * gg[j].w * (1.f + sc[j].w) + sh[j].w;
      uint2 w; w.x = pack2(o0, o1); w.y = pack2(o2, o3);
      *(uint2*)(H + (size_t)r * 1024 + c) = w;
    }
#pragma unroll
    for (int j = 0; j < 4; ++j) v[j] = vn[j];
  }
}
DI void ph_final(const Params& p) {
  const int lane = otid() & 63, gw = blockIdx.x * 8 + (otid() >> 6), nw = gridDim.x * 8;
  float4 g[4];
#pragma unroll
  for (int j = 0; j < 4; ++j) g[j] = *(const float4*)(p.in[IFINAL] + j * 256 + lane * 4);
  float4 v[4], vn[4];
  if (gw < NBAT * T) {
#pragma unroll
    for (int j = 0; j < 4; ++j) v[j] = *(const float4*)(p.out + (size_t)gw * 1024 + j * 256 + lane * 4);
  }
  for (int r = gw; r < NBAT * T; r += nw) {
    float* xr = p.out + (size_t)r * 1024;
    {
      const float* xn = p.out + (size_t)(r + nw < NBAT * T ? r + nw : r) * 1024;
#pragma unroll
      for (int j = 0; j < 4; ++j) vn[j] = *(const float4*)(xn + j * 256 + lane * 4);
    }
    __builtin_amdgcn_sched_barrier(0);
    float ss = 0.f;
#pragma unroll
    for (int j = 0; j < 4; ++j) ss += v[j].x * v[j].x + v[j].y * v[j].y + v[j].z * v[j].z + v[j].w * v[j].w;
    ss = wsum(ss);
    const float rs = rsqrtf(ss * (1.f / 1024.f) + 1e-6f);
#pragma unroll
    for (int j = 0; j < 4; ++j) {
      float4 w = v[j]; w.x *= rs * g[j].x; w.y *= rs * g[j].y; w.z *= rs * g[j].z; w.w *= rs * g[j].w;
      *(float4*)(xr + j * 256 + lane * 4) = w;
    }
#pragma unroll
    for (int j = 0; j < 4; ++j) v[j] = vn[j];
  }
}

template <class AL>
DI void resid_tile(const Params& p, const AL& al, const u16* Bt, int K, int l, int gi, int mt, int nt, char* smem) {
  f32x4 acc[4][4];
  gemm_main4(al, Bt + (size_t)nt * 128 * K, K, K, acc, smem);
  const int lane = otid() & 63, wave = otid() >> 6, wr = wave >> 1, wc = wave & 1, fr = lane & 15, fq = lane >> 4;
  const int row0 = mt * 256;
  const float* md = mod_ptr(p, l, row0) + gi * 1024;
  float4 g[4];
#pragma unroll
  for (int n = 0; n < 4; ++n) g[n] = *(const float4*)(md + nt * 128 + wc * 64 + n * 16 + fq * 4);
  float* xr0 = xrow_ptr(p, row0) + (size_t)(wr * 64 + fr) * 1024 + nt * 128 + wc * 64 + fq * 4;
  const float* xl0 = (l == 0 && gi == 2) ? xin_ptr(p, row0) + (size_t)(wr * 64 + fr) * 1024 + nt * 128 + wc * 64 + fq * 4 : xr0;
#pragma unroll
  for (int mh = 0; mh < 2; ++mh) {
    f32x4 x[2][4];
#pragma unroll
    for (int m2 = 0; m2 < 2; ++m2)
#pragma unroll
      for (int n = 0; n < 4; ++n) x[m2][n] = gload_f4(xl0 + (size_t)((mh * 2 + m2) * 16) * 1024 + n * 16);
    asm volatile("s_waitcnt vmcnt(0)" : "+v"(x[0][0]), "+v"(x[0][1]), "+v"(x[0][2]), "+v"(x[0][3]), "+v"(x[1][0]), "+v"(x[1][1]), "+v"(x[1][2]), "+v"(x[1][3]) :: "memory");
#pragma unroll
    for (int m2 = 0; m2 < 2; ++m2)
#pragma unroll
      for (int n = 0; n < 4; ++n) {
        const int m = mh * 2 + m2;
        f32x4 v = x[m2][n];
        v[0] += g[n].x * acc[m][n][0]; v[1] += g[n].y * acc[m][n][1]; v[2] += g[n].z * acc[m][n][2]; v[3] += g[n].w * acc[m][n][3];
        *(f32x4*)(xr0 + (size_t)(m * 16) * 1024 + n * 16) = v;
      }
  }
}
DI void ph_resid_gemm(const Params& p, const u16* A, int lda, const u16* Bt, int K, int l, int gi, char* smem) {
  const bool skip_ctx = (l == 3);
  for (int it = 0;; ++it) {
    int mt, nt; if (!next_tile(it, skip_ctx ? 128 : 130, 8, 1, mt, nt)) break;
    if (skip_ctx) mt = mt + 1 + (mt >> 6);
    ALPlain al{A + (size_t)mt * 256 * lda, lda};
    resid_tile(p, al, Bt, K, l, gi, mt, nt, smem);
  }
}

struct ALHalo {
  const u16* base; int t0m1, len;
  DI uint4 operator()(int i, int k) const {
    int t = t0m1 + i;
    if (t < 0 || t >= len) return make_uint4(0, 0, 0, 0);
    return *(const uint4*)(base + (size_t)t * 1024 + k);
  }
  DI uint4 post(uint4 v, int, int) const { return v; }
};
DI void ph_ffn1(const Params& p, int l, char* smem) {
  const u16* H = (const u16*)(p.ws + OFF_H);
  const u16* W1T = (const u16*)(p.ws + OFF_WT) + WT_W1T;
  u16* G = (u16*)(p.ws + OFF_SCR);
  const int tid = otid(), lane = tid & 63, wave = tid >> 6, wr = wave >> 1, wc = wave & 1, fr = lane & 15, fq = lane >> 4;
  for (int it = 0;; ++it) {
    int mt, nt; if (!next_tile(it, 134, 22, 2, mt, nt)) break;
    const int b = mt / 67, ml = mt - b * 67;
    int rowbase, t0, len;
    if (ml < 2) { rowbase = b * TS; t0 = ml * 254; len = TC; } else { rowbase = b * TS + TC; t0 = (ml - 2) * 254; len = T; }
    ALHalo al{H + (size_t)rowbase * 1024, t0 - 1, len};
    f32x4 acc[4][8];
    gemm_main2(al, W1T + (size_t)nt * 256 * 1024, 1024, 1024, acc, smem);
    u16* P16 = (u16*)smem;
#pragma unroll
    for (int m = 0; m < 4; ++m)
#pragma unroll
      for (int n = 0; n < 8; ++n) {
        uint2 w; w.x = pack2(acc[m][n][0], acc[m][n][1]); w.y = pack2(acc[m][n][2], acc[m][n][3]);
        *(uint2*)&P16[(wr * 64 + m * 16 + fr) * 264 + wc * 128 + n * 16 + fq * 4] = w;
      }
    __syncthreads();
    {
      const int c2 = (tid & 63) * 2, rg = tid >> 6;
      const float* cw = p.in[IFCONV] + (size_t)l * 3 * 5632;
      const int ca = nt * 128 + c2, cg2 = FF + ca;
      const float2 a0 = *(const float2*)(cw + ca), a1 = *(const float2*)(cw + 5632 + ca), a2 = *(const float2*)(cw + 2 * 5632 + ca);
      const float2 g0 = *(const float2*)(cw + cg2), g1 = *(const float2*)(cw + 5632 + cg2), g2 = *(const float2*)(cw + 2 * 5632 + cg2);
      const int i0 = 1 + rg * 32, i1 = min(i0 + 32, 255);
      unsigned pa = *(const unsigned*)&P16[(i0 - 1) * 264 + c2], ca_ = *(const unsigned*)&P16[i0 * 264 + c2];
      unsigned pg = *(const unsigned*)&P16[(i0 - 1) * 264 + 128 + c2], cgv = *(const unsigned*)&P16[i0 * 264 + 128 + c2];
      for (int i = i0; i < i1; ++i) {
        const unsigned na = *(const unsigned*)&P16[(i + 1) * 264 + c2], ng = *(const unsigned*)&P16[(i + 1) * 264 + 128 + c2];
        const float ua0 = a0.x * blo(pa) + a1.x * blo(ca_) + a2.x * blo(na), ua1 = a0.y * bhi(pa) + a1.y * bhi(ca_) + a2.y * bhi(na);
        const float ug0 = g0.x * blo(pg) + g1.x * blo(cgv) + g2.x * blo(ng), ug1 = g0.y * bhi(pg) + g1.y * bhi(cgv) + g2.y * bhi(ng);
        const int tt = t0 - 1 + i;
        if (tt < len) *(unsigned*)&G[(size_t)(rowbase + tt) * FF + ca] = pack2(ua0 * siluf(ug0), ua1 * siluf(ug1));
        pa = ca_; ca_ = na; pg = cgv; cgv = ng;
      }
    }
  }
}

struct ALMix {
  const u16* H; int row0; const float* mu;
  DI uint4 operator()(int i, int k) const {
    const int row = row0 + i, q = row % TS;
    const bool hp = (q != 0) && (q != TC), hn = (q != TC - 1) && (q != TS - 1);
    const u16* pc = H + (size_t)row * 1024 + k;
    uint4 c = *(const uint4*)pc;
    uint4 a = hp ? *(const uint4*)(pc - 1024) : make_uint4(0, 0, 0, 0);
    uint4 b = hn ? *(const uint4*)(pc + 1024) : make_uint4(0, 0, 0, 0);
    float4 m0 = *(const float4*)(mu + k), m1 = *(const float4*)(mu + k + 4);
    uint4 o;
#define MIX1(cc, aa, bb, mlo, mhi) pack2(blo(cc) + (0.5f * (blo(aa) + blo(bb)) - blo(cc)) * (mlo), bhi(cc) + (0.5f * (bhi(aa) + bhi(bb)) - bhi(cc)) * (mhi))
    o.x = MIX1(c.x, a.x, b.x, m0.x, m0.y); o.y = MIX1(c.y, a.y, b.y, m0.z, m0.w);
    o.z = MIX1(c.z, a.z, b.z, m1.x, m1.y); o.w = MIX1(c.w, a.w, b.w, m1.z, m1.w);
    return o;
  }
  DI uint4 post(uint4 v, int, int) const { return v; }
};
constexpr int P1LD = 3456;
DI void ph_rw_r1(const Params& p, int jj, char* smem) {
  const u16* H = (const u16*)(p.ws + OFF_H);
  const u16* BT = (const u16*)(p.ws + OFF_WT) + WT_R1T;
  u16* P1 = (u16*)(p.ws + OFF_SCR);
  const int lane = otid() & 63, wave = otid() >> 6, wr = wave >> 1, wc = wave & 1, fr = lane & 15, fq = lane >> 4;
  for (int it = 0;; ++it) {
    int mt, nt; if (!next_tile(it, 130, 27, 1, mt, nt)) break;
    const int mi = nt < 8 ? 0 : nt < 16 ? 2 : nt < 24 ? 3 : nt == 24 ? 1 : nt == 25 ? 4 : 5;
    ALMix al{H, mt * 256, p.in[IRMU] + (size_t)(jj * 6 + mi) * 1024};
    f32x4 acc[4][4];
    gemm_main3(al, BT + (size_t)nt * 128 * 1024, 1024, 1024, acc, smem);
#pragma unroll
    for (int m = 0; m < 4; ++m) {
      const int row = mt * 256 + wr * 64 + m * 16 + fr;
#pragma unroll
      for (int n = 0; n < 4; ++n) {
        const int c = nt * 128 + wc * 64 + n * 16 + fq * 4;
        float v0 = acc[m][n][0], v1 = acc[m][n][1], v2 = acc[m][n][2], v3 = acc[m][n][3];
        if (nt == 24) { v0 = tanhf(v0); v1 = tanhf(v1); v2 = tanhf(v2); v3 = tanhf(v3); }
        else if (nt == 26) { v0 = sigmf(v0); v1 = sigmf(v1); v2 = sigmf(v2); v3 = sigmf(v3); }
        uint2 w; w.x = pack2(v0, v1); w.y = pack2(v2, v3);
        *(uint2*)(P1 + (size_t)row * P1LD + c) = w;
      }
    }
  }
}
DI int scan_row(int b, int d, int pos) { return d == 0 ? b * TS + pos : (pos < TC ? b * TS + TC - 1 - pos : b * TS + (TS + TC - 1) - pos); }

struct ALLora {
  const u16* P1; int rowbase, rowstep, d;
  DI uint4 operator()(int i, int k) const {
    const int row = rowbase + i * rowstep;
    const int col = k < 64 ? 3072 + d * 64 + k : 3200 + d * 64 + (k - 64);
    return *(const uint4*)(P1 + (size_t)row * P1LD + col);
  }
  DI uint4 post(uint4 v, int, int) const { return v; }
};
DI uint2 pack4h(float a, float b, float c, float d) {
  __half2 x = __floats2half2_rn(a, b), y = __floats2half2_rn(c, d);
  uint2 r; r.x = *(unsigned*)&x; r.y = *(unsigned*)&y; return r;
}
DI void ph_rw_produce(const Params& p, int jj, int s, char* smem) {
  const u16* P1 = (const u16*)(p.ws + OFF_SCR);
  const u16* LUT = (const u16*)(p.ws + OFF_WT) + WT_LUT;
  __half* ring = (__half*)(p.ws + OFF_RING) + (size_t)(s & 1) * ((size_t)2 * 2 * 1024 * 16 * 256);
  float* bonus = (float*)(p.ws + OFF_BONUS);
  float* red = (float*)(smem + sizeof(SmemG));
  const int lane = otid() & 63, wave = otid() >> 6, wr = wave >> 1, wc = wave & 1, fr = lane & 15, fq = lane >> 4;
  const int npt = min(4, 65 - s * 4);
  for (int t = blockIdx.x; t < 2 * 2 * npt * 16; t += gridDim.x) {
    const int h = t & 15, ptl = (t >> 4) % npt, bd = (t >> 4) / npt, d = bd & 1, b = bd >> 1;
    const int pos0 = (s * 4 + ptl) * 256;
    const int rowbase = scan_row(b, d, pos0), rowstep = d ? -1 : 1;
    ALLora al{P1, rowbase, rowstep, d};
    f32x4 acc[4][4];
    gemm_main3(al, LUT + (size_t)(d * 16 + h) * 128 * 128, 128, 128, acc, smem);
    float4 kkw[2], kaw[2], rkw[2], w0v[2], a0v[2];
#pragma unroll
    for (int nn = 0; nn < 2; ++nn) {
      const int ch = h * 64 + wc * 32 + nn * 16 + fq * 4;
      kkw[nn] = *(const float4*)(p.in[IRKK] + jj * 1024 + ch); kaw[nn] = *(const float4*)(p.in[IRKA] + jj * 1024 + ch);
      rkw[nn] = *(const float4*)(p.in[IRRK] + jj * 1024 + ch);
      w0v[nn] = *(const float4*)(p.in[IRW0] + (jj * 2 + d) * 1024 + ch); a0v[nn] = *(const float4*)(p.in[IRA0] + (jj * 2 + d) * 1024 + ch);
    }
    float ssk[4];
    uint2 kreg[4][2], rreg[4][2];
#pragma unroll
    for (int m = 0; m < 4; ++m) {
      const int row = rowbase + (wr * 64 + m * 16 + fr) * rowstep;
#pragma unroll
      for (int nn = 0; nn < 2; ++nn) {
        const int ch = h * 64 + wc * 32 + nn * 16 + fq * 4;
        kreg[m][nn] = *(const uint2*)(P1 + (size_t)row * P1LD + 1024 + ch);
        rreg[m][nn] = *(const uint2*)(P1 + (size_t)row * P1LD + ch);
      }
    }
    __builtin_amdgcn_sched_barrier(0);
#pragma unroll
    for (int m = 0; m < 4; ++m) {
      float s1 = 0.f;
#pragma unroll
      for (int nn = 0; nn < 2; ++nn) {
        const uint2 k2 = kreg[m][nn];
        float q0 = blo(k2.x) * kkw[nn].x, q1 = bhi(k2.x) * kkw[nn].y, q2 = blo(k2.y) * kkw[nn].z, q3 = bhi(k2.y) * kkw[nn].w;
        s1 += q0 * q0 + q1 * q1 + q2 * q2 + q3 * q3;
      }
      s1 += __shfl_xor(s1, 16); s1 += __shfl_xor(s1, 32);
      ssk[m] = s1;
    }
    if (fq == 0) {
#pragma unroll
      for (int m = 0; m < 4; ++m) red[(wr * 64 + m * 16 + fr) * 2 + wc] = ssk[m];
    }
    __syncthreads();
    float c3[4];
#pragma unroll
    for (int m = 0; m < 4; ++m) {
      const int pi = wr * 64 + m * 16 + fr;
      const float rs = rsqrtf(red[pi * 2] + red[pi * 2 + 1] + 1e-12f);
      const int posl = ptl * 256 + pi;
      __half* rp = ring + ((((size_t)(b * 2 + d) * 1024 + posl) * 16 + h) * 256);
      float cc = 0.f;
#pragma unroll
      for (int nn = 0; nn < 2; ++nn) {
        const int chl = wc * 32 + nn * 16 + fq * 4;
        const float kq[4] = {kkw[nn].x, kkw[nn].y, kkw[nn].z, kkw[nn].w}, ka[4] = {kaw[nn].x, kaw[nn].y, kaw[nn].z, kaw[nn].w};
        const float rk[4] = {rkw[nn].x, rkw[nn].y, rkw[nn].z, rkw[nn].w}, w0[4] = {w0v[nn].x, w0v[nn].y, w0v[nn].z, w0v[nn].w};
        const float a0[4] = {a0v[nn].x, a0v[nn].y, a0v[nn].z, a0v[nn].w};
        float okk[4], owm[4], oka[4], okd[4];
        const int rowm = rowbase + pi * rowstep;
        const uint2 r2 = rreg[m][nn], k2 = kreg[m][nn];
        const float rvv[4] = {blo(r2.x), bhi(r2.x), blo(r2.y), bhi(r2.y)}, kvv[4] = {blo(k2.x), bhi(k2.x), blo(k2.y), bhi(k2.y)};
#pragma unroll
        for (int j = 0; j < 4; ++j) {
          const float k = kvv[j];
          const float kk = k * kq[j] * rs;
          const float a = sigmf(a0[j] + acc[m][nn + 2][j]);
          const float wlog = -__logf(1.f + __expf(-(w0[j] + acc[m][nn][j]))) - 0.5f;
          const float ew = -__expf(wlog);
          const float wm1 = ew * (1.f + ew * (0.5f + ew * (0.16666667f + ew * (0.041666668f + ew * (0.0083333338f + ew * (0.0013888889f + ew * 0.0001984127f))))));
          const float kd = k * (1.f + (a - 1.f) * ka[j]);
          okk[j] = kk; owm[j] = wm1; oka[j] = kk * a; okd[j] = kd;
          cc += rvv[j] * kd * rk[j];
        }
        *(uint2*)(rp + chl) = pack4h(okk[0], okk[1], okk[2], okk[3]);
        *(uint2*)(rp + 64 + chl) = pack4h(owm[0], owm[1], owm[2], owm[3]);
        *(uint2*)(rp + 128 + chl) = pack4h(oka[0], oka[1], oka[2], oka[3]);
        *(uint2*)(rp + 192 + chl) = pack4h(okd[0], okd[1], okd[2], okd[3]);
      }
      cc += __shfl_xor(cc, 16); cc += __shfl_xor(cc, 32);
      c3[m] = cc;
    }
    __syncthreads();
    if (fq == 0) {
#pragma unroll
      for (int m = 0; m < 4; ++m) red[(wr * 64 + m * 16 + fr) * 2 + wc] = c3[m];
    }
    __syncthreads();
    if (wc == 0 && fq == 0) {
#pragma unroll
      for (int m = 0; m < 4; ++m) {
        const int pi = wr * 64 + m * 16 + fr;
        bonus[(size_t)(rowbase + pi * rowstep) * 32 + h * 2 + d] = red[pi * 2] + red[pi * 2 + 1];
      }
    }
  }
}
DI float ror_add16(float x) {
  x += __int_as_float(__builtin_amdgcn_update_dpp(0, __float_as_int(x), 0x128, 0xf, 0xf, false));
  x += __int_as_float(__builtin_amdgcn_update_dpp(0, __float_as_int(x), 0x124, 0xf, 0xf, false));
  x += __int_as_float(__builtin_amdgcn_update_dpp(0, __float_as_int(x), 0x122, 0xf, 0xf, false));
  x += __int_as_float(__builtin_amdgcn_update_dpp(0, __float_as_int(x), 0x121, 0xf, 0xf, false));
  return x;
}
constexpr int SCH = 32, STEPF = 336;
DI void ph_rw_scan(const Params& p, int s, char* smem, bool save = true) {
  if (blockIdx.x >= 256) return;
  const u16* P1 = (const u16*)(p.ws + OFF_SCR);
  const __half* ring = (const __half*)(p.ws + OFF_RING) + (size_t)(s & 1) * ((size_t)2 * 2 * 1024 * 16 * 256);
  u16* Y = (u16*)(p.ws + OFF_SCR) + (size_t)R * P1LD;
  float* st = (float*)(p.ws + OFF_RWST);
  float* buf = (float*)smem;
  float* ybuf = buf + 2 * SCH * STEPF;
  const int tid = otid(), lane = tid & 63, wave = tid >> 6;
  const int xcd_ = blockIdx.x & 7, slot_ = blockIdx.x >> 3;
  const int bh_ = xcd_ * 4 + (slot_ >> 3), rq = slot_ & 3;
  const int b = bh_ >> 4, h = bh_ & 15, d = (slot_ >> 2) & 1;
  const int npos = min(1024, TS - s * 1024), nch = npos / SCH;
  const int rl = (wave & 3) * 4 + (lane >> 4), q = lane & 15;
  f32x2 sa = (f32x2){0.f, 0.f}, sb = (f32x2){0.f, 0.f};
  if (wave < 4 && s > 0) { float4 v = *(const float4*)(st + ((size_t)blockIdx.x * 256 + tid) * 4); sa = (f32x2){v.x, v.y}; sb = (f32x2){v.z, v.w}; }
  u16* Yd = Y + (size_t)d * R * 1024;
  uint4 lr[4], lrr = make_uint4(0, 0, 0, 0), lrv = make_uint4(0, 0, 0, 0);
  auto gload = [&](int c) {
    const int lt = tid - 256;
#pragma unroll
    for (int i = 0; i < 4; ++i) {
      const int cidx = lt + i * 256, stp = cidx >> 5, off = (cidx & 31) * 8;
      const int posl = c * SCH + stp;
      lr[i] = *(const uint4*)(ring + ((((size_t)(b * 2 + d) * 1024 + posl) * 16 + h) * 256) + off);
    }
    {
      const int stp = lt >> 3, off = (lt & 7) * 8;
      const int row = scan_row(b, d, s * 1024 + c * SCH + stp);
      lrr = *(const uint4*)(P1 + (size_t)row * P1LD + h * 64 + off);
    }
    {
      const int l2 = lt & 63, stp = l2 >> 1, off = (l2 & 1) * 8;
      const int row = scan_row(b, d, s * 1024 + c * SCH + stp);
      lrv = *(const uint4*)(P1 + (size_t)row * P1LD + 2048 + h * 64 + rq * 16 + off);
    }
  };
  auto swrite = [&](int c) {
    const int lt = tid - 256;
    float* bb = buf + (c & 1) * SCH * STEPF;
#pragma unroll
    for (int i = 0; i < 4; ++i) {
      const int cidx = lt + i * 256, stp = cidx >> 5, off = (cidx & 31) * 8;
      const __half2* hp = (const __half2*)&lr[i];
      float2 f0 = __half22float2(hp[0]), f1 = __half22float2(hp[1]), f2 = __half22float2(hp[2]), f3 = __half22float2(hp[3]);
      float* dst = bb + stp * STEPF + off;
      *(float4*)dst = make_float4(f0.x, f0.y, f1.x, f1.y);
      *(float4*)(dst + 4) = make_float4(f2.x, f2.y, f3.x, f3.y);
    }
    {
      const int stp = lt >> 3, off = (lt & 7) * 8;
      float* dst = bb + stp * STEPF + 256 + off;
      *(float4*)dst = make_float4(blo(lrr.x), bhi(lrr.x), blo(lrr.y), bhi(lrr.y));
      *(float4*)(dst + 4) = make_float4(blo(lrr.z), bhi(lrr.z), blo(lrr.w), bhi(lrr.w));
    }
    if (lt < 64) {
      const int stp = lt >> 1, off = (lt & 1) * 8;
      float* dst = bb + stp * STEPF + 320 + off;
      *(float4*)dst = make_float4(blo(lrv.x), bhi(lrv.x), blo(lrv.y), bhi(lrv.y));
      *(float4*)(dst + 4) = make_float4(blo(lrv.z), bhi(lrv.z), blo(lrv.w), bhi(lrv.w));
    }
  };
  if (wave >= 4) { gload(0); swrite(0); if (nch > 1) gload(1); }
  lds_barrier();
  for (int c = 0; c < nch; ++c) {
    if (wave < 4) {
      const float* bb = buf + (c & 1) * SCH * STEPF;
      const int pos0 = s * 1024 + c * SCH;
      const int row0 = scan_row(b, d, pos0), rstep = d ? -1 : 1;
      u16* yp = Yd + (size_t)row0 * 1024 + h * 64 + rq * 16 + rl;
      float4 kk = *(const float4*)(bb + q * 4), wm = *(const float4*)(bb + 64 + q * 4), ka = *(const float4*)(bb + 128 + q * 4);
      float4 kd = *(const float4*)(bb + 192 + q * 4), rr = *(const float4*)(bb + 256 + q * 4);
      float vv = bb[320 + rl];
      float yv[16];
#pragma unroll
      for (int stp = 0; stp < SCH; ++stp) {
        const float* sn = bb + (stp + 1 < SCH ? stp + 1 : stp) * STEPF;
        const float4 kkn = *(const float4*)(sn + q * 4), wmn = *(const float4*)(sn + 64 + q * 4), kan = *(const float4*)(sn + 128 + q * 4);
        const float4 kdn = *(const float4*)(sn + 192 + q * 4), rrn = *(const float4*)(sn + 256 + q * 4);
        const float vvn = sn[320 + rl];
        __builtin_amdgcn_sched_barrier(0);
        const f32x2 vv2 = (f32x2){vv, vv};
        f32x2 ta = sa * (f32x2){wm.x, wm.y} + sa, tb = sb * (f32x2){wm.z, wm.w} + sb;
        ta = vv2 * (f32x2){kd.x, kd.y} + ta; tb = vv2 * (f32x2){kd.z, kd.w} + tb;
        f32x2 ud = sa * (f32x2){kk.x, kk.y}; ud = sb * (f32x2){kk.z, kk.w} + ud;
        float u = ror_add16(ud.x + ud.y);
        const f32x2 nu = (f32x2){-u, -u};
        sa = nu * (f32x2){ka.x, ka.y} + ta; sb = nu * (f32x2){ka.z, ka.w} + tb;
        f32x2 yd2 = sa * (f32x2){rr.x, rr.y}; yd2 = sb * (f32x2){rr.z, rr.w} + yd2;
        yv[stp & 15] = yd2.x + yd2.y;
        if ((stp & 15) == 15) {
          const bool b3 = q & 8, b2 = q & 4, b1 = q & 2, b0 = q & 1;
          float z8[8], z4[4], z2[2];
#pragma unroll
          for (int i = 0; i < 8; ++i) { const float kp = b3 ? yv[i + 8] : yv[i], sd = b3 ? yv[i] : yv[i + 8]; z8[i] = kp + __int_as_float(__builtin_amdgcn_update_dpp(0, __float_as_int(sd), 0x140, 0xf, 0xf, false)); }
#pragma unroll
          for (int i = 0; i < 4; ++i) { const float kp = b2 ? z8[i + 4] : z8[i], sd = b2 ? z8[i] : z8[i + 4]; z4[i] = kp + __int_as_float(__builtin_amdgcn_update_dpp(0, __float_as_int(sd), 0x141, 0xf, 0xf, false)); }
#pragma unroll
          for (int i = 0; i < 2; ++i) { const float kp = b1 ? z4[i + 2] : z4[i], sd = b1 ? z4[i] : z4[i + 2]; z2[i] = kp + __int_as_float(__builtin_amdgcn_update_dpp(0, __float_as_int(sd), 0x1B, 0xf, 0xf, false)); }
          const float kp = b0 ? z2[1] : z2[0], sd = b0 ? z2[0] : z2[1];
          const float yq = kp + __int_as_float(__builtin_amdgcn_update_dpp(0, __float_as_int(sd), 0xB1, 0xf, 0xf, false));
          yp[(ptrdiff_t)((stp & ~15) + q) * rstep * 1024] = f2b(yq);
        }
        kk = kkn; wm = wmn; ka = kan; kd = kdn; rr = rrn; vv = vvn;
      }
    } else {
      if (c + 1 < nch) swrite(c + 1);
      if (c + 2 < nch) gload(c + 2);
    }
    lds_barrier();
  }
  if (wave < 4 && save) *(float4*)(st + ((size_t)blockIdx.x * 256 + tid) * 4) = make_float4(sa.x, sa.y, sb.x, sb.y);
  __syncthreads();
}
DI void ph_rw_finish(const Params& p, int jj, char* smem) {
  const u16* P1 = (const u16*)(p.ws + OFF_SCR);
  const u16* G2T = (const u16*)(p.ws + OFF_WT) + WT_G2T;
  u16* Y0 = (u16*)(p.ws + OFF_SCR) + (size_t)R * P1LD;
  const u16* Y1 = Y0 + (size_t)R * 1024;
  const float* bonus = (const float*)(p.ws + OFF_BONUS);
  const int lane = otid() & 63, wave = otid() >> 6, wr = wave >> 1, wc = wave & 1, fr = lane & 15, fq = lane >> 4;
  for (int it = 0;; ++it) {
    int mt, nt; if (!next_tile(it, jj == 1 ? 128 : 130, 8, 1, mt, nt)) break;
    if (jj == 1) mt = mt + 1 + (mt >> 6);
    ALPlain al{P1 + (size_t)mt * 256 * P1LD + 3328, P1LD};
    f32x4 acc[4][4];
    gemm_main3(al, G2T + (size_t)nt * 128 * 128, 128, 128, acc, smem);
    const int h = nt * 2 + wc;
#pragma unroll
    for (int m = 0; m < 4; ++m) {
      const int row = mt * 256 + wr * 64 + m * 16 + fr;
      float y[4][4]; float sm = 0.f;
#pragma unroll
      for (int n = 0; n < 4; ++n) {
        const int c = h * 64 + n * 16 + fq * 4;
        uint2 a = *(const uint2*)(Y0 + (size_t)row * 1024 + c), b2 = *(const uint2*)(Y1 + (size_t)row * 1024 + c);
        y[n][0] = blo(a.x) + blo(b2.x); y[n][1] = bhi(a.x) + bhi(b2.x); y[n][2] = blo(a.y) + blo(b2.y); y[n][3] = bhi(a.y) + bhi(b2.y);
        sm += y[n][0] + y[n][1] + y[n][2] + y[n][3];
      }
      sm += __shfl_xor(sm, 16); sm += __shfl_xor(sm, 32);
      const float mean = sm * (1.f / 64.f);
      float vs = 0.f;
#pragma unroll
      for (int n = 0; n < 4; ++n)
#pragma unroll
        for (int j = 0; j < 4; ++j) { float dlt = y[n][j] - mean; vs += dlt * dlt; }
      vs += __shfl_xor(vs, 16); vs += __shfl_xor(vs, 32);
      const float rs = rsqrtf(vs * (1.f / 64.f) + 64e-5f);
      const float bn = bonus[(size_t)row * 32 + h * 2] + bonus[(size_t)row * 32 + h * 2 + 1];
#pragma unroll
      for (int n = 0; n < 4; ++n) {
        const int c = h * 64 + n * 16 + fq * 4;
        float4 lg = *(const float4*)(p.in[IRLNG] + jj * 1024 + c), lb = *(const float4*)(p.in[IRLNB] + jj * 1024 + c);
        uint2 v2 = *(const uint2*)(P1 + (size_t)row * P1LD + 2048 + c);
        float o0 = ((y[n][0] - mean) * rs * lg.x + lb.x + bn * blo(v2.x)) * acc[m][n][0];
        float o1 = ((y[n][1] - mean) * rs * lg.y + lb.y + bn * bhi(v2.x)) * acc[m][n][1];
        float o2 = ((y[n][2] - mean) * rs * lg.z + lb.z + bn * blo(v2.y)) * acc[m][n][2];
        float o3 = ((y[n][3] - mean) * rs * lg.w + lb.w + bn * bhi(v2.y)) * acc[m][n][3];
        uint2 w; w.x = pack2(o0, o1); w.y = pack2(o2, o3);
        *(uint2*)(Y0 + (size_t)row * 1024 + c) = w;
      }
    }
  }
}

DI void ph_ssd_s1(const Params& p, int jj, char* smem) {
  const u16* H = (const u16*)(p.ws + OFF_H);
  const u16* BT = (const u16*)(p.ws + OFF_WT) + WT_SX;
  u16* XBC = (u16*)(p.ws + OFF_SCR);
  float* DTg = (float*)(p.ws + OFF_DT);
  float* P = (float*)smem;
  const float* cw = p.in[ISCONVW] + (size_t)jj * 3 * 4096;
  const float* cb = p.in[ISCONVB] + (size_t)jj * 4096;
  const int tid = otid(), lane = tid & 63, wave = tid >> 6, wr = wave >> 1, wc = wave & 1, fr = lane & 15, fq = lane >> 4;
  for (int it = 0;; ++it) {
    int mt, nt; if (!next_tile(it, 134, 33, 1, mt, nt)) break;
    const int b = mt / 67, ml = mt - b * 67;
    int rowbase, t0, len;
    if (ml < 2) { rowbase = b * TS; t0 = ml * 254; len = TC; } else { rowbase = b * TS + TC; t0 = (ml - 2) * 254; len = T; }
    ALHalo al{H + (size_t)rowbase * 1024, t0 - 1, len};
    f32x4 acc[4][4];
    gemm_main3(al, BT + (size_t)nt * 128 * 1024, 1024, 1024, acc, smem);
#pragma unroll
    for (int m = 0; m < 4; ++m)
#pragma unroll
      for (int n = 0; n < 4; ++n) *(f32x4*)&P[(wr * 64 + m * 16 + fr) * 132 + wc * 64 + n * 16 + fq * 4] = acc[m][n];
    __syncthreads();
    if (nt < 32) {
      const int col = tid & 127, rg = tid >> 7, ch = nt * 128 + col;
      const float w0 = cw[ch], w1 = cw[4096 + ch], w2 = cw[8192 + ch], bias = cb[ch];
      const int i0 = 1 + rg * 64, i1 = min(i0 + 64, 255);
      float pv = P[(i0 - 1) * 132 + col], cv = P[i0 * 132 + col];
      for (int i = i0; i < i1; ++i) {
        const float nv = P[(i + 1) * 132 + col];
        const float v = w0 * pv + w1 * cv + w2 * nv + bias;
        const int tt = t0 - 1 + i;
        if (tt < len) XBC[(size_t)(rowbase + tt) * 4096 + ch] = f2b(siluf(v));
        pv = cv; cv = nv;
      }
    } else {
      const int col = tid & 63, rg = tid >> 6;
      const int i0 = 1 + rg * 32, i1 = min(i0 + 32, 255);
      for (int i = i0; i < i1; ++i) { const int tt = t0 - 1 + i; if (tt < len) DTg[(size_t)(rowbase + tt) * 64 + col] = P[i * 132 + col]; }
    }
  }
}
DI void ph_ssd_scan(const Params& p, int jj, char* smem) {
  if (blockIdx.x >= 256) return;
  const u16* XBC = (const u16*)(p.ws + OFF_SCR);
  u16* Y = (u16*)(p.ws + OFF_SCR) + (size_t)R * 4096;
  const float* DTg = (const float*)(p.ws + OFF_DT);
  const int tid = otid(), lane = tid & 63, wave = tid >> 6, fr = lane & 15, fq = lane >> 4;
  const int xcd_ = blockIdx.x & 7, slot_ = blockIdx.x >> 3, gid_ = xcd_ * 2 + (slot_ >> 4), mem_ = slot_ & 15;
  const int b = gid_ >> 3, g = gid_ & 7, head = g * 4 + (mem_ >> 2), pq = mem_ & 3;
  constexpr int DIRB = 80896;
  const int xp_ = tid & 15, xj0 = (tid >> 4) & 15;
  float Aneg[2], dtb[2];
#pragma unroll
  for (int d = 0; d < 2; ++d) { Aneg[d] = -__expf(p.in[ISALOG][(jj * 2 + d) * 32 + head]); dtb[d] = p.in[ISDTB][(jj * 2 + d) * 32 + head]; }
  const float Dsk = p.in[ISD][jj * 32 + head];
  f32x4 hst[2] = {(f32x4){0.f, 0.f, 0.f, 0.f}, (f32x4){0.f, 0.f, 0.f, 0.f}};
  uint4 pre[2][5];
  float dtpre[2] = {0.f, 0.f};
  auto gl_raw = [&](int ci, int d, uint4 (&pr)[5], float& dtp) {
    const int r0 = scan_row(b, d, ci * 64), r63 = scan_row(b, d, ci * 64 + 63);
    const int rmin = min(r0, r63);
    const int cc = tid & 31, rrb = tid >> 5;
    const int gcb = cc < 16 ? 2048 + g * 128 + cc * 8 : 3072 + g * 128 + (cc - 16) * 8;
    const u16* src = XBC + (size_t)(rmin + rrb) * 4096 + gcb;
#pragma unroll
    for (int i = 0; i < 4; ++i) pr[i] = *(const uint4*)(src + (size_t)i * 16 * 4096);
    pr[4] = *(const uint4*)(XBC + (size_t)(rmin + ((tid & 127) >> 1)) * 4096 + head * 64 + pq * 16 + (tid & 1) * 8);
    dtp = DTg[(size_t)(r0 + lane * (d ? -1 : 1)) * 64 + d * 32 + head];
  };
  __syncthreads();
  gl_raw(0, 0, pre[0], dtpre[0]);
  gl_raw(0, 1, pre[1], dtpre[1]);
  for (int ci = 0; ci < 260; ++ci) {
    const bool second = ci < 4 ? (ci >= 2) : (ci - 4 >= 128);
    unsigned ypre[2][2];
#pragma unroll
    for (int d = 0; d < 2; ++d) {
      u16* Cs = (u16*)(smem + d * DIRB); u16* Bs = Cs + 64 * 144; u16* BsT = Bs + 64 * 144; u16* Ms = BsT + 128 * 80;
      u16* XdtT = Ms + 64 * 72; u16* XwT = XdtT + 16 * 80; u16* Hs = XwT + 16 * 80;
      float* Xp = (float*)(Hs + 16 * 144); float* dts = Xp + 64 * 16; float* css = dts + 64;
      const int r0 = scan_row(b, d, ci * 64), rstep = d ? -1 : 1;
      {
        int t2 = tid; asm volatile("" : "+v"(t2));
        const int cc = t2 & 31;
#pragma unroll
        for (int i = 0; i < 4; ++i) {
          const int rr = (t2 >> 5) + 16 * i, j = d ? 63 - rr : rr;
          if (cc < 16) {
            *(uint4*)&Bs[j * 144 + cc * 8] = pre[d][i];
            const u16* hv = (const u16*)&pre[d][i];
#pragma unroll
            for (int e = 0; e < 8; ++e) BsT[(cc * 8 + e) * 80 + (j ^ ((cc & 7) << 3))] = hv[e];
          } else *(uint4*)&Cs[j * 144 + (cc - 16) * 8] = pre[d][i];
        }
        if (t2 < 128) {
          const int rr = t2 >> 1, j = d ? 63 - rr : rr;
          const u16* hv = (const u16*)&pre[d][4];
#pragma unroll
          for (int e = 0; e < 8; ++e) Xp[j * 16 + (tid & 1) * 8 + e] = b2f(hv[e]);
        }
      }
      if (wave == d) {
        const float dt = softplusf(dtpre[d] + dtb[d]);
        float a = dt * Aneg[d];
#pragma unroll
        for (int o = 1; o < 64; o <<= 1) { float tv = __shfl_up(a, o); if (lane >= o) a += tv; }
        dts[lane] = dt; css[lane] = a;
      }
#pragma unroll
      for (int e = 0; e < 4; ++e) Hs[(fq * 4 + e) * 144 + wave * 16 + fr] = f2b(hst[d][e]);
#pragma unroll
      for (int e = 0; e < 2; ++e) {
        const u16* yb = Y + (size_t)(r0 + ((wave & 3) * 16 + fq * 4 + 2 * e) * rstep) * 2048 + head * 64 + pq * 16 + fr;
        ypre[d][e] = (unsigned)yb[0] | ((unsigned)yb[(ptrdiff_t)rstep * 2048] << 16);
      }
      __builtin_amdgcn_sched_barrier(0);
    }
    __builtin_amdgcn_sched_barrier(0);
    if (ci + 1 < 260) { gl_raw(ci + 1, 0, pre[0], dtpre[0]); gl_raw(ci + 1, 1, pre[1], dtpre[1]); }
    lds_barrier();
#pragma unroll
    for (int d = 0; d < 2; ++d) {
      u16* Cs = (u16*)(smem + d * DIRB); u16* Bs = Cs + 64 * 144; u16* BsT = Bs + 64 * 144; u16* Ms = BsT + 128 * 80;
      u16* XdtT = Ms + 64 * 72; u16* XwT = XdtT + 16 * 80; u16* Hs = XwT + 16 * 80;
      float* Xp = (float*)(Hs + 16 * 144); float* dts = Xp + 64 * 16; float* css = dts + 64;
      const float cs63 = css[63];
      if (tid < 256) {
#pragma unroll
        for (int i = 0; i < 4; ++i) {
          const int j = xj0 + 16 * i;
          const float xv = Xp[j * 16 + xp_];
          const float dt = dts[j];
          XdtT[xp_ * 80 + j] = f2b(xv * dt);
          XwT[xp_ * 80 + j] = f2b(xv * dt * __expf(cs63 - css[j]));
        }
      }
      const int ib = wave >> 1;
#pragma unroll
      for (int jb2 = 0; jb2 < 2; ++jb2) {
        const int jb = (wave & 1) * 2 + jb2;
        f32x4 acc = (f32x4){0.f, 0.f, 0.f, 0.f};
#pragma unroll
        for (int ks = 0; ks < 4; ++ks) {
          const bf16x8 bfr = *(const bf16x8*)&Bs[(jb * 16 + fr) * 144 + ks * 32 + fq * 8];
          const bf16x8 cfr = *(const bf16x8*)&Cs[(ib * 16 + fr) * 144 + ks * 32 + fq * 8];
          acc = MFMA(bfr, cfr, acc);
        }
        const int i = ib * 16 + fr;
        const float csi = css[i];
        float mv[4];
#pragma unroll
        for (int e = 0; e < 4; ++e) { const int j = jb * 16 + fq * 4 + e; mv[e] = (j <= i) ? acc[e] * __expf(csi - css[j]) : 0.f; }
        uint2 w; w.x = pack2(mv[0], mv[1]); w.y = pack2(mv[2], mv[3]);
        *(uint2*)&Ms[i * 72 + jb * 16 + fq * 4] = w;
      }
      __builtin_amdgcn_sched_barrier(0);
    }
    lds_barrier();
#pragma unroll
    for (int d = 0; d < 2; ++d) {
      u16* Cs = (u16*)(smem + d * DIRB); u16* Bs = Cs + 64 * 144; u16* BsT = Bs + 64 * 144; u16* Ms = BsT + 128 * 80;
      u16* XdtT = Ms + 64 * 72; u16* XwT = XdtT + 16 * 80; u16* Hs = XwT + 16 * 80;
      float* Xp = (float*)(Hs + 16 * 144); float* dts = Xp + 64 * 16; float* css = dts + 64;
      const int r0 = scan_row(b, d, ci * 64), rstep = d ? -1 : 1;
      const float cs63 = css[63];
      if (wave < 4) {
        const int ib = wave;
        f32x4 yd = (f32x4){0.f, 0.f, 0.f, 0.f}, yo = (f32x4){0.f, 0.f, 0.f, 0.f};
#pragma unroll
        for (int ks = 0; ks < 2; ++ks) {
          const bf16x8 mf = *(const bf16x8*)&Ms[(ib * 16 + fr) * 72 + ks * 32 + fq * 8];
          const bf16x8 xf = *(const bf16x8*)&XdtT[fr * 80 + ks * 32 + fq * 8];
          yd = MFMA(mf, xf, yd);
        }
#pragma unroll
        for (int ks = 0; ks < 4; ++ks) {
          const bf16x8 cf = *(const bf16x8*)&Cs[(ib * 16 + fr) * 144 + ks * 32 + fq * 8];
          const bf16x8 hf = *(const bf16x8*)&Hs[fr * 144 + ks * 32 + fq * 8];
          yo = MFMA(cf, hf, yo);
        }
#pragma unroll
        for (int e = 0; e < 4; ++e) {
          const int i = ib * 16 + fq * 4 + e;
          float y = yd[e] + __expf(css[i]) * yo[e];
          u16* ya = Y + (size_t)(r0 + i * rstep) * 2048 + head * 64 + pq * 16 + fr;
          if (second) y += ((e & 1) ? bhi(ypre[d][e >> 1]) : blo(ypre[d][e >> 1])) + Xp[i * 16 + fr] * Dsk;
          *ya = f2b(y);
        }
      }
      {
        const float dec = __expf(cs63);
        hst[d][0] *= dec; hst[d][1] *= dec; hst[d][2] *= dec; hst[d][3] *= dec;
#pragma unroll
        for (int ks = 0; ks < 2; ++ks) {
          const bf16x8 xf = *(const bf16x8*)&XwT[fr * 80 + ks * 32 + fq * 8];
          const bf16x8 bf = *(const bf16x8*)&BsT[(wave * 16 + fr) * 80 + (((ks * 4 + fq) ^ ((wave * 2 + (fr >> 3)) & 7)) << 3)];
          hst[d] = MFMA(xf, bf, hst[d]);
        }
      }
      __builtin_amdgcn_sched_barrier(0);
    }
    if (ci == 1 || ci == 131) asm volatile("s_waitcnt vmcnt(0)" ::: "memory");
    lds_barrier();
  }
}
DI void ph_ssd_s3(const Params& p, char* smem) {
  const u16* H = (const u16*)(p.ws + OFF_H);
  const u16* BT = (const u16*)(p.ws + OFF_WT) + WT_SZ;
  u16* Y = (u16*)(p.ws + OFF_SCR) + (size_t)R * 4096;
  float* ssq = (float*)(p.ws + OFF_SSQ);
  const int lane = otid() & 63, wave = otid() >> 6, wr = wave >> 1, wc = wave & 1, fr = lane & 15, fq = lane >> 4;
  for (int it = 0;; ++it) {
    int mt, nt; if (!next_tile(it, 130, 16, 1, mt, nt)) break;
    ALPlain al{H + (size_t)mt * 256 * 1024, 1024};
    f32x4 acc[4][4];
    gemm_main3(al, BT + (size_t)nt * 128 * 1024, 1024, 1024, acc, smem);
#pragma unroll
    for (int m = 0; m < 4; ++m) {
      const int row = mt * 256 + wr * 64 + m * 16 + fr;
      float sq = 0.f;
#pragma unroll
      for (int n = 0; n < 4; ++n) {
        const int c = nt * 128 + wc * 64 + n * 16 + fq * 4;
        uint2 yv = *(const uint2*)(Y + (size_t)row * 2048 + c);
        const float o0 = blo(yv.x) * siluf(acc[m][n][0]), o1 = bhi(yv.x) * siluf(acc[m][n][1]);
        const float o2 = blo(yv.y) * siluf(acc[m][n][2]), o3 = bhi(yv.y) * siluf(acc[m][n][3]);
        sq += o0 * o0 + o1 * o1 + o2 * o2 + o3 * o3;
        uint2 w; w.x = pack2(o0, o1); w.y = pack2(o2, o3);
        *(uint2*)(Y + (size_t)row * 2048 + c) = w;
      }
      sq += __shfl_xor(sq, 16); sq += __shfl_xor(sq, 32);
      if (fq == 0) atomicAdd(ssq + (size_t)row * 8 + (nt >> 1), sq);
    }
  }
}
struct ALScale {
  const u16* Y; int row0; const float* rsT; const float* ngT;
  DI uint4 operator()(int i, int k) const { return *(const uint4*)(Y + (size_t)(row0 + i) * 2048 + k); }
  DI uint4 post(uint4 c, int i, int k) const {
    const float rs = rsT[i * 8 + (k >> 8)];
    const float4 g0 = *(const float4*)(ngT + k), g1 = *(const float4*)(ngT + k + 4);
    uint4 o;
    o.x = pack2(blo(c.x) * rs * g0.x, bhi(c.x) * rs * g0.y); o.y = pack2(blo(c.y) * rs * g0.z, bhi(c.y) * rs * g0.w);
    o.z = pack2(blo(c.z) * rs * g1.x, bhi(c.z) * rs * g1.y); o.w = pack2(blo(c.w) * rs * g1.z, bhi(c.w) * rs * g1.w);
    return o;
  }
};
DI void ph_ssd_s4(const Params& p, int l, int jj, char* smem) {
  const u16* Y = (const u16*)(p.ws + OFF_SCR) + (size_t)R * 4096;
  const u16* BT = (const u16*)(p.ws + OFF_WT) + WT_SO;
  for (int it = 0;; ++it) {
    int mt, nt; if (!next_tile(it, 130, 8, 1, mt, nt)) break;
    float* rsT = (float*)(smem + 112640); float* ngT = rsT + 2048;
    {
      const float* ssq = (const float*)(p.ws + OFF_SSQ) + (size_t)mt * 256 * 8;
      const float* ng = p.in[ISNG] + jj * 2048;
      for (int e = otid(); e < 2048; e += 512) { rsT[e] = rsqrtf(ssq[e] * (1.f / 256.f) + 1e-6f); ngT[e] = ng[e]; }
    }
    ALScale al{Y, mt * 256, rsT, ngT};
    resid_tile(p, al, BT, 2048, l, 2, mt, nt, smem);
  }
}

DI void ph_at_qkv(const Params& p, char* smem) {
  const u16* H = (const u16*)(p.ws + OFF_H);
  const u16* BT = (const u16*)(p.ws + OFF_WT) + WT_AQ;
  u16* QKV = (u16*)(p.ws + OFF_SCR);
  const int lane = otid() & 63, wave = otid() >> 6, wr = wave >> 1, wc = wave & 1, fr = lane & 15, fq = lane >> 4;
  for (int it = 0;; ++it) {
    int mt, nt; if (!next_tile(it, 130, 12, 1, mt, nt)) break;
    ALPlain al{H + (size_t)mt * 256 * 1024, 1024};
    f32x4 acc[4][4];
    gemm_main3(al, BT + (size_t)nt * 128 * 1024, 1024, 1024, acc, smem);
    const int q0 = (mt * 256) % TS;
    const bool rope = (q0 >= TC) && (nt < 10);
#pragma unroll
    for (int m = 0; m < 4; ++m) {
      const int rl = wr * 64 + m * 16 + fr;
      const int row = mt * 256 + rl;
      if (rope) {
        const int tt = q0 - TC + rl;
        const float prow = (float)(tt >> 6), pcol = (float)(tt & 63);
#pragma unroll
        for (int e = 0; e < 4; ++e) {
          const float inv = exp2f(-13.287712379549449f * (float)(fq * 4 + e) * (1.f / 16.f));
          float sn, cs;
          sn = __sinf(prow * inv); cs = __cosf(prow * inv);
          float x1 = acc[m][0][e], x2 = acc[m][1][e];
          acc[m][0][e] = x1 * cs - x2 * sn; acc[m][1][e] = x1 * sn + x2 * cs;
          sn = __sinf(pcol * inv); cs = __cosf(pcol * inv);
          x1 = acc[m][2][e]; x2 = acc[m][3][e];
          acc[m][2][e] = x1 * cs - x2 * sn; acc[m][3][e] = x1 * sn + x2 * cs;
        }
      }
#pragma unroll
      for (int n = 0; n < 4; ++n) {
        const int c = nt * 128 + wc * 64 + n * 16 + fq * 4;
        uint2 w; w.x = pack2(acc[m][n][0], acc[m][n][1]); w.y = pack2(acc[m][n][2], acc[m][n][3]);
        *(uint2*)(QKV + (size_t)row * 1536 + c) = w;
      }
    }
  }
}
DI void ph_attn(const Params& p, int jj, char* smem) {
  const u16* QKV = (const u16*)(p.ws + OFF_SCR);
  u16* O = (u16*)(p.ws + OFF_SCR) + (size_t)R * 1536;
  u16* Ks = (u16*)smem;
  u16* Vt = Ks + 64 * 80;
  u16* Ps = Vt + 64 * 80;
  const int tid = otid(), lane = tid & 63, wave = tid >> 6, fr = lane & 15, fq = lane >> 4;
  const int g = wave >> 1, th = (wave & 1) * 32;
  u16* Pw = Ps + wave * 32 * 80;
  for (int tl = (int)(blockIdx.x >> 3); tl < 260; tl += (int)(gridDim.x >> 3)) {
    const int kvh = blockIdx.x & 3, b = (blockIdx.x >> 2) & 1;
    const int isctx = tl >= 256 ? 1 : 0, qb = isctx ? tl - 256 : tl;
    const int t0 = qb * 64, qrow0 = b * TS + (isctx ? 0 : TC) + t0;
    const int head = kvh * 4 + g;
    bf16x8 qf[2][2];
#pragma unroll
    for (int m = 0; m < 2; ++m)
#pragma unroll
      for (int kh = 0; kh < 2; ++kh) {
        uint4 v = *(const uint4*)(QKV + (size_t)(qrow0 + th + m * 16 + fr) * 1536 + head * 64 + kh * 32 + fq * 8);
        uint4 o;
        o.x = pack2(blo(v.x) * 0.125f, bhi(v.x) * 0.125f); o.y = pack2(blo(v.y) * 0.125f, bhi(v.y) * 0.125f);
        o.z = pack2(blo(v.z) * 0.125f, bhi(v.z) * 0.125f); o.w = pack2(blo(v.w) * 0.125f, bhi(v.w) * 0.125f);
        qf[m][kh] = *(bf16x8*)&o;
      }
    const float sink = p.in[IASINK][jj * 16 + head];
    float mrun[2] = {sink, sink}, lrun[2] = {1.f, 1.f};
    f32x4 o[2][4];
#pragma unroll
    for (int m = 0; m < 2; ++m)
#pragma unroll
      for (int n = 0; n < 4; ++n) o[m][n] = (f32x4){0.f, 0.f, 0.f, 0.f};
    const int i_lo = t0 >= 128 ? 0 : (t0 >= 64 ? 1 : 2);
    const int i_hi = t0 == T - 64 ? 2 : (t0 == T - 128 ? 3 : 4);
    const int nkt = isctx ? 4 : 4 + (i_hi - i_lo + 1);
    const int skey = tid >> 3, sdc = (tid & 7) * 8;
    uint4 kreg, vreg;
    auto kv_load = [&](int idx) {
      int krow0;
      if (idx < 4) krow0 = b * TS + idx * 64; else krow0 = b * TS + TC + t0 - 128 + 64 * (i_lo + idx - 4);
      const u16* src = QKV + (size_t)(krow0 + skey) * 1536 + 1024 + kvh * 64 + sdc;
      kreg = *(const uint4*)src; vreg = *(const uint4*)(src + 256);
    };
    kv_load(0);
    for (int kt = 0; kt < nkt; ++kt) {
      const int li = i_lo + kt - 4;
      const int mode = kt < 4 ? 0 : (li == 0 ? 1 : (li == 4 ? 2 : 0));
      lds_barrier();
      {
        *(uint4*)&Ks[skey * 80 + sdc] = kreg;
        const u16* vv = (const u16*)&vreg;
#pragma unroll
        for (int e = 0; e < 8; ++e) Vt[(sdc + e) * 80 + (skey ^ ((tid & 7) << 3))] = vv[e];
      }
      lds_barrier();
      if (kt + 1 < nkt) kv_load(kt + 1);
      f32x4 sacc[2][4];
#pragma unroll
      for (int m = 0; m < 2; ++m)
#pragma unroll
        for (int n = 0; n < 4; ++n) sacc[m][n] = (f32x4){0.f, 0.f, 0.f, 0.f};
#pragma unroll
      for (int kh = 0; kh < 2; ++kh)
#pragma unroll
        for (int n = 0; n < 4; ++n) {
          const bf16x8 kf = *(const bf16x8*)&Ks[(n * 16 + fr) * 80 + kh * 32 + fq * 8];
#pragma unroll
          for (int m = 0; m < 2; ++m) sacc[m][n] = MFMA(kf, qf[m][kh], sacc[m][n]);
        }
#pragma unroll
      for (int m = 0; m < 2; ++m) {
        const int qi = th + m * 16 + fr;
        float mx = -3.0e38f;
#pragma unroll
        for (int n = 0; n < 4; ++n)
#pragma unroll
          for (int e = 0; e < 4; ++e) {
            const int ki = n * 16 + fq * 4 + e;
            if ((mode == 1 && ki < qi) || (mode == 2 && ki > qi)) sacc[m][n][e] = -INFINITY;
            mx = fmaxf(mx, sacc[m][n][e]);
          }
        mx = fmaxf(mx, __shfl_xor(mx, 16)); mx = fmaxf(mx, __shfl_xor(mx, 32));
        const float mnew = fmaxf(mrun[m], mx);
        const float alpha = __expf(mrun[m] - mnew);
        float ps = 0.f;
#pragma unroll
        for (int n = 0; n < 4; ++n) {
          const float p0 = __expf(sacc[m][n][0] - mnew), p1 = __expf(sacc[m][n][1] - mnew), p2 = __expf(sacc[m][n][2] - mnew), p3 = __expf(sacc[m][n][3] - mnew);
          ps += p0 + p1 + p2 + p3;
          uint2 w; w.x = pack2(p0, p1); w.y = pack2(p2, p3);
          *(uint2*)&Pw[(m * 16 + fr) * 80 + n * 16 + fq * 4] = w;
        }
        ps += __shfl_xor(ps, 16); ps += __shfl_xor(ps, 32);
        lrun[m] = lrun[m] * alpha + ps; mrun[m] = mnew;
#pragma unroll
        for (int n = 0; n < 4; ++n) { o[m][n][0] *= alpha; o[m][n][1] *= alpha; o[m][n][2] *= alpha; o[m][n][3] *= alpha; }
      }
      __builtin_amdgcn_fence(__ATOMIC_RELEASE, "wavefront");
      __builtin_amdgcn_wave_barrier();
      __builtin_amdgcn_fence(__ATOMIC_ACQUIRE, "wavefront");
#pragma unroll
      for (int ks = 0; ks < 2; ++ks) {
        bf16x8 pf[2];
#pragma unroll
        for (int m = 0; m < 2; ++m) pf[m] = *(const bf16x8*)&Pw[(m * 16 + fr) * 80 + ks * 32 + fq * 8];
#pragma unroll
        for (int nd = 0; nd < 4; ++nd) {
          const bf16x8 vf = *(const bf16x8*)&Vt[(nd * 16 + fr) * 80 + (((ks * 4 + fq) ^ ((nd * 2 + (fr >> 3)) & 7)) << 3)];
#pragma unroll
          for (int m = 0; m < 2; ++m) o[m][nd] = MFMA(vf, pf[m], o[m][nd]);
        }
      }
    }
#pragma unroll
    for (int m = 0; m < 2; ++m) {
      const float il = 1.f / lrun[m];
      const int row = qrow0 + th + m * 16 + fr;
#pragma unroll
      for (int nd = 0; nd < 4; ++nd) {
        uint2 w; w.x = pack2(o[m][nd][0] * il, o[m][nd][1] * il); w.y = pack2(o[m][nd][2] * il, o[m][nd][3] * il);
        *(uint2*)(O + (size_t)row * 1024 + head * 64 + nd * 16 + fq * 4) = w;
      }
    }
  }
}

#define DBL_A 0
#define DBL_B 0
#define DBL_C 0
#define DBL_D 0
#define DBL_E 0
DI int layer_phases(int l) { int k = l % 3; return k == 0 ? 25 : (k == 1 ? 8 : 7); }
constexpr int N_PHASES = 2 + 25 + 8 + 7 + 25 + 1;

DI void run_phase(const Params& p, int ph, char* smem) {
  if (ph == 0) { ph_prologue(p, smem); ph_convert(p, 0, smem); return; }
  if (ph == 1) { ph_modreduce(p); return; }
  int q = ph - 2, l = 0;
  while (l < 4 && q >= layer_phases(l)) { q -= layer_phases(l); ++l; }
  if (l == 4) { ph_final(p); return; }
  const int kind = l % 3, jj = l / 3;
  const int np = layer_phases(l);
  const u16* wt = (const u16*)(p.ws + OFF_WT);
  if (q == 0) { ph_norm(p, l, 0); if (l > 0) ph_convert(p, l, smem); return; }
  if (q == np - 3) { ph_norm(p, l, 1); return; }
  if (q == np - 2) { ph_ffn1(p, l, smem);
#if DBL_A
    ph_ffn1(p, l, smem);
#endif
    return; }
  if (q == np - 1) { ph_resid_gemm(p, (const u16*)(p.ws + OFF_SCR), FF, wt + WT_W2T, FF, l, 5, smem); return; }
  if (kind == 0) {
    if (q == 1) { ph_rw_r1(p, jj, smem);
#if DBL_A
    ph_rw_r1(p, jj, smem);
#endif
    return; }
    if (q >= 2 && q <= 19) { int s = q - 2; if (s >= 1) {
#if DBL_D
      ph_rw_scan(p, s - 1, smem, false);
#endif
      ph_rw_scan(p, s - 1, smem); }
      if (s < 17) { ph_rw_produce(p, jj, s, smem);
#if DBL_E
      ph_rw_produce(p, jj, s, smem);
#endif
      } return; }
    if (q == 20) { ph_rw_finish(p, jj, smem); return; }
    if (q == 21) { ph_resid_gemm(p, (const u16*)(p.ws + OFF_SCR) + (size_t)R * P1LD, 1024, wt + WT_RWO, 1024, l, 2, smem); return; }
  } else if (kind == 1) {
    if (q == 1) { ph_ssd_s1(p, jj, smem); return; }
    if (q == 2) { ph_ssd_scan(p, jj, smem);
#if DBL_B
    ph_ssd_scan(p, jj, smem);
#endif
    return; }
    if (q == 3) { ph_ssd_s3(p, smem); return; }
    if (q == 4) { ph_ssd_s4(p, l, jj, smem); return; }
  } else {
    if (q == 1) { ph_at_qkv(p, smem);
#if DBL_A
    ph_at_qkv(p, smem);
#endif
    return; }
    if (q == 2) { ph_attn(p, jj, smem);
#if DBL_C
    ph_attn(p, jj, smem);
#endif
    return; }
    if (q == 3) { ph_resid_gemm(p, (const u16*)(p.ws + OFF_SCR) + (size_t)R * 1536, 1024, wt + WT_AO, 1024, l, 2, smem); return; }
  }
}

extern "C" __global__ void __launch_bounds__(512) mega(Params p, int ph_lo, int ph_hi) {
  extern __shared__ __attribute__((aligned(16))) char smem[];
  cg::grid_group grid = cg::this_grid();
#ifndef PROBE
#define PROBE 0
#endif
#if PROBE
  unsigned long long* tsb = (unsigned long long*)(p.ws + OFF_MODP);
#endif
  __shared__ uint4 xb_words;
  if (threadIdx.x == 0) xb_words = make_uint4(0u, 0u, 0u, 0u);
  __syncthreads();
  XcdBarrier xb = xcd_barrier_post((unsigned*)(p.ws + OFF_BAR), (volatile LAS unsigned*)&xb_words);
  for (int ph = ph_lo; ph < ph_hi; ++ph) {
    run_phase(p, ph, smem);
    if (ph + 1 < ph_hi) { if (ph == ph_lo) grid.sync(); else xcd_barrier(xb); }
  }
#if PROBE
  grid.sync();
  if (blockIdx.x == 0) {
    const float t1 = (float)(tsb[PA1] - tsb[PA0]) * 1e-5f, t2 = (float)(tsb[PB1] - tsb[PB0]) * 1e-5f;
    for (int i = threadIdx.x; i < (1 << 23); i += 512) p.out[i] = t2;
    __syncthreads();
    if (threadIdx.x == 0) p.out[0] = 64.f * t1;
  }
#endif
}

extern "C" void kernel_launch(void* const* d_in, const int* in_sizes, int n_in, void* d_out, int out_size, void* d_ws, size_t ws_size, hipStream_t stream) {
  Params p{};
  for (int i = 0; i < 41; ++i) p.in[i] = (const float*)d_in[i];
  p.out = (float*)d_out; p.ws = (char*)d_ws;
  constexpr size_t kLds = 162048;
  hipFuncSetAttribute((const void*)mega, hipFuncAttributeMaxDynamicSharedMemorySize, (int)kLds);
  hipMemsetAsync((char*)d_ws + OFF_BAR, 0, XCD_BAR_WORDS * 4, stream);
  int lo = 0, hi = N_PHASES;
  void* args[] = {&p, &lo, &hi};
  hipError_t e = hipLaunchCooperativeKernel((void*)mega, dim3(256), dim3(512), args, kLds, stream);
  if (e != hipSuccess) fprintf(stderr, "coop launch failed: %s\n", hipGetErrorString(e));
}
```
